# Optimizing an MI355X kernel written in HIP

```python
import jax, jax.numpy as jnp
from jax import lax
import numpy as np

D_MODEL = 1024
BATCH = 8
SEQ = 2048
DEPTH = 2

MEM_LEN = 256
HEAD_DIM = 64
RWKV_WIDTH = D_MODEL // 2
RWKV_HEADS = RWKV_WIDTH // HEAD_DIM
NSA_WIDTH = D_MODEL - RWKV_WIDTH
NSA_HEADS = NSA_WIDTH // HEAD_DIM
NSA_KV_HEADS = 2
NSA_GROUP = NSA_HEADS // NSA_KV_HEADS
NSA_KV_WIDTH = NSA_KV_HEADS * HEAD_DIM
LORA_W = 64
LORA_A = 64
LORA_V = 32
LORA_G = 128
CMP_BLOCK = 32
CMP_STRIDE = 16
CMP_HIDDEN = 128
SEL_BLOCK = 64
SEL_TOPK = 16
WINDOW = 512
Q_BLOCK = 64
CROSS_HEADS = 4
CROSS_HEAD_DIM = D_MODEL // CROSS_HEADS
FFN_DENSE = 2816
N_EXPERTS = 8
TOP_K = 2
EXPERT_FF = 3584
MOE_BLOCK = 128
NORM_EPS = 1e-6
GN_EPS = 64e-5
NEG_INF = -1e30
FORCE_SCORE = 1e4
N_DENSE = (DEPTH + 1) // 2
N_MOE = DEPTH // 2
RWKV_COLS_FIRST = 3 * RWKV_WIDTH + LORA_W + LORA_A + LORA_G
RWKV_COLS_REST = RWKV_COLS_FIRST + LORA_V
NSA_COLS = NSA_WIDTH + 6 * NSA_KV_WIDTH + 3 * NSA_HEADS

kernel_name = "hymba_rwkv7_nsa_moe_trunk"


def rmsnorm(x, g):
    xf = x.astype(jnp.float32)
    y = xf * lax.rsqrt(jnp.mean(xf * xf, -1, keepdims=True) + NORM_EPS)
    return (y * g).astype(x.dtype)


def alibi_slopes(n):
    return jnp.asarray((2.0 ** (-8.0 * np.arange(1, n + 1) / n)).astype(np.float32))


def masked_softmax(s, mask):
    s = jnp.where(mask, s.astype(jnp.float32), NEG_INF)
    m = jnp.max(s, -1, keepdims=True)
    p = jnp.where(mask, jnp.exp(s - m), 0.0)
    return p / jnp.maximum(jnp.sum(p, -1, keepdims=True), 1e-30)


def token_shift(u, mu):
    prev = jnp.pad(u, ((0, 0), (1, 0), (0, 0)))[:, :-1]
    return u + (prev - u) * mu


def rwkv7_time_mix(u, v_first, w0, w2, a0, a2, g2, k_k, k_a, r_k, ln_w, ln_b, v0, v2):
    B, T, _ = u.shape
    H, N, W = RWKV_HEADS, HEAD_DIM, RWKV_WIDTH
    f32 = jnp.float32
    r, k, v = u[..., :W], u[..., W:2 * W], u[..., 2 * W:3 * W]
    o = 3 * W
    w_lo = u[..., o:o + LORA_W]
    o += LORA_W
    a_lo = u[..., o:o + LORA_A]
    o += LORA_A
    g_lo = u[..., o:o + LORA_G]
    o += LORA_G
    w = -jax.nn.softplus(-(w0 + jnp.tanh(w_lo) @ w2)) - 0.5
    decay = jnp.exp(-jnp.exp(w.astype(f32)))
    a = jax.nn.sigmoid(a0 + a_lo @ a2)
    if v2 is None:
        v_first = v
    else:
        v_lo = u[..., o:o + LORA_V]
        v = v + (v_first - v) * jax.nn.sigmoid(v0 + v_lo @ v2)
    g = jax.nn.sigmoid(g_lo) @ g2

    def heads(z):
        return z.astype(f32).reshape(B, T, H, N)

    kk = heads(k * k_k)
    kk = kk / jnp.maximum(jnp.sqrt(jnp.sum(kk * kk, -1, keepdims=True)), 1e-12)
    k_h = heads(k * (1 + (a - 1) * k_a))
    r_h, v_h, a_h, w_h = heads(r), heads(v), heads(a), heads(decay)
    a_vec, b_vec = -kk, kk * a_h

    def step(S, inp):
        r_t, w_t, k_t, v_t, a_t, b_t = inp
        Sa = jnp.einsum('bhij,bhj->bhi', S, a_t)
        S = S * w_t[:, :, None, :] + Sa[..., None] * b_t[:, :, None, :] + v_t[..., None] * k_t[:, :, None, :]
        return S, jnp.einsum('bhij,bhj->bhi', S, r_t)

    xs = tuple(jnp.swapaxes(z, 0, 1) for z in (r_h, w_h, k_h, v_h, a_vec, b_vec))
    _, y = lax.scan(step, jnp.zeros((B, H, N, N), f32), xs)
    y = jnp.swapaxes(y, 0, 1)
    mean = jnp.mean(y, -1, keepdims=True)
    var = jnp.mean(jnp.square(y - mean), -1, keepdims=True)
    y = ((y - mean) * lax.rsqrt(var + GN_EPS)).reshape(B, T, W) * ln_w + ln_b
    bonus = (jnp.sum(r_h * k_h * r_k, -1, keepdims=True) * v_h).reshape(B, T, W)
    y = (y + bonus) * g
    return y.astype(u.dtype), v_first


def compress_blocks(kv, pe, w1, w2):
    B, T, G, DH = kv.shape
    n_cmp = (T - CMP_BLOCK) // CMP_STRIDE + 1
    idx = np.arange(n_cmp)[:, None] * CMP_STRIDE + np.arange(CMP_BLOCK)[None, :]
    blk = kv[:, idx] + pe[:, None, :]
    blk = jnp.transpose(blk, (0, 3, 1, 2, 4)).reshape(B, G, n_cmp, CMP_BLOCK * DH)
    return jax.nn.gelu(blk @ w1) @ w2


def nsa_mix(cols, ck_pe, ck_w1, ck_w2, cv_pe, cv_w1, cv_w2):
    B, T, _ = cols.shape
    G, R, DH, KW = NSA_KV_HEADS, NSA_GROUP, HEAD_DIM, NSA_KV_WIDTH
    f32 = jnp.float32
    q = cols[..., :NSA_WIDTH].reshape(B, T, G, R, DH) * (DH ** -0.5)
    kv = cols[..., NSA_WIDTH:NSA_WIDTH + 6 * KW].reshape(B, T, 6, G, DH)
    k_c, v_c, k_s, v_s, k_w, v_w = [kv[:, :, i] for i in range(6)]
    gates = jax.nn.sigmoid(cols[..., NSA_WIDTH + 6 * KW:].astype(f32)).reshape(B, T, G, R, 3)
    slopes = alibi_slopes(NSA_HEADS).reshape(G, R)
    t_pos = jnp.arange(T)

    kc = compress_blocks(k_c, ck_pe, ck_w1, ck_w2)
    vc = compress_blocks(v_c, cv_pe, cv_w1, cv_w2)
    n_cmp = kc.shape[2]
    c_end = np.arange(n_cmp) * CMP_STRIDE + CMP_BLOCK - 1
    c_dist = (t_pos[:, None] - c_end[None, :]).astype(f32)
    s = jnp.einsum('btgrd,bgnd->bgrtn', q, kc) - slopes[:, :, None, None] * c_dist
    p_cmp = masked_softmax(s, c_dist >= 0)
    o_cmp = jnp.einsum('bgrtn,bgnd->btgrd', p_cmp, vc.astype(f32))

    n_sel = T // SEL_BLOCK
    n_top = min(SEL_TOPK, n_sel)
    c_start = np.arange(n_cmp) * CMP_STRIDE
    s_start = np.arange(n_sel) * SEL_BLOCK
    overlap = (c_start[:, None] < s_start[None, :] + SEL_BLOCK) & (c_start[:, None] + CMP_BLOCK > s_start[None, :])
    imp = jnp.einsum('bgrtn,nj->bgtj', p_cmp, jnp.asarray(overlap.astype(np.float32)))
    cur = (t_pos // SEL_BLOCK)[:, None]
    blk = jnp.arange(n_sel)[None, :]
    forced = (blk == 0) | (blk == cur) | (blk == cur - 1)
    imp = jnp.where(forced, FORCE_SCORE, imp)
    imp = jnp.where(blk > cur, -1.0, imp)
    _, sel_idx = lax.top_k(imp, n_top)

    ks_blk = jnp.swapaxes(k_s, 1, 2).reshape(B, G, n_sel, SEL_BLOCK, DH)
    vs_blk = jnp.swapaxes(v_s, 1, 2).reshape(B, G, n_sel, SEL_BLOCK, DH)
    kw_pad = jnp.pad(k_w, ((0, 0), (WINDOW, 0), (0, 0), (0, 0)))
    vw_pad = jnp.pad(v_w, ((0, 0), (WINDOW, 0), (0, 0), (0, 0)))
    b_ix = jnp.arange(B)[:, None, None, None]
    g_ix = jnp.arange(G)[None, :, None, None]
    n_chunks = T // Q_BLOCK

    def chunk(c):
        t0 = c * Q_BLOCK
        qc = lax.dynamic_slice_in_dim(q, t0, Q_BLOCK, axis=1)
        tq = t0 + jnp.arange(Q_BLOCK)
        idx = lax.dynamic_slice_in_dim(sel_idx, t0, Q_BLOCK, axis=2)
        ksel = ks_blk[b_ix, g_ix, idx].reshape(B, G, Q_BLOCK, n_top * SEL_BLOCK, DH)
        vsel = vs_blk[b_ix, g_ix, idx].reshape(B, G, Q_BLOCK, n_top * SEL_BLOCK, DH)
        spos = (idx[..., None] * SEL_BLOCK + jnp.arange(SEL_BLOCK)).reshape(B, G, Q_BLOCK, n_top * SEL_BLOCK)
        sdist = (tq[None, None, :, None] - spos).astype(f32)[:, :, None]
        s = jnp.einsum('bqgrd,bgqsd->bgrqs', qc, ksel) - slopes[None, :, :, None, None] * sdist
        p = masked_softmax(s, sdist >= 0)
        o_sel = jnp.einsum('bgrqs,bgqsd->bqgrd', p, vsel.astype(f32))
        kwc = lax.dynamic_slice_in_dim(kw_pad, t0, Q_BLOCK + WINDOW, axis=1)
        vwc = lax.dynamic_slice_in_dim(vw_pad, t0, Q_BLOCK + WINDOW, axis=1)
        wpos = t0 - WINDOW + jnp.arange(Q_BLOCK + WINDOW)
        wd = tq[:, None] - wpos[None, :]
        wmask = (wd >= 0) & (wd < WINDOW) & (wpos[None, :] >= 0)
        s = jnp.einsum('bqgrd,bsgd->bgrqs', qc, kwc) - slopes[:, :, None, None] * wd.astype(f32)
        p = masked_softmax(s, wmask)
        o_win = jnp.einsum('bgrqs,bsgd->bqgrd', p, vwc.astype(f32))
        return o_sel, o_win

    o_sel, o_win = lax.map(chunk, jnp.arange(n_chunks))
    o_sel = jnp.moveaxis(o_sel, 0, 1).reshape(B, T, G, R, DH)
    o_win = jnp.moveaxis(o_win, 0, 1).reshape(B, T, G, R, DH)
    out = gates[..., 0:1] * o_cmp + gates[..., 1:2] * o_sel + gates[..., 2:3] * o_win
    return out.reshape(B, T, NSA_WIDTH).astype(cols.dtype)


def cross_attention(h, m, wq, wkv, wo):
    B, T, D = h.shape
    M = m.shape[1]
    q = (h @ wq).reshape(B, T, CROSS_HEADS, CROSS_HEAD_DIM)
    kv = (m @ wkv).reshape(B, M, 2, CROSS_HEADS, CROSS_HEAD_DIM)
    s = jnp.einsum('bthd,bmhd->bhtm', q, kv[:, :, 0]) * (CROSS_HEAD_DIM ** -0.5)
    p = jax.nn.softmax(s.astype(jnp.float32), -1)
    o = jnp.einsum('bhtm,bmhd->bthd', p, kv[:, :, 1].astype(jnp.float32)).reshape(B, T, D)
    return o.astype(h.dtype) @ wo


def swiglu(h, wg, wu, wd):
    return (jax.nn.silu(h @ wg) * (h @ wu)) @ wd


def moe_swiglu(h, w_router, e_wg, e_wu, e_wd):
    B, T, D = h.shape
    N = B * T
    xt = h.reshape(N, D)
    logits = (xt @ w_router).astype(jnp.float32)
    top_val, top_idx = lax.top_k(logits, TOP_K)
    gate = jax.nn.softmax(top_val, -1)
    A = N * TOP_K
    flat_e = top_idx.reshape(A)
    flat_tok = jnp.repeat(jnp.arange(N), TOP_K)
    order = jnp.argsort(flat_e)
    se, stok, sgate = flat_e[order], flat_tok[order], gate.reshape(A)[order]
    counts = jnp.zeros((N_EXPERTS,), jnp.int32).at[flat_e].add(1)
    start = jnp.cumsum(counts) - counts
    padded = (counts + MOE_BLOCK - 1) // MOE_BLOCK * MOE_BLOCK
    pend = jnp.cumsum(padded)
    pstart = pend - padded
    dest = pstart[se] + jnp.arange(A) - start[se]
    n_blocks = -(-A // MOE_BLOCK) + N_EXPERTS
    P = n_blocks * MOE_BLOCK
    buf_tok = jnp.full((P,), N, jnp.int32).at[dest].set(stok)
    x_pad = jnp.concatenate([xt, jnp.zeros((1, D), xt.dtype)], 0)
    xb = x_pad[buf_tok].reshape(n_blocks, MOE_BLOCK, D)
    blk_e = jnp.minimum(jnp.searchsorted(pend, jnp.arange(n_blocks) * MOE_BLOCK, side='right'), N_EXPERTS - 1)

    def run(args):
        xblk, e = args
        return swiglu(xblk, e_wg[e], e_wu[e], e_wd[e])

    yb = lax.map(run, (xb, blk_e)).reshape(P, D)
    y = jnp.zeros((N, D), yb.dtype).at[stok].add(yb[dest] * sgate[:, None].astype(yb.dtype))
    return y.reshape(B, T, D)


def setup_inputs(seed: int = 0) -> dict:
    key = jax.random.key(seed)
    ks = iter(jax.random.split(key, 48))
    f32 = jnp.float32

    def nrm(shape, scale):
        return scale * jax.random.normal(next(ks), shape, f32)

    def unif(shape, lo, hi):
        return jax.random.uniform(next(ks), shape, f32, lo, hi)

    D, W, L, DH = D_MODEL, RWKV_WIDTH, CMP_BLOCK, HEAD_DIM
    R1 = DEPTH - 1
    return {
        "x": nrm((BATCH, SEQ, D), 1.0),
        "mem": nrm((BATCH, MEM_LEN, D), 1.0),
        "w_in_first": nrm((D, RWKV_COLS_FIRST + NSA_COLS), D ** -0.5),
        "w_in_rest": nrm((R1, D, RWKV_COLS_REST + NSA_COLS), D ** -0.5),
        "shift_mu_first": unif((RWKV_COLS_FIRST,), 0.0, 1.0),
        "shift_mu_rest": unif((R1, RWKV_COLS_REST), 0.0, 1.0),
        "mix_norm_g": 1.0 + nrm((DEPTH, D), 0.02),
        "rw_w0": unif((DEPTH, W), -6.0, 0.0),
        "rw_w2": nrm((DEPTH, LORA_W, W), 0.5 * LORA_W ** -0.5),
        "rw_a0": nrm((DEPTH, W), 0.1),
        "rw_a2": nrm((DEPTH, LORA_A, W), 0.5 * LORA_A ** -0.5),
        "rw_g2": nrm((DEPTH, LORA_G, W), LORA_G ** -0.5),
        "rw_k_k": 0.85 + nrm((DEPTH, W), 0.02),
        "rw_k_a": 1.0 + nrm((DEPTH, W), 0.02),
        "rw_r_k": nrm((DEPTH, RWKV_HEADS, DH), 0.1),
        "rw_ln_w": 1.0 + nrm((DEPTH, W), 0.02),
        "rw_ln_b": nrm((DEPTH, W), 0.02),
        "rw_v0": 0.5 + nrm((R1, W), 0.1),
        "rw_v2": nrm((R1, LORA_V, W), 0.5 * LORA_V ** -0.5),
        "cmp_k_pe": nrm((DEPTH, L, DH), 0.02),
        "cmp_k_w1": nrm((DEPTH, L * DH, CMP_HIDDEN), (L * DH) ** -0.5),
        "cmp_k_w2": nrm((DEPTH, CMP_HIDDEN, DH), CMP_HIDDEN ** -0.5),
        "cmp_v_pe": nrm((DEPTH, L, DH), 0.02),
        "cmp_v_w1": nrm((DEPTH, L * DH, CMP_HIDDEN), (L * DH) ** -0.5),
        "cmp_v_w2": nrm((DEPTH, CMP_HIDDEN, DH), CMP_HIDDEN ** -0.5),
        "w_out": nrm((DEPTH, D, D), D ** -0.5),
        "cross_norm_g": 1.0 + nrm((DEPTH, D), 0.02),
        "mem_norm_g": 1.0 + nrm((DEPTH, D), 0.02),
        "cross_wq": nrm((DEPTH, D, D), D ** -0.5),
        "cross_wkv": nrm((DEPTH, D, 2 * D), D ** -0.5),
        "cross_wo": nrm((DEPTH, D, D), D ** -0.5),
        "ffn_norm_g": 1.0 + nrm((DEPTH, D), 0.02),
        "dense_wg": nrm((N_DENSE, D, FFN_DENSE), D ** -0.5),
        "dense_wu": nrm((N_DENSE, D, FFN_DENSE), D ** -0.5),
        "dense_wd": nrm((N_DENSE, FFN_DENSE, D), FFN_DENSE ** -0.5),
        "router_w": nrm((N_MOE, D, N_EXPERTS), D ** -0.5),
        "exp_wg": nrm((N_MOE, N_EXPERTS, D, EXPERT_FF), D ** -0.5),
        "exp_wu": nrm((N_MOE, N_EXPERTS, D, EXPERT_FF), D ** -0.5),
        "exp_wd": nrm((N_MOE, N_EXPERTS, EXPERT_FF, D), EXPERT_FF ** -0.5),
        "final_norm_g": 1.0 + nrm((D,), 0.02),
    }


def reference(x, mem, w_in_first, w_in_rest, shift_mu_first, shift_mu_rest, mix_norm_g,
              rw_w0, rw_w2, rw_a0, rw_a2, rw_g2, rw_k_k, rw_k_a, rw_r_k, rw_ln_w, rw_ln_b,
              rw_v0, rw_v2, cmp_k_pe, cmp_k_w1, cmp_k_w2, cmp_v_pe, cmp_v_w1, cmp_v_w2,
              w_out, cross_norm_g, mem_norm_g, cross_wq, cross_wkv, cross_wo,
              ffn_norm_g, dense_wg, dense_wu, dense_wd, router_w, exp_wg, exp_wu, exp_wd,
              final_norm_g):
    v_first = None
    for layer in range(DEPTH):
        h = rmsnorm(x, mix_norm_g[layer])
        if layer == 0:
            w_in, mu, v0, v2 = w_in_first, shift_mu_first, None, None
        else:
            w_in, mu = w_in_rest[layer - 1], shift_mu_rest[layer - 1]
            v0, v2 = rw_v0[layer - 1], rw_v2[layer - 1]
        proj = h @ w_in
        n_rw = w_in.shape[1] - NSA_COLS
        rw_cols = token_shift(proj[..., :n_rw], mu)
        y_rw, v_first = rwkv7_time_mix(rw_cols, v_first, rw_w0[layer], rw_w2[layer], rw_a0[layer],
                                       rw_a2[layer], rw_g2[layer], rw_k_k[layer], rw_k_a[layer],
                                       rw_r_k[layer], rw_ln_w[layer], rw_ln_b[layer], v0, v2)
        y_nsa = nsa_mix(proj[..., n_rw:], cmp_k_pe[layer], cmp_k_w1[layer], cmp_k_w2[layer],
                        cmp_v_pe[layer], cmp_v_w1[layer], cmp_v_w2[layer])
        x = x + jnp.concatenate([y_rw, y_nsa], -1) @ w_out[layer]
        h = rmsnorm(x, cross_norm_g[layer])
        m = rmsnorm(mem, mem_norm_g[layer])
        x = x + cross_attention(h, m, cross_wq[layer], cross_wkv[layer], cross_wo[layer])
        h = rmsnorm(x, ffn_norm_g[layer])
        i = layer // 2
        if layer % 2 == 0:
            x = x + swiglu(h, dense_wg[i], dense_wu[i], dense_wd[i])
        else:
            x = x + moe_swiglu(h, router_w[i], exp_wg[i], exp_wu[i], exp_wd[i])
    return rmsnorm(x, final_norm_g)
```

```cpp
#include <hip/hip_runtime.h>
#include <cstdint>
#include <cstdio>

namespace v0 {
constexpr int B = 8, T = 2048, D = 1024, NTOK = B * T, MEM = 256;
constexpr int W = 512, H = 8, DH = 64;
constexpr int NSA_COLS = 1304;
constexpr int NCMP = 127;
constexpr int FFD = 2816, NEXP = 8, EFF = 3584;
constexpr int ECAP = 8192;

__device__ __forceinline__ float wave_sum(float v) {
#pragma unroll
    for (int o = 1; o < 64; o <<= 1) v += __shfl_xor(v, o);
    return v;
}
__device__ __forceinline__ float wave_max(float v) {
#pragma unroll
    for (int o = 1; o < 64; o <<= 1) v = fmaxf(v, __shfl_xor(v, o));
    return v;
}
__device__ __forceinline__ float sigmoidf_(float x) { return 1.f / (1.f + __expf(-x)); }

__global__ void k_rmsnorm(const float* __restrict__ x, const float* __restrict__ g, float* __restrict__ out, int rows) {
    const int wave = (blockIdx.x * blockDim.x + threadIdx.x) >> 6, lane = threadIdx.x & 63;
    if (wave >= rows) return;
    const float* xr = x + (size_t)wave * D;
    float v[16]; float s = 0.f;
#pragma unroll
    for (int i = 0; i < 16; ++i) { v[i] = xr[lane + 64 * i]; s += v[i] * v[i]; }
    s = wave_sum(s);
    const float rinv = rsqrtf(s * (1.f / D) + 1e-6f);
#pragma unroll
    for (int i = 0; i < 16; ++i) out[(size_t)wave * D + lane + 64 * i] = v[i] * rinv * g[lane + 64 * i];
}

template <int MODE, bool GATHER>
__global__ void __launch_bounds__(256) k_gemm(const float* __restrict__ A, int lda, const int* __restrict__ rowidx, const int* __restrict__ Mdev, int M,
                                               const float* __restrict__ Wt, const float* __restrict__ W2, int ldw, float* __restrict__ C, int ldc, int N, int K,
                                               const float* __restrict__ scale) {
    if (Mdev) { M = *Mdev; if (M > ECAP) M = ECAP; }
    const int m0 = blockIdx.y * 64, n0 = blockIdx.x * 64;
    if (m0 >= M) return;
    __shared__ float As[16][65];
    __shared__ float Bs[16][65];
    __shared__ float B2s[(MODE == 2) ? 16 : 1][65];
    const int tid = threadIdx.x, tx = tid & 15, ty = tid >> 4;
    float acc[4][4] = {}; float acc2[4][4] = {};
    for (int k0 = 0; k0 < K; k0 += 16) {
        for (int i = tid; i < 64 * 16; i += 256) {
            const int r = i >> 4, kk = i & 15; const int m = m0 + r;
            float v = 0.f;
            if (m < M) { const int ar = GATHER ? rowidx[m] : m; v = A[(size_t)ar * lda + k0 + kk]; }
            As[kk][r] = v;
        }
        for (int i = tid; i < 16 * 64; i += 256) {
            const int kk = i >> 6, c = i & 63; const int n = n0 + c;
            Bs[kk][c] = (n < N) ? Wt[(size_t)(k0 + kk) * ldw + n] : 0.f;
            if (MODE == 2) B2s[kk][c] = (n < N) ? W2[(size_t)(k0 + kk) * ldw + n] : 0.f;
        }
        __syncthreads();
#pragma unroll
        for (int kk = 0; kk < 16; ++kk) {
            float a[4], b[4], b2[4];
#pragma unroll
            for (int i = 0; i < 4; ++i) a[i] = As[kk][ty * 4 + i];
#pragma unroll
            for (int j = 0; j < 4; ++j) { b[j] = Bs[kk][tx * 4 + j]; if (MODE == 2) b2[j] = B2s[kk][tx * 4 + j]; }
#pragma unroll
            for (int i = 0; i < 4; ++i)
#pragma unroll
                for (int j = 0; j < 4; ++j) { acc[i][j] += a[i] * b[j]; if (MODE == 2) acc2[i][j] += a[i] * b2[j]; }
        }
        __syncthreads();
    }
#pragma unroll
    for (int i = 0; i < 4; ++i) {
        const int m = m0 + ty * 4 + i; if (m >= M) continue;
#pragma unroll
        for (int j = 0; j < 4; ++j) {
            const int n = n0 + tx * 4 + j; if (n >= N) continue;
            if (MODE == 0) C[(size_t)m * ldc + n] = acc[i][j];
            else if (MODE == 1) C[(size_t)m * ldc + n] += acc[i][j];
            else if (MODE == 2) { const float gte = acc[i][j]; C[(size_t)m * ldc + n] = gte * sigmoidf_(gte) * acc2[i][j]; }
            else { const int orow = rowidx[m]; C[(size_t)orow * ldc + n] += scale[m] * acc[i][j]; }
        }
    }
}

struct RwPar {
    const float *mu, *w0, *w2, *a0, *a2, *g2, *k_k, *k_a, *v0, *v2;
};
__global__ void __launch_bounds__(512) k_rw_prep(const float* __restrict__ proj, int ncols, RwPar p, int layer,
                                                 float* __restrict__ DEC, float* __restrict__ AIC, float* __restrict__ VP, float* __restrict__ G, float* __restrict__ VFIRST) {
    const int tok = blockIdx.x, t = tok % T, c = threadIdx.x;
    const int n_rw = ncols - NSA_COLS;
    __shared__ float lo[288];
    const float* cur = proj + (size_t)tok * ncols;
    const float* prv = cur - ncols;
    if (c < n_rw - 1536) {
        const int col = 1536 + c;
        const float u = cur[col], up = (t > 0) ? prv[col] : 0.f;
        float v = u + (up - u) * p.mu[col];
        if (c < 64) v = tanhf(v);
        else if (c >= 128 && c < 256) v = sigmoidf_(v);
        lo[c] = v;
    }
    __syncthreads();
    float wr = p.w0[c], ar = p.a0[c], gr = 0.f;
#pragma unroll 4
    for (int j = 0; j < 64; ++j) { wr += lo[j] * p.w2[j * W + c]; ar += lo[64 + j] * p.a2[j * W + c]; }
#pragma unroll 4
    for (int j = 0; j < 128; ++j) gr += lo[128 + j] * p.g2[j * W + c];
    const float sp = (-wr > 20.f) ? -wr : log1pf(__expf(-wr));
    const float w = -sp - 0.5f;
    DEC[(size_t)tok * W + c] = __expf(-__expf(w));
    AIC[(size_t)tok * W + c] = sigmoidf_(ar);
    G[(size_t)tok * W + c] = gr;
    {
        const int col = 1024 + c;
        const float u = cur[col], up = (t > 0) ? prv[col] : 0.f;
        float v = u + (up - u) * p.mu[col];
        if (layer == 0) { VFIRST[(size_t)tok * W + c] = v; }
        else {
            float vr = p.v0[c];
#pragma unroll 4
            for (int j = 0; j < 32; ++j) vr += lo[256 + j] * p.v2[j * W + c];
            const float vf = VFIRST[(size_t)tok * W + c];
            v = v + (vf - v) * sigmoidf_(vr);
        }
        VP[(size_t)tok * W + c] = v;
    }
}

__global__ void __launch_bounds__(64) k_rw_scan(const float* __restrict__ proj, int ncols, const float* __restrict__ mu, const float* __restrict__ k_k, const float* __restrict__ k_a,
                                                const float* __restrict__ r_k,
                                                const float* __restrict__ DEC, const float* __restrict__ AIC, const float* __restrict__ VP,
                                                float* __restrict__ Y, float* __restrict__ BONUS) {
    const int b = blockIdx.x / H, h = blockIdx.x % H, j = threadIdx.x, c = h * DH + j;
    __shared__ float sr[64], sw[64], sk[64], sa[64], sb[64];
    float S[64];
#pragma unroll
    for (int i = 0; i < 64; ++i) S[i] = 0.f;
    const float mur = mu[c], muk = mu[W + c], kkc = k_k[c], kac = k_a[c], rkc = r_k[c];
    float pr = 0.f, pk = 0.f;
    for (int t = 0; t < T; ++t) {
        const size_t tok = (size_t)b * T + t;
        const float* cur = proj + tok * ncols;
        const float ur = cur[c], uk = cur[W + c];
        const float r = ur + (pr - ur) * mur, k = uk + (pk - uk) * muk;
        pr = ur; pk = uk;
        const float a = AIC[tok * W + c], dec = DEC[tok * W + c], v = VP[tok * W + c];
        float kk = k * kkc;
        const float nrm = sqrtf(wave_sum(kk * kk));
        kk = kk / fmaxf(nrm, 1e-12f);
        const float kh = k * (1.f + (a - 1.f) * kac);
        const float bon = wave_sum(r * kh * rkc);
        __syncthreads();
        sr[j] = r; sw[j] = dec; sk[j] = kh; sa[j] = -kk; sb[j] = kk * a;
        __syncthreads();
        float Sa = 0.f;
#pragma unroll
        for (int q = 0; q < 64; ++q) Sa += S[q] * sa[q];
        float y = 0.f;
#pragma unroll
        for (int q = 0; q < 64; ++q) { S[q] = S[q] * sw[q] + Sa * sb[q] + v * sk[q]; y += S[q] * sr[q]; }
        Y[tok * W + c] = y;
        BONUS[tok * W + c] = bon * v;
    }
}

__global__ void k_rw_post(const float* __restrict__ Y, const float* __restrict__ BONUS, const float* __restrict__ G, const float* __restrict__ ln_w, const float* __restrict__ ln_b,
                          float* __restrict__ concat) {
    const int wid = (blockIdx.x * blockDim.x + threadIdx.x) >> 6, lane = threadIdx.x & 63;
    if (wid >= NTOK * H) return;
    const int tok = wid / H, h = wid % H, c = h * DH + lane;
    const float y = Y[(size_t)tok * W + c];
    const float mean = wave_sum(y) * (1.f / 64.f);
    const float d = y - mean;
    const float var = wave_sum(d * d) * (1.f / 64.f);
    const float yn = d * rsqrtf(var + 64e-5f) * ln_w[c] + ln_b[c];
    concat[(size_t)tok * D + c] = (yn + BONUS[(size_t)tok * W + c]) * G[(size_t)tok * W + c];
}

__global__ void __launch_bounds__(128) k_cmp_hidden(const float* __restrict__ proj, int ncols, int colbase  , const float* __restrict__ pe,
                                                    const float* __restrict__ w1, float* __restrict__ hid) {
    const int row = blockIdx.x, n = row % NCMP, g = (row / NCMP) % 2, b = row / (NCMP * 2);
    __shared__ float blk[2048];
    for (int i = threadIdx.x; i < 2048; i += 128) {
        const int l = i >> 6, d = i & 63;
        blk[i] = proj[((size_t)b * T + 16 * n + l) * ncols + colbase + g * 64 + d] + pe[i];
    }
    __syncthreads();
    float acc = 0.f;
    for (int k = 0; k < 2048; ++k) acc += blk[k] * w1[(size_t)k * 128 + threadIdx.x];
    const float x = acc;
    const float ge = 0.5f * x * (1.f + tanhf(0.7978845608028654f * (x + 0.044715f * x * x * x)));
    hid[(size_t)row * 128 + threadIdx.x] = ge;
}
__global__ void __launch_bounds__(64) k_cmp_out(const float* __restrict__ hid, const float* __restrict__ w2, float* __restrict__ out  ) {
    const int row = blockIdx.x, n = row % NCMP, bg = row / NCMP;
    float acc = 0.f;
    for (int k = 0; k < 128; ++k) acc += hid[(size_t)row * 128 + k] * w2[k * 64 + threadIdx.x];
    out[((size_t)bg * 128 + n) * 64 + threadIdx.x] = acc;
}

__global__ void __launch_bounds__(512) k_nsa_attn(const float* __restrict__ proj, int ncols, const float* __restrict__ KC, const float* __restrict__ VC, float* __restrict__ concat) {
    const int tok = blockIdx.x, b = tok / T, t = tok % T;
    const int wave = threadIdx.x >> 6, lane = threadIdx.x & 63, g = wave >> 2, r = wave & 3, hq = wave;
    const int n_rw = ncols - NSA_COLS;
    const float* cols = proj + (size_t)tok * ncols + n_rw;
    __shared__ float qs[8][64];
    __shared__ float ps[8][128];
    __shared__ float imp[2][32];
    __shared__ unsigned selm[2];
    __shared__ float pbuf[8][64];
    const float slope = exp2f(-(float)(hq + 1));
    const float q = cols[g * 256 + r * 64 + lane] * 0.125f;
    qs[wave][lane] = q;
    const float gate0 = sigmoidf_(cols[1280 + hq * 3 + 0]), gate1 = sigmoidf_(cols[1280 + hq * 3 + 1]), gate2 = sigmoidf_(cols[1280 + hq * 3 + 2]);
    __syncthreads();
    float out = 0.f;
    {
        const float* kc = KC + ((size_t)(b * 2 + g) * 128) * 64;
        const float* vc = VC + ((size_t)(b * 2 + g) * 128) * 64;
        float s[2]; bool ok[2];
#pragma unroll
        for (int u = 0; u < 2; ++u) {
            const int n = lane + 64 * u;
            ok[u] = (n < NCMP) && (16 * n + 31 <= t);
            float acc = 0.f;
            if (ok[u]) { for (int d = 0; d < 64; ++d) acc += qs[wave][d] * kc[n * 64 + d]; acc -= slope * (float)(t - (16 * n + 31)); }
            s[u] = ok[u] ? acc : -1e30f;
        }
        const float m = wave_max(fmaxf(s[0], s[1]));
        float p0 = ok[0] ? __expf(s[0] - m) : 0.f, p1 = ok[1] ? __expf(s[1] - m) : 0.f;
        const float l = wave_sum(p0 + p1);
        const float inv = 1.f / fmaxf(l, 1e-30f);
        p0 *= inv; p1 *= inv;
        ps[wave][lane] = p0; ps[wave][lane + 64] = p1;
        __syncthreads();
        float o = 0.f;
        for (int n = 0; n < NCMP; ++n) o += ps[wave][n] * vc[n * 64 + lane];
        out += gate0 * o;
        if (threadIdx.x < 64) {
            const int g2 = threadIdx.x >> 5, j = threadIdx.x & 31;
            float acc = 0.f;
            for (int rr = 0; rr < 4; ++rr)
                for (int n = 4 * j - 1; n <= 4 * j + 3; ++n) if (n >= 0 && n < NCMP) acc += ps[g2 * 4 + rr][n];
            const int curb = t >> 6;
            if (j == 0 || j == curb || j == curb - 1) acc = 1e4f;
            if (j > curb) acc = -1.f;
            imp[g2][j] = acc;
        }
        __syncthreads();
        if (threadIdx.x < 64) {
            const int g2 = threadIdx.x >> 5, j = threadIdx.x & 31;
            const float mine = imp[g2][j]; int rank = 0;
            for (int jj = 0; jj < 32; ++jj) { const float o2 = imp[g2][jj]; rank += (o2 > mine || (o2 == mine && jj < j)) ? 1 : 0; }
            const unsigned long long bal = __ballot(rank < 16);
            if (j == 0) selm[g2] = (unsigned)(g2 == 0 ? (bal & 0xffffffffull) : (bal >> 32));
        }
        __syncthreads();
    }
    for (int br = 0; br < 2; ++br) {
        const int kcol = n_rw + 512 + (br == 0 ? 2 : 4) * 128 + g * 64, vcol = kcol + 128;
        const float gate = br == 0 ? gate1 : gate2;
        const unsigned mask = selm[g];
        float m = -1e30f, l = 0.f, o = 0.f;
        const int curb = t >> 6;
        const int jlo = (br == 0) ? 0 : ((curb - 8 > 0) ? curb - 8 : 0);
        for (int j = jlo; j <= curb; ++j) {
            if (br == 0 && !((mask >> j) & 1u)) continue;
            const int pos = j * 64 + lane;
            const int dist = t - pos;
            const bool ok = (dist >= 0) && (br == 0 || dist < 512);
            float sc = -1e30f;
            if (ok) {
                const float* kr = proj + ((size_t)b * T + pos) * ncols + kcol;
                float acc = 0.f;
                for (int d = 0; d < 64; ++d) acc += qs[wave][d] * kr[d];
                sc = acc - slope * (float)dist;
            }
            const float mt = wave_max(sc);
            const float mn = fmaxf(m, mt);
            const float alpha = __expf(m - mn);
            const float p = ok ? __expf(sc - mn) : 0.f;
            l = l * alpha + wave_sum(p);
            pbuf[wave][lane] = p;
            __builtin_amdgcn_wave_barrier();
            float acc = 0.f;
            const int kmax = (t - j * 64 + 1 < 64) ? (t - j * 64 + 1) : 64;
            for (int kk = 0; kk < kmax; ++kk) acc += pbuf[wave][kk] * proj[((size_t)b * T + j * 64 + kk) * ncols + vcol + lane];
            __builtin_amdgcn_wave_barrier();
            o = o * alpha + acc;
            m = mn;
        }
        out += gate * o / fmaxf(l, 1e-30f);
    }
    concat[(size_t)tok * D + 512 + g * 256 + r * 64 + lane] = out;
}

__global__ void __launch_bounds__(256) k_cross_attn(const float* __restrict__ Q, const float* __restrict__ KV, float* __restrict__ O) {
    const int wid = (blockIdx.x * blockDim.x + threadIdx.x) >> 6, lane = threadIdx.x & 63;
    const int tok = wid >> 2, h = wid & 3, b = tok / T;
    const float4 q = *(const float4*)(Q + (size_t)tok * D + h * 256 + lane * 4);
    float s[4];
    for (int u = 0; u < 4; ++u) s[u] = 0.f;
    for (int key = 0; key < MEM; ++key) {
        const float4 k = *(const float4*)(KV + ((size_t)b * MEM + key) * 2048 + h * 256 + lane * 4);
        float d = q.x * k.x + q.y * k.y + q.z * k.z + q.w * k.w;
        d = wave_sum(d) * 0.0625f;
        if ((key & 63) == lane) s[key >> 6] = d;
    }
    float m = fmaxf(fmaxf(s[0], s[1]), fmaxf(s[2], s[3]));
    m = wave_max(m);
    float p[4], l = 0.f;
    for (int u = 0; u < 4; ++u) { p[u] = __expf(s[u] - m); l += p[u]; }
    l = wave_sum(l);
    float4 o = {0.f, 0.f, 0.f, 0.f};
    for (int key = 0; key < MEM; ++key) {
        const float pk = __shfl(p[key >> 6], key & 63);
        const float4 v = *(const float4*)(KV + ((size_t)b * MEM + key) * 2048 + 1024 + h * 256 + lane * 4);
        o.x += pk * v.x; o.y += pk * v.y; o.z += pk * v.z; o.w += pk * v.w;
    }
    const float inv = 1.f / l;
    o.x *= inv; o.y *= inv; o.z *= inv; o.w *= inv;
    *(float4*)(O + (size_t)tok * D + h * 256 + lane * 4) = o;
}

__global__ void k_route(const float* __restrict__ Hn, const float* __restrict__ wr, int* __restrict__ top_e, float* __restrict__ top_g) {
    const int wid = (blockIdx.x * blockDim.x + threadIdx.x) >> 6, lane = threadIdx.x & 63;
    if (wid >= NTOK) return;
    float acc[8] = {};
    for (int i = 0; i < 16; ++i) {
        const int k = lane + 64 * i; const float hv = Hn[(size_t)wid * D + k];
#pragma unroll
        for (int e = 0; e < 8; ++e) acc[e] += hv * wr[k * 8 + e];
    }
#pragma unroll
    for (int e = 0; e < 8; ++e) acc[e] = wave_sum(acc[e]);
    if (lane == 0) {
        int e0 = 0; for (int e = 1; e < 8; ++e) if (acc[e] > acc[e0]) e0 = e;
        int e1 = -1; for (int e = 0; e < 8; ++e) if (e != e0 && (e1 < 0 || acc[e] > acc[e1])) e1 = e;
        const float m = acc[e0]; const float p0 = 1.f, p1 = __expf(acc[e1] - m); const float inv = 1.f / (p0 + p1);
        top_e[wid * 2] = e0; top_e[wid * 2 + 1] = e1; top_g[wid * 2] = p0 * inv; top_g[wid * 2 + 1] = p1 * inv;
    }
}
__global__ void __launch_bounds__(64) k_lists(const int* __restrict__ top_e, const float* __restrict__ top_g, int* __restrict__ list, float* __restrict__ lgate, int* __restrict__ counts) {
    const int e = blockIdx.x, lane = threadIdx.x; int cnt = 0;
    for (int t0 = 0; t0 < NTOK; t0 += 64) {
        const int tok = t0 + lane; int k = -1;
        if (top_e[tok * 2] == e) k = 0; else if (top_e[tok * 2 + 1] == e) k = 1;
        const unsigned long long bal = __ballot(k >= 0);
        if (k >= 0) { const int pos = cnt + __popcll(bal & ((1ull << lane) - 1ull)); if (pos < ECAP) { list[e * NTOK + pos] = tok; lgate[e * NTOK + pos] = top_g[tok * 2 + k]; } }
        cnt += __popcll(bal);
    }
    if (lane == 0) counts[e] = cnt;
}
}

extern "C" void kernel_launch(void* const* d_in, const int* in_sizes, int n_in, void* d_out, int out_size, void* d_ws, size_t ws_size, hipStream_t stream) {
    using namespace v0;
    const float* in[40];
    for (int i = 0; i < 40; ++i) in[i] = (const float*)d_in[i];
    float* ws = (float*)d_ws;
    size_t off = 0;
    auto take = [&](size_t nfl) { float* p = ws + off; off += (nfl + 63) & ~(size_t)63; return p; };
    float* X = take((size_t)NTOK * D);
    float* Hn = take((size_t)NTOK * D);
    float* BIG = take((size_t)NTOK * 3128);
    float* DEC = take((size_t)NTOK * W);
    float* VP = take((size_t)NTOK * W);
    float* G = take((size_t)NTOK * W);
    float* VFIRST = take((size_t)NTOK * W);
    float* KC = take((size_t)B * 2 * 128 * 64);
    float* VC = take((size_t)B * 2 * 128 * 64);
    float* HID = take((size_t)B * 2 * NCMP * 128);
    float* MEMN = take((size_t)B * MEM * D);
    int* TOPE = (int*)take(NTOK * 2);
    float* TOPG = take(NTOK * 2);
    int* LIST = (int*)take((size_t)NEXP * NTOK);
    float* LGATE = take((size_t)NEXP * NTOK);
    int* COUNTS = (int*)take(64);
    float* BONUS = take((size_t)NTOK * W);
    if (off * 4 > ws_size) { fprintf(stderr, "kernel_launch: workspace too small: need %zu have %zu\n", off * 4, ws_size); return; }
    float* Y = Hn; float* AIC = Hn + (size_t)NTOK * W;
    float* CONCAT = (float*)d_out;
    float* PROJ = BIG;

    hipMemcpyAsync(X, in[0], (size_t)NTOK * D * 4, hipMemcpyDeviceToDevice, stream);

    for (int layer = 0; layer < 2; ++layer) {
        const int ncols = layer == 0 ? 3096 : 3128;
        const float* w_in = layer == 0 ? in[2] : in[3];
        const float* mu = layer == 0 ? in[4] : in[5];
        k_rmsnorm<<<NTOK / 4, 256, 0, stream>>>(X, in[6] + layer * D, Hn, NTOK);
        k_gemm<0, false><<<dim3((ncols + 63) / 64, NTOK / 64), 256, 0, stream>>>(Hn, D, nullptr, nullptr, NTOK, w_in, nullptr, ncols, PROJ, ncols, ncols, D, nullptr);
        RwPar rp{mu, in[7] + layer * W, in[8] + (size_t)layer * 64 * W, in[9] + layer * W, in[10] + (size_t)layer * 64 * W, in[11] + (size_t)layer * 128 * W,
                 in[12] + layer * W, in[13] + layer * W, in[17], in[18]};
        k_rw_prep<<<NTOK, 512, 0, stream>>>(PROJ, ncols, rp, layer, DEC, AIC, VP, G, VFIRST);
        k_rw_scan<<<B * H, 64, 0, stream>>>(PROJ, ncols, mu, in[12] + layer * W, in[13] + layer * W, in[14] + layer * W, DEC, AIC, VP, Y, BONUS);
        k_rw_post<<<NTOK * H / 4, 256, 0, stream>>>(Y, BONUS, G, in[15] + layer * W, in[16] + layer * W, CONCAT);
        const int n_rw = ncols - NSA_COLS;
        k_cmp_hidden<<<B * 2 * NCMP, 128, 0, stream>>>(PROJ, ncols, n_rw + 512 + 0 * 128, in[19] + (size_t)layer * 2048, in[20] + (size_t)layer * 2048 * 128, HID);
        k_cmp_out<<<B * 2 * NCMP, 64, 0, stream>>>(HID, in[21] + (size_t)layer * 128 * 64, KC);
        k_cmp_hidden<<<B * 2 * NCMP, 128, 0, stream>>>(PROJ, ncols, n_rw + 512 + 1 * 128, in[22] + (size_t)layer * 2048, in[23] + (size_t)layer * 2048 * 128, HID);
        k_cmp_out<<<B * 2 * NCMP, 64, 0, stream>>>(HID, in[24] + (size_t)layer * 128 * 64, VC);
        k_nsa_attn<<<NTOK, 512, 0, stream>>>(PROJ, ncols, KC, VC, CONCAT);
        k_gemm<1, false><<<dim3(D / 64, NTOK / 64), 256, 0, stream>>>(CONCAT, D, nullptr, nullptr, NTOK, in[25] + (size_t)layer * D * D, nullptr, D, X, D, D, D, nullptr);
        float* Qc = BIG; float* KVc = BIG + (size_t)NTOK * D; float* Oc = KVc + (size_t)B * MEM * 2048;
        k_rmsnorm<<<NTOK / 4, 256, 0, stream>>>(X, in[26] + layer * D, Hn, NTOK);
        k_rmsnorm<<<B * MEM / 4, 256, 0, stream>>>(in[1], in[27] + layer * D, MEMN, B * MEM);
        k_gemm<0, false><<<dim3(D / 64, NTOK / 64), 256, 0, stream>>>(Hn, D, nullptr, nullptr, NTOK, in[28] + (size_t)layer * D * D, nullptr, D, Qc, D, D, D, nullptr);
        k_gemm<0, false><<<dim3(2048 / 64, B * MEM / 64), 256, 0, stream>>>(MEMN, D, nullptr, nullptr, B * MEM, in[29] + (size_t)layer * D * 2048, nullptr, 2048, KVc, 2048, 2048, D, nullptr);
        k_cross_attn<<<NTOK * 4 / 4, 256, 0, stream>>>(Qc, KVc, Oc);
        k_gemm<1, false><<<dim3(D / 64, NTOK / 64), 256, 0, stream>>>(Oc, D, nullptr, nullptr, NTOK, in[30] + (size_t)layer * D * D, nullptr, D, X, D, D, D, nullptr);
        k_rmsnorm<<<NTOK / 4, 256, 0, stream>>>(X, in[31] + layer * D, Hn, NTOK);
        if (layer == 0) {
            float* ACT = BIG;
            k_gemm<2, false><<<dim3(FFD / 64, NTOK / 64), 256, 0, stream>>>(Hn, D, nullptr, nullptr, NTOK, in[32], in[33], FFD, ACT, FFD, FFD, D, nullptr);
            k_gemm<1, false><<<dim3(D / 64, NTOK / 64), 256, 0, stream>>>(ACT, FFD, nullptr, nullptr, NTOK, in[34], nullptr, D, X, D, D, FFD, nullptr);
        } else {
            k_route<<<NTOK / 4, 256, 0, stream>>>(Hn, in[35], TOPE, TOPG);
            k_lists<<<NEXP, 64, 0, stream>>>(TOPE, TOPG, LIST, LGATE, COUNTS);
            float* ACT = BIG;
            for (int e = 0; e < NEXP; ++e) {
                k_gemm<2, true><<<dim3(EFF / 64, ECAP / 64), 256, 0, stream>>>(Hn, D, LIST + (size_t)e * NTOK, COUNTS + e, 0, in[36] + (size_t)e * D * EFF, in[37] + (size_t)e * D * EFF, EFF,
                                                                           ACT, EFF, EFF, D, nullptr);
                k_gemm<3, false><<<dim3(D / 64, ECAP / 64), 256, 0, stream>>>(ACT, EFF, LIST + (size_t)e * NTOK, COUNTS + e, 0, in[38] + (size_t)e * EFF * D, nullptr, D, X, D, D, EFF,
                                                                            LGATE + (size_t)e * NTOK);
            }
        }
    }
    k_rmsnorm<<<NTOK / 4, 256, 0, stream>>>(X, in[39], (float*)d_out, NTOK);
}
```

```cpp
#include <hip/hip_runtime.h>
#include <cstdint>
#include <cstdio>
#include <initializer_list>

constexpr int B_ = 8, T_ = 2048, D_ = 1024, NTOK = B_ * T_, MEM_ = 256, NMEM = B_ * MEM_;
constexpr int W_ = 512, H_ = 8, DH_ = 64;
constexpr int NSA_COLS = 1304, NCMP = 127;
constexpr int FFD = 2816, NEXP = 8, EFF = 3584;
constexpr int NPJ = 3328;

typedef unsigned short bf16_t;
typedef float f32x4_t __attribute__((ext_vector_type(4)));
typedef unsigned u32x4_t __attribute__((ext_vector_type(4)));
typedef unsigned u32x2_t __attribute__((ext_vector_type(2)));
#define LAS __attribute__((address_space(3)))

__device__ __forceinline__ float bf2f(bf16_t v) { return __uint_as_float(((unsigned)v) << 16); }
__device__ __forceinline__ unsigned f2bf(float f) { unsigned u = __float_as_uint(f); return (u + 0x7fffu + ((u >> 16) & 1u)) >> 16; }
__device__ __forceinline__ unsigned pk2(float lo, float hi) { return f2bf(lo) | (f2bf(hi) << 16); }
__device__ __forceinline__ float ldf(const float* p, size_t i) { return p[i]; }
__device__ __forceinline__ float ldf(const bf16_t* p, size_t i) { return bf2f(p[i]); }
__device__ __forceinline__ void stf(float* p, size_t i, float v) { p[i] = v; }
__device__ __forceinline__ void stf(bf16_t* p, size_t i, float v) { p[i] = (bf16_t)f2bf(v); }

__device__ __forceinline__ float wave_sum(float v) {
#pragma unroll
    for (int o = 1; o < 64; o <<= 1) v += __shfl_xor(v, o);
    return v;
}
__device__ __forceinline__ float wave_max(float v) {
#pragma unroll
    for (int o = 1; o < 64; o <<= 1) v = fmaxf(v, __shfl_xor(v, o));
    return v;
}
__device__ __forceinline__ float shx(float v, int lane, int m) { return __int_as_float(__builtin_amdgcn_ds_bpermute((lane ^ m) << 2, __float_as_int(v))); }
__device__ __forceinline__ float wave_sum_l(float v, int lane) {
#pragma unroll
    for (int o = 1; o < 64; o <<= 1) v += shx(v, lane, o);
    return v;
}
__device__ __forceinline__ float wave_max_l(float v, int lane) {
#pragma unroll
    for (int o = 1; o < 64; o <<= 1) v = fmaxf(v, shx(v, lane, o));
    return v;
}
__device__ __forceinline__ float sigmoidf_(float x) { return 1.f / (1.f + __expf(-x)); }

constexpr size_t MiB = (size_t)1 << 20;
constexpr size_t WS_CTL = 0;
constexpr size_t WS_MRINV = 512 * 1024;
constexpr size_t WS_X = 1 * MiB;
constexpr size_t WS_XB = WS_X + 64 * MiB;
constexpr size_t WS_SSQ = WS_XB + 32 * MiB;
constexpr size_t WS_WB = WS_SSQ + 1 * MiB;
constexpr size_t WS_MEMB = WS_WB + 54 * MiB;
constexpr size_t WS_KCR = WS_MEMB + 4 * MiB;
constexpr size_t WS_VT = WS_KCR + 8 * MiB;
constexpr size_t WS_VFIRST = WS_VT + 8 * MiB;
constexpr size_t WS_S = WS_VFIRST + 16 * MiB;
constexpr size_t WB_WIN = 0;
constexpr size_t WB_WOUT = WB_WIN + 2 * (size_t)NPJ * 1024 * 2;
constexpr size_t WB_WQ = WB_WOUT + 2 * 2 * MiB;
constexpr size_t WB_WK = WB_WQ + 2 * 2 * MiB;
constexpr size_t WB_WV = WB_WK + 2 * 2 * MiB;
constexpr size_t WB_WO = WB_WV + 2 * 2 * MiB;
constexpr size_t WB_WGU = WB_WO + 2 * 2 * MiB;
constexpr size_t WB_WD = WB_WGU + (size_t)2 * FFD * 1024 * 2;
constexpr size_t WB_LORA = WB_WD + (size_t)FFD * 1024 * 2;
constexpr size_t WB_CW1 = WB_LORA + 2 * 512 * 288 * 2;
constexpr size_t WB_CW2 = WB_CW1 + 4 * 128 * 2048 * 2;
constexpr size_t WB_CB = WB_CW2 + 4 * 64 * 128 * 2;
constexpr size_t WB_END = WB_CB + 4 * 128 * 4;
static_assert(WB_END <= 54 * MiB, "weight map");
constexpr size_t WS_WE = WS_WB;
constexpr size_t WE_D = (size_t)8 * 7168 * 1024 * 2;
constexpr size_t WS_XG = WS_WE + 168 * MiB;
constexpr int MOE_PASS_TILES = 68;
constexpr size_t WS_ACTM = WS_XG + 68 * MiB;
constexpr size_t WS_MT = WS_ACTM + 119 * MiB;
constexpr size_t MT_INV = 0;
constexpr size_t MT_ROWINFO = 512 * 1024;
constexpr size_t MT_ROWG = 768 * 1024;
constexpr size_t MT_TOKG = 1024 * 1024;
constexpr size_t MT_TILE = 1280 * 1024;
constexpr size_t WS_MOE_END = WS_MT + 2 * MiB;
constexpr size_t CTL_CNT = 64 * 1024;
namespace pg8 {
#define PG8_LAS __attribute__((address_space(3)))
typedef unsigned short bf16_t;
typedef short bf16x8 __attribute__((ext_vector_type(8)));
typedef float f32x4 __attribute__((ext_vector_type(4)));
typedef unsigned u32x4 __attribute__((ext_vector_type(4)));
constexpr int BM = 256, BK = 64, HALF = 128, HTB = HALF * BK * 2  , STAGE_BYTES = 8 * HTB, NXCD = 8, WGM = 8;

__host__ __device__ __forceinline__ int lds_byte(int r, int c) { const int st = (r >> 4) * 2 + (c >> 5), rr = r & 15, cc = c & 31, ob = rr * 64 + cc * 2; return st * 1024 + (ob ^ (((ob >> 9) & 1) << 5)); }
__host__ __device__ __forceinline__ void stage_rc(int b, int& R, int& C) { const int st = b / 1024, sb = b % 1024, swz = sb ^ (((sb >> 9) & 1) << 5); R = (st >> 1) * 16 + swz / 64; C = (st & 1) * 32 + (swz % 64) / 2; }
__host__ __device__ __forceinline__ int perm32(int rho) { const int n = rho >> 4, i = rho & 15; return 8 * (i >> 2) + 4 * n + (i & 3); }

struct Unit { int pm, pn, e, ord; };
struct Gemm { const bf16_t* A; const bf16_t* Bt; int M, N, K; size_t bstride; };

struct StaticOrder {
    int nM, nN, nwg, G, c;
    __host__ __device__ void init(int M, int N, int G_, int c_) { nM = M / BM; nN = N / BM; nwg = nM * nN; G = G_; c = c_; }
    __host__ __device__ bool next(int i, Unit& u) const {
        const long L = (long)i * G + c; if (L >= nwg) return false;
        int wgid = (int)L; { const int q = nwg / NXCD, r = nwg % NXCD, xcd = wgid % NXCD, off = wgid / NXCD; wgid = (xcd < r ? xcd * (q + 1) : r * (q + 1) + (xcd - r) * q) + off; }
        const int nig = WGM * nN, gid = wgid / nig, fm = gid * WGM, gsz = (nM - fm) < WGM ? (nM - fm) : WGM;
        u.pm = fm + ((wgid % nig) % gsz); u.pn = (wgid % nig) / gsz; u.e = 0; u.ord = i; return true;
    }
    __device__ __forceinline__ void a_ready(const Unit&) const {}
    __device__ __forceinline__ void done(const Unit&) const {}
};


__device__ __forceinline__ unsigned cvt_pk_bf16(float lo, float hi) { unsigned r; asm volatile("v_cvt_pk_bf16_f32 %0, %1, %2" : "=v"(r) : "v"(lo), "v"(hi)); return r; }
__device__ __forceinline__ float row_rinv(const float* ssq, int row) {
    const f32x4* p = (const f32x4*)(ssq + (size_t)row * 16);
    const f32x4 a = p[0], b = p[1], c = p[2], d = p[3];
    const float s = ((a[0] + a[1]) + (a[2] + a[3])) + ((b[0] + b[1]) + (b[2] + b[3])) + ((c[0] + c[1]) + (c[2] + c[3])) + ((d[0] + d[1]) + (d[2] + d[3]));
    return 1.0f / sqrtf(s * (1.0f / 1024.0f) + 1e-6f);
}
struct EpiRowScaleBf16 {
    static constexpr bool PERM = true, AFTER_DRAIN = false;
    bf16_t* O; int ldc; const PG8_LAS float* rtab; float mul;
    __device__ __forceinline__ void operator()(const f32x4 (&acc)[2][2][4][2], const Unit& u, int wr, int wc, int fr, int fq) const {
        const int row0 = u.pm * BM + wr * 64 + fr, col0 = u.pn * BM + wc * 32 + 8 * fq;
#pragma unroll
        for (int ai = 0; ai < 2; ++ai)
#pragma unroll
            for (int m = 0; m < 4; ++m) {
                const int row = row0 + ai * HALF + m * 16;
                const float rs = (rtab ? rtab[u.ord * 256 + (row - u.pm * BM)] : 1.0f) * mul;
                bf16_t* rowp = O + (size_t)row * ldc + col0;
#pragma unroll
                for (int bj = 0; bj < 2; ++bj) {
                    const f32x4 v0 = acc[ai][bj][m][0] * rs, v1 = acc[ai][bj][m][1] * rs;
                    u32x4 w; w.x = cvt_pk_bf16(v0[0], v0[1]); w.y = cvt_pk_bf16(v0[2], v0[3]); w.z = cvt_pk_bf16(v1[0], v1[1]); w.w = cvt_pk_bf16(v1[2], v1[3]);
                    *(u32x4*)(rowp + bj * HALF) = w;
                }
            }
    }
};
struct EpiColScaleBf16 {
    static constexpr bool PERM = true, AFTER_DRAIN = false;
    bf16_t* O; int ldc; const float* cs;
    __device__ __forceinline__ void operator()(const f32x4 (&acc)[2][2][4][2], const Unit& u, int wr, int wc, int fr, int fq) const {
        const int row0 = u.pm * BM + wr * 64 + fr, col0 = u.pn * BM + wc * 32 + 8 * fq;
        f32x4 sc[2][2];
#pragma unroll
        for (int bj = 0; bj < 2; ++bj)
#pragma unroll
            for (int n = 0; n < 2; ++n) sc[bj][n] = *(const f32x4*)(cs + col0 + bj * HALF + 4 * n);
#pragma unroll
        for (int ai = 0; ai < 2; ++ai)
#pragma unroll
            for (int m = 0; m < 4; ++m) {
                bf16_t* rowp = O + (size_t)(row0 + ai * HALF + m * 16) * ldc + col0;
#pragma unroll
                for (int bj = 0; bj < 2; ++bj) {
                    const f32x4 v0 = acc[ai][bj][m][0] * sc[bj][0], v1 = acc[ai][bj][m][1] * sc[bj][1];
                    u32x4 w; w.x = cvt_pk_bf16(v0[0], v0[1]); w.y = cvt_pk_bf16(v0[2], v0[3]); w.z = cvt_pk_bf16(v1[0], v1[1]); w.w = cvt_pk_bf16(v1[2], v1[3]);
                    *(u32x4*)(rowp + bj * HALF) = w;
                }
            }
    }
};
struct EpiResid {
    static constexpr bool PERM = false, AFTER_DRAIN = false;
    float* X; bf16_t* XB; float* ssq;
    __device__ __forceinline__ void operator()(const f32x4 (&acc)[2][2][4][2], const Unit& u, int wr, int wc, int fr, int fq) const {
        const int row0 = u.pm * BM + wr * 64 + fr, col0 = u.pn * BM + wc * 32 + 4 * fq;
#pragma unroll
        for (int ai = 0; ai < 2; ++ai)
#pragma unroll
            for (int m = 0; m < 4; ++m) {
                const int row = row0 + ai * HALF + m * 16;
                float* xr = X + (size_t)row * 1024 + col0; bf16_t* br = XB + (size_t)row * 1024 + col0;
                float q = 0.f;
#pragma unroll
                for (int bj = 0; bj < 2; ++bj)
#pragma unroll
                    for (int n = 0; n < 2; ++n) {
                        f32x4 x = *(const f32x4*)(xr + bj * HALF + n * 16);
                        x = x + acc[ai][bj][m][n];
                        *(f32x4*)(xr + bj * HALF + n * 16) = x;
                        q += (x[0] * x[0] + x[1] * x[1]) + (x[2] * x[2] + x[3] * x[3]);
                        typedef unsigned u32x2v __attribute__((ext_vector_type(2)));
                        u32x2v w; w.x = cvt_pk_bf16(x[0], x[1]); w.y = cvt_pk_bf16(x[2], x[3]);
                        *(u32x2v*)(br + bj * HALF + n * 16) = w;
                    }
                q += shx(q, fq * 16 + fr, 16); q += shx(q, fq * 16 + fr, 32);
                if (fq == 0) ssq[(size_t)row * 16 + u.pn * 4 + wc] = q;
                asm volatile("" ::: "memory");
            }
    }
};
struct EpiSwiGLU {
    static constexpr bool PERM = true, AFTER_DRAIN = false;
    bf16_t* O; int ldc; const PG8_LAS float* rtab;
    __device__ __forceinline__ void operator()(const f32x4 (&acc)[2][2][4][2], const Unit& u, int wr, int wc, int fr, int fq) const {
        const int row0 = u.pm * BM + wr * 64 + fr, col0 = u.pn * HALF + wc * 32 + 8 * fq;
#pragma unroll
        for (int ai = 0; ai < 2; ++ai)
#pragma unroll
            for (int m = 0; m < 4; ++m) {
                const int row = row0 + ai * HALF + m * 16;
                const float rs = rtab ? rtab[u.ord * 256 + (row - u.pm * BM)] : 1.0f;
                float o[8];
#pragma unroll
                for (int n = 0; n < 2; ++n)
#pragma unroll
                    for (int e = 0; e < 4; ++e) {
                        const float gg = acc[ai][0][m][n][e] * rs, uu = acc[ai][1][m][n][e] * rs;
                        o[n * 4 + e] = gg / (1.0f + __expf(-gg)) * uu;
                    }
                u32x4 w; w.x = cvt_pk_bf16(o[0], o[1]); w.y = cvt_pk_bf16(o[2], o[3]); w.z = cvt_pk_bf16(o[4], o[5]); w.w = cvt_pk_bf16(o[6], o[7]);
                *(u32x4*)(O + (size_t)row * ldc + col0) = w;
            }
    }
};

struct EpiMoeDown {
    static constexpr bool PERM = true, AFTER_DRAIN = false;
    bf16_t* Y2; const int* rinfo; const float* rg;
    __device__ __forceinline__ void operator()(const f32x4 (&acc)[2][2][4][2], const Unit& u, int wr, int wc, int fr, int fq) const {
        const int row0 = u.pm * BM + wr * 64 + fr, col0 = u.pn * BM + wc * 32 + 8 * fq;
#pragma unroll
        for (int ai = 0; ai < 2; ++ai)
#pragma unroll
            for (int m = 0; m < 4; ++m) {
                const int row = row0 + ai * HALF + m * 16;
                const int t2 = rinfo[row];
                if (t2 >= 0) {
                    const float gte = rg[row];
                    bf16_t* rowp = Y2 + (size_t)t2 * 1024 + col0;
#pragma unroll
                    for (int bj = 0; bj < 2; ++bj) {
                        const f32x4 v0 = acc[ai][bj][m][0] * gte, v1 = acc[ai][bj][m][1] * gte;
                        u32x4 w; w.x = cvt_pk_bf16(v0[0], v0[1]); w.y = cvt_pk_bf16(v0[2], v0[3]); w.z = cvt_pk_bf16(v1[0], v1[1]); w.w = cvt_pk_bf16(v1[2], v1[3]);
                        *(u32x4*)(rowp + bj * HALF) = w;
                    }
                }
                asm volatile("" ::: "memory");
            }
    }
};
struct MoeOrder {
    int nM, nN, nwg, G, c, pm_lo; const int* tile_e;
    __device__ void init(int nM_, int nN_, int G_, int c_, int pm_lo_, const int* te) { nM = nM_; nN = nN_; nwg = nM * nN; G = G_; c = c_; pm_lo = pm_lo_; tile_e = te; }
    __device__ bool next(int i, Unit& u) const {
        const long L = (long)i * G + c; if (L >= nwg) return false;
        int wgid = (int)L; { const int q = nwg / NXCD, r = nwg % NXCD, xcd = wgid % NXCD, off = wgid / NXCD; wgid = (xcd < r ? xcd * (q + 1) : r * (q + 1) + (xcd - r) * q) + off; }
        const int nig = WGM * nN, gid = wgid / nig, fm = gid * WGM, gsz = (nM - fm) < WGM ? (nM - fm) : WGM;
        u.pm = fm + ((wgid % nig) % gsz); u.pn = (wgid % nig) / gsz; u.e = __builtin_amdgcn_readfirstlane(tile_e[pm_lo + u.pm]); u.ord = i; return true;
    }
    __device__ __forceinline__ void a_ready(const Unit&) const {}
    __device__ __forceinline__ void done(const Unit&) const {}
};
template <class Epi, class Sched, bool ALIGN_EPI = false, bool SP2 = false>
__device__ __forceinline__ void gemm_phase(PG8_LAS unsigned char* lds, const Gemm g, const Sched& S, const Epi& E, const int tid_in) {
    const int tid = tid_in, wid = __builtin_amdgcn_readfirstlane(tid >> 6), lane = tid & 63, wr = wid >> 2, wc = wid & 3, fr = lane & 15, fq = lane >> 4;
    const int K = g.K, nt = K / BK;
    unsigned voffA[2], voffB[2];
#pragma unroll
    for (int i = 0; i < 2; ++i) { int R, C; stage_rc(tid * 16 + i * 8192, R, C); const int Rb = Epi::PERM ? ((R & ~31) + perm32(R & 31)) : R;
        voffA[i] = (unsigned)(R * K + C) * 2u; voffB[i] = (unsigned)(Rb * K + C) * 2u; }
    const size_t kstep = (size_t)(BK * 2);
    const size_t hstep = (size_t)HALF * K * 2;
    const size_t tstep = 2 * hstep;
    const unsigned ldsw = (unsigned)wid * 1024u;
    const int aoff = lds_byte(wr * 64 + fr, fq * 8), boff = lds_byte(wc * 32 + fr, fq * 8);
#define PG8_SA(b, h) (((b) * 2 + (h)) * HTB)
#define PG8_SB(b, h) ((4 + (b) * 2 + (h)) * HTB)
#define PG8_STAGE(bufoff, gbase, voff) do { _Pragma("unroll") for (int _i = 0; _i < 2; ++_i) \
        __builtin_amdgcn_global_load_lds((const unsigned*)((const char*)(gbase) + (voff)[_i]), (PG8_LAS unsigned*)(lds + (bufoff) + ldsw + _i * 8192), 16, 0, 0); } while (0)
#define PG8_LDA(dst, b, h) do { _Pragma("unroll") for (int m = 0; m < 4; ++m) _Pragma("unroll") for (int k = 0; k < 2; ++k) dst[m][k] = *(const PG8_LAS bf16x8*)(lds + PG8_SA(b, h) + aoff + m * 2048 + k * 1024); } while (0)
#define PG8_LDB(dst, b, h) do { _Pragma("unroll") for (int n = 0; n < 2; ++n) _Pragma("unroll") for (int k = 0; k < 2; ++k) dst[n][k] = *(const PG8_LAS bf16x8*)(lds + PG8_SB(b, h) + boff + n * 2048 + k * 1024); } while (0)
#define PG8_MMA(ai, bj, At, Bt) do { __builtin_amdgcn_s_setprio(1); _Pragma("unroll") for (int m = 0; m < 4; ++m) _Pragma("unroll") for (int n = 0; n < 2; ++n) _Pragma("unroll") for (int k = 0; k < 2; ++k) \
        acc[ai][bj][m][n] = __builtin_amdgcn_mfma_f32_16x16x32_bf16(Bt[n][k], At[m][k], acc[ai][bj][m][n], 0, 0, 0); __builtin_amdgcn_s_setprio(0); } while (0)
#define PG8_WAIT_V(n) asm volatile("s_waitcnt vmcnt(" #n ")" ::: "memory")
#define PG8_WAIT_L(n) asm volatile("s_waitcnt lgkmcnt(" #n ")" ::: "memory")
#define PG8_BAR __builtin_amdgcn_s_barrier()
#define PG8_SCHED __builtin_amdgcn_sched_barrier(0)
    Unit cur, nxt; int ui = 0;
    if (!S.next(0, cur)) return;
    f32x4 acc[2][2][4][2];
#pragma unroll
    for (int a = 0; a < 2; ++a)
#pragma unroll
        for (int b = 0; b < 2; ++b)
#pragma unroll
            for (int m = 0; m < 4; ++m)
#pragma unroll
                for (int n = 0; n < 2; ++n) acc[a][b][m][n] = (f32x4){0.f, 0.f, 0.f, 0.f};
    bf16x8 At[4][2], B0[2][2], B1[2][2];
    const char* cA = (const char*)g.A + (size_t)cur.pm * tstep; const char* cB = (const char*)g.Bt + (size_t)cur.e * g.bstride + (size_t)cur.pn * tstep;
    S.a_ready(cur);
    if constexpr (SP2) {
        PG8_STAGE(PG8_SB(0, 0), cB, voffB); PG8_STAGE(PG8_SB(0, 1), cB + hstep, voffB); PG8_STAGE(PG8_SA(0, 0), cA, voffA); PG8_STAGE(PG8_SA(0, 1), cA + hstep, voffA);
        if (wr == 1) PG8_BAR;
        PG8_WAIT_V(2); PG8_BAR;
        PG8_STAGE(PG8_SB(1, 0), cB + kstep, voffB); PG8_STAGE(PG8_SA(1, 0), cA + kstep, voffA); PG8_STAGE(PG8_SB(1, 1), cB + hstep + kstep, voffB);
        PG8_WAIT_V(6); PG8_BAR;
    } else {
        PG8_STAGE(PG8_SB(0, 0), cB, voffB); PG8_STAGE(PG8_SA(0, 0), cA, voffA); PG8_STAGE(PG8_SB(0, 1), cB + hstep, voffB); PG8_STAGE(PG8_SA(0, 1), cA + hstep, voffA);
        if (wr == 1) PG8_BAR;
        PG8_WAIT_V(4); PG8_BAR;
        PG8_STAGE(PG8_SB(1, 0), cB + kstep, voffB); PG8_STAGE(PG8_SA(1, 0), cA + kstep, voffA); PG8_STAGE(PG8_SB(1, 1), cB + hstep + kstep, voffB);
        PG8_WAIT_V(6); PG8_BAR;
    }
    for (;;) {
        const bool has_next = S.next(ui + 1, nxt);
        const char* nA = has_next ? (const char*)g.A + (size_t)nxt.pm * tstep : cA; const char* nB = has_next ? (const char*)g.Bt + (size_t)nxt.e * g.bstride + (size_t)nxt.pn * tstep : cB;
        for (int t = 0; t < nt; t += 2) {
            const bool last = (t == nt - 2);
            const char* a1 = cA + (size_t)(t + 1) * kstep;
            const char* a2 = last ? nA : cA + (size_t)(t + 2) * kstep; const char* b2 = last ? nB : cB + (size_t)(t + 2) * kstep;
            const char* a3 = a2 + kstep; const char* b3 = b2 + kstep;
            if (last && has_next) S.a_ready(nxt);
            if constexpr (SP2) {
            PG8_LDB(B0, 0, 0); PG8_LDB(B1, 0, 1); PG8_SCHED; PG8_LDA(At, 0, 0); PG8_STAGE(PG8_SA(1, 1), a1 + hstep, voffA);
            PG8_WAIT_V(8); PG8_WAIT_L(0); PG8_BAR; PG8_MMA(0, 0, At, B0); PG8_MMA(0, 1, At, B1); PG8_BAR; PG8_SCHED;
            PG8_LDA(At, 0, 1); PG8_STAGE(PG8_SB(0, 0), b2, voffB); PG8_STAGE(PG8_SB(0, 1), b2 + hstep, voffB); PG8_STAGE(PG8_SA(0, 0), a2, voffA);
            PG8_WAIT_V(8); PG8_WAIT_L(0); PG8_BAR; PG8_MMA(1, 0, At, B0); PG8_MMA(1, 1, At, B1); PG8_BAR; PG8_SCHED;
            PG8_LDB(B0, 1, 0); PG8_LDB(B1, 1, 1); PG8_SCHED; PG8_LDA(At, 1, 0); PG8_STAGE(PG8_SA(0, 1), a2 + hstep, voffA);
            PG8_WAIT_V(8); PG8_WAIT_L(0); PG8_BAR; PG8_MMA(0, 0, At, B0); PG8_MMA(0, 1, At, B1); PG8_BAR; PG8_SCHED;
            PG8_LDA(At, 1, 1); PG8_STAGE(PG8_SB(1, 0), b3, voffB); PG8_STAGE(PG8_SB(1, 1), b3 + hstep, voffB); PG8_STAGE(PG8_SA(1, 0), a3, voffA);
            PG8_WAIT_V(8); PG8_WAIT_L(0); PG8_BAR; PG8_MMA(1, 0, At, B0); PG8_MMA(1, 1, At, B1); PG8_BAR; PG8_SCHED;
            } else {
            PG8_LDB(B0, 0, 0); PG8_SCHED; PG8_LDA(At, 0, 0); PG8_STAGE(PG8_SA(1, 1), a1 + hstep, voffA);
            PG8_WAIT_L(8); PG8_BAR; PG8_WAIT_L(0); PG8_MMA(0, 0, At, B0); PG8_BAR; PG8_SCHED;
            PG8_LDB(B1, 0, 1); PG8_STAGE(PG8_SB(0, 0), b2, voffB);
            PG8_BAR; PG8_WAIT_L(0); PG8_MMA(0, 1, At, B1); PG8_BAR;
            PG8_LDA(At, 0, 1); PG8_STAGE(PG8_SA(0, 0), a2, voffA);
            PG8_BAR; PG8_WAIT_L(0); PG8_MMA(1, 0, At, B0); PG8_BAR; PG8_SCHED;
            PG8_STAGE(PG8_SB(0, 1), b2 + hstep, voffB);
            PG8_WAIT_V(6); PG8_BAR; PG8_MMA(1, 1, At, B1); PG8_BAR;
            PG8_LDB(B0, 1, 0); PG8_SCHED; PG8_LDA(At, 1, 0); PG8_STAGE(PG8_SA(0, 1), a2 + hstep, voffA);
            PG8_WAIT_L(8); PG8_BAR; PG8_WAIT_L(0); PG8_MMA(0, 0, At, B0); PG8_BAR; PG8_SCHED;
            PG8_LDB(B1, 1, 1); PG8_STAGE(PG8_SB(1, 0), b3, voffB);
            PG8_BAR; PG8_WAIT_L(0); PG8_MMA(0, 1, At, B1); PG8_BAR;
            PG8_LDA(At, 1, 1); PG8_STAGE(PG8_SA(1, 0), a3, voffA);
            PG8_BAR; PG8_WAIT_L(0); PG8_MMA(1, 0, At, B0); PG8_BAR; PG8_SCHED;
            PG8_STAGE(PG8_SB(1, 1), b3 + hstep, voffB);
            PG8_WAIT_V(6); PG8_BAR; PG8_MMA(1, 1, At, B1); PG8_BAR;
            }
        }
        if constexpr (ALIGN_EPI) { if (wr == 0) PG8_BAR; }
        if constexpr (!Epi::AFTER_DRAIN) { E(acc, cur, wr, wc, fr, fq); S.done(cur); }
        if (!has_next) break;
#pragma unroll
        for (int a = 0; a < 2; ++a)
#pragma unroll
            for (int b = 0; b < 2; ++b)
#pragma unroll
                for (int m = 0; m < 4; ++m)
#pragma unroll
                    for (int n = 0; n < 2; ++n) acc[a][b][m][n] = (f32x4){0.f, 0.f, 0.f, 0.f};
        cur = nxt; cA = nA; cB = nB; ++ui;
        if constexpr (ALIGN_EPI) { if (wr == 1) PG8_BAR; }
    }
    PG8_WAIT_V(0);
    if constexpr (!ALIGN_EPI) { if (wr == 0) PG8_BAR; }
    PG8_BAR;
    if constexpr (Epi::AFTER_DRAIN) { E.fused(acc, cur, wr, wc, fr, fq, lds, wid, lane); S.done(cur); }
#undef PG8_SA
#undef PG8_SB
#undef PG8_STAGE
#undef PG8_LDA
#undef PG8_LDB
#undef PG8_MMA
#undef PG8_WAIT_V
#undef PG8_WAIT_L
#undef PG8_BAR
#undef PG8_SCHED
}
}
#define GAS __attribute__((address_space(1)))
typedef unsigned v4u __attribute__((ext_vector_type(4)));
typedef GAS unsigned gu32;
typedef GAS unsigned long long gu64;
#define RLX_AGENT __ATOMIC_RELAXED, __HIP_MEMORY_SCOPE_AGENT
#define LDS_WAIT() asm volatile("s_waitcnt lgkmcnt(0)" ::: "memory")
#define VM_WAIT() asm volatile("s_waitcnt vmcnt(0)" ::: "memory")
#define XB_TMO      128
#define XB_XCNT(j)  (256  + 64 * (j))
#define XB_XSUB(j)  (1280 + 64 * (j))
#define XB_XGEN(j)  (2304 + 64 * (j))
#define XB_TOP      3328
#define XB_TOPGEN   3392
#define XCD_BAR_WORDS 3456
#define XB_SPIN_CAP (1u << 18)

__device__ __forceinline__ unsigned xb_ld(unsigned* p)              { return __hip_atomic_load(p, __ATOMIC_RELAXED, __HIP_MEMORY_SCOPE_AGENT); }
__device__ __forceinline__ unsigned xb_add(unsigned* p, unsigned v) { return __hip_atomic_fetch_add(p, v, __ATOMIC_RELAXED, __HIP_MEMORY_SCOPE_AGENT); }
__device__ __forceinline__ unsigned xb_xcc_id() { return (unsigned)__builtin_amdgcn_s_getreg((3 << 11) | 20) & 0xFu; }
#define XB_SPIN(cond, bar) do { unsigned _sp = 0; while (cond) { __builtin_amdgcn_s_sleep(1); \
    if ((++_sp & 255u) == 0u) { if (xb_ld(&(bar)[XB_TMO])) break; if (_sp > XB_SPIN_CAP) { atomicAdd(&(bar)[XB_TMO], 1u); break; } } } } while (0)

struct XcdBarrier {
    unsigned* bar; unsigned x;
    volatile LAS unsigned* st;
};

__device__ __forceinline__ XcdBarrier xcd_barrier_post(unsigned* bar, volatile LAS unsigned* st) {
    XcdBarrier b; b.bar = bar; b.x = xb_xcc_id(); b.st = st;
    if (threadIdx.x == 0) (void)xb_add(&bar[XB_XCNT(b.x)], 1u);
    return b;
}
__device__ __forceinline__ void xcd_barrier_complete(unsigned* bar, unsigned x, unsigned& nloc, unsigned& nx) {
    const unsigned G = gridDim.x * gridDim.y * gridDim.z;
    unsigned sum, cnt, mine, sp = 0u;
    for (;;) {
        sum = 0u; cnt = 0u; mine = 0u;
#pragma unroll
        for (unsigned j = 0; j < 16; ++j) { const unsigned c = xb_ld(&bar[XB_XCNT(j)]); sum += c; cnt += (c > 0u) ? 1u : 0u; mine = (j == x) ? c : mine; }
        if (sum == G) break;
        __builtin_amdgcn_s_sleep(1);
        if ((++sp & 255u) == 0u) { if (xb_ld(&bar[XB_TMO])) break; if (sp > XB_SPIN_CAP) { atomicAdd(&bar[XB_TMO], 1u); break; } }
    }
    nloc = mine > 0u ? mine : 1u; nx = cnt > 0u ? cnt : 1u;
}

__device__ __forceinline__ void xcd_barrier(const XcdBarrier& b) {
    asm volatile("s_waitcnt vmcnt(0)" ::: "memory");
    __syncthreads();
    if (threadIdx.x == 0) {
        unsigned* bar = b.bar;
        __builtin_amdgcn_s_waitcnt(0);
        unsigned nloc = b.st[0], nx = b.st[1];
        if (nloc == 0u) { xcd_barrier_complete(bar, b.x, nloc, nx); b.st[0] = nloc; b.st[1] = nx; }
        const unsigned old = xb_add(&bar[XB_XSUB(b.x)], 1u);
        const unsigned gen = old / nloc;
        if (old + 1u == (gen + 1u) * nloc) {
            __builtin_amdgcn_fence(__ATOMIC_RELEASE, "agent");
            asm volatile("s_waitcnt vmcnt(0)" ::: "memory");
            const unsigned og = xb_add(&bar[XB_TOP], 1u);
            const unsigned tg = og / nx;
            if (og + 1u == (tg + 1u) * nx) xb_add(&bar[XB_TOPGEN], 1u);
            else XB_SPIN(xb_ld(&bar[XB_TOPGEN]) == tg, bar);
            __builtin_amdgcn_fence(__ATOMIC_ACQUIRE, "agent");
            xb_add(&bar[XB_XGEN(b.x)], 1u);
            asm volatile("s_waitcnt vmcnt(0)" ::: "memory");
        } else {
            XB_SPIN(xb_ld(&bar[XB_XGEN(b.x)]) == gen, bar);
            __builtin_amdgcn_fence(__ATOMIC_ACQUIRE, "agent");
            asm volatile("s_waitcnt vmcnt(0)" ::: "memory");
        }
    }
    __syncthreads();
}

constexpr int RING_OFF = 0, RING_BYTES = 131072;
constexpr int LDSCTL_OFF = RING_BYTES, MISC_OFF = LDSCTL_OFF + 320;
constexpr int LDS_BYTES = 147456;
constexpr int NWAVES = 8;
constexpr int CW_BAR = 4096;

struct Args { const float* in[40]; float* out; unsigned char* ws; int nph; int ph[63]; };

struct Frame {
    LAS unsigned char* lds;
    volatile LAS unsigned* MISC;
    int tid, lane, wave, vcu, G;
    const float* const* in;
    unsigned char* ws; float* out;
};

__device__ __forceinline__ void conv_item(const float* W, int ldw, int coff, int nvalid, const float* g, bf16_t* dst, int K, int nblk, int rowmode, LAS float* scr, int item, int lane) {
    const int kb = item / nblk, nb = item % nblk, k0 = 64 * kb, n0 = 32 * nb;
    const int nn = n0 + (lane & 31);
#pragma unroll 8
    for (int i = 0; i < 32; ++i) {
        const int kk = 2 * i + (lane >> 5);
        float v = 0.f;
        if (nn < nvalid) { v = W[(size_t)(k0 + kk) * ldw + coff + nn]; if (g) v *= g[k0 + kk]; }
        scr[kk * 33 + (lane & 31)] = v;
    }
    LDS_WAIT(); asm volatile("" ::: "memory");
    const int c = lane & 7;
#pragma unroll
    for (int j = 0; j < 4; ++j) {
        const int nl = (lane >> 3) + 8 * j, n = n0 + nl; const LAS float* s = scr + (8 * c) * 33 + nl;
        v4u o; o.x = pk2(s[0 * 33], s[1 * 33]); o.y = pk2(s[2 * 33], s[3 * 33]); o.z = pk2(s[4 * 33], s[5 * 33]); o.w = pk2(s[6 * 33], s[7 * 33]);
        const int drow = rowmode == 0 ? n : ((n >> 7) * 256 + (n & 127) + (rowmode == 2 ? 128 : 0));
        *(GAS v4u*)(dst + (size_t)drow * K + k0 + 8 * c) = o;
    }
    LDS_WAIT(); asm volatile("" ::: "memory");
}
struct ConvJob { const float* W; const float* g; bf16_t* dst; int ldw, coff, nvalid, npad, K, rowmode; };
__device__ __forceinline__ ConvJob conv_job(const Frame& F, int j) {
    bf16_t* WB = (bf16_t*)(F.ws + WS_WB);
    ConvJob c; c.g = nullptr; c.coff = 0; c.rowmode = 0; c.K = 1024; c.ldw = D_; c.nvalid = D_; c.npad = D_;
    if (j < 16) {
        const int l = j >> 3, k = j & 7;
        switch (k) {
        case 0: { const int ncols = l == 0 ? 3096 : 3128; c.W = l == 0 ? F.in[2] : F.in[3]; c.ldw = ncols; c.nvalid = ncols; c.npad = NPJ; c.g = F.in[6] + l * D_; c.dst = WB + (WB_WIN / 2) + (size_t)l * NPJ * 1024; } break;
        case 1: c.W = F.in[25] + (size_t)l * D_ * D_; c.dst = WB + (WB_WOUT / 2) + (size_t)l * D_ * D_; break;
        case 2: c.W = F.in[28] + (size_t)l * D_ * D_; c.g = F.in[26] + l * D_; c.dst = WB + (WB_WQ / 2) + (size_t)l * D_ * D_; break;
        case 3: c.W = F.in[29] + (size_t)l * D_ * 2048; c.ldw = 2048; c.g = F.in[27] + l * D_; c.dst = WB + (WB_WK / 2) + (size_t)l * D_ * D_; break;
        case 4: c.W = F.in[29] + (size_t)l * D_ * 2048; c.ldw = 2048; c.coff = 1024; c.g = F.in[27] + l * D_; c.dst = WB + (WB_WV / 2) + (size_t)l * D_ * D_; break;
        case 5: c.W = F.in[30] + (size_t)l * D_ * D_; c.dst = WB + (WB_WO / 2) + (size_t)l * D_ * D_; break;
        case 6: c.W = F.in[20] + (size_t)l * 2048 * 128; c.ldw = 128; c.nvalid = 128; c.npad = 128; c.K = 2048; c.dst = WB + (WB_CW1 / 2) + (size_t)(l * 2 + 0) * 128 * 2048; break;
        default: c.W = F.in[23] + (size_t)l * 2048 * 128; c.ldw = 128; c.nvalid = 128; c.npad = 128; c.K = 2048; c.dst = WB + (WB_CW1 / 2) + (size_t)(l * 2 + 1) * 128 * 2048; break;
        }
    } else if (j == 16) { c.W = F.in[32]; c.ldw = FFD; c.nvalid = FFD; c.npad = FFD; c.g = F.in[31]; c.dst = WB + (WB_WGU / 2); c.rowmode = 1; }
    else if (j == 17) { c.W = F.in[33]; c.ldw = FFD; c.nvalid = FFD; c.npad = FFD; c.g = F.in[31]; c.dst = WB + (WB_WGU / 2); c.rowmode = 2; }
    else { c.W = F.in[34]; c.K = FFD; c.dst = WB + (WB_WD / 2); }
    return c;
}

__device__ __forceinline__ void p_prologue(Frame& F) {
    LAS float* scr = (LAS float*)(F.lds + RING_OFF + F.wave * 16384);
    const int gw = F.vcu * NWAVES + F.wave, NGW = F.G * NWAVES;
    int base = 0;
    bf16_t* WB = (bf16_t*)(F.ws + WS_WB);
#pragma nounroll
    for (int j = 0; j < 19; ++j) {
        const ConvJob c = conv_job(F, j);
        const int nblk = c.npad / 32, items = (c.K / 64) * nblk;
#pragma nounroll
        for (int it = (gw + NGW - (base % NGW)) % NGW; it < items; it += NGW) conv_item(c.W, c.ldw, c.coff, c.nvalid, c.g, c.dst, c.K, nblk, c.rowmode, scr, it, F.lane);
        base += items;
    }
    const int gt = (F.vcu * NWAVES + F.wave) * 64 + F.lane, NGT = F.G * NWAVES * 64;
    for (int l = 0; l < 2; ++l) {
        bf16_t* LT = WB + (WB_LORA / 2) + (size_t)l * 512 * 288;
        for (int i = gt; i < 512 * 288; i += NGT) {
            const int c = i / 288, k = i % 288; float v;
            if (k < 64) v = F.in[8][((size_t)l * 64 + k) * 512 + c];
            else if (k < 128) v = F.in[10][((size_t)l * 64 + (k - 64)) * 512 + c];
            else if (k < 256) v = F.in[11][((size_t)l * 128 + (k - 128)) * 512 + c];
            else v = (l == 1) ? F.in[18][(size_t)(k - 256) * 512 + c] : 0.f;
            LT[i] = (bf16_t)f2bf(v);
        }
        for (int kv = 0; kv < 2; ++kv) {
            bf16_t* C2 = WB + (WB_CW2 / 2) + (size_t)(l * 2 + kv) * 64 * 128;
            const float* w2 = (kv == 0 ? F.in[21] : F.in[24]) + (size_t)l * 128 * 64;
            for (int i = gt; i < 64 * 128; i += NGT) { const int d = i / 128, k = i % 128; C2[i] = (bf16_t)f2bf(w2[k * 64 + d]); }
        }
    }
    for (int o = gw; o < 512; o += NGW) {
        const int l = o >> 8, kv = (o >> 7) & 1, hid = o & 127;
        const float* pe = (kv == 0 ? F.in[19] : F.in[22]) + (size_t)l * 2048;
        const float* w1 = (kv == 0 ? F.in[20] : F.in[23]) + (size_t)l * 2048 * 128;
        float a = 0.f;
        for (int i = F.lane; i < 2048; i += 64) a += pe[i] * w1[(size_t)i * 128 + hid];
        a = wave_sum_l(a, F.lane);
        if (F.lane == 0) ((float*)(F.ws + WS_WB + WB_CB))[o] = a;
    }
    {
        float* X = (float*)(F.ws + WS_X); bf16_t* XB = (bf16_t*)(F.ws + WS_XB); float* SSQ = (float*)(F.ws + WS_SSQ);
        for (int m = gw; m < NTOK; m += NGW) {
            const GAS f32x4_t* xr = (const GAS f32x4_t*)(F.in[0] + (size_t)m * D_) + F.lane;
            f32x4_t v[4]; float s = 0.f;
#pragma unroll
            for (int j = 0; j < 4; ++j) { v[j] = xr[64 * j]; s += (v[j].x * v[j].x + v[j].y * v[j].y) + (v[j].z * v[j].z + v[j].w * v[j].w); }
            s = wave_sum_l(s, F.lane);
            GAS f32x4_t* xo = (GAS f32x4_t*)(X + (size_t)m * D_) + F.lane;
            GAS unsigned long long* o8 = (GAS unsigned long long*)(XB + (size_t)m * D_) + F.lane;
#pragma unroll
            for (int j = 0; j < 4; ++j) { xo[64 * j] = v[j]; o8[64 * j] = (unsigned long long)pk2(v[j].x, v[j].y) | ((unsigned long long)pk2(v[j].z, v[j].w) << 32); }
            if (F.lane < 16) SSQ[(size_t)m * 16 + F.lane] = (F.lane == 0) ? s : 0.f;
        }
        bf16_t* MB = (bf16_t*)(F.ws + WS_MEMB); float* MRINV = (float*)(F.ws + WS_MRINV);
        for (int m = gw; m < NMEM; m += NGW) {
            const GAS f32x4_t* xr = (const GAS f32x4_t*)(F.in[1] + (size_t)m * D_) + F.lane;
            f32x4_t v[4]; float s = 0.f;
#pragma unroll
            for (int j = 0; j < 4; ++j) { v[j] = xr[64 * j]; s += (v[j].x * v[j].x + v[j].y * v[j].y) + (v[j].z * v[j].z + v[j].w * v[j].w); }
            s = wave_sum_l(s, F.lane);
            GAS unsigned long long* o8 = (GAS unsigned long long*)(MB + (size_t)m * D_) + F.lane;
#pragma unroll
            for (int j = 0; j < 4; ++j) o8[64 * j] = (unsigned long long)pk2(v[j].x, v[j].y) | ((unsigned long long)pk2(v[j].z, v[j].w) << 32);
            if (F.lane == 0) MRINV[m] = 1.0f / sqrtf(s * (1.0f / 1024.0f) + 1e-6f);
        }
    }
}


#define RELAUNDER(F) do { int t_ = (F).tid; asm volatile("" : "+v"(t_)); (F).tid = t_; (F).lane = t_ & 63; (F).wave = __builtin_amdgcn_readfirstlane(t_ >> 6); \
    unsigned char* w_ = (F).ws; asm volatile("" : "+s"(w_)); (F).ws = w_; } while (0)
constexpr int RTAB_OFF = 132096, RTAB_UNITS = 8;
static_assert(RTAB_OFF + RTAB_UNITS * 256 * 4 <= LDS_BYTES && RTAB_OFF >= MISC_OFF + 128, "LDS map");
template <class Sched> __device__ __forceinline__ void fill_rtab(Frame& F, const Sched& S, const float* direct = nullptr) {
    const float* ssq = (const float*)(F.ws + WS_SSQ);
    LAS float* rtab = (LAS float*)(F.lds + RTAB_OFF);
    pg8::Unit u;
    for (int i = 0; i < RTAB_UNITS && S.next(i, u); ++i)
        if (F.tid < 256) rtab[i * 256 + F.tid] = direct ? direct[u.pm * 256 + F.tid] : pg8::row_rinv(ssq, u.pm * 256 + F.tid);
    __syncthreads();
}
__device__ __forceinline__ void p_inproj(Frame& F, int l) {
    RELAUNDER(F);
    pg8::Gemm g{(const bf16_t*)(F.ws + WS_XB), (const bf16_t*)(F.ws + WS_WB + WB_WIN) + (size_t)l * NPJ * 1024, NTOK, NPJ, 1024, 0};
    pg8::StaticOrder S; S.init(NTOK, NPJ, F.G, (int)blockIdx.x);
    fill_rtab(F, S);
    pg8::EpiRowScaleBf16 E{(bf16_t*)(F.ws + WS_S), NPJ, (const LAS float*)(F.lds + RTAB_OFF), 1.0f};
    pg8::gemm_phase<pg8::EpiRowScaleBf16, pg8::StaticOrder, true, true>(F.lds + RING_OFF, g, S, E, F.tid);
}

constexpr size_t S_PROJ = 0;
constexpr size_t S_CONCAT = 104 * MiB;
constexpr size_t S_SC = 136 * MiB;
constexpr size_t S_Y = 232 * MiB;
constexpr size_t S_G = 264 * MiB;
constexpr size_t S_BON = 280 * MiB;
constexpr size_t S_END = 281 * MiB;
constexpr size_t S_QC = 0, S_OC = 32 * MiB;
constexpr size_t S_ACT = 0;

__device__ __forceinline__ void p_resid_gemm(Frame& F, const bf16_t* A, const bf16_t* Bt, int K) {
    RELAUNDER(F);
    pg8::Gemm g{A, Bt, NTOK, 1024, K, 0};
    pg8::StaticOrder S; S.init(NTOK, 1024, F.G, (int)blockIdx.x);
    pg8::EpiResid E{(float*)(F.ws + WS_X), (bf16_t*)(F.ws + WS_XB), (float*)(F.ws + WS_SSQ)};
    pg8::gemm_phase<pg8::EpiResid, pg8::StaticOrder, true, true>(F.lds + RING_OFF, g, S, E, F.tid);
}
__device__ __forceinline__ void p_crossq(Frame& F, int l) {
    RELAUNDER(F);
    pg8::Gemm g{(const bf16_t*)(F.ws + WS_XB), (const bf16_t*)(F.ws + WS_WB + WB_WQ) + (size_t)l * D_ * D_, NTOK, 1024, 1024, 0};
    pg8::StaticOrder S; S.init(NTOK, 1024, F.G, (int)blockIdx.x);
    fill_rtab(F, S);
    pg8::EpiRowScaleBf16 E{(bf16_t*)(F.ws + WS_S + S_QC), 1024, (const LAS float*)(F.lds + RTAB_OFF), 0.0625f * 1.4426950408889634f};
    pg8::gemm_phase<pg8::EpiRowScaleBf16, pg8::StaticOrder, true, true>(F.lds + RING_OFF, g, S, E, F.tid);
}
__device__ __forceinline__ void p_kv(Frame& F) {
    RELAUNDER(F);
    if (F.vcu >= 128) return;
    const int which = F.vcu >> 5, l = which >> 1, c = F.vcu & 31;
    const bf16_t* MB = (const bf16_t*)(F.ws + WS_MEMB); const float* MRINV = (const float*)(F.ws + WS_MRINV);
    if ((which & 1) == 0) {
        pg8::Gemm g{MB, (const bf16_t*)(F.ws + WS_WB + WB_WK) + (size_t)l * D_ * D_, NMEM, 1024, 1024, 0};
        pg8::StaticOrder S; S.init(NMEM, 1024, 32, c);
        fill_rtab(F, S, MRINV);
        pg8::EpiRowScaleBf16 E{(bf16_t*)(F.ws + WS_KCR) + (size_t)l * NMEM * 1024, 1024, (const LAS float*)(F.lds + RTAB_OFF), 1.0f};
        pg8::gemm_phase<pg8::EpiRowScaleBf16, pg8::StaticOrder, true, true>(F.lds + RING_OFF, g, S, E, F.tid);
    } else {
        pg8::Gemm g{(const bf16_t*)(F.ws + WS_WB + WB_WV) + (size_t)l * D_ * D_, MB, 1024, NMEM, 1024, 0};
        pg8::StaticOrder S; S.init(1024, NMEM, 32, c);
        pg8::EpiColScaleBf16 E{(bf16_t*)(F.ws + WS_VT) + (size_t)l * 1024 * NMEM, NMEM, MRINV};
        pg8::gemm_phase<pg8::EpiColScaleBf16, pg8::StaticOrder, true, true>(F.lds + RING_OFF, g, S, E, F.tid);
    }
}
__device__ __forceinline__ void p_ffn_up(Frame& F) {
    RELAUNDER(F);
    pg8::Gemm g{(const bf16_t*)(F.ws + WS_XB), (const bf16_t*)(F.ws + WS_WB + WB_WGU), NTOK, 2 * FFD, 1024, 0};
    pg8::StaticOrder S; S.init(NTOK, 2 * FFD, F.G, (int)blockIdx.x);
    fill_rtab(F, S);
    pg8::EpiSwiGLU E{(bf16_t*)(F.ws + WS_S + S_ACT), FFD, (const LAS float*)(F.lds + RTAB_OFF)};
    pg8::gemm_phase<pg8::EpiSwiGLU, pg8::StaticOrder, true, true>(F.lds + RING_OFF, g, S, E, F.tid);
}

typedef short bf16x8_t __attribute__((ext_vector_type(8)));
constexpr int LDX = 296;
__device__ __forceinline__ void p_rw_prep(Frame& F, int l) {
    RELAUNDER(F);
    const int n_lo = l == 0 ? 256 : 288;
    const bf16_t* P = (const bf16_t*)(F.ws + WS_S + S_PROJ);
    const float* mu = l == 0 ? F.in[4] : F.in[5];
    const bf16_t* LT0 = (const bf16_t*)(F.ws + WS_WB + WB_LORA) + (size_t)l * 512 * 288;
    bf16_t* SC = (bf16_t*)(F.ws + WS_S + S_SC); bf16_t* Gb = (bf16_t*)(F.ws + WS_S + S_G); float* BON = (float*)(F.ws + WS_S + S_BON);
    bf16_t* VF = (bf16_t*)(F.ws + WS_VFIRST);
    LAS bf16_t* Xs = (LAS bf16_t*)F.lds;
    const float* w0 = F.in[7] + l * W_; const float* a0 = F.in[9] + l * W_; const float* kkp = F.in[12] + l * W_; const float* kap = F.in[13] + l * W_; const float* rkp = F.in[14] + l * W_;
    const float* v0p = F.in[17];
    for (int chunk = F.vcu; chunk < NTOK / 64; chunk += F.G) {
        const int tok0 = chunk * 64;
        __syncthreads();
        for (int c = F.tid; c < 64 * 36; c += NWAVES * 64) {
            const int row = c / 36, ch = c % 36, tok = tok0 + row, t = tok & (T_ - 1);
            u32x4_t o = {0u, 0u, 0u, 0u};
            if (ch * 8 < n_lo) {
                const u32x4_t cu = *(const u32x4_t*)(P + (size_t)tok * NPJ + 1536 + ch * 8);
                u32x4_t pv = {0u, 0u, 0u, 0u};
                if (t > 0) pv = *(const u32x4_t*)(P + (size_t)(tok - 1) * NPJ + 1536 + ch * 8);
                const f32x4_t m0 = *(const f32x4_t*)(mu + 1536 + ch * 8), m1 = *(const f32x4_t*)(mu + 1536 + ch * 8 + 4);
                float v[8];
#pragma unroll
                for (int q = 0; q < 4; ++q) {
                    const float u0 = __uint_as_float(cu[q] << 16), u1 = __uint_as_float(cu[q] & 0xffff0000u), p0 = __uint_as_float(pv[q] << 16), p1 = __uint_as_float(pv[q] & 0xffff0000u);
                    const float ma = q < 2 ? m0[2 * q] : m1[2 * q - 4], mb = q < 2 ? m0[2 * q + 1] : m1[2 * q - 3];
                    v[2 * q] = u0 + (p0 - u0) * ma; v[2 * q + 1] = u1 + (p1 - u1) * mb;
                }
                if (ch < 8) { for (int q = 0; q < 8; ++q) v[q] = tanhf(v[q]); }
                else if (ch >= 16 && ch < 32) { for (int q = 0; q < 8; ++q) v[q] = sigmoidf_(v[q]); }
                o.x = pk2(v[0], v[1]); o.y = pk2(v[2], v[3]); o.z = pk2(v[4], v[5]); o.w = pk2(v[6], v[7]);
            }
            *(LAS u32x4_t*)(Xs + row * LDX + ch * 8) = o;
        }
        __syncthreads();
        const int h = F.wave, fr = F.lane & 15, fq = F.lane >> 4;
#define LORA_MMA(acc, KS0, KS1) do { _Pragma("unroll") for (int mt = 0; mt < 4; ++mt) acc[mt] = (pg8::f32x4){0.f, 0.f, 0.f, 0.f}; \
        _Pragma("unroll") for (int ks = KS0; ks < KS1; ++ks) { const bf16x8_t bx = *(const LAS bf16x8_t*)(Xs + (nt * 16 + fr) * LDX + ks * 32 + fq * 8); \
            _Pragma("unroll") for (int mt = 0; mt < 4; ++mt) { const bf16x8_t ax = *(const bf16x8_t*)(LT + (size_t)(h * 64 + mt * 16 + fr) * 288 + ks * 32 + fq * 8); \
                acc[mt] = __builtin_amdgcn_mfma_f32_16x16x32_bf16(ax, bx, acc[mt], 0, 0, 0); } } } while (0)
#define UNPK(w, e) (((e) & 1) ? __uint_as_float(((e) < 2 ? (w).x : (w).y) & 0xffff0000u) : __uint_as_float(((e) < 2 ? (w).x : (w).y) << 16))
#define SHIFTED(dst, colbase, mt) do { const int c_ = h * 64 + (mt) * 16 + fq * 4; const u32x2_t cu_ = *(const u32x2_t*)(pc + (colbase) + c_); u32x2_t pu_ = {0u, 0u}; \
        if (t > 0) pu_ = *(const u32x2_t*)(pp + (colbase) + c_); const f32x4_t m_ = *(const f32x4_t*)(mu + (colbase) + c_); \
        _Pragma("unroll") for (int e = 0; e < 4; ++e) { const float u_ = UNPK(cu_, e), q_ = UNPK(pu_, e); dst[e] = u_ + (q_ - u_) * m_[e]; } } while (0)
#pragma nounroll
        for (int nt = 0; nt < 4; ++nt) {
            const bf16_t* LT = LT0; asm volatile("" : "+s"(LT));
            const int tok = tok0 + nt * 16 + fr, t = tok & (T_ - 1), b = tok >> 11;
            const bf16_t* pc = P + (size_t)tok * NPJ; const bf16_t* pp = pc - NPJ;
            const size_t sb0 = ((((size_t)b * 8 + h) * T_ + t) * 6) * 64 + fq * 4;
            pg8::f32x4 acc[4];
            LORA_MMA(acc, 0, 2);
#pragma unroll
            for (int mt = 0; mt < 4; ++mt) {
                const int c = h * 64 + mt * 16 + fq * 4; const f32x4_t w0v = *(const f32x4_t*)(w0 + c); float om[4];
#pragma unroll
                for (int e = 0; e < 4; ++e) { const float wraw = w0v[e] + acc[mt][e]; const float sp = (-wraw > 20.f) ? -wraw : log1pf(__expf(-wraw)); om[e] = 1.0f - __expf(-__expf(-sp - 0.5f)); }
                u32x2_t o; o.x = pk2(om[0], om[1]); o.y = pk2(om[2], om[3]); *(u32x2_t*)(SC + sb0 + mt * 16 + 1 * 64) = o;
            }
            asm volatile("" ::: "memory");
            LORA_MMA(acc, 4, 8);
#pragma unroll
            for (int mt = 0; mt < 4; ++mt) { const int c = h * 64 + mt * 16 + fq * 4; u32x2_t o; o.x = pk2(acc[mt][0], acc[mt][1]); o.y = pk2(acc[mt][2], acc[mt][3]); *(u32x2_t*)(Gb + (size_t)tok * W_ + c) = o; }
            asm volatile("" ::: "memory");
            if (l == 1) LORA_MMA(acc, 8, 9);
#pragma unroll
            for (int mt = 0; mt < 4; ++mt) {
                const int c = h * 64 + mt * 16 + fq * 4; float v[4]; SHIFTED(v, 1024, mt);
                if (l == 1) {
                    const f32x4_t v0v = *(const f32x4_t*)(v0p + c); const u32x2_t vfr = *(const u32x2_t*)(VF + (size_t)tok * W_ + c);
#pragma unroll
                    for (int e = 0; e < 4; ++e) { const float vf = UNPK(vfr, e); v[e] = v[e] + (vf - v[e]) * sigmoidf_(v0v[e] + acc[mt][e]); }
                }
                u32x2_t o; o.x = pk2(v[0], v[1]); o.y = pk2(v[2], v[3]);
                *(u32x2_t*)(SC + sb0 + mt * 16 + 3 * 64) = o;
                if (l == 0) *(u32x2_t*)(VF + (size_t)tok * W_ + c) = o;
            }
            asm volatile("" ::: "memory");
            LORA_MMA(acc, 2, 4);
            float kn[4][4], ai[4][4]; float ssk = 0.f, bsum = 0.f;
#pragma unroll
            for (int mt = 0; mt < 4; ++mt) {
                const int c = h * 64 + mt * 16 + fq * 4; float r[4], k[4]; SHIFTED(r, 0, mt); SHIFTED(k, 512, mt);
                const f32x4_t a0v = *(const f32x4_t*)(a0 + c), kkv = *(const f32x4_t*)(kkp + c), kav = *(const f32x4_t*)(kap + c), rkv = *(const f32x4_t*)(rkp + c);
                float kh[4];
#pragma unroll
                for (int e = 0; e < 4; ++e) {
                    const float a = sigmoidf_(a0v[e] + acc[mt][e]); const float kk = k[e] * kkv[e];
                    ssk += kk * kk; kh[e] = k[e] * (1.f + (a - 1.f) * kav[e]); bsum += r[e] * kh[e] * rkv[e];
                    kn[mt][e] = kk; ai[mt][e] = a;
                }
                { u32x2_t o; o.x = pk2(r[0], r[1]); o.y = pk2(r[2], r[3]); *(u32x2_t*)(SC + sb0 + mt * 16 + 0 * 64) = o; }
                { u32x2_t o; o.x = pk2(kh[0], kh[1]); o.y = pk2(kh[2], kh[3]); *(u32x2_t*)(SC + sb0 + mt * 16 + 2 * 64) = o; }
            }
            ssk += shx(ssk, F.lane, 16); ssk += shx(ssk, F.lane, 32);
            bsum += shx(bsum, F.lane, 16); bsum += shx(bsum, F.lane, 32);
            const float kinv = 1.0f / fmaxf(sqrtf(ssk), 1e-12f);
            if (fq == 0) BON[(size_t)tok * 8 + h] = bsum;
#pragma unroll
            for (int mt = 0; mt < 4; ++mt) {
                float kq[4], bq[4];
#pragma unroll
                for (int e = 0; e < 4; ++e) { kq[e] = kn[mt][e] * kinv; bq[e] = kq[e] * ai[mt][e]; }
                { u32x2_t o; o.x = pk2(kq[0], kq[1]); o.y = pk2(kq[2], kq[3]); *(u32x2_t*)(SC + sb0 + mt * 16 + 4 * 64) = o; }
                { u32x2_t o; o.x = pk2(bq[0], bq[1]); o.y = pk2(bq[2], bq[3]); *(u32x2_t*)(SC + sb0 + mt * 16 + 5 * 64) = o; }
            }
            asm volatile("" ::: "memory");
        }
#undef LORA_MMA
#undef UNPK
#undef SHIFTED
    }
}

constexpr int SC_STEPS = 32, SC_CHUNK_F = SC_STEPS * 6 * 64;
constexpr int SCAN_YB = 2 * SC_CHUNK_F * 4;
__device__ __forceinline__ float dpp_ror_add(float v, int) { return v; }
#define ROW_ALLREDUCE(v) do { \
    v += __int_as_float(__builtin_amdgcn_update_dpp(0, __float_as_int(v), 0x128, 0xf, 0xf, false)); \
    v += __int_as_float(__builtin_amdgcn_update_dpp(0, __float_as_int(v), 0x124, 0xf, 0xf, false)); \
    v += __int_as_float(__builtin_amdgcn_update_dpp(0, __float_as_int(v), 0x122, 0xf, 0xf, false)); \
    v += __int_as_float(__builtin_amdgcn_update_dpp(0, __float_as_int(v), 0x121, 0xf, 0xf, false)); } while (0)
__device__ __forceinline__ void p_rw_scan(Frame& F) {
    RELAUNDER(F);
    const bf16_t* SC = (const bf16_t*)(F.ws + WS_S + S_SC); float* Y = (float*)(F.ws + WS_S + S_Y);
    LAS float* ring = (LAS float*)F.lds; LAS float* yring = (LAS float*)(F.lds + SCAN_YB);
    constexpr int NCH = T_ / SC_STEPS;
    for (int unit = F.vcu; unit < B_ * H_ * 4; unit += F.G) {
        const int bh = unit >> 2, qtr = unit & 3;
        const bf16_t* src = SC + (size_t)bh * T_ * 384;
        __syncthreads();
        if (F.wave >= 4) {
            const int lt = F.tid - 256;
            u32x4_t regs[6];
#pragma unroll
            for (int i = 0; i < 6; ++i) regs[i] = *(const u32x4_t*)(src + (size_t)(lt + 256 * i) * 8);
#pragma unroll
            for (int i = 0; i < 6; ++i) {
                LAS f32x4_t* d = (LAS f32x4_t*)(ring + (lt + 256 * i) * 8);
                d[0] = (f32x4_t){__uint_as_float(regs[i].x << 16), __uint_as_float(regs[i].x & 0xffff0000u), __uint_as_float(regs[i].y << 16), __uint_as_float(regs[i].y & 0xffff0000u)};
                d[1] = (f32x4_t){__uint_as_float(regs[i].z << 16), __uint_as_float(regs[i].z & 0xffff0000u), __uint_as_float(regs[i].w << 16), __uint_as_float(regs[i].w & 0xffff0000u)};
            }
#pragma unroll
            for (int i = 0; i < 6; ++i) regs[i] = *(const u32x4_t*)(src + (size_t)SC_CHUNK_F + (size_t)(lt + 256 * i) * 8);
            __syncthreads();
            for (int c = 0; c < NCH; ++c) {
                if (c + 1 < NCH) {
                    LAS float* dst = ring + ((c + 1) & 1) * SC_CHUNK_F;
#pragma unroll
                    for (int i = 0; i < 6; ++i) {
                        LAS f32x4_t* d = (LAS f32x4_t*)(dst + (lt + 256 * i) * 8);
                        d[0] = (f32x4_t){__uint_as_float(regs[i].x << 16), __uint_as_float(regs[i].x & 0xffff0000u), __uint_as_float(regs[i].y << 16), __uint_as_float(regs[i].y & 0xffff0000u)};
                        d[1] = (f32x4_t){__uint_as_float(regs[i].z << 16), __uint_as_float(regs[i].z & 0xffff0000u), __uint_as_float(regs[i].w << 16), __uint_as_float(regs[i].w & 0xffff0000u)};
                    }
                    if (c + 2 < NCH) {
#pragma unroll
                        for (int i = 0; i < 6; ++i) regs[i] = *(const u32x4_t*)(src + (size_t)(c + 2) * SC_CHUNK_F + (size_t)(lt + 256 * i) * 8);
                    }
                }
                if (c > 0) {
                    const int st = lt >> 3, r2 = (lt & 7) * 2;
                    const LAS float* ys = yring + ((c - 1) & 1) * (SC_STEPS * 16) + st * 16 + r2;
                    const size_t tok = (size_t)(bh >> 3) * T_ + (size_t)(c - 1) * SC_STEPS + st;
                    typedef float f32x2_t __attribute__((ext_vector_type(2)));
                    *(f32x2_t*)(Y + tok * W_ + (bh & 7) * 64 + qtr * 16 + r2) = (f32x2_t){ys[0], ys[1]};
                }
                __syncthreads();
            }
            {
                const int c = NCH;
                const int st = lt >> 3, r2 = (lt & 7) * 2;
                const LAS float* ys = yring + ((c - 1) & 1) * (SC_STEPS * 16) + st * 16 + r2;
                const size_t tok = (size_t)(bh >> 3) * T_ + (size_t)(c - 1) * SC_STEPS + st;
                typedef float f32x2_t __attribute__((ext_vector_type(2)));
                *(f32x2_t*)(Y + tok * W_ + (bh & 7) * 64 + qtr * 16 + r2) = (f32x2_t){ys[0], ys[1]};
            }
        } else {
            const int rl = F.wave * 4 + (F.lane >> 4);
            const int cj = (F.lane & 15) * 4;
            const int vch = qtr * 16 + rl;
            float S0 = 0.f, S1 = 0.f, S2 = 0.f, S3 = 0.f;
            __syncthreads();
            for (int c = 0; c < NCH; ++c) {
                const LAS float* buf = ring + (c & 1) * SC_CHUNK_F;
                LAS float* yb = yring + (c & 1) * (SC_STEPS * 16);
#pragma unroll 4
                for (int st = 0; st < SC_STEPS; ++st) {
                    const LAS float* sp = buf + st * 384;
                    const f32x4_t r4 = *(const LAS f32x4_t*)(sp + 0 * 64 + cj), om4 = *(const LAS f32x4_t*)(sp + 1 * 64 + cj), k4 = *(const LAS f32x4_t*)(sp + 2 * 64 + cj),
                                  kk4 = *(const LAS f32x4_t*)(sp + 4 * 64 + cj), b4 = *(const LAS f32x4_t*)(sp + 5 * 64 + cj);
                    const float v = sp[3 * 64 + vch];
                    float sa = (S0 * kk4.x + S1 * kk4.y) + (S2 * kk4.z + S3 * kk4.w);
                    ROW_ALLREDUCE(sa);
                    S0 = (S0 - S0 * om4.x) + (v * k4.x - sa * b4.x);
                    S1 = (S1 - S1 * om4.y) + (v * k4.y - sa * b4.y);
                    S2 = (S2 - S2 * om4.z) + (v * k4.z - sa * b4.z);
                    S3 = (S3 - S3 * om4.w) + (v * k4.w - sa * b4.w);
                    float y = (S0 * r4.x + S1 * r4.y) + (S2 * r4.z + S3 * r4.w);
                    ROW_ALLREDUCE(y);
                    if ((F.lane & 15) == 0) yb[st * 16 + rl] = y;
                }
                __syncthreads();
            }
        }
    }
}

__device__ __forceinline__ void p_rw_post(Frame& F, int l) {
    RELAUNDER(F);
    const int gw = F.vcu * NWAVES + F.wave, NGW = F.G * NWAVES;
    const float* Y = (const float*)(F.ws + WS_S + S_Y); const bf16_t* SC = (const bf16_t*)(F.ws + WS_S + S_SC); const bf16_t* Gb = (const bf16_t*)(F.ws + WS_S + S_G);
    const float* BON = (const float*)(F.ws + WS_S + S_BON); bf16_t* CC = (bf16_t*)(F.ws + WS_S + S_CONCAT);
    const float* lnw = F.in[15] + l * W_; const float* lnb = F.in[16] + l * W_;
    for (int tok = gw; tok < NTOK; tok += NGW) {
        const int c = F.lane * 8, h = F.lane >> 3, b = tok >> 11, t = tok & (T_ - 1);
        const f32x4_t y0 = *(const f32x4_t*)(Y + (size_t)tok * W_ + c), y1 = *(const f32x4_t*)(Y + (size_t)tok * W_ + c + 4);
        float s = ((y0.x + y0.y) + (y0.z + y0.w)) + ((y1.x + y1.y) + (y1.z + y1.w));
        s += shx(s, F.lane, 1); s += shx(s, F.lane, 2); s += shx(s, F.lane, 4);
        const float mean = s * (1.f / 64.f);
        const f32x4_t d0 = y0 - mean, d1 = y1 - mean;
        float q = ((d0.x * d0.x + d0.y * d0.y) + (d0.z * d0.z + d0.w * d0.w)) + ((d1.x * d1.x + d1.y * d1.y) + (d1.z * d1.z + d1.w * d1.w));
        q += shx(q, F.lane, 1); q += shx(q, F.lane, 2); q += shx(q, F.lane, 4);
        const float rstd = 1.0f / sqrtf(q * (1.f / 64.f) + 64e-5f);
        const float bon = BON[(size_t)tok * 8 + h];
        const u32x4_t vw = *(const u32x4_t*)(SC + ((((size_t)b * 8 + h) * T_ + t) * 6 + 3) * 64 + (c & 63));
        const u32x4_t gw4 = *(const u32x4_t*)(Gb + (size_t)tok * W_ + c);
        const f32x4_t w0 = *(const f32x4_t*)(lnw + c), w1 = *(const f32x4_t*)(lnw + c + 4), b0 = *(const f32x4_t*)(lnb + c), b1 = *(const f32x4_t*)(lnb + c + 4);
        float o[8];
#pragma unroll
        for (int e = 0; e < 8; ++e) {
            const float d = e < 4 ? d0[e] : d1[e - 4], lw = e < 4 ? w0[e] : w1[e - 4], lb = e < 4 ? b0[e] : b1[e - 4];
            const unsigned vq = vw[e >> 1], gq = gw4[e >> 1];
            const float v = (e & 1) ? __uint_as_float(vq & 0xffff0000u) : __uint_as_float(vq << 16), g = (e & 1) ? __uint_as_float(gq & 0xffff0000u) : __uint_as_float(gq << 16);
            o[e] = (d * rstd * lw + lb + bon * v) * g;
        }
        u32x4_t ow; ow.x = pk2(o[0], o[1]); ow.y = pk2(o[2], o[3]); ow.z = pk2(o[4], o[5]); ow.w = pk2(o[6], o[7]);
        *(u32x4_t*)(CC + (size_t)tok * D_ + c) = ow;
    }
}

__device__ __forceinline__ void p_route(Frame& F) {
    RELAUNDER(F);
    LAS int* lcnt = (LAS int*)F.lds;
    LAS int* gbase = lcnt + 8;
    LAS int* te = lcnt + 16;
    LAS int* tr = te + 128;
    LAS float* tg = (LAS float*)(tr + 128);
    const float* X = (const float*)(F.ws + WS_X); const float* ssq = (const float*)(F.ws + WS_SSQ);
    const float* gn = F.in[31] + D_; const float* wr = F.in[35];
    int* CNT = (int*)(F.ws + WS_CTL + CTL_CNT);
    int* INV = (int*)(F.ws + WS_MT + MT_INV); float* TOKG = (float*)(F.ws + WS_MT + MT_TOKG);
    for (int chunk = F.vcu; chunk < NTOK / 64; chunk += F.G) {
        if (F.tid < 8) lcnt[F.tid] = 0;
        __syncthreads();
        for (int i = 0; i < 8; ++i) {
            const int tokl = F.wave * 8 + i, tok = chunk * 64 + tokl;
            float acc[8];
#pragma unroll
            for (int e = 0; e < 8; ++e) acc[e] = 0.f;
#pragma unroll
            for (int j = 0; j < 4; ++j) {
                const int k0 = F.lane * 4 + 256 * j;
                const f32x4_t xv = *(const f32x4_t*)(X + (size_t)tok * D_ + k0), gv = *(const f32x4_t*)(gn + k0);
#pragma unroll
                for (int q = 0; q < 4; ++q) {
                    const float hv = xv[q] * gv[q];
                    const f32x4_t w0 = *(const f32x4_t*)(wr + (size_t)(k0 + q) * 8), w1 = *(const f32x4_t*)(wr + (size_t)(k0 + q) * 8 + 4);
                    acc[0] += hv * w0[0]; acc[1] += hv * w0[1]; acc[2] += hv * w0[2]; acc[3] += hv * w0[3];
                    acc[4] += hv * w1[0]; acc[5] += hv * w1[1]; acc[6] += hv * w1[2]; acc[7] += hv * w1[3];
                }
            }
            const float rinv = pg8::row_rinv(ssq, tok);
#pragma unroll
            for (int e = 0; e < 8; ++e) acc[e] = wave_sum_l(acc[e], F.lane) * rinv;
            int e0 = 0; float v0 = acc[0];
#pragma unroll
            for (int e = 1; e < 8; ++e) if (acc[e] > v0) { v0 = acc[e]; e0 = e; }
            int e1 = -1; float v1 = 0.f;
#pragma unroll
            for (int e = 0; e < 8; ++e) if (e != e0 && (e1 < 0 || acc[e] > v1)) { v1 = acc[e]; e1 = e; }
            if (F.lane == 0) {
                const float p1 = __expf(v1 - v0), inv = 1.f / (1.f + p1);
                te[tokl * 2] = e0; te[tokl * 2 + 1] = e1; tg[tokl * 2] = inv; tg[tokl * 2 + 1] = p1 * inv;
                tr[tokl * 2] = __hip_atomic_fetch_add(lcnt + e0, 1, __ATOMIC_RELAXED, __HIP_MEMORY_SCOPE_WORKGROUP);
                tr[tokl * 2 + 1] = __hip_atomic_fetch_add(lcnt + e1, 1, __ATOMIC_RELAXED, __HIP_MEMORY_SCOPE_WORKGROUP);
            }
        }
        __syncthreads();
        if (F.tid < 8) gbase[F.tid] = atomicAdd(CNT + F.tid, lcnt[F.tid]);
        __syncthreads();
        if (F.tid < 128) {
            const int e = te[F.tid], idx = gbase[e] + tr[F.tid], t2 = chunk * 128 + F.tid;
            TOKG[t2] = tg[F.tid]; INV[(size_t)e * NTOK + idx] = t2;
        }
        __syncthreads();
    }
}
__device__ __forceinline__ ConvJob conv_job_exp(const Frame& F, int j) {
    const int e = j / 3, k = j % 3; ConvJob c; c.coff = 0;
    if (k < 2) { c.W = (k == 0 ? F.in[36] : F.in[37]) + (size_t)e * D_ * EFF; c.ldw = EFF; c.nvalid = EFF; c.npad = EFF; c.K = 1024; c.g = F.in[31] + D_; c.rowmode = 1 + k;
                 c.dst = (bf16_t*)(F.ws + WS_WE) + (size_t)e * 7168 * 1024; }
    else { c.W = F.in[38] + (size_t)e * EFF * D_; c.ldw = D_; c.nvalid = D_; c.npad = D_; c.K = EFF; c.g = nullptr; c.rowmode = 0; c.dst = (bf16_t*)(F.ws + WS_WE + WE_D) + (size_t)e * 1024 * EFF; }
    return c;
}
__device__ __forceinline__ void p_moe_prep(Frame& F) {
    RELAUNDER(F);
    LAS int* tb = (LAS int*)F.lds;
    LAS int* cn = tb + 16;
    const int* CNT = (const int*)(F.ws + WS_CTL + CTL_CNT);
    int* TILE = (int*)(F.ws + WS_MT + MT_TILE);
    if (F.tid == 0) { int acc = 0; for (int e = 0; e < 8; ++e) { const int c = CNT[e]; cn[e] = c; tb[e] = acc; acc += (c + 255) >> 8; } tb[8] = acc; }
    __syncthreads();
    const int MT = tb[8];
    if (F.vcu == 0) {
        if (F.tid == 0) TILE[0] = MT;
        if (F.tid < 9) TILE[16 + F.tid] = tb[F.tid];
        for (int pm = F.tid; pm < MT; pm += NWAVES * 64) { int e = 0; for (int q = 1; q < 8; ++q) if (pm >= tb[q]) e = q; TILE[64 + pm] = e; }
    }
    const int gw = F.vcu * NWAVES + F.wave, NGW = F.G * NWAVES;
    const float* X = (const float*)(F.ws + WS_X); const float* ssq = (const float*)(F.ws + WS_SSQ);
    const int* INV = (const int*)(F.ws + WS_MT + MT_INV); const float* TOKG = (const float*)(F.ws + WS_MT + MT_TOKG);
    int* ROWINFO = (int*)(F.ws + WS_MT + MT_ROWINFO); float* ROWG = (float*)(F.ws + WS_MT + MT_ROWG);
    bf16_t* XG = (bf16_t*)(F.ws + WS_XG);
    for (int row = gw; row < MT * 256; row += NGW) {
        const int pm = row >> 8; int e = 0;
        for (int q = 1; q < 8; ++q) if (pm >= tb[q]) e = q;
        const int idx = (pm - tb[e]) * 256 + (row & 255);
        GAS unsigned long long* o8 = (GAS unsigned long long*)(XG + (size_t)row * D_) + F.lane;
        if (idx < cn[e]) {
            const int t2 = INV[(size_t)e * NTOK + idx], tok = t2 >> 1;
            const float rinv = pg8::row_rinv(ssq, tok);
            const GAS f32x4_t* xr = (const GAS f32x4_t*)(X + (size_t)tok * D_) + F.lane;
#pragma unroll
            for (int j = 0; j < 4; ++j) { const f32x4_t v = xr[64 * j] * rinv; o8[64 * j] = (unsigned long long)pk2(v.x, v.y) | ((unsigned long long)pk2(v.z, v.w) << 32); }
            if (F.lane == 0) { ROWINFO[row] = t2; ROWG[row] = TOKG[t2]; }
        } else {
#pragma unroll
            for (int j = 0; j < 4; ++j) o8[64 * j] = 0ull;
            if (F.lane == 0) { ROWINFO[row] = -1; ROWG[row] = 0.f; }
        }
    }
    LAS float* scr = (LAS float*)(F.lds + RING_OFF + 1024 + F.wave * 16384);
    int base = 0;
#pragma nounroll
    for (int j = 0; j < 24; ++j) {
        const ConvJob c = conv_job_exp(F, j);
        const int nblk = c.npad / 32, items = (c.K / 64) * nblk;
#pragma nounroll
        for (int it = (gw + NGW - (base % NGW)) % NGW; it < items; it += NGW) conv_item(c.W, c.ldw, c.coff, c.nvalid, c.g, c.dst, c.K, nblk, c.rowmode, scr, it, F.lane);
        base += items;
    }
}
__device__ __forceinline__ void p_moe_gemm1(Frame& F, int pass) {
    RELAUNDER(F);
    const int* TILE = (const int*)(F.ws + WS_MT + MT_TILE);
    const int MT = __builtin_amdgcn_readfirstlane(TILE[0]), pm_lo = pass * MOE_PASS_TILES; int nMp = MT - pm_lo; nMp = nMp < 0 ? 0 : (nMp > MOE_PASS_TILES ? MOE_PASS_TILES : nMp);
    pg8::Gemm g{(const bf16_t*)(F.ws + WS_XG) + (size_t)pm_lo * 256 * 1024, (const bf16_t*)(F.ws + WS_WE), nMp * 256, 7168, 1024, (size_t)7168 * 1024 * 2};
    pg8::MoeOrder S; S.init(nMp, 28, F.G, (int)blockIdx.x, pm_lo, TILE + 64);
    pg8::EpiSwiGLU E{(bf16_t*)(F.ws + WS_ACTM), EFF, nullptr};
    pg8::gemm_phase<pg8::EpiSwiGLU, pg8::MoeOrder, true, true>(F.lds + RING_OFF, g, S, E, F.tid);
}
__device__ __forceinline__ void p_moe_gemm2(Frame& F, int pass) {
    RELAUNDER(F);
    const int* TILE = (const int*)(F.ws + WS_MT + MT_TILE);
    const int MT = __builtin_amdgcn_readfirstlane(TILE[0]), pm_lo = pass * MOE_PASS_TILES; int nMp = MT - pm_lo; nMp = nMp < 0 ? 0 : (nMp > MOE_PASS_TILES ? MOE_PASS_TILES : nMp);
    pg8::Gemm g{(const bf16_t*)(F.ws + WS_ACTM), (const bf16_t*)(F.ws + WS_WE + WE_D), nMp * 256, 1024, EFF, (size_t)1024 * EFF * 2};
    pg8::MoeOrder S; S.init(nMp, 4, F.G, (int)blockIdx.x, pm_lo, TILE + 64);
    pg8::EpiMoeDown E{(bf16_t*)F.out, (const int*)(F.ws + WS_MT + MT_ROWINFO) + pm_lo * 256, (const float*)(F.ws + WS_MT + MT_ROWG) + pm_lo * 256};
    pg8::gemm_phase<pg8::EpiMoeDown, pg8::MoeOrder, true, true>(F.lds + RING_OFF, g, S, E, F.tid);
}
__device__ __forceinline__ void p_final(Frame& F, bool moe) {
    RELAUNDER(F);
    const int gw = F.vcu * NWAVES + F.wave, NGW = F.G * NWAVES;
    const float* X = (const float*)(F.ws + WS_X); const float* gn = F.in[39];
    for (int tok = gw; tok < NTOK; tok += NGW) {
        f32x4_t s[4]; float q = 0.f;
#pragma unroll
        for (int j = 0; j < 4; ++j) {
            const int col = F.lane * 4 + 256 * j;
            f32x4_t v = *(const f32x4_t*)(X + (size_t)tok * D_ + col);
            if (moe) {
                const u32x2_t a = *(const u32x2_t*)((const bf16_t*)F.out + (size_t)tok * 2048 + col), b = *(const u32x2_t*)((const bf16_t*)F.out + (size_t)tok * 2048 + 1024 + col);
                v.x += __uint_as_float(a.x << 16) + __uint_as_float(b.x << 16); v.y += __uint_as_float(a.x & 0xffff0000u) + __uint_as_float(b.x & 0xffff0000u);
                v.z += __uint_as_float(a.y << 16) + __uint_as_float(b.y << 16); v.w += __uint_as_float(a.y & 0xffff0000u) + __uint_as_float(b.y & 0xffff0000u);
            }
            s[j] = v; q += (v.x * v.x + v.y * v.y) + (v.z * v.z + v.w * v.w);
        }
        q = wave_sum_l(q, F.lane);
        const float rinv = 1.0f / sqrtf(q * (1.0f / 1024.0f) + 1e-6f);
#pragma unroll
        for (int j = 0; j < 4; ++j) {
            const int col = F.lane * 4 + 256 * j;
            const f32x4_t gv = *(const f32x4_t*)(gn + col);
            *(f32x4_t*)(F.out + (size_t)tok * D_ + col) = s[j] * rinv * gv;
        }
    }
}


constexpr size_t S_KCB = S_BON + 512 * 1024;
constexpr size_t S_VCB = S_KCB + 256 * 1024;
static_assert(S_VCB + 256 * 1024 <= S_END, "scratch map");
namespace nsa {
typedef short bf16x8 __attribute__((ext_vector_type(8)));
typedef short s16x4 __attribute__((ext_vector_type(4)));
typedef float f32x16 __attribute__((ext_vector_type(16)));
typedef float f32x4 __attribute__((ext_vector_type(4)));
constexpr float LOG2E = 1.4426950408889634f;
__device__ __forceinline__ int crow(int r, int hi) { return (r & 3) + 8 * (r >> 2) + 4 * hi; }
__device__ __forceinline__ unsigned cvtpk(float lo, float hi) { unsigned r; asm volatile("v_cvt_pk_bf16_f32 %0, %1, %2" : "=v"(r) : "v"(lo), "v"(hi)); return r; }
constexpr int L_KB = 0, L_VB = 16384, L_WSF = 32768, L_IMPQ = 36864, L_IMPL = L_IMPQ + 4 * 64 * 33 * 4, L_IMPF = L_IMPL + 4 * 64 * 33 * 4, L_SELM = L_IMPF + 64 * 33 * 4, L_MISC = L_SELM + 256, L_LIST = L_MISC + 16, L_END = L_LIST + 64 * 4;
static_assert(L_END <= 131072, "NSA LDS map");

__device__ __forceinline__ void qkt(f32x16& p0, f32x16& p1, const LAS unsigned char* Kslot, const bf16x8* qr, int r32, int hi) {
    const LAS unsigned char* kb = Kslot + hi * 1024 + r32 * 16;
    p0 = (f32x16){}; p1 = (f32x16){};
#pragma unroll
    for (int d0 = 0; d0 < 4; ++d0) {
        const bf16x8 b0 = *(const LAS bf16x8*)(kb + d0 * 2048);
        const bf16x8 b1 = *(const LAS bf16x8*)(kb + d0 * 2048 + 512);
        p0 = __builtin_amdgcn_mfma_f32_32x32x16_bf16(b0, qr[d0], p0, 0, 0, 0);
        p1 = __builtin_amdgcn_mfma_f32_32x32x16_bf16(b1, qr[d0], p1, 0, 0, 0);
    }
}
__device__ __forceinline__ void pv(f32x16* o, int vb, bf16x8 pa0, bf16x8 pa1, bf16x8 pa2, bf16x8 pa3) {
#pragma unroll
    for (int d0 = 0; d0 < 2; ++d0) {
        s16x4 lo[4], hi[4];
#pragma unroll
        for (int ks = 0; ks < 4; ++ks) {
            asm volatile("ds_read_b64_tr_b16 %0,%1 offset:%c2" : "=&v"(lo[ks]) : "v"(vb), "i"(d0 * 4096 + ks * 1024) : "memory");
            asm volatile("ds_read_b64_tr_b16 %0,%1 offset:%c2" : "=&v"(hi[ks]) : "v"(vb), "i"(d0 * 4096 + ks * 1024 + 512) : "memory");
        }
        asm volatile("s_waitcnt lgkmcnt(0)" ::: "memory"); __builtin_amdgcn_sched_barrier(0);
#define NSA_PK(k) (bf16x8){lo[k][0], lo[k][1], lo[k][2], lo[k][3], hi[k][0], hi[k][1], hi[k][2], hi[k][3]}
        o[d0] = __builtin_amdgcn_mfma_f32_32x32x16_bf16(pa0, NSA_PK(0), o[d0], 0, 0, 0);
        o[d0] = __builtin_amdgcn_mfma_f32_32x32x16_bf16(pa1, NSA_PK(1), o[d0], 0, 0, 0);
        o[d0] = __builtin_amdgcn_mfma_f32_32x32x16_bf16(pa2, NSA_PK(2), o[d0], 0, 0, 0);
        o[d0] = __builtin_amdgcn_mfma_f32_32x32x16_bf16(pa3, NSA_PK(3), o[d0], 0, 0, 0);
#undef NSA_PK
    }
}
__device__ __forceinline__ float swap_max(float m) { auto rr = __builtin_amdgcn_permlane32_swap(__float_as_uint(m), __float_as_uint(m), false, false); return fmaxf(__uint_as_float(rr[0]), __uint_as_float(rr[1])); }
__device__ __forceinline__ float swap_sum(float m) { auto rr = __builtin_amdgcn_permlane32_swap(__float_as_uint(m), __float_as_uint(m), false, false); return __uint_as_float(rr[0]) + __uint_as_float(rr[1]); }
__device__ __forceinline__ void pack_p(const f32x16& p0, const f32x16& p1, bf16x8& a0, bf16x8& a1, bf16x8& a2, bf16x8& a3) {
    u32x4_t w0, w1, w2, w3;
    w0.x = cvtpk(p0[0], p0[1]); w0.y = cvtpk(p0[2], p0[3]); w0.z = cvtpk(p0[4], p0[5]); w0.w = cvtpk(p0[6], p0[7]);
    w1.x = cvtpk(p0[8], p0[9]); w1.y = cvtpk(p0[10], p0[11]); w1.z = cvtpk(p0[12], p0[13]); w1.w = cvtpk(p0[14], p0[15]);
    w2.x = cvtpk(p1[0], p1[1]); w2.y = cvtpk(p1[2], p1[3]); w2.z = cvtpk(p1[4], p1[5]); w2.w = cvtpk(p1[6], p1[7]);
    w3.x = cvtpk(p1[8], p1[9]); w3.y = cvtpk(p1[10], p1[11]); w3.z = cvtpk(p1[12], p1[13]); w3.w = cvtpk(p1[14], p1[15]);
    a0 = __builtin_bit_cast(bf16x8, w0); a1 = __builtin_bit_cast(bf16x8, w1); a2 = __builtin_bit_cast(bf16x8, w2); a3 = __builtin_bit_cast(bf16x8, w3);
}
__device__ __forceinline__ void scale_o(f32x16* o, float fac, LAS float* wsf, int r32, int hi) {
    if (hi == 0) wsf[r32] = fac;
    asm volatile("s_waitcnt lgkmcnt(0)" ::: "memory");
#pragma unroll
    for (int r = 0; r < 16; ++r) { const float f = wsf[crow(r, hi)]; o[0][r] *= f; o[1][r] *= f; }
}
__device__ __forceinline__ void axpy_o(f32x16* out, const f32x16* o, float fac, LAS float* wsf, int r32, int hi) {
    if (hi == 0) wsf[32 + r32] = fac;
    asm volatile("s_waitcnt lgkmcnt(0)" ::: "memory");
#pragma unroll
    for (int r = 0; r < 16; ++r) { const float f = wsf[32 + crow(r, hi)]; out[0][r] += f * o[0][r]; out[1][r] += f * o[1][r]; }
}
}

__device__ __forceinline__ void p_nsa_cmp(Frame& F, int l) {
    RELAUNDER(F);
    const int n_rw = l == 0 ? 1792 : 1824;
    const bf16_t* P = (const bf16_t*)(F.ws + WS_S + S_PROJ);
    LAS bf16_t* Hs = (LAS bf16_t*)F.lds;
    const int w = F.wave, fr = F.lane & 15, fq = F.lane >> 4;
    for (int item = F.vcu; item < 256; item += F.G) {
        const int kv = item >> 7, b = (item >> 4) & 7, g = (item >> 3) & 1, ch = item & 7;
        const int colbase = n_rw + 512 + kv * 128 + g * 64;
        const bf16_t* W1T = (const bf16_t*)(F.ws + WS_WB + WB_CW1) + (size_t)(l * 2 + kv) * 128 * 2048;
        const bf16_t* W2T = (const bf16_t*)(F.ws + WS_WB + WB_CW2) + (size_t)(l * 2 + kv) * 64 * 128;
        const float* cb = (const float*)(F.ws + WS_WB + WB_CB) + (l * 2 + kv) * 128;
        const int n = ch * 16 + fr, nc = n < NCMP ? n : NCMP - 1;
        const bf16_t* arow = P + ((size_t)b * T_ + 16 * nc) * NPJ + colbase;
        const bf16_t* brow = W1T + (size_t)(16 * w + fr) * 2048;
        pg8::f32x4 acc = {0.f, 0.f, 0.f, 0.f};
#pragma unroll 8
        for (int ks = 0; ks < 64; ++ks) {
            const int k0 = ks * 32 + fq * 8;
            const nsa::bf16x8 a = *(const nsa::bf16x8*)(arow + (size_t)(k0 >> 6) * NPJ + (k0 & 63));
            const nsa::bf16x8 bw = *(const nsa::bf16x8*)(brow + k0);
            acc = __builtin_amdgcn_mfma_f32_16x16x32_bf16(a, bw, acc, 0, 0, 0);
        }
        __syncthreads();
        const float bias = cb[16 * w + fr];
#pragma unroll
        for (int r = 0; r < 4; ++r) {
            const float x = acc[r] + bias;
            const float ge = 0.5f * x * (1.f + tanhf(0.7978845608028654f * (x + 0.044715f * x * x * x)));
            Hs[(4 * fq + r) * 136 + 16 * w + fr] = (bf16_t)f2bf(ge);
        }
        __syncthreads();
        if (w < 4) {
            pg8::f32x4 acc2 = {0.f, 0.f, 0.f, 0.f};
#pragma unroll
            for (int ks = 0; ks < 4; ++ks) {
                const nsa::bf16x8 a = *(const LAS nsa::bf16x8*)(Hs + fr * 136 + ks * 32 + fq * 8);
                const nsa::bf16x8 bw = *(const nsa::bf16x8*)(W2T + (size_t)(16 * w + fr) * 128 + ks * 32 + fq * 8);
                acc2 = __builtin_amdgcn_mfma_f32_16x16x32_bf16(a, bw, acc2, 0, 0, 0);
            }
            bf16_t* dst = (bf16_t*)(F.ws + WS_S + (kv == 0 ? S_KCB : S_VCB)) + ((size_t)(b * 2 + g) * 128) * 64;
#pragma unroll
            for (int r = 0; r < 4; ++r) { const int nn = ch * 16 + 4 * fq + r; dst[(size_t)nn * 64 + 16 * w + fr] = (bf16_t)f2bf(nn < NCMP ? acc2[r] : 0.f); }
        }
    }
}

__device__ __forceinline__ void nsa_item(Frame& F, const bf16_t* P, int n_rw, int b, int g, int c) {
    using namespace nsa;
    int tidl = F.tid; asm volatile("" : "+v"(tidl));
    const int lanel = tidl & 63;
    const int w = __builtin_amdgcn_readfirstlane(tidl >> 6), rh = w >> 1, th = w & 1, r32 = lanel & 31, hi = lanel >> 5;
    const int t0 = c * 64, tq = t0 + th * 32 + r32;
    const int hq = g * 4 + rh;
    const float slope2 = exp2f(-(float)(hq + 1)) * LOG2E;
    const size_t tokrow = (size_t)b * T_ + tq;
    LAS unsigned char* L = F.lds;
    LAS float* wsf = (LAS float*)(L + L_WSF) + w * 64;
    LAS float* IMPQ = (LAS float*)(L + L_IMPQ); LAS float* IMPL = (LAS float*)(L + L_IMPL); LAS float* IMPF = (LAS float*)(L + L_IMPF);
    LAS unsigned* SELM = (LAS unsigned*)(L + L_SELM); LAS int* MISCL = (LAS int*)(L + L_MISC); LAS int* LIST = (LAS int*)(L + L_LIST);
    const unsigned lds0 = (unsigned)(uintptr_t)L;
    const int vboff = ((lanel >> 4) & 1) * 32 + (lanel & 3) * 8 + (4 * hi + ((lanel & 15) >> 2)) * 64;
    bf16x8 qr[4];
    {
        const bf16_t* qp = P + tokrow * NPJ + n_rw + g * 256 + rh * 64 + hi * 8;
#pragma unroll
        for (int d0 = 0; d0 < 4; ++d0) {
            const u32x4_t raw = *(const u32x4_t*)(qp + d0 * 16); u32x4_t sc;
#pragma unroll
            for (int e = 0; e < 4; ++e) sc[e] = cvtpk(__uint_as_float(raw[e] << 16) * (0.125f * LOG2E), __uint_as_float(raw[e] & 0xffff0000u) * (0.125f * LOG2E));
            qr[d0] = __builtin_bit_cast(bf16x8, sc);
        }
    }
    const bf16_t* gp = P + tokrow * NPJ + n_rw + 1280 + hq * 3;
    const float gate0 = sigmoidf_(bf2f(gp[0])), gate1 = sigmoidf_(bf2f(gp[1])), gate2 = sigmoidf_(bf2f(gp[2]));
    f32x16 out[2]; out[0] = (f32x16){}; out[1] = (f32x16){};
    const int lk_key = tidl & 63, lk_c8 = tidl >> 6, lv_key = tidl >> 3, lv_p = tidl & 7;
    const int lk_dst = lk_c8 * 1024 + lk_key * 16, lv_dst = (lv_p >> 2) * 4096 + lv_key * 64 + (lv_p & 3) * 16;
    const int lv_src = (lv_p >> 2) * 32 + (lv_p & 3) * 8;
    __syncthreads();
    {
        const bf16_t* KCB = (const bf16_t*)(F.ws + WS_S + S_KCB) + ((size_t)(b * 2 + g) * 128) * 64;
        const bf16_t* VCB = (const bf16_t*)(F.ws + WS_S + S_VCB) + ((size_t)(b * 2 + g) * 128) * 64;
#pragma unroll
        for (int jt = 0; jt < 2; ++jt) {
            *(LAS u32x4_t*)(L + L_KB + jt * 8192 + lk_dst) = *(const u32x4_t*)(KCB + (size_t)(jt * 64 + lk_key) * 64 + lk_c8 * 8);
            *(LAS u32x4_t*)(L + L_VB + jt * 8192 + lv_dst) = *(const u32x4_t*)(VCB + (size_t)(jt * 64 + lv_key) * 64 + lv_src);
        }
        __syncthreads();
        f32x16 s0a, s0b, s1a, s1b;
        qkt(s0a, s0b, L + L_KB, qr, r32, hi);
        qkt(s1a, s1b, L + L_KB + 8192, qr, r32, hi);
        float m = -INFINITY;
#pragma unroll
        for (int r = 0; r < 16; ++r) {
            const int key = crow(r, hi);
#define CMP_MASK(S, nn) { const int n_ = (nn); const int dist_ = tq - (16 * n_ + 31); const bool ok_ = (n_ < NCMP) && (dist_ >= 0); S[r] = ok_ ? S[r] - slope2 * (float)dist_ : -INFINITY; m = fmaxf(m, S[r]); }
            CMP_MASK(s0a, key) CMP_MASK(s0b, key + 32) CMP_MASK(s1a, 64 + key) CMP_MASK(s1b, 96 + key)
#undef CMP_MASK
        }
        m = swap_max(m);
        if (m == -INFINITY) m = 0.f;
        float lsum = 0.f;
#pragma unroll
        for (int r = 0; r < 16; ++r) { s0a[r] = __builtin_amdgcn_exp2f(s0a[r] - m); s0b[r] = __builtin_amdgcn_exp2f(s0b[r] - m); s1a[r] = __builtin_amdgcn_exp2f(s1a[r] - m); s1b[r] = __builtin_amdgcn_exp2f(s1b[r] - m); lsum += (s0a[r] + s0b[r]) + (s1a[r] + s1b[r]); }
        lsum = swap_sum(lsum);
        const float inv = lsum > 0.f ? 1.0f / lsum : 0.f;
#pragma unroll
        for (int r = 0; r < 16; ++r) { s0a[r] *= inv; s0b[r] *= inv; s1a[r] *= inv; s1b[r] *= inv; }
        {
            LAS float* iq = IMPQ + (rh * 64 + th * 32 + r32) * 33; LAS float* il = IMPL + (rh * 64 + th * 32 + r32) * 33;
#pragma unroll
            for (int rq = 0; rq < 4; ++rq) {
#define IMP_Q(S, Qb) { const int Q_ = (Qb) + 2 * rq + hi; iq[Q_] = (S[4 * rq] + S[4 * rq + 1]) + (S[4 * rq + 2] + S[4 * rq + 3]); il[Q_] = S[4 * rq + 3]; }
                IMP_Q(s0a, 0) IMP_Q(s0b, 8) IMP_Q(s1a, 16) IMP_Q(s1b, 24)
#undef IMP_Q
            }
        }
        bf16x8 a0, a1, a2, a3;
        pack_p(s0a, s0b, a0, a1, a2, a3); pv(out, (int)(lds0 + L_VB) + vboff, a0, a1, a2, a3);
        pack_p(s1a, s1b, a0, a1, a2, a3); pv(out, (int)(lds0 + L_VB + 8192) + vboff, a0, a1, a2, a3);
        scale_o(out, gate0, wsf, r32, hi);
    }
    __syncthreads();
    for (int idx = tidl; idx < 64 * 32; idx += NWAVES * 64) {
        const int tokl = idx >> 5, j = idx & 31; float s = 0.f;
#pragma unroll
        for (int h4 = 0; h4 < 4; ++h4) { s += IMPQ[(h4 * 64 + tokl) * 33 + j]; if (j > 0) s += IMPL[(h4 * 64 + tokl) * 33 + j - 1]; }
        IMPF[tokl * 33 + j] = s;
    }
    __syncthreads();
#pragma unroll 1
    for (int pass = 0; pass < 4; ++pass) {
        const int tokl = pass * 16 + (tidl >> 5), j = tidl & 31;
        bool sel;
        if (c < 16) sel = (j <= c);
        else {
            const float mine = IMPF[tokl * 33 + j]; int rank = 0;
            for (int jj = 1; jj <= c - 2; ++jj) { const float o2 = IMPF[tokl * 33 + jj]; rank += (o2 > mine || (o2 == mine && jj < j)) ? 1 : 0; }
            sel = (j == 0) || (j == c) || (j == c - 1) || (j >= 1 && j <= c - 2 && rank < 13);
        }
        const unsigned long long bal = __ballot(sel);
        if ((lanel & 31) == 0) SELM[tokl] = (lanel == 0) ? (unsigned)(bal & 0xffffffffull) : (unsigned)(bal >> 32);
    }
    __syncthreads();
    if (tidl < 64) {
        unsigned um = SELM[tidl];
#pragma unroll
        for (int o = 1; o < 64; o <<= 1) um |= (unsigned)__builtin_amdgcn_ds_bpermute((lanel ^ o) << 2, (int)um);
        if (tidl == 0) {
            int n = 0;
            const int jlo = c - 8 > 0 ? c - 8 : 0;
            for (int j = jlo; j <= c; ++j) LIST[n++] = (1 << 8) | j;
            for (int j = 0; j <= c; ++j) if ((um >> j) & 1u) LIST[n++] = (0 << 8) | j;
            MISCL[0] = n;
        }
    }
    __syncthreads();
    const int ntl = MISCL[0];
    const unsigned selq = SELM[th * 32 + r32];
    {
        const bf16_t* Pb = P + (size_t)b * T_ * NPJ;
        u32x4_t kreg, vreg;
#define TILE_LOAD(ent) do { const int ty_ = (ent) >> 8, j_ = (ent) & 255; const int kc_ = n_rw + 512 + (ty_ ? 4 : 2) * 128 + g * 64; \
        kreg = *(const u32x4_t*)(Pb + (size_t)(j_ * 64 + lk_key) * NPJ + kc_ + lk_c8 * 8); vreg = *(const u32x4_t*)(Pb + (size_t)(j_ * 64 + lv_key) * NPJ + kc_ + 128 + lv_src); } while (0)
#define TILE_STORE(buf) do { *(LAS u32x4_t*)(L + L_KB + (buf) * 8192 + lk_dst) = kreg; *(LAS u32x4_t*)(L + L_VB + (buf) * 8192 + lv_dst) = vreg; } while (0)
        TILE_LOAD(LIST[0]); TILE_STORE(0);
        __syncthreads();
        float m = -1e30f, lp = 0.f; f32x16 o[2]; o[0] = (f32x16){}; o[1] = (f32x16){};
        int curty = 1;
        for (int i = 0; i < ntl; ++i) {
            const int ent = LIST[i], ty = ent >> 8, j = ent & 255, buf = i & 1;
            if (i + 1 < ntl) TILE_LOAD(LIST[i + 1]);
            if (ty != curty) {
                const float lt = swap_sum(lp);
                axpy_o(out, o, gate2 / fmaxf(lt, 1e-30f), wsf, r32, hi);
                m = -1e30f; lp = 0.f; o[0] = (f32x16){}; o[1] = (f32x16){}; curty = ty;
            }
            f32x16 p0, p1;
            qkt(p0, p1, L + L_KB + buf * 8192, qr, r32, hi);
            const bool rowok = ty ? true : (((selq >> j) & 1u) != 0u);
            float rm = -INFINITY;
#pragma unroll
            for (int r = 0; r < 16; ++r) {
                const int d0_ = tq - (j * 64 + crow(r, hi)), d1_ = d0_ - 32;
                const bool ok0 = rowok && d0_ >= 0 && (ty == 0 || d0_ < 512), ok1 = rowok && d1_ >= 0 && (ty == 0 || d1_ < 512);
                p0[r] = ok0 ? p0[r] - slope2 * (float)d0_ : -INFINITY; p1[r] = ok1 ? p1[r] - slope2 * (float)d1_ : -INFINITY;
                rm = fmaxf(rm, fmaxf(p0[r], p1[r]));
            }
            rm = swap_max(rm);
            const float mn = fmaxf(m, rm);
            const float alpha = __builtin_amdgcn_exp2f(m - mn);
            m = mn;
            float ps = 0.f;
#pragma unroll
            for (int r = 0; r < 16; ++r) { p0[r] = __builtin_amdgcn_exp2f(p0[r] - mn); p1[r] = __builtin_amdgcn_exp2f(p1[r] - mn); ps += p0[r] + p1[r]; }
            lp = lp * alpha + ps;
            if (__any(alpha != 1.0f)) scale_o(o, alpha, wsf, r32, hi);
            bf16x8 a0, a1, a2, a3;
            pack_p(p0, p1, a0, a1, a2, a3);
            pv(o, (int)(lds0 + L_VB + buf * 8192) + vboff, a0, a1, a2, a3);
            if (i + 1 < ntl) TILE_STORE(buf ^ 1);
            __syncthreads();
        }
        {
            const float lt = swap_sum(lp);
            axpy_o(out, o, (curty ? gate2 : gate1) / fmaxf(lt, 1e-30f), wsf, r32, hi);
        }
#undef TILE_LOAD
#undef TILE_STORE
    }
    {
        bf16_t* CC = (bf16_t*)(F.ws + WS_S + S_CONCAT) + ((size_t)b * T_ + t0 + th * 32) * D_ + 512 + g * 256 + rh * 64 + r32;
#pragma unroll
        for (int r = 0; r < 16; ++r) {
            bf16_t* rowp = CC + (size_t)crow(r, hi) * D_;
            rowp[0] = (bf16_t)f2bf(out[0][r]); rowp[32] = (bf16_t)f2bf(out[1][r]);
        }
    }
}
__device__ __forceinline__ void p_nsa_attn(Frame& F, int l) {
    RELAUNDER(F);
    const int n_rw = l == 0 ? 1792 : 1824;
    const bf16_t* P = (const bf16_t*)(F.ws + WS_S + S_PROJ);
    for (int v = F.vcu; v < 256; v += F.G) {
        const int bg = v >> 4, s = v & 15;
#pragma unroll 1
        for (int half = 0; half < 2; ++half) nsa_item(F, P, n_rw, bg >> 1, bg & 1, half == 0 ? 31 - s : s);
    }
}

namespace xat {
constexpr int L_P = 0, PPITCH = 264, L_PMAX = 64 * PPITCH * 2, L_PSUM = L_PMAX + 8 * 64 * 4, L_LINV = L_PSUM + 8 * 64 * 4;
constexpr float QSCALE = 0.0625f * 1.4426950408889634f;
}
__device__ __forceinline__ void cross_item(Frame& F, const bf16_t* QC, const bf16_t* KCR, const bf16_t* VT, bf16_t* OC, int b, int h, int t0) {
    using namespace nsa;
    int tidl = F.tid; asm volatile("" : "+v"(tidl));
    const int lanel = tidl & 63, w = __builtin_amdgcn_readfirstlane(tidl >> 6), r32 = lanel & 31, hi = lanel >> 5;
    LAS unsigned char* L = F.lds;
    LAS bf16_t* Pl = (LAS bf16_t*)(L + xat::L_P); LAS float* PMAX = (LAS float*)(L + xat::L_PMAX); LAS float* PSUM = (LAS float*)(L + xat::L_PSUM); LAS float* LINV = (LAS float*)(L + xat::L_LINV);
    f32x16 s[2];
    {
        const bf16_t* kp = KCR + ((size_t)b * MEM_ + 32 * w + r32) * 1024 + h * 256 + hi * 8;
        bf16x8 kf[16];
#pragma unroll
        for (int d0 = 0; d0 < 16; ++d0) kf[d0] = *(const bf16x8*)(kp + d0 * 16);
#pragma unroll
        for (int qs = 0; qs < 2; ++qs) {
            const bf16_t* qp = QC + ((size_t)b * T_ + t0 + qs * 32 + r32) * 1024 + h * 256 + hi * 8;
            s[qs] = (f32x16){};
#pragma unroll
            for (int d0 = 0; d0 < 16; ++d0) { const bf16x8 qf = *(const bf16x8*)(qp + d0 * 16); s[qs] = __builtin_amdgcn_mfma_f32_32x32x16_bf16(kf[d0], qf, s[qs], 0, 0, 0); }
        }
    }
#pragma unroll
    for (int qs = 0; qs < 2; ++qs) {
        float pm = s[qs][0];
#pragma unroll
        for (int r = 1; r < 16; ++r) pm = fmaxf(pm, s[qs][r]);
        pm = swap_max(pm);
        if (hi == 0) PMAX[w * 64 + qs * 32 + r32] = pm;
    }
    __syncthreads();
#pragma unroll
    for (int qs = 0; qs < 2; ++qs) {
        float m = PMAX[qs * 32 + r32];
#pragma unroll
        for (int ww = 1; ww < 8; ++ww) m = fmaxf(m, PMAX[ww * 64 + qs * 32 + r32]);
        float ps = 0.f;
#pragma unroll
        for (int r = 0; r < 16; ++r) { s[qs][r] = __builtin_amdgcn_exp2f(s[qs][r] - m); ps += s[qs][r]; }
        ps = swap_sum(ps);
        if (hi == 0) PSUM[w * 64 + qs * 32 + r32] = ps;
#pragma unroll
        for (int rq = 0; rq < 4; ++rq) {
            u32x2_t pk; pk.x = cvtpk(s[qs][4 * rq], s[qs][4 * rq + 1]); pk.y = cvtpk(s[qs][4 * rq + 2], s[qs][4 * rq + 3]);
            *(LAS u32x2_t*)(Pl + (qs * 32 + r32) * xat::PPITCH + 32 * w + 8 * rq + 4 * hi) = pk;
        }
    }
    __syncthreads();
    if (tidl < 64) { float t = 0.f;
#pragma unroll
        for (int ww = 0; ww < 8; ++ww) t += PSUM[ww * 64 + tidl];
        LINV[tidl] = 1.0f / t; }
    f32x16 o[2]; o[0] = (f32x16){}; o[1] = (f32x16){};
    {
        const bf16_t* vp = VT + ((size_t)(h * 256 + 32 * w + r32)) * NMEM + b * MEM_ + hi * 8;
        bf16x8 vf[16];
#pragma unroll
        for (int ks = 0; ks < 16; ++ks) vf[ks] = *(const bf16x8*)(vp + ks * 16);
#pragma unroll
        for (int qs = 0; qs < 2; ++qs)
#pragma unroll
            for (int ks = 0; ks < 16; ++ks) {
                const bf16x8 pf = *(const LAS bf16x8*)(Pl + (qs * 32 + r32) * xat::PPITCH + ks * 16 + hi * 8);
                o[qs] = __builtin_amdgcn_mfma_f32_32x32x16_bf16(pf, vf[ks], o[qs], 0, 0, 0);
            }
    }
    __syncthreads();
#pragma unroll
    for (int qs = 0; qs < 2; ++qs) {
        bf16_t* op = OC + ((size_t)b * T_ + t0 + qs * 32) * 1024 + h * 256 + 32 * w + r32;
#pragma unroll
        for (int r = 0; r < 16; ++r) { const int q = crow(r, hi); op[(size_t)q * 1024] = (bf16_t)f2bf(o[qs][r] * LINV[qs * 32 + q]); }
    }
}
__device__ __forceinline__ void p_cross_attn(Frame& F, int l) {
    RELAUNDER(F);
    const bf16_t* QC = (const bf16_t*)(F.ws + WS_S + S_QC); bf16_t* OC = (bf16_t*)(F.ws + WS_S + S_OC);
    const bf16_t* KCR = (const bf16_t*)(F.ws + WS_KCR) + (size_t)l * NMEM * 1024; const bf16_t* VT = (const bf16_t*)(F.ws + WS_VT) + (size_t)l * 1024 * NMEM;
    for (int grp = F.vcu; grp < 256; grp += F.G) {
#pragma unroll 1
        for (int i = 0; i < 4; ++i) { const int item = grp * 4 + i, bh = item >> 5, qt = item & 31; cross_item(F, QC, KCR, VT, OC, bh >> 2, bh & 3, qt * 64); }
    }
}
__global__ void __launch_bounds__(NWAVES * 64, 2) mega(Args args) {
    extern __shared__ __attribute__((aligned(16))) unsigned char lds[];
    {
        LAS unsigned char* l3 = (LAS unsigned char*)lds;
        for (int u = threadIdx.x; u < (LDS_BYTES - LDSCTL_OFF) / 4; u += NWAVES * 64) ((LAS unsigned*)(l3 + LDSCTL_OFF))[u] = 0u;
    }
    __syncthreads();
    {
        const int ph = args.ph[0];
        Frame F;
        { unsigned char* w = args.ws; asm volatile("" : "+s"(w)); F.ws = w; }
        { int t = threadIdx.x; asm volatile("" : "+v"(t)); F.tid = t; }
        F.lds = (LAS unsigned char*)lds;
        F.MISC = (volatile LAS unsigned*)(F.lds + MISC_OFF);
        F.lane = F.tid & 63; F.wave = __builtin_amdgcn_readfirstlane(F.tid >> 6);
        F.G = gridDim.x; { const int bx = blockIdx.x; F.vcu = (F.G % 8 == 0) ? (bx % 8) * (F.G / 8) + bx / 8 : bx; }
        F.in = args.in; F.out = args.out;
        if (ph == 0) p_prologue(F);
        else if (ph == 1) p_kv(F);
        else if (ph == 10 || ph == 11) p_inproj(F, ph - 10);
        else if (ph == 20 || ph == 21) p_rw_prep(F, ph - 20);
        else if (ph == 25 || ph == 26) p_nsa_cmp(F, ph - 25);
        else if (ph == 30 || ph == 31) p_rw_scan(F);
        else if (ph == 45 || ph == 46) p_nsa_attn(F, ph - 45);
        else if (ph == 40 || ph == 41) p_rw_post(F, ph - 40);
        else if (ph == 50 || ph == 51) p_resid_gemm(F, (const bf16_t*)(F.ws + WS_S + S_CONCAT), (const bf16_t*)(F.ws + WS_WB + WB_WOUT) + (size_t)(ph - 50) * D_ * D_, 1024);
        else if (ph == 60 || ph == 61) p_crossq(F, ph - 60);
        else if (ph == 70 || ph == 71) p_cross_attn(F, ph - 70);
        else if (ph == 80 || ph == 81) p_resid_gemm(F, (const bf16_t*)(F.ws + WS_S + S_OC), (const bf16_t*)(F.ws + WS_WB + WB_WO) + (size_t)(ph - 80) * D_ * D_, 1024);
        else if (ph == 90) p_ffn_up(F);
        else if (ph == 100) p_route(F);
        else if (ph == 101) p_moe_prep(F);
        else if (ph == 102 || ph == 104) p_moe_gemm1(F, (ph - 102) >> 1);
        else if (ph == 103 || ph == 105) p_moe_gemm2(F, (ph - 103) >> 1);
        else if (ph == 110) p_final(F, true);
        else if (ph == 91) p_resid_gemm(F, (const bf16_t*)(F.ws + WS_S + S_ACT), (const bf16_t*)(F.ws + WS_WB + WB_WD), FFD);
        __syncthreads();
    }
}

namespace v0 {
constexpr int B = B_, T = T_, D = D_, W = W_, H = H_, DH = DH_, MEM = MEM_;
constexpr int ECAP = 8192;
__global__ void k_rmsnorm(const float* __restrict__ x, const float* __restrict__ g, float* __restrict__ out, int rows) {
    const int wave = (blockIdx.x * blockDim.x + threadIdx.x) >> 6, lane = threadIdx.x & 63;
    if (wave >= rows) return;
    const float* xr = x + (size_t)wave * D;
    float v[16]; float s = 0.f;
#pragma unroll
    for (int i = 0; i < 16; ++i) { v[i] = xr[lane + 64 * i]; s += v[i] * v[i]; }
    s = wave_sum(s);
    const float rinv = rsqrtf(s * (1.f / D) + 1e-6f);
#pragma unroll
    for (int i = 0; i < 16; ++i) out[(size_t)wave * D + lane + 64 * i] = v[i] * rinv * g[lane + 64 * i];
}

template <int MODE, bool GATHER>
__global__ void __launch_bounds__(256) k_gemm(const float* __restrict__ A, int lda, const int* __restrict__ rowidx, const int* __restrict__ Mdev, int M,
                                               const float* __restrict__ Wt, const float* __restrict__ W2, int ldw, float* __restrict__ C, int ldc, int N, int K,
                                               const float* __restrict__ scale) {
    if (Mdev) { M = *Mdev; if (M > ECAP) M = ECAP; }
    const int m0 = blockIdx.y * 64, n0 = blockIdx.x * 64;
    if (m0 >= M) return;
    __shared__ float As[16][65];
    __shared__ float Bs[16][65];
    __shared__ float B2s[(MODE == 2) ? 16 : 1][65];
    const int tid = threadIdx.x, tx = tid & 15, ty = tid >> 4;
    float acc[4][4] = {}; float acc2[4][4] = {};
    for (int k0 = 0; k0 < K; k0 += 16) {
        for (int i = tid; i < 64 * 16; i += 256) {
            const int r = i >> 4, kk = i & 15; const int m = m0 + r;
            float v = 0.f;
            if (m < M) { const int ar = GATHER ? rowidx[m] : m; v = A[(size_t)ar * lda + k0 + kk]; }
            As[kk][r] = v;
        }
        for (int i = tid; i < 16 * 64; i += 256) {
            const int kk = i >> 6, c = i & 63; const int n = n0 + c;
            Bs[kk][c] = (n < N) ? Wt[(size_t)(k0 + kk) * ldw + n] : 0.f;
            if (MODE == 2) B2s[kk][c] = (n < N) ? W2[(size_t)(k0 + kk) * ldw + n] : 0.f;
        }
        __syncthreads();
#pragma unroll
        for (int kk = 0; kk < 16; ++kk) {
            float a[4], b[4], b2[4];
#pragma unroll
            for (int i = 0; i < 4; ++i) a[i] = As[kk][ty * 4 + i];
#pragma unroll
            for (int j = 0; j < 4; ++j) { b[j] = Bs[kk][tx * 4 + j]; if (MODE == 2) b2[j] = B2s[kk][tx * 4 + j]; }
#pragma unroll
            for (int i = 0; i < 4; ++i)
#pragma unroll
                for (int j = 0; j < 4; ++j) { acc[i][j] += a[i] * b[j]; if (MODE == 2) acc2[i][j] += a[i] * b2[j]; }
        }
        __syncthreads();
    }
#pragma unroll
    for (int i = 0; i < 4; ++i) {
        const int m = m0 + ty * 4 + i; if (m >= M) continue;
#pragma unroll
        for (int j = 0; j < 4; ++j) {
            const int n = n0 + tx * 4 + j; if (n >= N) continue;
            if (MODE == 0) C[(size_t)m * ldc + n] = acc[i][j];
            else if (MODE == 1) C[(size_t)m * ldc + n] += acc[i][j];
            else if (MODE == 2) { const float gte = acc[i][j]; C[(size_t)m * ldc + n] = gte * sigmoidf_(gte) * acc2[i][j]; }
            else { const int orow = rowidx[m]; C[(size_t)orow * ldc + n] += scale[m] * acc[i][j]; }
        }
    }
}

struct RwPar {
    const float *mu, *w0, *w2, *a0, *a2, *g2, *k_k, *k_a, *v0, *v2;
};
template <class TP>
__global__ void __launch_bounds__(512) k_rw_prep(const TP* __restrict__ proj, int ncols, int n_rw, RwPar p, int layer,
                                                 float* __restrict__ DEC, float* __restrict__ AIC, float* __restrict__ VP, float* __restrict__ G, float* __restrict__ VFIRST) {
    const int tok = blockIdx.x, t = tok % T, c = threadIdx.x;
    __shared__ float lo[288];
    const TP* cur = proj + (size_t)tok * ncols;
    const TP* prv = cur - ncols;
    if (c < n_rw - 1536) {
        const int col = 1536 + c;
        const float u = ldf(cur, col), up = (t > 0) ? ldf(prv, col) : 0.f;
        float v = u + (up - u) * p.mu[col];
        if (c < 64) v = tanhf(v);
        else if (c >= 128 && c < 256) v = sigmoidf_(v);
        lo[c] = v;
    }
    __syncthreads();
    float wr = p.w0[c], ar = p.a0[c], gr = 0.f;
#pragma unroll 4
    for (int j = 0; j < 64; ++j) { wr += lo[j] * p.w2[j * W + c]; ar += lo[64 + j] * p.a2[j * W + c]; }
#pragma unroll 4
    for (int j = 0; j < 128; ++j) gr += lo[128 + j] * p.g2[j * W + c];
    const float sp = (-wr > 20.f) ? -wr : log1pf(__expf(-wr));
    const float w = -sp - 0.5f;
    DEC[(size_t)tok * W + c] = __expf(-__expf(w));
    AIC[(size_t)tok * W + c] = sigmoidf_(ar);
    G[(size_t)tok * W + c] = gr;
    {
        const int col = 1024 + c;
        const float u = ldf(cur, col), up = (t > 0) ? ldf(prv, col) : 0.f;
        float v = u + (up - u) * p.mu[col];
        if (layer == 0) { VFIRST[(size_t)tok * W + c] = v; }
        else {
            float vr = p.v0[c];
#pragma unroll 4
            for (int j = 0; j < 32; ++j) vr += lo[256 + j] * p.v2[j * W + c];
            const float vf = VFIRST[(size_t)tok * W + c];
            v = v + (vf - v) * sigmoidf_(vr);
        }
        VP[(size_t)tok * W + c] = v;
    }
}

template <class TP>
__global__ void __launch_bounds__(64) k_rw_scan(const TP* __restrict__ proj, int ncols, const float* __restrict__ mu, const float* __restrict__ k_k, const float* __restrict__ k_a,
                                                const float* __restrict__ r_k,
                                                const float* __restrict__ DEC, const float* __restrict__ AIC, const float* __restrict__ VP,
                                                float* __restrict__ Y, float* __restrict__ BON) {
    const int b = blockIdx.x / H, h = blockIdx.x % H, j = threadIdx.x, c = h * DH + j;
    __shared__ float sr[64], sw[64], sk[64], sa[64], sb[64];
    float S[64];
#pragma unroll
    for (int i = 0; i < 64; ++i) S[i] = 0.f;
    const float mur = mu[c], muk = mu[W + c], kkc = k_k[c], kac = k_a[c], rkc = r_k[c];
    float pr = 0.f, pk = 0.f;
    for (int t = 0; t < T; ++t) {
        const size_t tok = (size_t)b * T + t;
        const TP* cur = proj + tok * ncols;
        const float ur = ldf(cur, c), uk = ldf(cur, W + c);
        const float r = ur + (pr - ur) * mur, k = uk + (pk - uk) * muk;
        pr = ur; pk = uk;
        const float a = AIC[tok * W + c], dec = DEC[tok * W + c], v = VP[tok * W + c];
        float kk = k * kkc;
        const float nrm = sqrtf(wave_sum(kk * kk));
        kk = kk / fmaxf(nrm, 1e-12f);
        const float kh = k * (1.f + (a - 1.f) * kac);
        const float bon = wave_sum(r * kh * rkc);
        __syncthreads();
        sr[j] = r; sw[j] = dec; sk[j] = kh; sa[j] = -kk; sb[j] = kk * a;
        __syncthreads();
        float Sa = 0.f;
#pragma unroll
        for (int q = 0; q < 64; ++q) Sa += S[q] * sa[q];
        float y = 0.f;
#pragma unroll
        for (int q = 0; q < 64; ++q) { S[q] = S[q] * sw[q] + Sa * sb[q] + v * sk[q]; y += S[q] * sr[q]; }
        Y[tok * W + c] = y;
        if (j == 0) BON[tok * H + h] = bon;
    }
}

template <class TC>
__global__ void k_rw_post(const float* __restrict__ Y, const float* __restrict__ BON, const float* __restrict__ VP, const float* __restrict__ G, const float* __restrict__ ln_w, const float* __restrict__ ln_b,
                          TC* __restrict__ concat) {
    const int wid = (blockIdx.x * blockDim.x + threadIdx.x) >> 6, lane = threadIdx.x & 63;
    if (wid >= NTOK * H) return;
    const int tok = wid / H, h = wid % H, c = h * DH + lane;
    const float y = Y[(size_t)tok * W + c];
    const float mean = wave_sum(y) * (1.f / 64.f);
    const float d = y - mean;
    const float var = wave_sum(d * d) * (1.f / 64.f);
    const float yn = d * rsqrtf(var + 64e-5f) * ln_w[c] + ln_b[c];
    stf(concat, (size_t)tok * D + c, (yn + BON[(size_t)tok * H + h] * VP[(size_t)tok * W + c]) * G[(size_t)tok * W + c]);
}

template <class TP>
__global__ void __launch_bounds__(128) k_cmp_hidden(const TP* __restrict__ proj, int ncols, int colbase  , const float* __restrict__ pe,
                                                    const float* __restrict__ w1, float* __restrict__ hid) {
    const int row = blockIdx.x, n = row % NCMP, g = (row / NCMP) % 2, b = row / (NCMP * 2);
    __shared__ float blk[2048];
    for (int i = threadIdx.x; i < 2048; i += 128) {
        const int l = i >> 6, d = i & 63;
        blk[i] = ldf(proj, ((size_t)b * T + 16 * n + l) * ncols + colbase + g * 64 + d) + pe[i];
    }
    __syncthreads();
    float acc = 0.f;
    for (int k = 0; k < 2048; ++k) acc += blk[k] * w1[(size_t)k * 128 + threadIdx.x];
    const float x = acc;
    const float ge = 0.5f * x * (1.f + tanhf(0.7978845608028654f * (x + 0.044715f * x * x * x)));
    hid[(size_t)row * 128 + threadIdx.x] = ge;
}
__global__ void __launch_bounds__(64) k_cmp_out(const float* __restrict__ hid, const float* __restrict__ w2, float* __restrict__ out  ) {
    const int row = blockIdx.x, n = row % NCMP, bg = row / NCMP;
    float acc = 0.f;
    for (int k = 0; k < 128; ++k) acc += hid[(size_t)row * 128 + k] * w2[k * 64 + threadIdx.x];
    out[((size_t)bg * 128 + n) * 64 + threadIdx.x] = acc;
}

template <class TP, class TC>
__global__ void __launch_bounds__(512) k_nsa_attn(const TP* __restrict__ proj, int ncols, int n_rw, const float* __restrict__ KC, const float* __restrict__ VC, TC* __restrict__ concat) {
    const int tok = blockIdx.x, b = tok / T, t = tok % T;
    const int wave = threadIdx.x >> 6, lane = threadIdx.x & 63, g = wave >> 2, r = wave & 3, hq = wave;
    const TP* cols = proj + (size_t)tok * ncols + n_rw;
    __shared__ float qs[8][64];
    __shared__ float ps[8][128];
    __shared__ float imp[2][32];
    __shared__ unsigned selm[2];
    __shared__ float pbuf[8][64];
    const float slope = exp2f(-(float)(hq + 1));
    const float q = ldf(cols, g * 256 + r * 64 + lane) * 0.125f;
    qs[wave][lane] = q;
    const float gate0 = sigmoidf_(ldf(cols, 1280 + hq * 3 + 0)), gate1 = sigmoidf_(ldf(cols, 1280 + hq * 3 + 1)), gate2 = sigmoidf_(ldf(cols, 1280 + hq * 3 + 2));
    __syncthreads();
    float out = 0.f;
    {
        const float* kc = KC + ((size_t)(b * 2 + g) * 128) * 64;
        const float* vc = VC + ((size_t)(b * 2 + g) * 128) * 64;
        float s[2]; bool ok[2];
#pragma unroll
        for (int u = 0; u < 2; ++u) {
            const int n = lane + 64 * u;
            ok[u] = (n < NCMP) && (16 * n + 31 <= t);
            float acc = 0.f;
            if (ok[u]) { for (int d = 0; d < 64; ++d) acc += qs[wave][d] * kc[n * 64 + d]; acc -= slope * (float)(t - (16 * n + 31)); }
            s[u] = ok[u] ? acc : -1e30f;
        }
        const float m = wave_max(fmaxf(s[0], s[1]));
        float p0 = ok[0] ? __expf(s[0] - m) : 0.f, p1 = ok[1] ? __expf(s[1] - m) : 0.f;
        const float l = wave_sum(p0 + p1);
        const float inv = 1.f / fmaxf(l, 1e-30f);
        p0 *= inv; p1 *= inv;
        ps[wave][lane] = p0; ps[wave][lane + 64] = p1;
        __syncthreads();
        float o = 0.f;
        for (int n = 0; n < NCMP; ++n) o += ps[wave][n] * vc[n * 64 + lane];
        out += gate0 * o;
        if (threadIdx.x < 64) {
            const int g2 = threadIdx.x >> 5, j = threadIdx.x & 31;
            float acc = 0.f;
            for (int rr = 0; rr < 4; ++rr)
                for (int n = 4 * j - 1; n <= 4 * j + 3; ++n) if (n >= 0 && n < NCMP) acc += ps[g2 * 4 + rr][n];
            const int curb = t >> 6;
            if (j == 0 || j == curb || j == curb - 1) acc = 1e4f;
            if (j > curb) acc = -1.f;
            imp[g2][j] = acc;
        }
        __syncthreads();
        if (threadIdx.x < 64) {
            const int g2 = threadIdx.x >> 5, j = threadIdx.x & 31;
            const float mine = imp[g2][j]; int rank = 0;
            for (int jj = 0; jj < 32; ++jj) { const float o2 = imp[g2][jj]; rank += (o2 > mine || (o2 == mine && jj < j)) ? 1 : 0; }
            const unsigned long long bal = __ballot(rank < 16);
            if (j == 0) selm[g2] = (unsigned)(g2 == 0 ? (bal & 0xffffffffull) : (bal >> 32));
        }
        __syncthreads();
    }
    for (int br = 0; br < 2; ++br) {
        const int kcol = n_rw + 512 + (br == 0 ? 2 : 4) * 128 + g * 64, vcol = kcol + 128;
        const float gate = br == 0 ? gate1 : gate2;
        const unsigned mask = selm[g];
        float m = -1e30f, l = 0.f, o = 0.f;
        const int curb = t >> 6;
        const int jlo = (br == 0) ? 0 : ((curb - 8 > 0) ? curb - 8 : 0);
        for (int j = jlo; j <= curb; ++j) {
            if (br == 0 && !((mask >> j) & 1u)) continue;
            const int pos = j * 64 + lane;
            const int dist = t - pos;
            const bool ok = (dist >= 0) && (br == 0 || dist < 512);
            float sc = -1e30f;
            if (ok) {
                const TP* kr = proj + ((size_t)b * T + pos) * ncols + kcol;
                float acc = 0.f;
                for (int d = 0; d < 64; ++d) acc += qs[wave][d] * ldf(kr, d);
                sc = acc - slope * (float)dist;
            }
            const float mt = wave_max(sc);
            const float mn = fmaxf(m, mt);
            const float alpha = __expf(m - mn);
            const float p = ok ? __expf(sc - mn) : 0.f;
            l = l * alpha + wave_sum(p);
            pbuf[wave][lane] = p;
            __builtin_amdgcn_wave_barrier();
            float acc = 0.f;
            const int kmax = (t - j * 64 + 1 < 64) ? (t - j * 64 + 1) : 64;
            for (int kk = 0; kk < kmax; ++kk) acc += pbuf[wave][kk] * ldf(proj, ((size_t)b * T + j * 64 + kk) * ncols + vcol + lane);
            __builtin_amdgcn_wave_barrier();
            o = o * alpha + acc;
            m = mn;
        }
        out += gate * o / fmaxf(l, 1e-30f);
    }
    stf(concat, (size_t)tok * D + 512 + g * 256 + r * 64 + lane, out);
}

__global__ void __launch_bounds__(256) k_cross_attn(const bf16_t* __restrict__ Q, const bf16_t* __restrict__ Kc, const bf16_t* __restrict__ VT, bf16_t* __restrict__ O) {
    const int wid = (blockIdx.x * blockDim.x + threadIdx.x) >> 6, lane = threadIdx.x & 63;
    const int tok = wid >> 2, h = wid & 3, b = tok / T;
    float q[4];
    for (int i = 0; i < 4; ++i) q[i] = ldf(Q, (size_t)tok * D + h * 256 + lane * 4 + i);
    float s[4];
    for (int u = 0; u < 4; ++u) s[u] = 0.f;
    for (int key = 0; key < MEM; ++key) {
        const bf16_t* kr = Kc + ((size_t)b * MEM + key) * 1024 + h * 256 + lane * 4;
        float d = q[0] * bf2f(kr[0]) + q[1] * bf2f(kr[1]) + q[2] * bf2f(kr[2]) + q[3] * bf2f(kr[3]);
        d = wave_sum(d) * 0.0625f;
        if ((key & 63) == lane) s[key >> 6] = d;
    }
    float m = fmaxf(fmaxf(s[0], s[1]), fmaxf(s[2], s[3]));
    m = wave_max(m);
    float p[4], l = 0.f;
    for (int u = 0; u < 4; ++u) { p[u] = __expf(s[u] - m); l += p[u]; }
    l = wave_sum(l);
    float o[4] = {0.f, 0.f, 0.f, 0.f};
    for (int key = 0; key < MEM; ++key) {
        const float pk = __shfl(p[key >> 6], key & 63);
        for (int i = 0; i < 4; ++i) o[i] += pk * bf2f(VT[(size_t)(h * 256 + lane * 4 + i) * NMEM + b * MEM + key]);
    }
    const float inv = 1.f / l;
    for (int i = 0; i < 4; ++i) stf(O, (size_t)tok * D + h * 256 + lane * 4 + i, o[i] * inv);
}

__global__ void k_route(const float* __restrict__ Hn, const float* __restrict__ wr, int* __restrict__ top_e, float* __restrict__ top_g) {
    const int wid = (blockIdx.x * blockDim.x + threadIdx.x) >> 6, lane = threadIdx.x & 63;
    if (wid >= NTOK) return;
    float acc[8] = {};
    for (int i = 0; i < 16; ++i) {
        const int k = lane + 64 * i; const float hv = Hn[(size_t)wid * D + k];
#pragma unroll
        for (int e = 0; e < 8; ++e) acc[e] += hv * wr[k * 8 + e];
    }
#pragma unroll
    for (int e = 0; e < 8; ++e) acc[e] = wave_sum(acc[e]);
    if (lane == 0) {
        int e0 = 0; for (int e = 1; e < 8; ++e) if (acc[e] > acc[e0]) e0 = e;
        int e1 = -1; for (int e = 0; e < 8; ++e) if (e != e0 && (e1 < 0 || acc[e] > acc[e1])) e1 = e;
        const float m = acc[e0]; const float p0 = 1.f, p1 = __expf(acc[e1] - m); const float inv = 1.f / (p0 + p1);
        top_e[wid * 2] = e0; top_e[wid * 2 + 1] = e1; top_g[wid * 2] = p0 * inv; top_g[wid * 2 + 1] = p1 * inv;
    }
}
__global__ void __launch_bounds__(64) k_lists(const int* __restrict__ top_e, const float* __restrict__ top_g, int* __restrict__ list, float* __restrict__ lgate, int* __restrict__ counts) {
    const int e = blockIdx.x, lane = threadIdx.x; int cnt = 0;
    for (int t0 = 0; t0 < NTOK; t0 += 64) {
        const int tok = t0 + lane; int k = -1;
        if (top_e[tok * 2] == e) k = 0; else if (top_e[tok * 2 + 1] == e) k = 1;
        const unsigned long long bal = __ballot(k >= 0);
        if (k >= 0) { const int pos = cnt + __popcll(bal & ((1ull << lane) - 1ull)); if (pos < ECAP) { list[e * NTOK + pos] = tok; lgate[e * NTOK + pos] = top_g[tok * 2 + k]; } }
        cnt += __popcll(bal);
    }
    if (lane == 0) counts[e] = cnt;
}

__global__ void k_xb_ssq(const float* __restrict__ X, bf16_t* __restrict__ XB, float* __restrict__ SSQ) {
    const int m = (blockIdx.x * blockDim.x + threadIdx.x) >> 6, lane = threadIdx.x & 63;
    if (m >= NTOK) return;
    float s = 0.f;
    for (int i = 0; i < 16; ++i) { const float v = X[(size_t)m * D + lane + 64 * i]; s += v * v; XB[(size_t)m * D + lane + 64 * i] = (bf16_t)f2bf(v); }
    s = wave_sum(s);
    if (lane < 16) SSQ[(size_t)m * 16 + lane] = lane == 0 ? s : 0.f;
}
}

static int g_grid = 0;
static void launch_mega(const Args& base, std::initializer_list<int> phs, hipStream_t stream) {
    Args a = base; a.nph = 0;
    for (int p : phs) a.ph[a.nph++] = p;
    hipLaunchKernelGGL(mega, dim3(g_grid), dim3(NWAVES * 64), LDS_BYTES, stream, a);
}

extern "C" void kernel_launch(void* const* d_in, const int* in_sizes, int n_in, void* d_out, int out_size, void* d_ws, size_t ws_size, hipStream_t stream) {
    using namespace v0;
    if (g_grid == 0) {
        int dev = 0, cus = 0;
        if (hipGetDevice(&dev) != hipSuccess || hipDeviceGetAttribute(&cus, hipDeviceAttributeMultiprocessorCount, dev) != hipSuccess) { g_grid = -1; return; }
        if (hipFuncSetAttribute((const void*)mega, hipFuncAttributeMaxDynamicSharedMemorySize, LDS_BYTES) != hipSuccess) { fprintf(stderr, "kernel_launch: hipFuncSetAttribute failed\n"); g_grid = -1; return; }
        (void)hipGetLastError();
        g_grid = cus;
    }
    if (g_grid < 0) return;
    const float* in[40];
    for (int i = 0; i < 40; ++i) in[i] = (const float*)d_in[i];
    unsigned char* wsb = (unsigned char*)d_ws;
    Args base{};
    for (int i = 0; i < 40; ++i) base.in[i] = in[i];
    base.out = (float*)d_out; base.ws = wsb;

    float* X = (float*)(wsb + WS_X);
    bf16_t* XB = (bf16_t*)(wsb + WS_XB);
    float* SSQ = (float*)(wsb + WS_SSQ);
    bf16_t* PROJ = (bf16_t*)(wsb + WS_S);
    size_t off = (WS_S + S_END + 1 * MiB) / 4;
    float* ws = (float*)d_ws;
    auto take = [&](size_t nfl) { float* p = ws + off; off += (nfl + 63) & ~(size_t)63; return p; };
    float* KC = take((size_t)B * 2 * 128 * 64);
    float* VC = take((size_t)B * 2 * 128 * 64);
    float* HID = take((size_t)B * 2 * NCMP * 128);
    if (off * 4 < WS_MOE_END) off = WS_MOE_END / 4;
    if (off * 4 > ws_size) { fprintf(stderr, "kernel_launch: workspace too small: need %zu have %zu\n", off * 4, ws_size); return; }

    hipMemsetAsync(wsb + WS_CTL, 0, 1 * MiB, stream);
    launch_mega(base, {0}, stream);
    launch_mega(base, {1}, stream);
    bf16_t* CONCATB = (bf16_t*)(wsb + WS_S + S_CONCAT);

    for (int layer = 0; layer < 2; ++layer) {
        const int ncols = layer == 0 ? 3096 : 3128;
        const int n_rw = ncols - NSA_COLS;
        launch_mega(base, {10 + layer}, stream);
        launch_mega(base, {20 + layer}, stream);
        launch_mega(base, {30 + layer}, stream);
        launch_mega(base, {40 + layer}, stream);
        launch_mega(base, {25 + layer}, stream);
        launch_mega(base, {45 + layer}, stream);
        launch_mega(base, {50 + layer}, stream);
        launch_mega(base, {60 + layer}, stream);
        launch_mega(base, {70 + layer}, stream);
        launch_mega(base, {80 + layer}, stream);
        if (layer == 0) {
            launch_mega(base, {90}, stream);
            launch_mega(base, {91}, stream);
        } else {
            launch_mega(base, {100}, stream);
            launch_mega(base, {101}, stream);
            launch_mega(base, {102}, stream);
            launch_mega(base, {103}, stream);
            launch_mega(base, {104}, stream);
            launch_mega(base, {105}, stream);
        }
    }
    launch_mega(base, {110}, stream);
}
```

```cpp
#include <hip/hip_runtime.h>
#include <cstdint>
#include <cstdio>
#include <initializer_list>

constexpr int B_ = 8, T_ = 2048, D_ = 1024, NTOK = B_ * T_, MEM_ = 256, NMEM = B_ * MEM_;
constexpr int W_ = 512, H_ = 8, DH_ = 64;
constexpr int NSA_COLS = 1304, NCMP = 127;
constexpr int FFD = 2816, NEXP = 8, EFF = 3584;
constexpr int NPJ = 3328;

typedef unsigned short bf16_t;
typedef float f32x4_t __attribute__((ext_vector_type(4)));
typedef unsigned u32x4_t __attribute__((ext_vector_type(4)));
typedef unsigned u32x2_t __attribute__((ext_vector_type(2)));
#define LAS __attribute__((address_space(3)))

__device__ __forceinline__ float bf2f(bf16_t v) { return __uint_as_float(((unsigned)v) << 16); }
__device__ __forceinline__ unsigned f2bf(float f) { unsigned u = __float_as_uint(f); return (u + 0x7fffu + ((u >> 16) & 1u)) >> 16; }
__device__ __forceinline__ unsigned pk2(float lo, float hi) { return f2bf(lo) | (f2bf(hi) << 16); }
__device__ __forceinline__ float ldf(const float* p, size_t i) { return p[i]; }
__device__ __forceinline__ float ldf(const bf16_t* p, size_t i) { return bf2f(p[i]); }
__device__ __forceinline__ void stf(float* p, size_t i, float v) { p[i] = v; }
__device__ __forceinline__ void stf(bf16_t* p, size_t i, float v) { p[i] = (bf16_t)f2bf(v); }

__device__ __forceinline__ float wave_sum(float v) {
#pragma unroll
    for (int o = 1; o < 64; o <<= 1) v += __shfl_xor(v, o);
    return v;
}
__device__ __forceinline__ float wave_max(float v) {
#pragma unroll
    for (int o = 1; o < 64; o <<= 1) v = fmaxf(v, __shfl_xor(v, o));
    return v;
}
__device__ __forceinline__ float shx(float v, int lane, int m) { return __int_as_float(__builtin_amdgcn_ds_bpermute((lane ^ m) << 2, __float_as_int(v))); }
__device__ __forceinline__ float wave_sum_l(float v, int lane) {
#pragma unroll
    for (int o = 1; o < 64; o <<= 1) v += shx(v, lane, o);
    return v;
}
__device__ __forceinline__ float wave_max_l(float v, int lane) {
#pragma unroll
    for (int o = 1; o < 64; o <<= 1) v = fmaxf(v, shx(v, lane, o));
    return v;
}
__device__ __forceinline__ float sigmoidf_(float x) { return 1.f / (1.f + __expf(-x)); }

constexpr size_t MiB = (size_t)1 << 20;
constexpr size_t WS_CTL = 0;
constexpr size_t WS_MRINV = 512 * 1024;
constexpr size_t WS_X = 1 * MiB;
constexpr size_t WS_XB = WS_X + 64 * MiB;
constexpr size_t WS_SSQ = WS_XB + 32 * MiB;
constexpr size_t WS_WB = WS_SSQ + 1 * MiB;
constexpr size_t WS_MEMB = WS_WB + 54 * MiB;
constexpr size_t WS_KCR = WS_MEMB + 4 * MiB;
constexpr size_t WS_VT = WS_KCR + 8 * MiB;
constexpr size_t WS_VFIRST = WS_VT + 8 * MiB;
constexpr size_t WS_S = WS_VFIRST + 16 * MiB;
constexpr size_t WB_WIN = 0;
constexpr size_t WB_WOUT = WB_WIN + 2 * (size_t)NPJ * 1024 * 2;
constexpr size_t WB_WQ = WB_WOUT + 2 * 2 * MiB;
constexpr size_t WB_WK = WB_WQ + 2 * 2 * MiB;
constexpr size_t WB_WV = WB_WK + 2 * 2 * MiB;
constexpr size_t WB_WO = WB_WV + 2 * 2 * MiB;
constexpr size_t WB_WGU = WB_WO + 2 * 2 * MiB;
constexpr size_t WB_WD = WB_WGU + (size_t)2 * FFD * 1024 * 2;
constexpr size_t WB_LORA = WB_WD + (size_t)FFD * 1024 * 2;
constexpr size_t WB_CW1 = WB_LORA + 2 * 512 * 288 * 2;
constexpr size_t WB_CW2 = WB_CW1 + 4 * 128 * 2048 * 2;
constexpr size_t WB_CB = WB_CW2 + 4 * 64 * 128 * 2;
constexpr size_t WB_END = WB_CB + 4 * 128 * 4;
static_assert(WB_END <= 54 * MiB, "weight map");
constexpr size_t WS_WE = WS_WB;
constexpr size_t WE_D = (size_t)8 * 7168 * 1024 * 2;
constexpr size_t WS_XG = WS_WE + 168 * MiB;
constexpr int MOE_PASS_TILES = 68;
constexpr size_t WS_ACTM = WS_XG + 68 * MiB;
constexpr size_t WS_MT = WS_ACTM + 119 * MiB;
constexpr size_t MT_INV = 0;
constexpr size_t MT_ROWINFO = 512 * 1024;
constexpr size_t MT_ROWG = 768 * 1024;
constexpr size_t MT_TOKG = 1024 * 1024;
constexpr size_t MT_TILE = 1280 * 1024;
constexpr size_t WS_MOE_END = WS_MT + 2 * MiB;
constexpr size_t CTL_CNT = 64 * 1024;
namespace pg8 {
#define PG8_LAS __attribute__((address_space(3)))
typedef unsigned short bf16_t;
typedef short bf16x8 __attribute__((ext_vector_type(8)));
typedef float f32x4 __attribute__((ext_vector_type(4)));
typedef unsigned u32x4 __attribute__((ext_vector_type(4)));
constexpr int BM = 256, BK = 64, HALF = 128, HTB = HALF * BK * 2  , STAGE_BYTES = 8 * HTB, NXCD = 8, WGM = 8;

__host__ __device__ __forceinline__ int lds_byte(int r, int c) { const int st = (r >> 4) * 2 + (c >> 5), rr = r & 15, cc = c & 31, ob = rr * 64 + cc * 2; return st * 1024 + (ob ^ (((ob >> 9) & 1) << 5)); }
__host__ __device__ __forceinline__ void stage_rc(int b, int& R, int& C) { const int st = b / 1024, sb = b % 1024, swz = sb ^ (((sb >> 9) & 1) << 5); R = (st >> 1) * 16 + swz / 64; C = (st & 1) * 32 + (swz % 64) / 2; }
__host__ __device__ __forceinline__ int perm32(int rho) { const int n = rho >> 4, i = rho & 15; return 8 * (i >> 2) + 4 * n + (i & 3); }

struct Unit { int pm, pn, e, ord; };
struct Gemm { const bf16_t* A; const bf16_t* Bt; int M, N, K; size_t bstride; };

struct StaticOrder {
    int nM, nN, nwg, G, c;
    __host__ __device__ void init(int M, int N, int G_, int c_) { nM = M / BM; nN = N / BM; nwg = nM * nN; G = G_; c = c_; }
    __host__ __device__ bool next(int i, Unit& u) const {
        const long L = (long)i * G + c; if (L >= nwg) return false;
        int wgid = (int)L; { const int q = nwg / NXCD, r = nwg % NXCD, xcd = wgid % NXCD, off = wgid / NXCD; wgid = (xcd < r ? xcd * (q + 1) : r * (q + 1) + (xcd - r) * q) + off; }
        const int nig = WGM * nN, gid = wgid / nig, fm = gid * WGM, gsz = (nM - fm) < WGM ? (nM - fm) : WGM;
        u.pm = fm + ((wgid % nig) % gsz); u.pn = (wgid % nig) / gsz; u.e = 0; u.ord = i; return true;
    }
    __device__ __forceinline__ void a_ready(const Unit&) const {}
    __device__ __forceinline__ void done(const Unit&) const {}
};


__device__ __forceinline__ unsigned cvt_pk_bf16(float lo, float hi) { unsigned r; asm volatile("v_cvt_pk_bf16_f32 %0, %1, %2" : "=v"(r) : "v"(lo), "v"(hi)); return r; }
__device__ __forceinline__ float row_rinv(const float* ssq, int row) {
    const f32x4* p = (const f32x4*)(ssq + (size_t)row * 16);
    const f32x4 a = p[0], b = p[1], c = p[2], d = p[3];
    const float s = ((a[0] + a[1]) + (a[2] + a[3])) + ((b[0] + b[1]) + (b[2] + b[3])) + ((c[0] + c[1]) + (c[2] + c[3])) + ((d[0] + d[1]) + (d[2] + d[3]));
    return 1.0f / sqrtf(s * (1.0f / 1024.0f) + 1e-6f);
}
struct EpiRowScaleBf16 {
    static constexpr bool PERM = true, AFTER_DRAIN = false;
    bf16_t* O; int ldc; const PG8_LAS float* rtab; float mul;
    __device__ __forceinline__ void operator()(const f32x4 (&acc)[2][2][4][2], const Unit& u, int wr, int wc, int fr, int fq) const {
        const int row0 = u.pm * BM + wr * 64 + fr, col0 = u.pn * BM + wc * 32 + 8 * fq;
#pragma unroll
        for (int ai = 0; ai < 2; ++ai)
#pragma unroll
            for (int m = 0; m < 4; ++m) {
                const int row = row0 + ai * HALF + m * 16;
                const float rs = (rtab ? rtab[u.ord * 256 + (row - u.pm * BM)] : 1.0f) * mul;
                bf16_t* rowp = O + (size_t)row * ldc + col0;
#pragma unroll
                for (int bj = 0; bj < 2; ++bj) {
                    const f32x4 v0 = acc[ai][bj][m][0] * rs, v1 = acc[ai][bj][m][1] * rs;
                    u32x4 w; w.x = cvt_pk_bf16(v0[0], v0[1]); w.y = cvt_pk_bf16(v0[2], v0[3]); w.z = cvt_pk_bf16(v1[0], v1[1]); w.w = cvt_pk_bf16(v1[2], v1[3]);
                    *(u32x4*)(rowp + bj * HALF) = w;
                }
            }
    }
};
struct EpiColScaleBf16 {
    static constexpr bool PERM = true, AFTER_DRAIN = false;
    bf16_t* O; int ldc; const float* cs;
    __device__ __forceinline__ void operator()(const f32x4 (&acc)[2][2][4][2], const Unit& u, int wr, int wc, int fr, int fq) const {
        const int row0 = u.pm * BM + wr * 64 + fr, col0 = u.pn * BM + wc * 32 + 8 * fq;
        f32x4 sc[2][2];
#pragma unroll
        for (int bj = 0; bj < 2; ++bj)
#pragma unroll
            for (int n = 0; n < 2; ++n) sc[bj][n] = *(const f32x4*)(cs + col0 + bj * HALF + 4 * n);
#pragma unroll
        for (int ai = 0; ai < 2; ++ai)
#pragma unroll
            for (int m = 0; m < 4; ++m) {
                bf16_t* rowp = O + (size_t)(row0 + ai * HALF + m * 16) * ldc + col0;
#pragma unroll
                for (int bj = 0; bj < 2; ++bj) {
                    const f32x4 v0 = acc[ai][bj][m][0] * sc[bj][0], v1 = acc[ai][bj][m][1] * sc[bj][1];
                    u32x4 w; w.x = cvt_pk_bf16(v0[0], v0[1]); w.y = cvt_pk_bf16(v0[2], v0[3]); w.z = cvt_pk_bf16(v1[0], v1[1]); w.w = cvt_pk_bf16(v1[2], v1[3]);
                    *(u32x4*)(rowp + bj * HALF) = w;
                }
            }
    }
};
struct EpiResid {
    static constexpr bool PERM = false, AFTER_DRAIN = false;
    float* X; bf16_t* XB; float* ssq;
    __device__ __forceinline__ void operator()(const f32x4 (&acc)[2][2][4][2], const Unit& u, int wr, int wc, int fr, int fq) const {
        const int row0 = u.pm * BM + wr * 64 + fr, col0 = u.pn * BM + wc * 32 + 4 * fq;
#pragma unroll
        for (int ai = 0; ai < 2; ++ai)
#pragma unroll
            for (int m = 0; m < 4; ++m) {
                const int row = row0 + ai * HALF + m * 16;
                float* xr = X + (size_t)row * 1024 + col0; bf16_t* br = XB + (size_t)row * 1024 + col0;
                float q = 0.f;
#pragma unroll
                for (int bj = 0; bj < 2; ++bj)
#pragma unroll
                    for (int n = 0; n < 2; ++n) {
                        f32x4 x = *(const f32x4*)(xr + bj * HALF + n * 16);
                        x = x + acc[ai][bj][m][n];
                        *(f32x4*)(xr + bj * HALF + n * 16) = x;
                        q += (x[0] * x[0] + x[1] * x[1]) + (x[2] * x[2] + x[3] * x[3]);
                        typedef unsigned u32x2v __attribute__((ext_vector_type(2)));
                        u32x2v w; w.x = cvt_pk_bf16(x[0], x[1]); w.y = cvt_pk_bf16(x[2], x[3]);
                        *(u32x2v*)(br + bj * HALF + n * 16) = w;
                    }
                q += shx(q, fq * 16 + fr, 16); q += shx(q, fq * 16 + fr, 32);
                if (fq == 0) ssq[(size_t)row * 16 + u.pn * 4 + wc] = q;
                asm volatile("" ::: "memory");
            }
    }
};
struct EpiSwiGLU {
    static constexpr bool PERM = true, AFTER_DRAIN = false;
    bf16_t* O; int ldc; const PG8_LAS float* rtab;
    __device__ __forceinline__ void operator()(const f32x4 (&acc)[2][2][4][2], const Unit& u, int wr, int wc, int fr, int fq) const {
        const int row0 = u.pm * BM + wr * 64 + fr, col0 = u.pn * HALF + wc * 32 + 8 * fq;
#pragma unroll
        for (int ai = 0; ai < 2; ++ai)
#pragma unroll
            for (int m = 0; m < 4; ++m) {
                const int row = row0 + ai * HALF + m * 16;
                const float rs = rtab ? rtab[u.ord * 256 + (row - u.pm * BM)] : 1.0f;
                float o[8];
#pragma unroll
                for (int n = 0; n < 2; ++n)
#pragma unroll
                    for (int e = 0; e < 4; ++e) {
                        const float gg = acc[ai][0][m][n][e] * rs, uu = acc[ai][1][m][n][e] * rs;
                        o[n * 4 + e] = gg / (1.0f + __expf(-gg)) * uu;
                    }
                u32x4 w; w.x = cvt_pk_bf16(o[0], o[1]); w.y = cvt_pk_bf16(o[2], o[3]); w.z = cvt_pk_bf16(o[4], o[5]); w.w = cvt_pk_bf16(o[6], o[7]);
                *(u32x4*)(O + (size_t)row * ldc + col0) = w;
            }
    }
};

struct EpiMoeDown {
    static constexpr bool PERM = true, AFTER_DRAIN = false;
    bf16_t* Y2; const int* rinfo; const float* rg;
    __device__ __forceinline__ void operator()(const f32x4 (&acc)[2][2][4][2], const Unit& u, int wr, int wc, int fr, int fq) const {
        const int row0 = u.pm * BM + wr * 64 + fr, col0 = u.pn * BM + wc * 32 + 8 * fq;
#pragma unroll
        for (int ai = 0; ai < 2; ++ai)
#pragma unroll
            for (int m = 0; m < 4; ++m) {
                const int row = row0 + ai * HALF + m * 16;
                const int t2 = rinfo[row];
                if (t2 >= 0) {
                    const float gte = rg[row];
                    bf16_t* rowp = Y2 + (size_t)t2 * 1024 + col0;
#pragma unroll
                    for (int bj = 0; bj < 2; ++bj) {
                        const f32x4 v0 = acc[ai][bj][m][0] * gte, v1 = acc[ai][bj][m][1] * gte;
                        u32x4 w; w.x = cvt_pk_bf16(v0[0], v0[1]); w.y = cvt_pk_bf16(v0[2], v0[3]); w.z = cvt_pk_bf16(v1[0], v1[1]); w.w = cvt_pk_bf16(v1[2], v1[3]);
                        *(u32x4*)(rowp + bj * HALF) = w;
                    }
                }
                asm volatile("" ::: "memory");
            }
    }
};
struct MoeOrder {
    int nM, nN, nwg, G, c, pm_lo; const int* tile_e;
    __device__ void init(int nM_, int nN_, int G_, int c_, int pm_lo_, const int* te) { nM = nM_; nN = nN_; nwg = nM * nN; G = G_; c = c_; pm_lo = pm_lo_; tile_e = te; }
    __device__ bool next(int i, Unit& u) const {
        const long L = (long)i * G + c; if (L >= nwg) return false;
        int wgid = (int)L; { const int q = nwg / NXCD, r = nwg % NXCD, xcd = wgid % NXCD, off = wgid / NXCD; wgid = (xcd < r ? xcd * (q + 1) : r * (q + 1) + (xcd - r) * q) + off; }
        const int nig = WGM * nN, gid = wgid / nig, fm = gid * WGM, gsz = (nM - fm) < WGM ? (nM - fm) : WGM;
        u.pm = fm + ((wgid % nig) % gsz); u.pn = (wgid % nig) / gsz; u.e = __builtin_amdgcn_readfirstlane(tile_e[pm_lo + u.pm]); u.ord = i; return true;
    }
    __device__ __forceinline__ void a_ready(const Unit&) const {}
    __device__ __forceinline__ void done(const Unit&) const {}
};
template <class Epi, class Sched, bool ALIGN_EPI = false, bool SP2 = false>
__device__ __forceinline__ void gemm_phase(PG8_LAS unsigned char* lds, const Gemm g, const Sched& S, const Epi& E, const int tid_in) {
    const int tid = tid_in, wid = __builtin_amdgcn_readfirstlane(tid >> 6), lane = tid & 63, wr = wid >> 2, wc = wid & 3, fr = lane & 15, fq = lane >> 4;
    const int K = g.K, nt = K / BK;
    unsigned voffA[2], voffB[2];
#pragma unroll
    for (int i = 0; i < 2; ++i) { int R, C; stage_rc(tid * 16 + i * 8192, R, C); const int Rb = Epi::PERM ? ((R & ~31) + perm32(R & 31)) : R;
        voffA[i] = (unsigned)(R * K + C) * 2u; voffB[i] = (unsigned)(Rb * K + C) * 2u; }
    const size_t kstep = (size_t)(BK * 2);
    const size_t hstep = (size_t)HALF * K * 2;
    const size_t tstep = 2 * hstep;
    const unsigned ldsw = (unsigned)wid * 1024u;
    const int aoff = lds_byte(wr * 64 + fr, fq * 8), boff = lds_byte(wc * 32 + fr, fq * 8);
#define PG8_SA(b, h) (((b) * 2 + (h)) * HTB)
#define PG8_SB(b, h) ((4 + (b) * 2 + (h)) * HTB)
#define PG8_STAGE(bufoff, gbase, voff) do { _Pragma("unroll") for (int _i = 0; _i < 2; ++_i) \
        __builtin_amdgcn_global_load_lds((const unsigned*)((const char*)(gbase) + (voff)[_i]), (PG8_LAS unsigned*)(lds + (bufoff) + ldsw + _i * 8192), 16, 0, 0); } while (0)
#define PG8_LDA(dst, b, h) do { _Pragma("unroll") for (int m = 0; m < 4; ++m) _Pragma("unroll") for (int k = 0; k < 2; ++k) dst[m][k] = *(const PG8_LAS bf16x8*)(lds + PG8_SA(b, h) + aoff + m * 2048 + k * 1024); } while (0)
#define PG8_LDB(dst, b, h) do { _Pragma("unroll") for (int n = 0; n < 2; ++n) _Pragma("unroll") for (int k = 0; k < 2; ++k) dst[n][k] = *(const PG8_LAS bf16x8*)(lds + PG8_SB(b, h) + boff + n * 2048 + k * 1024); } while (0)
#define PG8_MMA(ai, bj, At, Bt) do { __builtin_amdgcn_s_setprio(1); _Pragma("unroll") for (int m = 0; m < 4; ++m) _Pragma("unroll") for (int n = 0; n < 2; ++n) _Pragma("unroll") for (int k = 0; k < 2; ++k) \
        acc[ai][bj][m][n] = __builtin_amdgcn_mfma_f32_16x16x32_bf16(Bt[n][k], At[m][k], acc[ai][bj][m][n], 0, 0, 0); __builtin_amdgcn_s_setprio(0); } while (0)
#define PG8_WAIT_V(n) asm volatile("s_waitcnt vmcnt(" #n ")" ::: "memory")
#define PG8_WAIT_L(n) asm volatile("s_waitcnt lgkmcnt(" #n ")" ::: "memory")
#define PG8_BAR __builtin_amdgcn_s_barrier()
#define PG8_SCHED __builtin_amdgcn_sched_barrier(0)
    Unit cur, nxt; int ui = 0;
    if (!S.next(0, cur)) return;
    f32x4 acc[2][2][4][2];
#pragma unroll
    for (int a = 0; a < 2; ++a)
#pragma unroll
        for (int b = 0; b < 2; ++b)
#pragma unroll
            for (int m = 0; m < 4; ++m)
#pragma unroll
                for (int n = 0; n < 2; ++n) acc[a][b][m][n] = (f32x4){0.f, 0.f, 0.f, 0.f};
    bf16x8 At[4][2], B0[2][2], B1[2][2];
    const char* cA = (const char*)g.A + (size_t)cur.pm * tstep; const char* cB = (const char*)g.Bt + (size_t)cur.e * g.bstride + (size_t)cur.pn * tstep;
    S.a_ready(cur);
    if constexpr (SP2) {
        PG8_STAGE(PG8_SB(0, 0), cB, voffB); PG8_STAGE(PG8_SB(0, 1), cB + hstep, voffB); PG8_STAGE(PG8_SA(0, 0), cA, voffA); PG8_STAGE(PG8_SA(0, 1), cA + hstep, voffA);
        if (wr == 1) PG8_BAR;
        PG8_WAIT_V(2); PG8_BAR;
        PG8_STAGE(PG8_SB(1, 0), cB + kstep, voffB); PG8_STAGE(PG8_SA(1, 0), cA + kstep, voffA); PG8_STAGE(PG8_SB(1, 1), cB + hstep + kstep, voffB);
        PG8_WAIT_V(6); PG8_BAR;
    } else {
        PG8_STAGE(PG8_SB(0, 0), cB, voffB); PG8_STAGE(PG8_SA(0, 0), cA, voffA); PG8_STAGE(PG8_SB(0, 1), cB + hstep, voffB); PG8_STAGE(PG8_SA(0, 1), cA + hstep, voffA);
        if (wr == 1) PG8_BAR;
        PG8_WAIT_V(4); PG8_BAR;
        PG8_STAGE(PG8_SB(1, 0), cB + kstep, voffB); PG8_STAGE(PG8_SA(1, 0), cA + kstep, voffA); PG8_STAGE(PG8_SB(1, 1), cB + hstep + kstep, voffB);
        PG8_WAIT_V(6); PG8_BAR;
    }
    for (;;) {
        const bool has_next = S.next(ui + 1, nxt);
        const char* nA = has_next ? (const char*)g.A + (size_t)nxt.pm * tstep : cA; const char* nB = has_next ? (const char*)g.Bt + (size_t)nxt.e * g.bstride + (size_t)nxt.pn * tstep : cB;
        for (int t = 0; t < nt; t += 2) {
            const bool last = (t == nt - 2);
            const char* a1 = cA + (size_t)(t + 1) * kstep;
            const char* a2 = last ? nA : cA + (size_t)(t + 2) * kstep; const char* b2 = last ? nB : cB + (size_t)(t + 2) * kstep;
            const char* a3 = a2 + kstep; const char* b3 = b2 + kstep;
            if (last && has_next) S.a_ready(nxt);
            if constexpr (SP2) {
            PG8_LDB(B0, 0, 0); PG8_LDB(B1, 0, 1); PG8_SCHED; PG8_LDA(At, 0, 0); PG8_STAGE(PG8_SA(1, 1), a1 + hstep, voffA);
            PG8_WAIT_V(8); PG8_WAIT_L(0); PG8_BAR; PG8_MMA(0, 0, At, B0); PG8_MMA(0, 1, At, B1); PG8_BAR; PG8_SCHED;
            PG8_LDA(At, 0, 1); PG8_STAGE(PG8_SB(0, 0), b2, voffB); PG8_STAGE(PG8_SB(0, 1), b2 + hstep, voffB); PG8_STAGE(PG8_SA(0, 0), a2, voffA);
            PG8_WAIT_V(8); PG8_WAIT_L(0); PG8_BAR; PG8_MMA(1, 0, At, B0); PG8_MMA(1, 1, At, B1); PG8_BAR; PG8_SCHED;
            PG8_LDB(B0, 1, 0); PG8_LDB(B1, 1, 1); PG8_SCHED; PG8_LDA(At, 1, 0); PG8_STAGE(PG8_SA(0, 1), a2 + hstep, voffA);
            PG8_WAIT_V(8); PG8_WAIT_L(0); PG8_BAR; PG8_MMA(0, 0, At, B0); PG8_MMA(0, 1, At, B1); PG8_BAR; PG8_SCHED;
            PG8_LDA(At, 1, 1); PG8_STAGE(PG8_SB(1, 0), b3, voffB); PG8_STAGE(PG8_SB(1, 1), b3 + hstep, voffB); PG8_STAGE(PG8_SA(1, 0), a3, voffA);
            PG8_WAIT_V(8); PG8_WAIT_L(0); PG8_BAR; PG8_MMA(1, 0, At, B0); PG8_MMA(1, 1, At, B1); PG8_BAR; PG8_SCHED;
            } else {
            PG8_LDB(B0, 0, 0); PG8_SCHED; PG8_LDA(At, 0, 0); PG8_STAGE(PG8_SA(1, 1), a1 + hstep, voffA);
            PG8_WAIT_L(8); PG8_BAR; PG8_WAIT_L(0); PG8_MMA(0, 0, At, B0); PG8_BAR; PG8_SCHED;
            PG8_LDB(B1, 0, 1); PG8_STAGE(PG8_SB(0, 0), b2, voffB);
            PG8_BAR; PG8_WAIT_L(0); PG8_MMA(0, 1, At, B1); PG8_BAR;
            PG8_LDA(At, 0, 1); PG8_STAGE(PG8_SA(0, 0), a2, voffA);
            PG8_BAR; PG8_WAIT_L(0); PG8_MMA(1, 0, At, B0); PG8_BAR; PG8_SCHED;
            PG8_STAGE(PG8_SB(0, 1), b2 + hstep, voffB);
            PG8_WAIT_V(6); PG8_BAR; PG8_MMA(1, 1, At, B1); PG8_BAR;
            PG8_LDB(B0, 1, 0); PG8_SCHED; PG8_LDA(At, 1, 0); PG8_STAGE(PG8_SA(0, 1), a2 + hstep, voffA);
            PG8_WAIT_L(8); PG8_BAR; PG8_WAIT_L(0); PG8_MMA(0, 0, At, B0); PG8_BAR; PG8_SCHED;
            PG8_LDB(B1, 1, 1); PG8_STAGE(PG8_SB(1, 0), b3, voffB);
            PG8_BAR; PG8_WAIT_L(0); PG8_MMA(0, 1, At, B1); PG8_BAR;
            PG8_LDA(At, 1, 1); PG8_STAGE(PG8_SA(1, 0), a3, voffA);
            PG8_BAR; PG8_WAIT_L(0); PG8_MMA(1, 0, At, B0); PG8_BAR; PG8_SCHED;
            PG8_STAGE(PG8_SB(1, 1), b3 + hstep, voffB);
            PG8_WAIT_V(6); PG8_BAR; PG8_MMA(1, 1, At, B1); PG8_BAR;
            }
        }
        if constexpr (ALIGN_EPI) { if (wr == 0) PG8_BAR; }
        if constexpr (!Epi::AFTER_DRAIN) { E(acc, cur, wr, wc, fr, fq); S.done(cur); }
        if (!has_next) break;
#pragma unroll
        for (int a = 0; a < 2; ++a)
#pragma unroll
            for (int b = 0; b < 2; ++b)
#pragma unroll
                for (int m = 0; m < 4; ++m)
#pragma unroll
                    for (int n = 0; n < 2; ++n) acc[a][b][m][n] = (f32x4){0.f, 0.f, 0.f, 0.f};
        cur = nxt; cA = nA; cB = nB; ++ui;
        if constexpr (ALIGN_EPI) { if (wr == 1) PG8_BAR; }
    }
    PG8_WAIT_V(0);
    if constexpr (!ALIGN_EPI) { if (wr == 0) PG8_BAR; }
    PG8_BAR;
    if constexpr (Epi::AFTER_DRAIN) { E.fused(acc, cur, wr, wc, fr, fq, lds, wid, lane); S.done(cur); }
#undef PG8_SA
#undef PG8_SB
#undef PG8_STAGE
#undef PG8_LDA
#undef PG8_LDB
#undef PG8_MMA
#undef PG8_WAIT_V
#undef PG8_WAIT_L
#undef PG8_BAR
#undef PG8_SCHED
}
}
#define GAS __attribute__((address_space(1)))
typedef unsigned v4u __attribute__((ext_vector_type(4)));
typedef GAS unsigned gu32;
typedef GAS unsigned long long gu64;
#define RLX_AGENT __ATOMIC_RELAXED, __HIP_MEMORY_SCOPE_AGENT
#define LDS_WAIT() asm volatile("s_waitcnt lgkmcnt(0)" ::: "memory")
#define VM_WAIT() asm volatile("s_waitcnt vmcnt(0)" ::: "memory")
#define XB_TMO      128
#define XB_XCNT(j)  (256  + 64 * (j))
#define XB_XSUB(j)  (1280 + 64 * (j))
#define XB_XGEN(j)  (2304 + 64 * (j))
#define XB_TOP      3328
#define XB_TOPGEN   3392
#define XCD_BAR_WORDS 3456
#define XB_SPIN_CAP (1u << 18)

__device__ __forceinline__ unsigned xb_ld(unsigned* p)              { return __hip_atomic_load(p, __ATOMIC_RELAXED, __HIP_MEMORY_SCOPE_AGENT); }
__device__ __forceinline__ unsigned xb_add(unsigned* p, unsigned v) { return __hip_atomic_fetch_add(p, v, __ATOMIC_RELAXED, __HIP_MEMORY_SCOPE_AGENT); }
__device__ __forceinline__ unsigned xb_xcc_id() { return (unsigned)__builtin_amdgcn_s_getreg((3 << 11) | 20) & 0xFu; }
#define XB_SPIN(cond, bar) do { unsigned _sp = 0; while (cond) { __builtin_amdgcn_s_sleep(1); \
    if ((++_sp & 255u) == 0u) { if (xb_ld(&(bar)[XB_TMO])) break; if (_sp > XB_SPIN_CAP) { atomicAdd(&(bar)[XB_TMO], 1u); break; } } } } while (0)

struct XcdBarrier {
    unsigned* bar; unsigned x;
    volatile LAS unsigned* st;
};

__device__ __forceinline__ XcdBarrier xcd_barrier_post(unsigned* bar, volatile LAS unsigned* st) {
    XcdBarrier b; b.bar = bar; b.x = xb_xcc_id(); b.st = st;
    if (threadIdx.x == 0) (void)xb_add(&bar[XB_XCNT(b.x)], 1u);
    return b;
}
__device__ __forceinline__ void xcd_barrier_complete(unsigned* bar, unsigned x, unsigned& nloc, unsigned& nx) {
    const unsigned G = gridDim.x * gridDim.y * gridDim.z;
    unsigned sum, cnt, mine, sp = 0u;
    for (;;) {
        sum = 0u; cnt = 0u; mine = 0u;
#pragma unroll
        for (unsigned j = 0; j < 16; ++j) { const unsigned c = xb_ld(&bar[XB_XCNT(j)]); sum += c; cnt += (c > 0u) ? 1u : 0u; mine = (j == x) ? c : mine; }
        if (sum == G) break;
        __builtin_amdgcn_s_sleep(1);
        if ((++sp & 255u) == 0u) { if (xb_ld(&bar[XB_TMO])) break; if (sp > XB_SPIN_CAP) { atomicAdd(&bar[XB_TMO], 1u); break; } }
    }
    nloc = mine > 0u ? mine : 1u; nx = cnt > 0u ? cnt : 1u;
}

__device__ __forceinline__ void xcd_barrier(const XcdBarrier& b) {
    asm volatile("s_waitcnt vmcnt(0)" ::: "memory");
    __syncthreads();
    if (threadIdx.x == 0) {
        unsigned* bar = b.bar;
        __builtin_amdgcn_s_waitcnt(0);
        unsigned nloc = b.st[0], nx = b.st[1];
        if (nloc == 0u) { xcd_barrier_complete(bar, b.x, nloc, nx); b.st[0] = nloc; b.st[1] = nx; }
        const unsigned old = xb_add(&bar[XB_XSUB(b.x)], 1u);
        const unsigned gen = old / nloc;
        if (old + 1u == (gen + 1u) * nloc) {
            __builtin_amdgcn_fence(__ATOMIC_RELEASE, "agent");
            asm volatile("s_waitcnt vmcnt(0)" ::: "memory");
            const unsigned og = xb_add(&bar[XB_TOP], 1u);
            const unsigned tg = og / nx;
            if (og + 1u == (tg + 1u) * nx) xb_add(&bar[XB_TOPGEN], 1u);
            else XB_SPIN(xb_ld(&bar[XB_TOPGEN]) == tg, bar);
            __builtin_amdgcn_fence(__ATOMIC_ACQUIRE, "agent");
            xb_add(&bar[XB_XGEN(b.x)], 1u);
            asm volatile("s_waitcnt vmcnt(0)" ::: "memory");
        } else {
            XB_SPIN(xb_ld(&bar[XB_XGEN(b.x)]) == gen, bar);
            __builtin_amdgcn_fence(__ATOMIC_ACQUIRE, "agent");
            asm volatile("s_waitcnt vmcnt(0)" ::: "memory");
        }
    }
    __syncthreads();
}

constexpr int RING_OFF = 0, RING_BYTES = 131072;
constexpr int LDSCTL_OFF = RING_BYTES, MISC_OFF = LDSCTL_OFF + 320;
constexpr int LDS_BYTES = 147456;
constexpr int NWAVES = 8;
constexpr int CW_BAR = 4096;

struct Args { const float* in[40]; float* out; unsigned char* ws; int nph; int ph[63]; };

struct Frame {
    LAS unsigned char* lds;
    volatile LAS unsigned* MISC;
    int tid, lane, wave, vcu, G;
    const float* const* in;
    unsigned char* ws; float* out;
};

__device__ __forceinline__ void conv_item(const float* W, int ldw, int coff, int nvalid, const float* g, bf16_t* dst, int K, int nblk, int rowmode, LAS float* scr, int item, int lane) {
    const int kb = item / nblk, nb = item % nblk, k0 = 64 * kb, n0 = 32 * nb;
    const int nn = n0 + (lane & 31);
#pragma unroll 8
    for (int i = 0; i < 32; ++i) {
        const int kk = 2 * i + (lane >> 5);
        float v = 0.f;
        if (nn < nvalid) { v = W[(size_t)(k0 + kk) * ldw + coff + nn]; if (g) v *= g[k0 + kk]; }
        scr[kk * 33 + (lane & 31)] = v;
    }
    LDS_WAIT(); asm volatile("" ::: "memory");
    const int c = lane & 7;
#pragma unroll
    for (int j = 0; j < 4; ++j) {
        const int nl = (lane >> 3) + 8 * j, n = n0 + nl; const LAS float* s = scr + (8 * c) * 33 + nl;
        v4u o; o.x = pk2(s[0 * 33], s[1 * 33]); o.y = pk2(s[2 * 33], s[3 * 33]); o.z = pk2(s[4 * 33], s[5 * 33]); o.w = pk2(s[6 * 33], s[7 * 33]);
        const int drow = rowmode == 0 ? n : ((n >> 7) * 256 + (n & 127) + (rowmode == 2 ? 128 : 0));
        *(GAS v4u*)(dst + (size_t)drow * K + k0 + 8 * c) = o;
    }
    LDS_WAIT(); asm volatile("" ::: "memory");
}
struct ConvJob { const float* W; const float* g; bf16_t* dst; int ldw, coff, nvalid, npad, K, rowmode; };
__device__ __forceinline__ ConvJob conv_job(const Frame& F, int j) {
    bf16_t* WB = (bf16_t*)(F.ws + WS_WB);
    ConvJob c; c.g = nullptr; c.coff = 0; c.rowmode = 0; c.K = 1024; c.ldw = D_; c.nvalid = D_; c.npad = D_;
    if (j < 16) {
        const int l = j >> 3, k = j & 7;
        switch (k) {
        case 0: { const int ncols = l == 0 ? 3096 : 3128; c.W = l == 0 ? F.in[2] : F.in[3]; c.ldw = ncols; c.nvalid = ncols; c.npad = NPJ; c.g = F.in[6] + l * D_; c.dst = WB + (WB_WIN / 2) + (size_t)l * NPJ * 1024; } break;
        case 1: c.W = F.in[25] + (size_t)l * D_ * D_; c.dst = WB + (WB_WOUT / 2) + (size_t)l * D_ * D_; break;
        case 2: c.W = F.in[28] + (size_t)l * D_ * D_; c.g = F.in[26] + l * D_; c.dst = WB + (WB_WQ / 2) + (size_t)l * D_ * D_; break;
        case 3: c.W = F.in[29] + (size_t)l * D_ * 2048; c.ldw = 2048; c.g = F.in[27] + l * D_; c.dst = WB + (WB_WK / 2) + (size_t)l * D_ * D_; break;
        case 4: c.W = F.in[29] + (size_t)l * D_ * 2048; c.ldw = 2048; c.coff = 1024; c.g = F.in[27] + l * D_; c.dst = WB + (WB_WV / 2) + (size_t)l * D_ * D_; break;
        case 5: c.W = F.in[30] + (size_t)l * D_ * D_; c.dst = WB + (WB_WO / 2) + (size_t)l * D_ * D_; break;
        case 6: c.W = F.in[20] + (size_t)l * 2048 * 128; c.ldw = 128; c.nvalid = 128; c.npad = 128; c.K = 2048; c.dst = WB + (WB_CW1 / 2) + (size_t)(l * 2 + 0) * 128 * 2048; break;
        default: c.W = F.in[23] + (size_t)l * 2048 * 128; c.ldw = 128; c.nvalid = 128; c.npad = 128; c.K = 2048; c.dst = WB + (WB_CW1 / 2) + (size_t)(l * 2 + 1) * 128 * 2048; break;
        }
    } else if (j == 16) { c.W = F.in[32]; c.ldw = FFD; c.nvalid = FFD; c.npad = FFD; c.g = F.in[31]; c.dst = WB + (WB_WGU / 2); c.rowmode = 1; }
    else if (j == 17) { c.W = F.in[33]; c.ldw = FFD; c.nvalid = FFD; c.npad = FFD; c.g = F.in[31]; c.dst = WB + (WB_WGU / 2); c.rowmode = 2; }
    else { c.W = F.in[34]; c.K = FFD; c.dst = WB + (WB_WD / 2); }
    return c;
}

__device__ __forceinline__ void p_prologue(Frame& F) {
    LAS float* scr = (LAS float*)(F.lds + RING_OFF + F.wave * 16384);
    const int gw = F.vcu * NWAVES + F.wave, NGW = F.G * NWAVES;
    int base = 0;
    bf16_t* WB = (bf16_t*)(F.ws + WS_WB);
#pragma nounroll
    for (int j = 0; j < 19; ++j) {
        const ConvJob c = conv_job(F, j);
        const int nblk = c.npad / 32, items = (c.K / 64) * nblk;
#pragma nounroll
        for (int it = (gw + NGW - (base % NGW)) % NGW; it < items; it += NGW) conv_item(c.W, c.ldw, c.coff, c.nvalid, c.g, c.dst, c.K, nblk, c.rowmode, scr, it, F.lane);
        base += items;
    }
    const int gt = (F.vcu * NWAVES + F.wave) * 64 + F.lane, NGT = F.G * NWAVES * 64;
    for (int l = 0; l < 2; ++l) {
        bf16_t* LT = WB + (WB_LORA / 2) + (size_t)l * 512 * 288;
        for (int i = gt; i < 512 * 288; i += NGT) {
            const int c = i / 288, k = i % 288; float v;
            if (k < 64) v = F.in[8][((size_t)l * 64 + k) * 512 + c];
            else if (k < 128) v = F.in[10][((size_t)l * 64 + (k - 64)) * 512 + c];
            else if (k < 256) v = F.in[11][((size_t)l * 128 + (k - 128)) * 512 + c];
            else v = (l == 1) ? F.in[18][(size_t)(k - 256) * 512 + c] : 0.f;
            LT[i] = (bf16_t)f2bf(v);
        }
        for (int kv = 0; kv < 2; ++kv) {
            bf16_t* C2 = WB + (WB_CW2 / 2) + (size_t)(l * 2 + kv) * 64 * 128;
            const float* w2 = (kv == 0 ? F.in[21] : F.in[24]) + (size_t)l * 128 * 64;
            for (int i = gt; i < 64 * 128; i += NGT) { const int d = i / 128, k = i % 128; C2[i] = (bf16_t)f2bf(w2[k * 64 + d]); }
        }
    }
    for (int o = gw; o < 512; o += NGW) {
        const int l = o >> 8, kv = (o >> 7) & 1, hid = o & 127;
        const float* pe = (kv == 0 ? F.in[19] : F.in[22]) + (size_t)l * 2048;
        const float* w1 = (kv == 0 ? F.in[20] : F.in[23]) + (size_t)l * 2048 * 128;
        float a = 0.f;
        for (int i = F.lane; i < 2048; i += 64) a += pe[i] * w1[(size_t)i * 128 + hid];
        a = wave_sum_l(a, F.lane);
        if (F.lane == 0) ((float*)(F.ws + WS_WB + WB_CB))[o] = a;
    }
    {
        float* X = (float*)(F.ws + WS_X); bf16_t* XB = (bf16_t*)(F.ws + WS_XB); float* SSQ = (float*)(F.ws + WS_SSQ);
        for (int m = gw; m < NTOK; m += NGW) {
            const GAS f32x4_t* xr = (const GAS f32x4_t*)(F.in[0] + (size_t)m * D_) + F.lane;
            f32x4_t v[4]; float s = 0.f;
#pragma unroll
            for (int j = 0; j < 4; ++j) { v[j] = xr[64 * j]; s += (v[j].x * v[j].x + v[j].y * v[j].y) + (v[j].z * v[j].z + v[j].w * v[j].w); }
            s = wave_sum_l(s, F.lane);
            GAS f32x4_t* xo = (GAS f32x4_t*)(X + (size_t)m * D_) + F.lane;
            GAS unsigned long long* o8 = (GAS unsigned long long*)(XB + (size_t)m * D_) + F.lane;
#pragma unroll
            for (int j = 0; j < 4; ++j) { xo[64 * j] = v[j]; o8[64 * j] = (unsigned long long)pk2(v[j].x, v[j].y) | ((unsigned long long)pk2(v[j].z, v[j].w) << 32); }
            if (F.lane < 16) SSQ[(size_t)m * 16 + F.lane] = (F.lane == 0) ? s : 0.f;
        }
        bf16_t* MB = (bf16_t*)(F.ws + WS_MEMB); float* MRINV = (float*)(F.ws + WS_MRINV);
        for (int m = gw; m < NMEM; m += NGW) {
            const GAS f32x4_t* xr = (const GAS f32x4_t*)(F.in[1] + (size_t)m * D_) + F.lane;
            f32x4_t v[4]; float s = 0.f;
#pragma unroll
            for (int j = 0; j < 4; ++j) { v[j] = xr[64 * j]; s += (v[j].x * v[j].x + v[j].y * v[j].y) + (v[j].z * v[j].z + v[j].w * v[j].w); }
            s = wave_sum_l(s, F.lane);
            GAS unsigned long long* o8 = (GAS unsigned long long*)(MB + (size_t)m * D_) + F.lane;
#pragma unroll
            for (int j = 0; j < 4; ++j) o8[64 * j] = (unsigned long long)pk2(v[j].x, v[j].y) | ((unsigned long long)pk2(v[j].z, v[j].w) << 32);
            if (F.lane == 0) MRINV[m] = 1.0f / sqrtf(s * (1.0f / 1024.0f) + 1e-6f);
        }
    }
}


__device__ __forceinline__ unsigned char* launder_ptr(unsigned char* p) {
    unsigned lo = (unsigned)(uintptr_t)p, hi = (unsigned)((uintptr_t)p >> 32);
    asm volatile("" : "+v"(lo), "+v"(hi));
    lo = __builtin_amdgcn_readfirstlane(lo); hi = __builtin_amdgcn_readfirstlane(hi);
    return (unsigned char*)(((uintptr_t)hi << 32) | (uintptr_t)lo);
}
#define RELAUNDER(F) do { int t_ = (F).tid; asm volatile("" : "+v"(t_)); (F).tid = t_; (F).lane = t_ & 63; (F).wave = __builtin_amdgcn_readfirstlane(t_ >> 6); \
    (F).ws = launder_ptr((F).ws); } while (0)
constexpr int RTAB_OFF = 132096, RTAB_UNITS = 8;
static_assert(RTAB_OFF + RTAB_UNITS * 256 * 4 <= LDS_BYTES && RTAB_OFF >= MISC_OFF + 128, "LDS map");
template <class Sched> __device__ __forceinline__ void fill_rtab(Frame& F, const Sched& S, const float* direct = nullptr) {
    const float* ssq = (const float*)(F.ws + WS_SSQ);
    LAS float* rtab = (LAS float*)(F.lds + RTAB_OFF);
    pg8::Unit u;
    for (int i = 0; i < RTAB_UNITS && S.next(i, u); ++i)
        if (F.tid < 256) rtab[i * 256 + F.tid] = direct ? direct[u.pm * 256 + F.tid] : pg8::row_rinv(ssq, u.pm * 256 + F.tid);
    __syncthreads();
}
__device__ __forceinline__ void p_inproj(Frame& F, int l) {
    RELAUNDER(F);
    pg8::Gemm g{(const bf16_t*)(F.ws + WS_XB), (const bf16_t*)(F.ws + WS_WB + WB_WIN) + (size_t)l * NPJ * 1024, NTOK, NPJ, 1024, 0};
    pg8::StaticOrder S; S.init(NTOK, NPJ, F.G, (int)blockIdx.x);
    fill_rtab(F, S);
    pg8::EpiRowScaleBf16 E{(bf16_t*)(F.ws + WS_S), NPJ, (const LAS float*)(F.lds + RTAB_OFF), 1.0f};
    pg8::gemm_phase<pg8::EpiRowScaleBf16, pg8::StaticOrder, true, true>(F.lds + RING_OFF, g, S, E, F.tid);
}

constexpr size_t S_PROJ = 0;
constexpr size_t S_CONCAT = 104 * MiB;
constexpr size_t S_SC = 136 * MiB;
constexpr size_t S_Y = 232 * MiB;
constexpr size_t S_G = 264 * MiB;
constexpr size_t S_BON = 280 * MiB;
constexpr size_t S_END = 281 * MiB;
constexpr size_t S_QC = 0, S_OC = 32 * MiB;
constexpr size_t S_ACT = 0;

__device__ __forceinline__ void p_resid_gemm(Frame& F, const bf16_t* A, const bf16_t* Bt, int K) {
    RELAUNDER(F);
    pg8::Gemm g{A, Bt, NTOK, 1024, K, 0};
    pg8::StaticOrder S; S.init(NTOK, 1024, F.G, (int)blockIdx.x);
    pg8::EpiResid E{(float*)(F.ws + WS_X), (bf16_t*)(F.ws + WS_XB), (float*)(F.ws + WS_SSQ)};
    pg8::gemm_phase<pg8::EpiResid, pg8::StaticOrder, true, true>(F.lds + RING_OFF, g, S, E, F.tid);
}
__device__ __forceinline__ void p_crossq(Frame& F, int l) {
    RELAUNDER(F);
    pg8::Gemm g{(const bf16_t*)(F.ws + WS_XB), (const bf16_t*)(F.ws + WS_WB + WB_WQ) + (size_t)l * D_ * D_, NTOK, 1024, 1024, 0};
    pg8::StaticOrder S; S.init(NTOK, 1024, F.G, (int)blockIdx.x);
    fill_rtab(F, S);
    pg8::EpiRowScaleBf16 E{(bf16_t*)(F.ws + WS_S + S_QC), 1024, (const LAS float*)(F.lds + RTAB_OFF), 0.0625f * 1.4426950408889634f};
    pg8::gemm_phase<pg8::EpiRowScaleBf16, pg8::StaticOrder, true, true>(F.lds + RING_OFF, g, S, E, F.tid);
}
__device__ __forceinline__ void p_kv(Frame& F) {
    RELAUNDER(F);
    if (F.vcu >= 128) return;
    const int which = F.vcu >> 5, l = which >> 1, c = F.vcu & 31;
    const bf16_t* MB = (const bf16_t*)(F.ws + WS_MEMB); const float* MRINV = (const float*)(F.ws + WS_MRINV);
    if ((which & 1) == 0) {
        pg8::Gemm g{MB, (const bf16_t*)(F.ws + WS_WB + WB_WK) + (size_t)l * D_ * D_, NMEM, 1024, 1024, 0};
        pg8::StaticOrder S; S.init(NMEM, 1024, 32, c);
        fill_rtab(F, S, MRINV);
        pg8::EpiRowScaleBf16 E{(bf16_t*)(F.ws + WS_KCR) + (size_t)l * NMEM * 1024, 1024, (const LAS float*)(F.lds + RTAB_OFF), 1.0f};
        pg8::gemm_phase<pg8::EpiRowScaleBf16, pg8::StaticOrder, true, true>(F.lds + RING_OFF, g, S, E, F.tid);
    } else {
        pg8::Gemm g{(const bf16_t*)(F.ws + WS_WB + WB_WV) + (size_t)l * D_ * D_, MB, 1024, NMEM, 1024, 0};
        pg8::StaticOrder S; S.init(1024, NMEM, 32, c);
        pg8::EpiColScaleBf16 E{(bf16_t*)(F.ws + WS_VT) + (size_t)l * 1024 * NMEM, NMEM, MRINV};
        pg8::gemm_phase<pg8::EpiColScaleBf16, pg8::StaticOrder, true, true>(F.lds + RING_OFF, g, S, E, F.tid);
    }
}
__device__ __forceinline__ void p_ffn_up(Frame& F) {
    RELAUNDER(F);
    pg8::Gemm g{(const bf16_t*)(F.ws + WS_XB), (const bf16_t*)(F.ws + WS_WB + WB_WGU), NTOK, 2 * FFD, 1024, 0};
    pg8::StaticOrder S; S.init(NTOK, 2 * FFD, F.G, (int)blockIdx.x);
    fill_rtab(F, S);
    pg8::EpiSwiGLU E{(bf16_t*)(F.ws + WS_S + S_ACT), FFD, (const LAS float*)(F.lds + RTAB_OFF)};
    pg8::gemm_phase<pg8::EpiSwiGLU, pg8::StaticOrder, true, true>(F.lds + RING_OFF, g, S, E, F.tid);
}

typedef short bf16x8_t __attribute__((ext_vector_type(8)));
constexpr int LDX = 296;
__device__ __forceinline__ void p_rw_prep(Frame& F, int l) {
    RELAUNDER(F);
    const int n_lo = l == 0 ? 256 : 288;
    const bf16_t* P = (const bf16_t*)(F.ws + WS_S + S_PROJ);
    const float* mu = l == 0 ? F.in[4] : F.in[5];
    const bf16_t* LT0 = (const bf16_t*)(F.ws + WS_WB + WB_LORA) + (size_t)l * 512 * 288;
    bf16_t* SC = (bf16_t*)(F.ws + WS_S + S_SC); bf16_t* Gb = (bf16_t*)(F.ws + WS_S + S_G); float* BON = (float*)(F.ws + WS_S + S_BON);
    bf16_t* VF = (bf16_t*)(F.ws + WS_VFIRST);
    LAS bf16_t* Xs = (LAS bf16_t*)F.lds;
    const float* w0 = F.in[7] + l * W_; const float* a0 = F.in[9] + l * W_; const float* kkp = F.in[12] + l * W_; const float* kap = F.in[13] + l * W_; const float* rkp = F.in[14] + l * W_;
    const float* v0p = F.in[17];
    for (int chunk = F.vcu; chunk < NTOK / 64; chunk += F.G) {
        const int tok0 = chunk * 64;
        __syncthreads();
        for (int c = F.tid; c < 64 * 36; c += NWAVES * 64) {
            const int row = c / 36, ch = c % 36, tok = tok0 + row, t = tok & (T_ - 1);
            u32x4_t o = {0u, 0u, 0u, 0u};
            if (ch * 8 < n_lo) {
                const u32x4_t cu = *(const u32x4_t*)(P + (size_t)tok * NPJ + 1536 + ch * 8);
                u32x4_t pv = {0u, 0u, 0u, 0u};
                if (t > 0) pv = *(const u32x4_t*)(P + (size_t)(tok - 1) * NPJ + 1536 + ch * 8);
                const f32x4_t m0 = *(const f32x4_t*)(mu + 1536 + ch * 8), m1 = *(const f32x4_t*)(mu + 1536 + ch * 8 + 4);
                float v[8];
#pragma unroll
                for (int q = 0; q < 4; ++q) {
                    const float u0 = __uint_as_float(cu[q] << 16), u1 = __uint_as_float(cu[q] & 0xffff0000u), p0 = __uint_as_float(pv[q] << 16), p1 = __uint_as_float(pv[q] & 0xffff0000u);
                    const float ma = q < 2 ? m0[2 * q] : m1[2 * q - 4], mb = q < 2 ? m0[2 * q + 1] : m1[2 * q - 3];
                    v[2 * q] = u0 + (p0 - u0) * ma; v[2 * q + 1] = u1 + (p1 - u1) * mb;
                }
                if (ch < 8) { for (int q = 0; q < 8; ++q) v[q] = tanhf(v[q]); }
                else if (ch >= 16 && ch < 32) { for (int q = 0; q < 8; ++q) v[q] = sigmoidf_(v[q]); }
                o.x = pk2(v[0], v[1]); o.y = pk2(v[2], v[3]); o.z = pk2(v[4], v[5]); o.w = pk2(v[6], v[7]);
            }
            *(LAS u32x4_t*)(Xs + row * LDX + ch * 8) = o;
        }
        __syncthreads();
        const int h = F.wave, fr = F.lane & 15, fq = F.lane >> 4;
#define LORA_MMA(acc, KS0, KS1) do { _Pragma("unroll") for (int mt = 0; mt < 4; ++mt) acc[mt] = (pg8::f32x4){0.f, 0.f, 0.f, 0.f}; \
        _Pragma("unroll") for (int ks = KS0; ks < KS1; ++ks) { const bf16x8_t bx = *(const LAS bf16x8_t*)(Xs + (nt * 16 + fr) * LDX + ks * 32 + fq * 8); \
            _Pragma("unroll") for (int mt = 0; mt < 4; ++mt) { const bf16x8_t ax = *(const bf16x8_t*)(LT + (size_t)(h * 64 + mt * 16 + fr) * 288 + ks * 32 + fq * 8); \
                acc[mt] = __builtin_amdgcn_mfma_f32_16x16x32_bf16(ax, bx, acc[mt], 0, 0, 0); } } } while (0)
#define UNPK(w, e) (((e) & 1) ? __uint_as_float(((e) < 2 ? (w).x : (w).y) & 0xffff0000u) : __uint_as_float(((e) < 2 ? (w).x : (w).y) << 16))
#define SHIFTED(dst, colbase, mt) do { const int c_ = h * 64 + (mt) * 16 + fq * 4; const u32x2_t cu_ = *(const u32x2_t*)(pc + (colbase) + c_); u32x2_t pu_ = {0u, 0u}; \
        if (t > 0) pu_ = *(const u32x2_t*)(pp + (colbase) + c_); const f32x4_t m_ = *(const f32x4_t*)(mu + (colbase) + c_); \
        _Pragma("unroll") for (int e = 0; e < 4; ++e) { const float u_ = UNPK(cu_, e), q_ = UNPK(pu_, e); dst[e] = u_ + (q_ - u_) * m_[e]; } } while (0)
#pragma nounroll
        for (int nt = 0; nt < 4; ++nt) {
            const bf16_t* LT = LT0; asm volatile("" : "+s"(LT));
            const int tok = tok0 + nt * 16 + fr, t = tok & (T_ - 1), b = tok >> 11;
            const bf16_t* pc = P + (size_t)tok * NPJ; const bf16_t* pp = pc - NPJ;
            const size_t sb0 = ((((size_t)b * 8 + h) * T_ + t) * 6) * 64 + fq * 4;
            pg8::f32x4 acc[4];
            LORA_MMA(acc, 0, 2);
#pragma unroll
            for (int mt = 0; mt < 4; ++mt) {
                const int c = h * 64 + mt * 16 + fq * 4; const f32x4_t w0v = *(const f32x4_t*)(w0 + c); float om[4];
#pragma unroll
                for (int e = 0; e < 4; ++e) { const float wraw = w0v[e] + acc[mt][e]; const float sp = (-wraw > 20.f) ? -wraw : log1pf(__expf(-wraw)); om[e] = 1.0f - __expf(-__expf(-sp - 0.5f)); }
                u32x2_t o; o.x = pk2(om[0], om[1]); o.y = pk2(om[2], om[3]); *(u32x2_t*)(SC + sb0 + mt * 16 + 1 * 64) = o;
            }
            asm volatile("" ::: "memory");
            LORA_MMA(acc, 4, 8);
#pragma unroll
            for (int mt = 0; mt < 4; ++mt) { const int c = h * 64 + mt * 16 + fq * 4; u32x2_t o; o.x = pk2(acc[mt][0], acc[mt][1]); o.y = pk2(acc[mt][2], acc[mt][3]); *(u32x2_t*)(Gb + (size_t)tok * W_ + c) = o; }
            asm volatile("" ::: "memory");
            if (l == 1) LORA_MMA(acc, 8, 9);
#pragma unroll
            for (int mt = 0; mt < 4; ++mt) {
                const int c = h * 64 + mt * 16 + fq * 4; float v[4]; SHIFTED(v, 1024, mt);
                if (l == 1) {
                    const f32x4_t v0v = *(const f32x4_t*)(v0p + c); const u32x2_t vfr = *(const u32x2_t*)(VF + (size_t)tok * W_ + c);
#pragma unroll
                    for (int e = 0; e < 4; ++e) { const float vf = UNPK(vfr, e); v[e] = v[e] + (vf - v[e]) * sigmoidf_(v0v[e] + acc[mt][e]); }
                }
                u32x2_t o; o.x = pk2(v[0], v[1]); o.y = pk2(v[2], v[3]);
                *(u32x2_t*)(SC + sb0 + mt * 16 + 3 * 64) = o;
                if (l == 0) *(u32x2_t*)(VF + (size_t)tok * W_ + c) = o;
            }
            asm volatile("" ::: "memory");
            LORA_MMA(acc, 2, 4);
            float kn[4][4], ai[4][4]; float ssk = 0.f, bsum = 0.f;
#pragma unroll
            for (int mt = 0; mt < 4; ++mt) {
                const int c = h * 64 + mt * 16 + fq * 4; float r[4], k[4]; SHIFTED(r, 0, mt); SHIFTED(k, 512, mt);
                const f32x4_t a0v = *(const f32x4_t*)(a0 + c), kkv = *(const f32x4_t*)(kkp + c), kav = *(const f32x4_t*)(kap + c), rkv = *(const f32x4_t*)(rkp + c);
                float kh[4];
#pragma unroll
                for (int e = 0; e < 4; ++e) {
                    const float a = sigmoidf_(a0v[e] + acc[mt][e]); const float kk = k[e] * kkv[e];
                    ssk += kk * kk; kh[e] = k[e] * (1.f + (a - 1.f) * kav[e]); bsum += r[e] * kh[e] * rkv[e];
                    kn[mt][e] = kk; ai[mt][e] = a;
                }
                { u32x2_t o; o.x = pk2(r[0], r[1]); o.y = pk2(r[2], r[3]); *(u32x2_t*)(SC + sb0 + mt * 16 + 0 * 64) = o; }
                { u32x2_t o; o.x = pk2(kh[0], kh[1]); o.y = pk2(kh[2], kh[3]); *(u32x2_t*)(SC + sb0 + mt * 16 + 2 * 64) = o; }
            }
            ssk += shx(ssk, F.lane, 16); ssk += shx(ssk, F.lane, 32);
            bsum += shx(bsum, F.lane, 16); bsum += shx(bsum, F.lane, 32);
            const float kinv = 1.0f / fmaxf(sqrtf(ssk), 1e-12f);
            if (fq == 0) BON[(size_t)tok * 8 + h] = bsum;
#pragma unroll
            for (int mt = 0; mt < 4; ++mt) {
                float kq[4], bq[4];
#pragma unroll
                for (int e = 0; e < 4; ++e) { kq[e] = kn[mt][e] * kinv; bq[e] = kq[e] * ai[mt][e]; }
                { u32x2_t o; o.x = pk2(kq[0], kq[1]); o.y = pk2(kq[2], kq[3]); *(u32x2_t*)(SC + sb0 + mt * 16 + 4 * 64) = o; }
                { u32x2_t o; o.x = pk2(bq[0], bq[1]); o.y = pk2(bq[2], bq[3]); *(u32x2_t*)(SC + sb0 + mt * 16 + 5 * 64) = o; }
            }
            asm volatile("" ::: "memory");
        }
#undef LORA_MMA
#undef UNPK
#undef SHIFTED
    }
}

constexpr int SC_STEPS = 32, SC_CHUNK_F = SC_STEPS * 6 * 64;
constexpr int SCAN_YB = 2 * SC_CHUNK_F * 4;
__device__ __forceinline__ float dpp_ror_add(float v, int) { return v; }
#define ROW_ALLREDUCE(v) do { \
    v += __int_as_float(__builtin_amdgcn_update_dpp(0, __float_as_int(v), 0x128, 0xf, 0xf, false)); \
    v += __int_as_float(__builtin_amdgcn_update_dpp(0, __float_as_int(v), 0x124, 0xf, 0xf, false)); \
    v += __int_as_float(__builtin_amdgcn_update_dpp(0, __float_as_int(v), 0x122, 0xf, 0xf, false)); \
    v += __int_as_float(__builtin_amdgcn_update_dpp(0, __float_as_int(v), 0x121, 0xf, 0xf, false)); } while (0)
__device__ __forceinline__ void p_rw_scan(Frame& F) {
    RELAUNDER(F);
    const bf16_t* SC = (const bf16_t*)(F.ws + WS_S + S_SC); float* Y = (float*)(F.ws + WS_S + S_Y);
    LAS float* ring = (LAS float*)F.lds; LAS float* yring = (LAS float*)(F.lds + SCAN_YB);
    constexpr int NCH = T_ / SC_STEPS;
    for (int unit = F.vcu; unit < B_ * H_ * 4; unit += F.G) {
        const int bh = unit >> 2, qtr = unit & 3;
        const bf16_t* src = SC + (size_t)bh * T_ * 384;
        __syncthreads();
        if (F.wave >= 4) {
            const int lt = F.tid - 256;
            u32x4_t regs[6];
#pragma unroll
            for (int i = 0; i < 6; ++i) regs[i] = *(const u32x4_t*)(src + (size_t)(lt + 256 * i) * 8);
#pragma unroll
            for (int i = 0; i < 6; ++i) {
                LAS f32x4_t* d = (LAS f32x4_t*)(ring + (lt + 256 * i) * 8);
                d[0] = (f32x4_t){__uint_as_float(regs[i].x << 16), __uint_as_float(regs[i].x & 0xffff0000u), __uint_as_float(regs[i].y << 16), __uint_as_float(regs[i].y & 0xffff0000u)};
                d[1] = (f32x4_t){__uint_as_float(regs[i].z << 16), __uint_as_float(regs[i].z & 0xffff0000u), __uint_as_float(regs[i].w << 16), __uint_as_float(regs[i].w & 0xffff0000u)};
            }
#pragma unroll
            for (int i = 0; i < 6; ++i) regs[i] = *(const u32x4_t*)(src + (size_t)SC_CHUNK_F + (size_t)(lt + 256 * i) * 8);
            __syncthreads();
            for (int c = 0; c < NCH; ++c) {
                if (c + 1 < NCH) {
                    LAS float* dst = ring + ((c + 1) & 1) * SC_CHUNK_F;
#pragma unroll
                    for (int i = 0; i < 6; ++i) {
                        LAS f32x4_t* d = (LAS f32x4_t*)(dst + (lt + 256 * i) * 8);
                        d[0] = (f32x4_t){__uint_as_float(regs[i].x << 16), __uint_as_float(regs[i].x & 0xffff0000u), __uint_as_float(regs[i].y << 16), __uint_as_float(regs[i].y & 0xffff0000u)};
                        d[1] = (f32x4_t){__uint_as_float(regs[i].z << 16), __uint_as_float(regs[i].z & 0xffff0000u), __uint_as_float(regs[i].w << 16), __uint_as_float(regs[i].w & 0xffff0000u)};
                    }
                    if (c + 2 < NCH) {
#pragma unroll
                        for (int i = 0; i < 6; ++i) regs[i] = *(const u32x4_t*)(src + (size_t)(c + 2) * SC_CHUNK_F + (size_t)(lt + 256 * i) * 8);
                    }
                }
                if (c > 0) {
                    const int st = lt >> 3, r2 = (lt & 7) * 2;
                    const LAS float* ys = yring + ((c - 1) & 1) * (SC_STEPS * 16) + st * 16 + r2;
                    const size_t tok = (size_t)(bh >> 3) * T_ + (size_t)(c - 1) * SC_STEPS + st;
                    typedef float f32x2_t __attribute__((ext_vector_type(2)));
                    *(f32x2_t*)(Y + tok * W_ + (bh & 7) * 64 + qtr * 16 + r2) = (f32x2_t){ys[0], ys[1]};
                }
                __syncthreads();
            }
            {
                const int c = NCH;
                const int st = lt >> 3, r2 = (lt & 7) * 2;
                const LAS float* ys = yring + ((c - 1) & 1) * (SC_STEPS * 16) + st * 16 + r2;
                const size_t tok = (size_t)(bh >> 3) * T_ + (size_t)(c - 1) * SC_STEPS + st;
                typedef float f32x2_t __attribute__((ext_vector_type(2)));
                *(f32x2_t*)(Y + tok * W_ + (bh & 7) * 64 + qtr * 16 + r2) = (f32x2_t){ys[0], ys[1]};
            }
        } else {
            const int rl = F.wave * 4 + (F.lane >> 4);
            const int cj = (F.lane & 15) * 4;
            const int vch = qtr * 16 + rl;
            float S0 = 0.f, S1 = 0.f, S2 = 0.f, S3 = 0.f;
            __syncthreads();
            for (int c = 0; c < NCH; ++c) {
                const LAS float* buf = ring + (c & 1) * SC_CHUNK_F;
                LAS float* yb = yring + (c & 1) * (SC_STEPS * 16);
#pragma unroll 4
                for (int st = 0; st < SC_STEPS; ++st) {
                    const LAS float* sp = buf + st * 384;
                    const f32x4_t r4 = *(const LAS f32x4_t*)(sp + 0 * 64 + cj), om4 = *(const LAS f32x4_t*)(sp + 1 * 64 + cj), k4 = *(const LAS f32x4_t*)(sp + 2 * 64 + cj),
                                  kk4 = *(const LAS f32x4_t*)(sp + 4 * 64 + cj), b4 = *(const LAS f32x4_t*)(sp + 5 * 64 + cj);
                    const float v = sp[3 * 64 + vch];
                    float sa = (S0 * kk4.x + S1 * kk4.y) + (S2 * kk4.z + S3 * kk4.w);
                    ROW_ALLREDUCE(sa);
                    S0 = (S0 - S0 * om4.x) + (v * k4.x - sa * b4.x);
                    S1 = (S1 - S1 * om4.y) + (v * k4.y - sa * b4.y);
                    S2 = (S2 - S2 * om4.z) + (v * k4.z - sa * b4.z);
                    S3 = (S3 - S3 * om4.w) + (v * k4.w - sa * b4.w);
                    float y = (S0 * r4.x + S1 * r4.y) + (S2 * r4.z + S3 * r4.w);
                    ROW_ALLREDUCE(y);
                    if ((F.lane & 15) == 0) yb[st * 16 + rl] = y;
                }
                __syncthreads();
            }
        }
    }
}

__device__ __forceinline__ void p_rw_post(Frame& F, int l) {
    RELAUNDER(F);
    const int gw = F.vcu * NWAVES + F.wave, NGW = F.G * NWAVES;
    const float* Y = (const float*)(F.ws + WS_S + S_Y); const bf16_t* SC = (const bf16_t*)(F.ws + WS_S + S_SC); const bf16_t* Gb = (const bf16_t*)(F.ws + WS_S + S_G);
    const float* BON = (const float*)(F.ws + WS_S + S_BON); bf16_t* CC = (bf16_t*)(F.ws + WS_S + S_CONCAT);
    const float* lnw = F.in[15] + l * W_; const float* lnb = F.in[16] + l * W_;
    for (int tok = gw; tok < NTOK; tok += NGW) {
        const int c = F.lane * 8, h = F.lane >> 3, b = tok >> 11, t = tok & (T_ - 1);
        const f32x4_t y0 = *(const f32x4_t*)(Y + (size_t)tok * W_ + c), y1 = *(const f32x4_t*)(Y + (size_t)tok * W_ + c + 4);
        float s = ((y0.x + y0.y) + (y0.z + y0.w)) + ((y1.x + y1.y) + (y1.z + y1.w));
        s += shx(s, F.lane, 1); s += shx(s, F.lane, 2); s += shx(s, F.lane, 4);
        const float mean = s * (1.f / 64.f);
        const f32x4_t d0 = y0 - mean, d1 = y1 - mean;
        float q = ((d0.x * d0.x + d0.y * d0.y) + (d0.z * d0.z + d0.w * d0.w)) + ((d1.x * d1.x + d1.y * d1.y) + (d1.z * d1.z + d1.w * d1.w));
        q += shx(q, F.lane, 1); q += shx(q, F.lane, 2); q += shx(q, F.lane, 4);
        const float rstd = 1.0f / sqrtf(q * (1.f / 64.f) + 64e-5f);
        const float bon = BON[(size_t)tok * 8 + h];
        const u32x4_t vw = *(const u32x4_t*)(SC + ((((size_t)b * 8 + h) * T_ + t) * 6 + 3) * 64 + (c & 63));
        const u32x4_t gw4 = *(const u32x4_t*)(Gb + (size_t)tok * W_ + c);
        const f32x4_t w0 = *(const f32x4_t*)(lnw + c), w1 = *(const f32x4_t*)(lnw + c + 4), b0 = *(const f32x4_t*)(lnb + c), b1 = *(const f32x4_t*)(lnb + c + 4);
        float o[8];
#pragma unroll
        for (int e = 0; e < 8; ++e) {
            const float d = e < 4 ? d0[e] : d1[e - 4], lw = e < 4 ? w0[e] : w1[e - 4], lb = e < 4 ? b0[e] : b1[e - 4];
            const unsigned vq = vw[e >> 1], gq = gw4[e >> 1];
            const float v = (e & 1) ? __uint_as_float(vq & 0xffff0000u) : __uint_as_float(vq << 16), g = (e & 1) ? __uint_as_float(gq & 0xffff0000u) : __uint_as_float(gq << 16);
            o[e] = (d * rstd * lw + lb + bon * v) * g;
        }
        u32x4_t ow; ow.x = pk2(o[0], o[1]); ow.y = pk2(o[2], o[3]); ow.z = pk2(o[4], o[5]); ow.w = pk2(o[6], o[7]);
        *(u32x4_t*)(CC + (size_t)tok * D_ + c) = ow;
    }
}

__device__ __forceinline__ void p_route(Frame& F) {
    RELAUNDER(F);
    LAS int* lcnt = (LAS int*)F.lds;
    LAS int* gbase = lcnt + 8;
    LAS int* te = lcnt + 16;
    LAS int* tr = te + 128;
    LAS float* tg = (LAS float*)(tr + 128);
    const float* X = (const float*)(F.ws + WS_X); const float* ssq = (const float*)(F.ws + WS_SSQ);
    const float* gn = F.in[31] + D_; const float* wr = F.in[35];
    int* CNT = (int*)(F.ws + WS_CTL + CTL_CNT);
    int* INV = (int*)(F.ws + WS_MT + MT_INV); float* TOKG = (float*)(F.ws + WS_MT + MT_TOKG);
    for (int chunk = F.vcu; chunk < NTOK / 64; chunk += F.G) {
        if (F.tid < 8) lcnt[F.tid] = 0;
        __syncthreads();
        for (int i = 0; i < 8; ++i) {
            const int tokl = F.wave * 8 + i, tok = chunk * 64 + tokl;
            float acc[8];
#pragma unroll
            for (int e = 0; e < 8; ++e) acc[e] = 0.f;
#pragma unroll
            for (int j = 0; j < 4; ++j) {
                const int k0 = F.lane * 4 + 256 * j;
                const f32x4_t xv = *(const f32x4_t*)(X + (size_t)tok * D_ + k0), gv = *(const f32x4_t*)(gn + k0);
#pragma unroll
                for (int q = 0; q < 4; ++q) {
                    const float hv = xv[q] * gv[q];
                    const f32x4_t w0 = *(const f32x4_t*)(wr + (size_t)(k0 + q) * 8), w1 = *(const f32x4_t*)(wr + (size_t)(k0 + q) * 8 + 4);
                    acc[0] += hv * w0[0]; acc[1] += hv * w0[1]; acc[2] += hv * w0[2]; acc[3] += hv * w0[3];
                    acc[4] += hv * w1[0]; acc[5] += hv * w1[1]; acc[6] += hv * w1[2]; acc[7] += hv * w1[3];
                }
            }
            const float rinv = pg8::row_rinv(ssq, tok);
#pragma unroll
            for (int e = 0; e < 8; ++e) acc[e] = wave_sum_l(acc[e], F.lane) * rinv;
            int e0 = 0; float v0 = acc[0];
#pragma unroll
            for (int e = 1; e < 8; ++e) if (acc[e] > v0) { v0 = acc[e]; e0 = e; }
            int e1 = -1; float v1 = 0.f;
#pragma unroll
            for (int e = 0; e < 8; ++e) if (e != e0 && (e1 < 0 || acc[e] > v1)) { v1 = acc[e]; e1 = e; }
            if (F.lane == 0) {
                const float p1 = __expf(v1 - v0), inv = 1.f / (1.f + p1);
                te[tokl * 2] = e0; te[tokl * 2 + 1] = e1; tg[tokl * 2] = inv; tg[tokl * 2 + 1] = p1 * inv;
                tr[tokl * 2] = __hip_atomic_fetch_add(lcnt + e0, 1, __ATOMIC_RELAXED, __HIP_MEMORY_SCOPE_WORKGROUP);
                tr[tokl * 2 + 1] = __hip_atomic_fetch_add(lcnt + e1, 1, __ATOMIC_RELAXED, __HIP_MEMORY_SCOPE_WORKGROUP);
            }
        }
        __syncthreads();
        if (F.tid < 8) gbase[F.tid] = atomicAdd(CNT + F.tid, lcnt[F.tid]);
        __syncthreads();
        if (F.tid < 128) {
            const int e = te[F.tid], idx = gbase[e] + tr[F.tid], t2 = chunk * 128 + F.tid;
            TOKG[t2] = tg[F.tid]; INV[(size_t)e * NTOK + idx] = t2;
        }
        __syncthreads();
    }
}
__device__ __forceinline__ ConvJob conv_job_exp(const Frame& F, int j) {
    const int e = j / 3, k = j % 3; ConvJob c; c.coff = 0;
    if (k < 2) { c.W = (k == 0 ? F.in[36] : F.in[37]) + (size_t)e * D_ * EFF; c.ldw = EFF; c.nvalid = EFF; c.npad = EFF; c.K = 1024; c.g = F.in[31] + D_; c.rowmode = 1 + k;
                 c.dst = (bf16_t*)(F.ws + WS_WE) + (size_t)e * 7168 * 1024; }
    else { c.W = F.in[38] + (size_t)e * EFF * D_; c.ldw = D_; c.nvalid = D_; c.npad = D_; c.K = EFF; c.g = nullptr; c.rowmode = 0; c.dst = (bf16_t*)(F.ws + WS_WE + WE_D) + (size_t)e * 1024 * EFF; }
    return c;
}
__device__ __forceinline__ void p_moe_prep(Frame& F) {
    RELAUNDER(F);
    LAS int* tb = (LAS int*)F.lds;
    LAS int* cn = tb + 16;
    const int* CNT = (const int*)(F.ws + WS_CTL + CTL_CNT);
    int* TILE = (int*)(F.ws + WS_MT + MT_TILE);
    if (F.tid == 0) { int acc = 0; for (int e = 0; e < 8; ++e) { const int c = CNT[e]; cn[e] = c; tb[e] = acc; acc += (c + 255) >> 8; } tb[8] = acc; }
    __syncthreads();
    const int MT = tb[8];
    if (F.vcu == 0) {
        if (F.tid == 0) TILE[0] = MT;
        if (F.tid < 9) TILE[16 + F.tid] = tb[F.tid];
        for (int pm = F.tid; pm < MT; pm += NWAVES * 64) { int e = 0; for (int q = 1; q < 8; ++q) if (pm >= tb[q]) e = q; TILE[64 + pm] = e; }
    }
    const int gw = F.vcu * NWAVES + F.wave, NGW = F.G * NWAVES;
    const float* X = (const float*)(F.ws + WS_X); const float* ssq = (const float*)(F.ws + WS_SSQ);
    const int* INV = (const int*)(F.ws + WS_MT + MT_INV); const float* TOKG = (const float*)(F.ws + WS_MT + MT_TOKG);
    int* ROWINFO = (int*)(F.ws + WS_MT + MT_ROWINFO); float* ROWG = (float*)(F.ws + WS_MT + MT_ROWG);
    bf16_t* XG = (bf16_t*)(F.ws + WS_XG);
    for (int row = gw; row < MT * 256; row += NGW) {
        const int pm = row >> 8; int e = 0;
        for (int q = 1; q < 8; ++q) if (pm >= tb[q]) e = q;
        const int idx = (pm - tb[e]) * 256 + (row & 255);
        GAS unsigned long long* o8 = (GAS unsigned long long*)(XG + (size_t)row * D_) + F.lane;
        if (idx < cn[e]) {
            const int t2 = INV[(size_t)e * NTOK + idx], tok = t2 >> 1;
            const float rinv = pg8::row_rinv(ssq, tok);
            const GAS f32x4_t* xr = (const GAS f32x4_t*)(X + (size_t)tok * D_) + F.lane;
#pragma unroll
            for (int j = 0; j < 4; ++j) { const f32x4_t v = xr[64 * j] * rinv; o8[64 * j] = (unsigned long long)pk2(v.x, v.y) | ((unsigned long long)pk2(v.z, v.w) << 32); }
            if (F.lane == 0) { ROWINFO[row] = t2; ROWG[row] = TOKG[t2]; }
        } else {
#pragma unroll
            for (int j = 0; j < 4; ++j) o8[64 * j] = 0ull;
            if (F.lane == 0) { ROWINFO[row] = -1; ROWG[row] = 0.f; }
        }
    }
    LAS float* scr = (LAS float*)(F.lds + RING_OFF + 1024 + F.wave * 16384);
    int base = 0;
#pragma nounroll
    for (int j = 0; j < 24; ++j) {
        const ConvJob c = conv_job_exp(F, j);
        const int nblk = c.npad / 32, items = (c.K / 64) * nblk;
#pragma nounroll
        for (int it = (gw + NGW - (base % NGW)) % NGW; it < items; it += NGW) conv_item(c.W, c.ldw, c.coff, c.nvalid, c.g, c.dst, c.K, nblk, c.rowmode, scr, it, F.lane);
        base += items;
    }
}
__device__ __forceinline__ void p_moe_gemm1(Frame& F, int pass) {
    RELAUNDER(F);
    const int* TILE = (const int*)(F.ws + WS_MT + MT_TILE);
    const int MT = __builtin_amdgcn_readfirstlane(TILE[0]), pm_lo = pass * MOE_PASS_TILES; int nMp = MT - pm_lo; nMp = nMp < 0 ? 0 : (nMp > MOE_PASS_TILES ? MOE_PASS_TILES : nMp);
    pg8::Gemm g{(const bf16_t*)(F.ws + WS_XG) + (size_t)pm_lo * 256 * 1024, (const bf16_t*)(F.ws + WS_WE), nMp * 256, 7168, 1024, (size_t)7168 * 1024 * 2};
    pg8::MoeOrder S; S.init(nMp, 28, F.G, (int)blockIdx.x, pm_lo, TILE + 64);
    pg8::EpiSwiGLU E{(bf16_t*)(F.ws + WS_ACTM), EFF, nullptr};
    pg8::gemm_phase<pg8::EpiSwiGLU, pg8::MoeOrder, true, true>(F.lds + RING_OFF, g, S, E, F.tid);
}
__device__ __forceinline__ void p_moe_gemm2(Frame& F, int pass) {
    RELAUNDER(F);
    const int* TILE = (const int*)(F.ws + WS_MT + MT_TILE);
    const int MT = __builtin_amdgcn_readfirstlane(TILE[0]), pm_lo = pass * MOE_PASS_TILES; int nMp = MT - pm_lo; nMp = nMp < 0 ? 0 : (nMp > MOE_PASS_TILES ? MOE_PASS_TILES : nMp);
    pg8::Gemm g{(const bf16_t*)(F.ws + WS_ACTM), (const bf16_t*)(F.ws + WS_WE + WE_D), nMp * 256, 1024, EFF, (size_t)1024 * EFF * 2};
    pg8::MoeOrder S; S.init(nMp, 4, F.G, (int)blockIdx.x, pm_lo, TILE + 64);
    pg8::EpiMoeDown E{(bf16_t*)F.out, (const int*)(F.ws + WS_MT + MT_ROWINFO) + pm_lo * 256, (const float*)(F.ws + WS_MT + MT_ROWG) + pm_lo * 256};
    pg8::gemm_phase<pg8::EpiMoeDown, pg8::MoeOrder, true, true>(F.lds + RING_OFF, g, S, E, F.tid);
}
__device__ __forceinline__ void p_final(Frame& F, bool moe) {
    RELAUNDER(F);
    const int gw = F.vcu * NWAVES + F.wave, NGW = F.G * NWAVES;
    const float* X = (const float*)(F.ws + WS_X); const float* gn = F.in[39];
    for (int tok = gw; tok < NTOK; tok += NGW) {
        f32x4_t s[4]; float q = 0.f;
#pragma unroll
        for (int j = 0; j < 4; ++j) {
            const int col = F.lane * 4 + 256 * j;
            f32x4_t v = *(const f32x4_t*)(X + (size_t)tok * D_ + col);
            if (moe) {
                const u32x2_t a = *(const u32x2_t*)((const bf16_t*)F.out + (size_t)tok * 2048 + col), b = *(const u32x2_t*)((const bf16_t*)F.out + (size_t)tok * 2048 + 1024 + col);
                v.x += __uint_as_float(a.x << 16) + __uint_as_float(b.x << 16); v.y += __uint_as_float(a.x & 0xffff0000u) + __uint_as_float(b.x & 0xffff0000u);
                v.z += __uint_as_float(a.y << 16) + __uint_as_float(b.y << 16); v.w += __uint_as_float(a.y & 0xffff0000u) + __uint_as_float(b.y & 0xffff0000u);
            }
            s[j] = v; q += (v.x * v.x + v.y * v.y) + (v.z * v.z + v.w * v.w);
        }
        q = wave_sum_l(q, F.lane);
        const float rinv = 1.0f / sqrtf(q * (1.0f / 1024.0f) + 1e-6f);
#pragma unroll
        for (int j = 0; j < 4; ++j) {
            const int col = F.lane * 4 + 256 * j;
            const f32x4_t gv = *(const f32x4_t*)(gn + col);
            *(f32x4_t*)(F.out + (size_t)tok * D_ + col) = s[j] * rinv * gv;
        }
    }
}


constexpr size_t S_KCB = S_BON + 512 * 1024;
constexpr size_t S_VCB = S_KCB + 256 * 1024;
static_assert(S_VCB + 256 * 1024 <= S_END, "scratch map");
namespace nsa {
typedef short bf16x8 __attribute__((ext_vector_type(8)));
typedef short s16x4 __attribute__((ext_vector_type(4)));
typedef float f32x16 __attribute__((ext_vector_type(16)));
typedef float f32x4 __attribute__((ext_vector_type(4)));
constexpr float LOG2E = 1.4426950408889634f;
__device__ __forceinline__ int crow(int r, int hi) { return (r & 3) + 8 * (r >> 2) + 4 * hi; }
__device__ __forceinline__ unsigned cvtpk(float lo, float hi) { unsigned r; asm volatile("v_cvt_pk_bf16_f32 %0, %1, %2" : "=v"(r) : "v"(lo), "v"(hi)); return r; }
constexpr int L_KB = 0, L_VB = 16384, L_WSF = 32768, L_IMPQ = 36864, L_IMPL = L_IMPQ + 4 * 64 * 33 * 4, L_IMPF = L_IMPL + 4 * 64 * 33 * 4, L_SELM = L_IMPF + 64 * 33 * 4, L_MISC = L_SELM + 256, L_LIST = L_MISC + 16, L_END = L_LIST + 64 * 4;
static_assert(L_END <= 131072, "NSA LDS map");

__device__ __forceinline__ void qkt(f32x16& p0, f32x16& p1, const LAS unsigned char* Kslot, const bf16x8* qr, int r32, int hi) {
    const LAS unsigned char* kb = Kslot + hi * 1024 + r32 * 16;
    p0 = (f32x16){}; p1 = (f32x16){};
#pragma unroll
    for (int d0 = 0; d0 < 4; ++d0) {
        const bf16x8 b0 = *(const LAS bf16x8*)(kb + d0 * 2048);
        const bf16x8 b1 = *(const LAS bf16x8*)(kb + d0 * 2048 + 512);
        p0 = __builtin_amdgcn_mfma_f32_32x32x16_bf16(b0, qr[d0], p0, 0, 0, 0);
        p1 = __builtin_amdgcn_mfma_f32_32x32x16_bf16(b1, qr[d0], p1, 0, 0, 0);
    }
}
__device__ __forceinline__ void pv(f32x16* o, int vb, bf16x8 pa0, bf16x8 pa1, bf16x8 pa2, bf16x8 pa3) {
#pragma unroll
    for (int d0 = 0; d0 < 2; ++d0) {
        s16x4 lo[4], hi[4];
#pragma unroll
        for (int ks = 0; ks < 4; ++ks) {
            asm volatile("ds_read_b64_tr_b16 %0,%1 offset:%c2" : "=&v"(lo[ks]) : "v"(vb), "i"(d0 * 4096 + ks * 1024) : "memory");
            asm volatile("ds_read_b64_tr_b16 %0,%1 offset:%c2" : "=&v"(hi[ks]) : "v"(vb), "i"(d0 * 4096 + ks * 1024 + 512) : "memory");
        }
        asm volatile("s_waitcnt lgkmcnt(0)" ::: "memory"); __builtin_amdgcn_sched_barrier(0);
#define NSA_PK(k) (bf16x8){lo[k][0], lo[k][1], lo[k][2], lo[k][3], hi[k][0], hi[k][1], hi[k][2], hi[k][3]}
        o[d0] = __builtin_amdgcn_mfma_f32_32x32x16_bf16(pa0, NSA_PK(0), o[d0], 0, 0, 0);
        o[d0] = __builtin_amdgcn_mfma_f32_32x32x16_bf16(pa1, NSA_PK(1), o[d0], 0, 0, 0);
        o[d0] = __builtin_amdgcn_mfma_f32_32x32x16_bf16(pa2, NSA_PK(2), o[d0], 0, 0, 0);
        o[d0] = __builtin_amdgcn_mfma_f32_32x32x16_bf16(pa3, NSA_PK(3), o[d0], 0, 0, 0);
#undef NSA_PK
    }
}
__device__ __forceinline__ float swap_max(float m) { auto rr = __builtin_amdgcn_permlane32_swap(__float_as_uint(m), __float_as_uint(m), false, false); return fmaxf(__uint_as_float(rr[0]), __uint_as_float(rr[1])); }
__device__ __forceinline__ float swap_sum(float m) { auto rr = __builtin_amdgcn_permlane32_swap(__float_as_uint(m), __float_as_uint(m), false, false); return __uint_as_float(rr[0]) + __uint_as_float(rr[1]); }
__device__ __forceinline__ void pack_p(const f32x16& p0, const f32x16& p1, bf16x8& a0, bf16x8& a1, bf16x8& a2, bf16x8& a3) {
    u32x4_t w0, w1, w2, w3;
    w0.x = cvtpk(p0[0], p0[1]); w0.y = cvtpk(p0[2], p0[3]); w0.z = cvtpk(p0[4], p0[5]); w0.w = cvtpk(p0[6], p0[7]);
    w1.x = cvtpk(p0[8], p0[9]); w1.y = cvtpk(p0[10], p0[11]); w1.z = cvtpk(p0[12], p0[13]); w1.w = cvtpk(p0[14], p0[15]);
    w2.x = cvtpk(p1[0], p1[1]); w2.y = cvtpk(p1[2], p1[3]); w2.z = cvtpk(p1[4], p1[5]); w2.w = cvtpk(p1[6], p1[7]);
    w3.x = cvtpk(p1[8], p1[9]); w3.y = cvtpk(p1[10], p1[11]); w3.z = cvtpk(p1[12], p1[13]); w3.w = cvtpk(p1[14], p1[15]);
    a0 = __builtin_bit_cast(bf16x8, w0); a1 = __builtin_bit_cast(bf16x8, w1); a2 = __builtin_bit_cast(bf16x8, w2); a3 = __builtin_bit_cast(bf16x8, w3);
}
__device__ __forceinline__ void scale_o(f32x16* o, float fac, LAS float* wsf, int r32, int hi) {
    if (hi == 0) wsf[r32] = fac;
    asm volatile("s_waitcnt lgkmcnt(0)" ::: "memory");
#pragma unroll
    for (int r = 0; r < 16; ++r) { const float f = wsf[crow(r, hi)]; o[0][r] *= f; o[1][r] *= f; }
}
__device__ __forceinline__ void axpy_o(f32x16* out, const f32x16* o, float fac, LAS float* wsf, int r32, int hi) {
    if (hi == 0) wsf[32 + r32] = fac;
    asm volatile("s_waitcnt lgkmcnt(0)" ::: "memory");
#pragma unroll
    for (int r = 0; r < 16; ++r) { const float f = wsf[32 + crow(r, hi)]; out[0][r] += f * o[0][r]; out[1][r] += f * o[1][r]; }
}
}

__device__ __forceinline__ void p_nsa_cmp(Frame& F, int l) {
    RELAUNDER(F);
    const int n_rw = l == 0 ? 1792 : 1824;
    const bf16_t* P = (const bf16_t*)(F.ws + WS_S + S_PROJ);
    LAS bf16_t* Hs = (LAS bf16_t*)F.lds;
    const int w = F.wave, fr = F.lane & 15, fq = F.lane >> 4;
    for (int item = F.vcu; item < 256; item += F.G) {
        const int kv = item >> 7, b = (item >> 4) & 7, g = (item >> 3) & 1, ch = item & 7;
        const int colbase = n_rw + 512 + kv * 128 + g * 64;
        const bf16_t* W1T = (const bf16_t*)(F.ws + WS_WB + WB_CW1) + (size_t)(l * 2 + kv) * 128 * 2048;
        const bf16_t* W2T = (const bf16_t*)(F.ws + WS_WB + WB_CW2) + (size_t)(l * 2 + kv) * 64 * 128;
        const float* cb = (const float*)(F.ws + WS_WB + WB_CB) + (l * 2 + kv) * 128;
        const int n = ch * 16 + fr, nc = n < NCMP ? n : NCMP - 1;
        const bf16_t* arow = P + ((size_t)b * T_ + 16 * nc) * NPJ + colbase;
        const bf16_t* brow = W1T + (size_t)(16 * w + fr) * 2048;
        pg8::f32x4 acc = {0.f, 0.f, 0.f, 0.f};
#pragma unroll 8
        for (int ks = 0; ks < 64; ++ks) {
            const int k0 = ks * 32 + fq * 8;
            const nsa::bf16x8 a = *(const nsa::bf16x8*)(arow + (size_t)(k0 >> 6) * NPJ + (k0 & 63));
            const nsa::bf16x8 bw = *(const nsa::bf16x8*)(brow + k0);
            acc = __builtin_amdgcn_mfma_f32_16x16x32_bf16(a, bw, acc, 0, 0, 0);
        }
        __syncthreads();
        const float bias = cb[16 * w + fr];
#pragma unroll
        for (int r = 0; r < 4; ++r) {
            const float x = acc[r] + bias;
            const float ge = 0.5f * x * (1.f + tanhf(0.7978845608028654f * (x + 0.044715f * x * x * x)));
            Hs[(4 * fq + r) * 136 + 16 * w + fr] = (bf16_t)f2bf(ge);
        }
        __syncthreads();
        if (w < 4) {
            pg8::f32x4 acc2 = {0.f, 0.f, 0.f, 0.f};
#pragma unroll
            for (int ks = 0; ks < 4; ++ks) {
                const nsa::bf16x8 a = *(const LAS nsa::bf16x8*)(Hs + fr * 136 + ks * 32 + fq * 8);
                const nsa::bf16x8 bw = *(const nsa::bf16x8*)(W2T + (size_t)(16 * w + fr) * 128 + ks * 32 + fq * 8);
                acc2 = __builtin_amdgcn_mfma_f32_16x16x32_bf16(a, bw, acc2, 0, 0, 0);
            }
            bf16_t* dst = (bf16_t*)(F.ws + WS_S + (kv == 0 ? S_KCB : S_VCB)) + ((size_t)(b * 2 + g) * 128) * 64;
#pragma unroll
            for (int r = 0; r < 4; ++r) { const int nn = ch * 16 + 4 * fq + r; dst[(size_t)nn * 64 + 16 * w + fr] = (bf16_t)f2bf(nn < NCMP ? acc2[r] : 0.f); }
        }
    }
}

__device__ __forceinline__ void nsa_item(Frame& F, const bf16_t* P, int n_rw, int b, int g, int c) {
    using namespace nsa;
    int tidl = F.tid; asm volatile("" : "+v"(tidl));
    const int lanel = tidl & 63;
    const int w = __builtin_amdgcn_readfirstlane(tidl >> 6), rh = w >> 1, th = w & 1, r32 = lanel & 31, hi = lanel >> 5;
    const int t0 = c * 64, tq = t0 + th * 32 + r32;
    const int hq = g * 4 + rh;
    const float slope2 = exp2f(-(float)(hq + 1)) * LOG2E;
    const size_t tokrow = (size_t)b * T_ + tq;
    LAS unsigned char* L = F.lds;
    LAS float* wsf = (LAS float*)(L + L_WSF) + w * 64;
    LAS float* IMPQ = (LAS float*)(L + L_IMPQ); LAS float* IMPL = (LAS float*)(L + L_IMPL); LAS float* IMPF = (LAS float*)(L + L_IMPF);
    LAS unsigned* SELM = (LAS unsigned*)(L + L_SELM); LAS int* MISCL = (LAS int*)(L + L_MISC); LAS int* LIST = (LAS int*)(L + L_LIST);
    const unsigned lds0 = (unsigned)(uintptr_t)L;
    const int vboff = ((lanel >> 4) & 1) * 32 + (lanel & 3) * 8 + (4 * hi + ((lanel & 15) >> 2)) * 64;
    bf16x8 qr[4];
    {
        const bf16_t* qp = P + tokrow * NPJ + n_rw + g * 256 + rh * 64 + hi * 8;
#pragma unroll
        for (int d0 = 0; d0 < 4; ++d0) {
            const u32x4_t raw = *(const u32x4_t*)(qp + d0 * 16); u32x4_t sc;
#pragma unroll
            for (int e = 0; e < 4; ++e) sc[e] = cvtpk(__uint_as_float(raw[e] << 16) * (0.125f * LOG2E), __uint_as_float(raw[e] & 0xffff0000u) * (0.125f * LOG2E));
            qr[d0] = __builtin_bit_cast(bf16x8, sc);
        }
    }
    const bf16_t* gp = P + tokrow * NPJ + n_rw + 1280 + hq * 3;
    const float gate0 = sigmoidf_(bf2f(gp[0])), gate1 = sigmoidf_(bf2f(gp[1])), gate2 = sigmoidf_(bf2f(gp[2]));
    f32x16 out[2]; out[0] = (f32x16){}; out[1] = (f32x16){};
    const int lk_key = tidl & 63, lk_c8 = tidl >> 6, lv_key = tidl >> 3, lv_p = tidl & 7;
    const int lk_dst = lk_c8 * 1024 + lk_key * 16, lv_dst = (lv_p >> 2) * 4096 + lv_key * 64 + (lv_p & 3) * 16;
    const int lv_src = (lv_p >> 2) * 32 + (lv_p & 3) * 8;
    __syncthreads();
    {
        const bf16_t* KCB = (const bf16_t*)(F.ws + WS_S + S_KCB) + ((size_t)(b * 2 + g) * 128) * 64;
        const bf16_t* VCB = (const bf16_t*)(F.ws + WS_S + S_VCB) + ((size_t)(b * 2 + g) * 128) * 64;
#pragma unroll
        for (int jt = 0; jt < 2; ++jt) {
            *(LAS u32x4_t*)(L + L_KB + jt * 8192 + lk_dst) = *(const u32x4_t*)(KCB + (size_t)(jt * 64 + lk_key) * 64 + lk_c8 * 8);
            *(LAS u32x4_t*)(L + L_VB + jt * 8192 + lv_dst) = *(const u32x4_t*)(VCB + (size_t)(jt * 64 + lv_key) * 64 + lv_src);
        }
        __syncthreads();
        f32x16 s0a, s0b, s1a, s1b;
        qkt(s0a, s0b, L + L_KB, qr, r32, hi);
        qkt(s1a, s1b, L + L_KB + 8192, qr, r32, hi);
        float m = -INFINITY;
#pragma unroll
        for (int r = 0; r < 16; ++r) {
            const int key = crow(r, hi);
#define CMP_MASK(S, nn) { const int n_ = (nn); const int dist_ = tq - (16 * n_ + 31); const bool ok_ = (n_ < NCMP) && (dist_ >= 0); S[r] = ok_ ? S[r] - slope2 * (float)dist_ : -INFINITY; m = fmaxf(m, S[r]); }
            CMP_MASK(s0a, key) CMP_MASK(s0b, key + 32) CMP_MASK(s1a, 64 + key) CMP_MASK(s1b, 96 + key)
#undef CMP_MASK
        }
        m = swap_max(m);
        if (m == -INFINITY) m = 0.f;
        float lsum = 0.f;
#pragma unroll
        for (int r = 0; r < 16; ++r) { s0a[r] = __builtin_amdgcn_exp2f(s0a[r] - m); s0b[r] = __builtin_amdgcn_exp2f(s0b[r] - m); s1a[r] = __builtin_amdgcn_exp2f(s1a[r] - m); s1b[r] = __builtin_amdgcn_exp2f(s1b[r] - m); lsum += (s0a[r] + s0b[r]) + (s1a[r] + s1b[r]); }
        lsum = swap_sum(lsum);
        const float inv = lsum > 0.f ? 1.0f / lsum : 0.f;
#pragma unroll
        for (int r = 0; r < 16; ++r) { s0a[r] *= inv; s0b[r] *= inv; s1a[r] *= inv; s1b[r] *= inv; }
        {
            LAS float* iq = IMPQ + (rh * 64 + th * 32 + r32) * 33; LAS float* il = IMPL + (rh * 64 + th * 32 + r32) * 33;
#pragma unroll
            for (int rq = 0; rq < 4; ++rq) {
#define IMP_Q(S, Qb) { const int Q_ = (Qb) + 2 * rq + hi; iq[Q_] = (S[4 * rq] + S[4 * rq + 1]) + (S[4 * rq + 2] + S[4 * rq + 3]); il[Q_] = S[4 * rq + 3]; }
                IMP_Q(s0a, 0) IMP_Q(s0b, 8) IMP_Q(s1a, 16) IMP_Q(s1b, 24)
#undef IMP_Q
            }
        }
        bf16x8 a0, a1, a2, a3;
        pack_p(s0a, s0b, a0, a1, a2, a3); pv(out, (int)(lds0 + L_VB) + vboff, a0, a1, a2, a3);
        pack_p(s1a, s1b, a0, a1, a2, a3); pv(out, (int)(lds0 + L_VB + 8192) + vboff, a0, a1, a2, a3);
        scale_o(out, gate0, wsf, r32, hi);
    }
    __syncthreads();
    for (int idx = tidl; idx < 64 * 32; idx += NWAVES * 64) {
        const int tokl = idx >> 5, j = idx & 31; float s = 0.f;
#pragma unroll
        for (int h4 = 0; h4 < 4; ++h4) { s += IMPQ[(h4 * 64 + tokl) * 33 + j]; if (j > 0) s += IMPL[(h4 * 64 + tokl) * 33 + j - 1]; }
        IMPF[tokl * 33 + j] = s;
    }
    __syncthreads();
#pragma unroll 1
    for (int pass = 0; pass < 4; ++pass) {
        const int tokl = pass * 16 + (tidl >> 5), j = tidl & 31;
        bool sel;
        if (c < 16) sel = (j <= c);
        else {
            const float mine = IMPF[tokl * 33 + j]; int rank = 0;
            for (int jj = 1; jj <= c - 2; ++jj) { const float o2 = IMPF[tokl * 33 + jj]; rank += (o2 > mine || (o2 == mine && jj < j)) ? 1 : 0; }
            sel = (j == 0) || (j == c) || (j == c - 1) || (j >= 1 && j <= c - 2 && rank < 13);
        }
        const unsigned long long bal = __ballot(sel);
        if ((lanel & 31) == 0) SELM[tokl] = (lanel == 0) ? (unsigned)(bal & 0xffffffffull) : (unsigned)(bal >> 32);
    }
    __syncthreads();
    if (tidl < 64) {
        unsigned um = SELM[tidl];
#pragma unroll
        for (int o = 1; o < 64; o <<= 1) um |= (unsigned)__builtin_amdgcn_ds_bpermute((lanel ^ o) << 2, (int)um);
        if (tidl == 0) {
            int n = 0;
            const int jlo = c - 8 > 0 ? c - 8 : 0;
            for (int j = jlo; j <= c; ++j) LIST[n++] = (1 << 8) | j;
            for (int j = 0; j <= c; ++j) if ((um >> j) & 1u) LIST[n++] = (0 << 8) | j;
            MISCL[0] = n;
        }
    }
    __syncthreads();
    const int ntl = MISCL[0];
    const unsigned selq = SELM[th * 32 + r32];
    {
        const bf16_t* Pb = P + (size_t)b * T_ * NPJ;
        u32x4_t kreg, vreg;
#define TILE_LOAD(ent) do { const int ty_ = (ent) >> 8, j_ = (ent) & 255; const int kc_ = n_rw + 512 + (ty_ ? 4 : 2) * 128 + g * 64; \
        kreg = *(const u32x4_t*)(Pb + (size_t)(j_ * 64 + lk_key) * NPJ + kc_ + lk_c8 * 8); vreg = *(const u32x4_t*)(Pb + (size_t)(j_ * 64 + lv_key) * NPJ + kc_ + 128 + lv_src); } while (0)
#define TILE_STORE(buf) do { *(LAS u32x4_t*)(L + L_KB + (buf) * 8192 + lk_dst) = kreg; *(LAS u32x4_t*)(L + L_VB + (buf) * 8192 + lv_dst) = vreg; } while (0)
        TILE_LOAD(LIST[0]); TILE_STORE(0);
        __syncthreads();
        float m = -1e30f, lp = 0.f; f32x16 o[2]; o[0] = (f32x16){}; o[1] = (f32x16){};
        int curty = 1;
        for (int i = 0; i < ntl; ++i) {
            const int ent = LIST[i], ty = ent >> 8, j = ent & 255, buf = i & 1;
            if (i + 1 < ntl) TILE_LOAD(LIST[i + 1]);
            if (ty != curty) {
                const float lt = swap_sum(lp);
                axpy_o(out, o, gate2 / fmaxf(lt, 1e-30f), wsf, r32, hi);
                m = -1e30f; lp = 0.f; o[0] = (f32x16){}; o[1] = (f32x16){}; curty = ty;
            }
            f32x16 p0, p1;
            qkt(p0, p1, L + L_KB + buf * 8192, qr, r32, hi);
            const bool rowok = ty ? true : (((selq >> j) & 1u) != 0u);
            float rm = -INFINITY;
#pragma unroll
            for (int r = 0; r < 16; ++r) {
                const int d0_ = tq - (j * 64 + crow(r, hi)), d1_ = d0_ - 32;
                const bool ok0 = rowok && d0_ >= 0 && (ty == 0 || d0_ < 512), ok1 = rowok && d1_ >= 0 && (ty == 0 || d1_ < 512);
                p0[r] = ok0 ? p0[r] - slope2 * (float)d0_ : -INFINITY; p1[r] = ok1 ? p1[r] - slope2 * (float)d1_ : -INFINITY;
                rm = fmaxf(rm, fmaxf(p0[r], p1[r]));
            }
            rm = swap_max(rm);
            const float mn = fmaxf(m, rm);
            const float alpha = __builtin_amdgcn_exp2f(m - mn);
            m = mn;
            float ps = 0.f;
#pragma unroll
            for (int r = 0; r < 16; ++r) { p0[r] = __builtin_amdgcn_exp2f(p0[r] - mn); p1[r] = __builtin_amdgcn_exp2f(p1[r] - mn); ps += p0[r] + p1[r]; }
            lp = lp * alpha + ps;
            if (__any(alpha != 1.0f)) scale_o(o, alpha, wsf, r32, hi);
            bf16x8 a0, a1, a2, a3;
            pack_p(p0, p1, a0, a1, a2, a3);
            pv(o, (int)(lds0 + L_VB + buf * 8192) + vboff, a0, a1, a2, a3);
            if (i + 1 < ntl) TILE_STORE(buf ^ 1);
            __syncthreads();
        }
        {
            const float lt = swap_sum(lp);
            axpy_o(out, o, (curty ? gate2 : gate1) / fmaxf(lt, 1e-30f), wsf, r32, hi);
        }
#undef TILE_LOAD
#undef TILE_STORE
    }
    {
        bf16_t* CC = (bf16_t*)(F.ws + WS_S + S_CONCAT) + ((size_t)b * T_ + t0 + th * 32) * D_ + 512 + g * 256 + rh * 64 + r32;
#pragma unroll
        for (int r = 0; r < 16; ++r) {
            bf16_t* rowp = CC + (size_t)crow(r, hi) * D_;
            rowp[0] = (bf16_t)f2bf(out[0][r]); rowp[32] = (bf16_t)f2bf(out[1][r]);
        }
    }
}
__device__ __forceinline__ void p_nsa_attn(Frame& F, int l) {
    RELAUNDER(F);
    const int n_rw = l == 0 ? 1792 : 1824;
    const bf16_t* P = (const bf16_t*)(F.ws + WS_S + S_PROJ);
    for (int v = F.vcu; v < 256; v += F.G) {
        const int bg = v >> 4, s = v & 15;
#pragma unroll 1
        for (int half = 0; half < 2; ++half) nsa_item(F, P, n_rw, bg >> 1, bg & 1, half == 0 ? 31 - s : s);
    }
}

namespace xat {
constexpr int L_P = 0, PPITCH = 264, L_PMAX = 64 * PPITCH * 2, L_PSUM = L_PMAX + 8 * 64 * 4, L_LINV = L_PSUM + 8 * 64 * 4;
constexpr float QSCALE = 0.0625f * 1.4426950408889634f;
}
__device__ __forceinline__ void cross_item(Frame& F, const bf16_t* QC, const bf16_t* KCR, const bf16_t* VT, bf16_t* OC, int b, int h, int t0) {
    using namespace nsa;
    int tidl = F.tid; asm volatile("" : "+v"(tidl));
    const int lanel = tidl & 63, w = __builtin_amdgcn_readfirstlane(tidl >> 6), r32 = lanel & 31, hi = lanel >> 5;
    LAS unsigned char* L = F.lds;
    LAS bf16_t* Pl = (LAS bf16_t*)(L + xat::L_P); LAS float* PMAX = (LAS float*)(L + xat::L_PMAX); LAS float* PSUM = (LAS float*)(L + xat::L_PSUM); LAS float* LINV = (LAS float*)(L + xat::L_LINV);
    f32x16 s[2];
    {
        const bf16_t* kp = KCR + ((size_t)b * MEM_ + 32 * w + r32) * 1024 + h * 256 + hi * 8;
        bf16x8 kf[16];
#pragma unroll
        for (int d0 = 0; d0 < 16; ++d0) kf[d0] = *(const bf16x8*)(kp + d0 * 16);
#pragma unroll
        for (int qs = 0; qs < 2; ++qs) {
            const bf16_t* qp = QC + ((size_t)b * T_ + t0 + qs * 32 + r32) * 1024 + h * 256 + hi * 8;
            s[qs] = (f32x16){};
#pragma unroll
            for (int d0 = 0; d0 < 16; ++d0) { const bf16x8 qf = *(const bf16x8*)(qp + d0 * 16); s[qs] = __builtin_amdgcn_mfma_f32_32x32x16_bf16(kf[d0], qf, s[qs], 0, 0, 0); }
        }
    }
#pragma unroll
    for (int qs = 0; qs < 2; ++qs) {
        float pm = s[qs][0];
#pragma unroll
        for (int r = 1; r < 16; ++r) pm = fmaxf(pm, s[qs][r]);
        pm = swap_max(pm);
        if (hi == 0) PMAX[w * 64 + qs * 32 + r32] = pm;
    }
    __syncthreads();
#pragma unroll
    for (int qs = 0; qs < 2; ++qs) {
        float m = PMAX[qs * 32 + r32];
#pragma unroll
        for (int ww = 1; ww < 8; ++ww) m = fmaxf(m, PMAX[ww * 64 + qs * 32 + r32]);
        float ps = 0.f;
#pragma unroll
        for (int r = 0; r < 16; ++r) { s[qs][r] = __builtin_amdgcn_exp2f(s[qs][r] - m); ps += s[qs][r]; }
        ps = swap_sum(ps);
        if (hi == 0) PSUM[w * 64 + qs * 32 + r32] = ps;
#pragma unroll
        for (int rq = 0; rq < 4; ++rq) {
            u32x2_t pk; pk.x = cvtpk(s[qs][4 * rq], s[qs][4 * rq + 1]); pk.y = cvtpk(s[qs][4 * rq + 2], s[qs][4 * rq + 3]);
            *(LAS u32x2_t*)(Pl + (qs * 32 + r32) * xat::PPITCH + 32 * w + 8 * rq + 4 * hi) = pk;
        }
    }
    __syncthreads();
    if (tidl < 64) { float t = 0.f;
#pragma unroll
        for (int ww = 0; ww < 8; ++ww) t += PSUM[ww * 64 + tidl];
        LINV[tidl] = 1.0f / t; }
    f32x16 o[2]; o[0] = (f32x16){}; o[1] = (f32x16){};
    {
        const bf16_t* vp = VT + ((size_t)(h * 256 + 32 * w + r32)) * NMEM + b * MEM_ + hi * 8;
        bf16x8 vf[16];
#pragma unroll
        for (int ks = 0; ks < 16; ++ks) vf[ks] = *(const bf16x8*)(vp + ks * 16);
#pragma unroll
        for (int qs = 0; qs < 2; ++qs)
#pragma unroll
            for (int ks = 0; ks < 16; ++ks) {
                const bf16x8 pf = *(const LAS bf16x8*)(Pl + (qs * 32 + r32) * xat::PPITCH + ks * 16 + hi * 8);
                o[qs] = __builtin_amdgcn_mfma_f32_32x32x16_bf16(pf, vf[ks], o[qs], 0, 0, 0);
            }
    }
    __syncthreads();
#pragma unroll
    for (int qs = 0; qs < 2; ++qs) {
        bf16_t* op = OC + ((size_t)b * T_ + t0 + qs * 32) * 1024 + h * 256 + 32 * w + r32;
#pragma unroll
        for (int r = 0; r < 16; ++r) { const int q = crow(r, hi); op[(size_t)q * 1024] = (bf16_t)f2bf(o[qs][r] * LINV[qs * 32 + q]); }
    }
}
__device__ __forceinline__ void p_cross_attn(Frame& F, int l) {
    RELAUNDER(F);
    const bf16_t* QC = (const bf16_t*)(F.ws + WS_S + S_QC); bf16_t* OC = (bf16_t*)(F.ws + WS_S + S_OC);
    const bf16_t* KCR = (const bf16_t*)(F.ws + WS_KCR) + (size_t)l * NMEM * 1024; const bf16_t* VT = (const bf16_t*)(F.ws + WS_VT) + (size_t)l * 1024 * NMEM;
    for (int grp = F.vcu; grp < 256; grp += F.G) {
#pragma unroll 1
        for (int i = 0; i < 4; ++i) { const int item = grp * 4 + i, bh = item >> 5, qt = item & 31; cross_item(F, QC, KCR, VT, OC, bh >> 2, bh & 3, qt * 64); }
    }
}
#ifndef MK_FUSED
#define MK_FUSED 1
#endif
#if !MK_FUSED
__global__ void __launch_bounds__(NWAVES * 64, 2) mega(Args args) {
    extern __shared__ __attribute__((aligned(16))) unsigned char lds[];
    {
        LAS unsigned char* l3 = (LAS unsigned char*)lds;
        for (int u = threadIdx.x; u < (LDS_BYTES - LDSCTL_OFF) / 4; u += NWAVES * 64) ((LAS unsigned*)(l3 + LDSCTL_OFF))[u] = 0u;
    }
    __syncthreads();
    {
        const int ph = args.ph[0];
        Frame F;
        F.ws = launder_ptr(args.ws);
        { int t = threadIdx.x; asm volatile("" : "+v"(t)); F.tid = t; }
        F.lds = (LAS unsigned char*)lds;
        F.MISC = (volatile LAS unsigned*)(F.lds + MISC_OFF);
        F.lane = F.tid & 63; F.wave = __builtin_amdgcn_readfirstlane(F.tid >> 6);
        F.G = gridDim.x; { const int bx = blockIdx.x; F.vcu = (F.G % 8 == 0) ? (bx % 8) * (F.G / 8) + bx / 8 : bx; }
        F.in = args.in; F.out = args.out;
        if (ph == 0) p_prologue(F);
        else if (ph == 1) p_kv(F);
        else if (ph == 10 || ph == 11) p_inproj(F, ph - 10);
        else if (ph == 20 || ph == 21) p_rw_prep(F, ph - 20);
        else if (ph == 25 || ph == 26) p_nsa_cmp(F, ph - 25);
        else if (ph == 30 || ph == 31) p_rw_scan(F);
        else if (ph == 45 || ph == 46) p_nsa_attn(F, ph - 45);
        else if (ph == 40 || ph == 41) p_rw_post(F, ph - 40);
        else if (ph == 50 || ph == 51) p_resid_gemm(F, (const bf16_t*)(F.ws + WS_S + S_CONCAT), (const bf16_t*)(F.ws + WS_WB + WB_WOUT) + (size_t)(ph - 50) * D_ * D_, 1024);
        else if (ph == 60 || ph == 61) p_crossq(F, ph - 60);
        else if (ph == 70 || ph == 71) p_cross_attn(F, ph - 70);
        else if (ph == 80 || ph == 81) p_resid_gemm(F, (const bf16_t*)(F.ws + WS_S + S_OC), (const bf16_t*)(F.ws + WS_WB + WB_WO) + (size_t)(ph - 80) * D_ * D_, 1024);
        else if (ph == 90) p_ffn_up(F);
        else if (ph == 100) p_route(F);
        else if (ph == 101) p_moe_prep(F);
        else if (ph == 102 || ph == 104) p_moe_gemm1(F, (ph - 102) >> 1);
        else if (ph == 103 || ph == 105) p_moe_gemm2(F, (ph - 103) >> 1);
        else if (ph == 110) p_final(F, true);
        else if (ph == 91) p_resid_gemm(F, (const bf16_t*)(F.ws + WS_S + S_ACT), (const bf16_t*)(F.ws + WS_WB + WB_WD), FFD);
        __syncthreads();
    }
}
#else
__global__ void __launch_bounds__(NWAVES * 64, 2) mega(Args args) {
    extern __shared__ __attribute__((aligned(16))) unsigned char lds[];
    {
        LAS unsigned char* l3 = (LAS unsigned char*)lds;
        for (int u = threadIdx.x; u < (LDS_BYTES - LDSCTL_OFF) / 4; u += NWAVES * 64) ((LAS unsigned*)(l3 + LDSCTL_OFF))[u] = 0u;
    }
    __syncthreads();
    const XcdBarrier bar = xcd_barrier_post((unsigned*)(args.ws + WS_CTL) + CW_BAR, (volatile LAS unsigned*)((LAS unsigned char*)lds + MISC_OFF) + 8);
    Frame F;
    F.ws = launder_ptr(args.ws);
    { int t = threadIdx.x; asm volatile("" : "+v"(t)); F.tid = t; }
    F.lds = (LAS unsigned char*)lds;
    F.MISC = (volatile LAS unsigned*)(F.lds + MISC_OFF);
    F.lane = F.tid & 63; F.wave = __builtin_amdgcn_readfirstlane(F.tid >> 6);
    F.G = gridDim.x; { const int bx = blockIdx.x; F.vcu = (F.G % 8 == 0) ? (bx % 8) * (F.G / 8) + bx / 8 : bx; }
    F.in = args.in; F.out = args.out;
#define SEAM() xcd_barrier(bar)
    p_prologue(F); SEAM();
    p_inproj(F, 0); __syncthreads(); p_kv(F); SEAM();
    p_rw_prep(F, 0); __syncthreads(); p_nsa_cmp(F, 0); SEAM();
    p_rw_scan(F); SEAM();
    p_nsa_attn(F, 0); __syncthreads(); p_rw_post(F, 0); SEAM();
    p_resid_gemm(F, (const bf16_t*)(F.ws + WS_S + S_CONCAT), (const bf16_t*)(F.ws + WS_WB + WB_WOUT), 1024); SEAM();
    p_crossq(F, 0); SEAM();
    p_cross_attn(F, 0); SEAM();
    p_resid_gemm(F, (const bf16_t*)(F.ws + WS_S + S_OC), (const bf16_t*)(F.ws + WS_WB + WB_WO), 1024); SEAM();
    p_ffn_up(F); SEAM();
    p_resid_gemm(F, (const bf16_t*)(F.ws + WS_S + S_ACT), (const bf16_t*)(F.ws + WS_WB + WB_WD), FFD); SEAM();
    p_inproj(F, 1); SEAM();
    p_rw_prep(F, 1); __syncthreads(); p_nsa_cmp(F, 1); SEAM();
    p_rw_scan(F); SEAM();
    p_nsa_attn(F, 1); __syncthreads(); p_rw_post(F, 1); SEAM();
    p_resid_gemm(F, (const bf16_t*)(F.ws + WS_S + S_CONCAT), (const bf16_t*)(F.ws + WS_WB + WB_WOUT) + (size_t)D_ * D_, 1024); SEAM();
    p_crossq(F, 1); SEAM();
    p_cross_attn(F, 1); SEAM();
    p_resid_gemm(F, (const bf16_t*)(F.ws + WS_S + S_OC), (const bf16_t*)(F.ws + WS_WB + WB_WO) + (size_t)D_ * D_, 1024); SEAM();
    p_route(F); SEAM();
    p_moe_prep(F); SEAM();
    p_moe_gemm1(F, 0); SEAM();
    p_moe_gemm2(F, 0); SEAM();
    p_moe_gemm1(F, 1); SEAM();
    p_moe_gemm2(F, 1); SEAM();
    p_final(F, true);
#undef SEAM
}
#endif

namespace v0 {
constexpr int B = B_, T = T_, D = D_, W = W_, H = H_, DH = DH_, MEM = MEM_;
constexpr int ECAP = 8192;
__global__ void k_rmsnorm(const float* __restrict__ x, const float* __restrict__ g, float* __restrict__ out, int rows) {
    const int wave = (blockIdx.x * blockDim.x + threadIdx.x) >> 6, lane = threadIdx.x & 63;
    if (wave >= rows) return;
    const float* xr = x + (size_t)wave * D;
    float v[16]; float s = 0.f;
#pragma unroll
    for (int i = 0; i < 16; ++i) { v[i] = xr[lane + 64 * i]; s += v[i] * v[i]; }
    s = wave_sum(s);
    const float rinv = rsqrtf(s * (1.f / D) + 1e-6f);
#pragma unroll
    for (int i = 0; i < 16; ++i) out[(size_t)wave * D + lane + 64 * i] = v[i] * rinv * g[lane + 64 * i];
}

template <int MODE, bool GATHER>
__global__ void __launch_bounds__(256) k_gemm(const float* __restrict__ A, int lda, const int* __restrict__ rowidx, const int* __restrict__ Mdev, int M,
                                               const float* __restrict__ Wt, const float* __restrict__ W2, int ldw, float* __restrict__ C, int ldc, int N, int K,
                                               const float* __restrict__ scale) {
    if (Mdev) { M = *Mdev; if (M > ECAP) M = ECAP; }
    const int m0 = blockIdx.y * 64, n0 = blockIdx.x * 64;
    if (m0 >= M) return;
    __shared__ float As[16][65];
    __shared__ float Bs[16][65];
    __shared__ float B2s[(MODE == 2) ? 16 : 1][65];
    const int tid = threadIdx.x, tx = tid & 15, ty = tid >> 4;
    float acc[4][4] = {}; float acc2[4][4] = {};
    for (int k0 = 0; k0 < K; k0 += 16) {
        for (int i = tid; i < 64 * 16; i += 256) {
            const int r = i >> 4, kk = i & 15; const int m = m0 + r;
            float v = 0.f;
            if (m < M) { const int ar = GATHER ? rowidx[m] : m; v = A[(size_t)ar * lda + k0 + kk]; }
            As[kk][r] = v;
        }
        for (int i = tid; i < 16 * 64; i += 256) {
            const int kk = i >> 6, c = i & 63; const int n = n0 + c;
            Bs[kk][c] = (n < N) ? Wt[(size_t)(k0 + kk) * ldw + n] : 0.f;
            if (MODE == 2) B2s[kk][c] = (n < N) ? W2[(size_t)(k0 + kk) * ldw + n] : 0.f;
        }
        __syncthreads();
#pragma unroll
        for (int kk = 0; kk < 16; ++kk) {
            float a[4], b[4], b2[4];
#pragma unroll
            for (int i = 0; i < 4; ++i) a[i] = As[kk][ty * 4 + i];
#pragma unroll
            for (int j = 0; j < 4; ++j) { b[j] = Bs[kk][tx * 4 + j]; if (MODE == 2) b2[j] = B2s[kk][tx * 4 + j]; }
#pragma unroll
            for (int i = 0; i < 4; ++i)
#pragma unroll
                for (int j = 0; j < 4; ++j) { acc[i][j] += a[i] * b[j]; if (MODE == 2) acc2[i][j] += a[i] * b2[j]; }
        }
        __syncthreads();
    }
#pragma unroll
    for (int i = 0; i < 4; ++i) {
        const int m = m0 + ty * 4 + i; if (m >= M) continue;
#pragma unroll
        for (int j = 0; j < 4; ++j) {
            const int n = n0 + tx * 4 + j; if (n >= N) continue;
            if (MODE == 0) C[(size_t)m * ldc + n] = acc[i][j];
            else if (MODE == 1) C[(size_t)m * ldc + n] += acc[i][j];
            else if (MODE == 2) { const float gte = acc[i][j]; C[(size_t)m * ldc + n] = gte * sigmoidf_(gte) * acc2[i][j]; }
            else { const int orow = rowidx[m]; C[(size_t)orow * ldc + n] += scale[m] * acc[i][j]; }
        }
    }
}

struct RwPar {
    const float *mu, *w0, *w2, *a0, *a2, *g2, *k_k, *k_a, *v0, *v2;
};
template <class TP>
__global__ void __launch_bounds__(512) k_rw_prep(const TP* __restrict__ proj, int ncols, int n_rw, RwPar p, int layer,
                                                 float* __restrict__ DEC, float* __restrict__ AIC, float* __restrict__ VP, float* __restrict__ G, float* __restrict__ VFIRST) {
    const int tok = blockIdx.x, t = tok % T, c = threadIdx.x;
    __shared__ float lo[288];
    const TP* cur = proj + (size_t)tok * ncols;
    const TP* prv = cur - ncols;
    if (c < n_rw - 1536) {
        const int col = 1536 + c;
        const float u = ldf(cur, col), up = (t > 0) ? ldf(prv, col) : 0.f;
        float v = u + (up - u) * p.mu[col];
        if (c < 64) v = tanhf(v);
        else if (c >= 128 && c < 256) v = sigmoidf_(v);
        lo[c] = v;
    }
    __syncthreads();
    float wr = p.w0[c], ar = p.a0[c], gr = 0.f;
#pragma unroll 4
    for (int j = 0; j < 64; ++j) { wr += lo[j] * p.w2[j * W + c]; ar += lo[64 + j] * p.a2[j * W + c]; }
#pragma unroll 4
    for (int j = 0; j < 128; ++j) gr += lo[128 + j] * p.g2[j * W + c];
    const float sp = (-wr > 20.f) ? -wr : log1pf(__expf(-wr));
    const float w = -sp - 0.5f;
    DEC[(size_t)tok * W + c] = __expf(-__expf(w));
    AIC[(size_t)tok * W + c] = sigmoidf_(ar);
    G[(size_t)tok * W + c] = gr;
    {
        const int col = 1024 + c;
        const float u = ldf(cur, col), up = (t > 0) ? ldf(prv, col) : 0.f;
        float v = u + (up - u) * p.mu[col];
        if (layer == 0) { VFIRST[(size_t)tok * W + c] = v; }
        else {
            float vr = p.v0[c];
#pragma unroll 4
            for (int j = 0; j < 32; ++j) vr += lo[256 + j] * p.v2[j * W + c];
            const float vf = VFIRST[(size_t)tok * W + c];
            v = v + (vf - v) * sigmoidf_(vr);
        }
        VP[(size_t)tok * W + c] = v;
    }
}

template <class TP>
__global__ void __launch_bounds__(64) k_rw_scan(const TP* __restrict__ proj, int ncols, const float* __restrict__ mu, const float* __restrict__ k_k, const float* __restrict__ k_a,
                                                const float* __restrict__ r_k,
                                                const float* __restrict__ DEC, const float* __restrict__ AIC, const float* __restrict__ VP,
                                                float* __restrict__ Y, float* __restrict__ BON) {
    const int b = blockIdx.x / H, h = blockIdx.x % H, j = threadIdx.x, c = h * DH + j;
    __shared__ float sr[64], sw[64], sk[64], sa[64], sb[64];
    float S[64];
#pragma unroll
    for (int i = 0; i < 64; ++i) S[i] = 0.f;
    const float mur = mu[c], muk = mu[W + c], kkc = k_k[c], kac = k_a[c], rkc = r_k[c];
    float pr = 0.f, pk = 0.f;
    for (int t = 0; t < T; ++t) {
        const size_t tok = (size_t)b * T + t;
        const TP* cur = proj + tok * ncols;
        const float ur = ldf(cur, c), uk = ldf(cur, W + c);
        const float r = ur + (pr - ur) * mur, k = uk + (pk - uk) * muk;
        pr = ur; pk = uk;
        const float a = AIC[tok * W + c], dec = DEC[tok * W + c], v = VP[tok * W + c];
        float kk = k * kkc;
        const float nrm = sqrtf(wave_sum(kk * kk));
        kk = kk / fmaxf(nrm, 1e-12f);
        const float kh = k * (1.f + (a - 1.f) * kac);
        const float bon = wave_sum(r * kh * rkc);
        __syncthreads();
        sr[j] = r; sw[j] = dec; sk[j] = kh; sa[j] = -kk; sb[j] = kk * a;
        __syncthreads();
        float Sa = 0.f;
#pragma unroll
        for (int q = 0; q < 64; ++q) Sa += S[q] * sa[q];
        float y = 0.f;
#pragma unroll
        for (int q = 0; q < 64; ++q) { S[q] = S[q] * sw[q] + Sa * sb[q] + v * sk[q]; y += S[q] * sr[q]; }
        Y[tok * W + c] = y;
        if (j == 0) BON[tok * H + h] = bon;
    }
}

template <class TC>
__global__ void k_rw_post(const float* __restrict__ Y, const float* __restrict__ BON, const float* __restrict__ VP, const float* __restrict__ G, const float* __restrict__ ln_w, const float* __restrict__ ln_b,
                          TC* __restrict__ concat) {
    const int wid = (blockIdx.x * blockDim.x + threadIdx.x) >> 6, lane = threadIdx.x & 63;
    if (wid >= NTOK * H) return;
    const int tok = wid / H, h = wid % H, c = h * DH + lane;
    const float y = Y[(size_t)tok * W + c];
    const float mean = wave_sum(y) * (1.f / 64.f);
    const float d = y - mean;
    const float var = wave_sum(d * d) * (1.f / 64.f);
    const float yn = d * rsqrtf(var + 64e-5f) * ln_w[c] + ln_b[c];
    stf(concat, (size_t)tok * D + c, (yn + BON[(size_t)tok * H + h] * VP[(size_t)tok * W + c]) * G[(size_t)tok * W + c]);
}

template <class TP>
__global__ void __launch_bounds__(128) k_cmp_hidden(const TP* __restrict__ proj, int ncols, int colbase  , const float* __restrict__ pe,
                                                    const float* __restrict__ w1, float* __restrict__ hid) {
    const int row = blockIdx.x, n = row % NCMP, g = (row / NCMP) % 2, b = row / (NCMP * 2);
    __shared__ float blk[2048];
    for (int i = threadIdx.x; i < 2048; i += 128) {
        const int l = i >> 6, d = i & 63;
        blk[i] = ldf(proj, ((size_t)b * T + 16 * n + l) * ncols + colbase + g * 64 + d) + pe[i];
    }
    __syncthreads();
    float acc = 0.f;
    for (int k = 0; k < 2048; ++k) acc += blk[k] * w1[(size_t)k * 128 + threadIdx.x];
    const float x = acc;
    const float ge = 0.5f * x * (1.f + tanhf(0.7978845608028654f * (x + 0.044715f * x * x * x)));
    hid[(size_t)row * 128 + threadIdx.x] = ge;
}
__global__ void __launch_bounds__(64) k_cmp_out(const float* __restrict__ hid, const float* __restrict__ w2, float* __restrict__ out  ) {
    const int row = blockIdx.x, n = row % NCMP, bg = row / NCMP;
    float acc = 0.f;
    for (int k = 0; k < 128; ++k) acc += hid[(size_t)row * 128 + k] * w2[k * 64 + threadIdx.x];
    out[((size_t)bg * 128 + n) * 64 + threadIdx.x] = acc;
}

template <class TP, class TC>
__global__ void __launch_bounds__(512) k_nsa_attn(const TP* __restrict__ proj, int ncols, int n_rw, const float* __restrict__ KC, const float* __restrict__ VC, TC* __restrict__ concat) {
    const int tok = blockIdx.x, b = tok / T, t = tok % T;
    const int wave = threadIdx.x >> 6, lane = threadIdx.x & 63, g = wave >> 2, r = wave & 3, hq = wave;
    const TP* cols = proj + (size_t)tok * ncols + n_rw;
    __shared__ float qs[8][64];
    __shared__ float ps[8][128];
    __shared__ float imp[2][32];
    __shared__ unsigned selm[2];
    __shared__ float pbuf[8][64];
    const float slope = exp2f(-(float)(hq + 1));
    const float q = ldf(cols, g * 256 + r * 64 + lane) * 0.125f;
    qs[wave][lane] = q;
    const float gate0 = sigmoidf_(ldf(cols, 1280 + hq * 3 + 0)), gate1 = sigmoidf_(ldf(cols, 1280 + hq * 3 + 1)), gate2 = sigmoidf_(ldf(cols, 1280 + hq * 3 + 2));
    __syncthreads();
    float out = 0.f;
    {
        const float* kc = KC + ((size_t)(b * 2 + g) * 128) * 64;
        const float* vc = VC + ((size_t)(b * 2 + g) * 128) * 64;
        float s[2]; bool ok[2];
#pragma unroll
        for (int u = 0; u < 2; ++u) {
            const int n = lane + 64 * u;
            ok[u] = (n < NCMP) && (16 * n + 31 <= t);
            float acc = 0.f;
            if (ok[u]) { for (int d = 0; d < 64; ++d) acc += qs[wave][d] * kc[n * 64 + d]; acc -= slope * (float)(t - (16 * n + 31)); }
            s[u] = ok[u] ? acc : -1e30f;
        }
        const float m = wave_max(fmaxf(s[0], s[1]));
        float p0 = ok[0] ? __expf(s[0] - m) : 0.f, p1 = ok[1] ? __expf(s[1] - m) : 0.f;
        const float l = wave_sum(p0 + p1);
        const float inv = 1.f / fmaxf(l, 1e-30f);
        p0 *= inv; p1 *= inv;
        ps[wave][lane] = p0; ps[wave][lane + 64] = p1;
        __syncthreads();
        float o = 0.f;
        for (int n = 0; n < NCMP; ++n) o += ps[wave][n] * vc[n * 64 + lane];
        out += gate0 * o;
        if (threadIdx.x < 64) {
            const int g2 = threadIdx.x >> 5, j = threadIdx.x & 31;
            float acc = 0.f;
            for (int rr = 0; rr < 4; ++rr)
                for (int n = 4 * j - 1; n <= 4 * j + 3; ++n) if (n >= 0 && n < NCMP) acc += ps[g2 * 4 + rr][n];
            const int curb = t >> 6;
            if (j == 0 || j == curb || j == curb - 1) acc = 1e4f;
            if (j > curb) acc = -1.f;
            imp[g2][j] = acc;
        }
        __syncthreads();
        if (threadIdx.x < 64) {
            const int g2 = threadIdx.x >> 5, j = threadIdx.x & 31;
            const float mine = imp[g2][j]; int rank = 0;
            for (int jj = 0; jj < 32; ++jj) { const float o2 = imp[g2][jj]; rank += (o2 > mine || (o2 == mine && jj < j)) ? 1 : 0; }
            const unsigned long long bal = __ballot(rank < 16);
            if (j == 0) selm[g2] = (unsigned)(g2 == 0 ? (bal & 0xffffffffull) : (bal >> 32));
        }
        __syncthreads();
    }
    for (int br = 0; br < 2; ++br) {
        const int kcol = n_rw + 512 + (br == 0 ? 2 : 4) * 128 + g * 64, vcol = kcol + 128;
        const float gate = br == 0 ? gate1 : gate2;
        const unsigned mask = selm[g];
        float m = -1e30f, l = 0.f, o = 0.f;
        const int curb = t >> 6;
        const int jlo = (br == 0) ? 0 : ((curb - 8 > 0) ? curb - 8 : 0);
        for (int j = jlo; j <= curb; ++j) {
            if (br == 0 && !((mask >> j) & 1u)) continue;
            const int pos = j * 64 + lane;
            const int dist = t - pos;
            const bool ok = (dist >= 0) && (br == 0 || dist < 512);
            float sc = -1e30f;
            if (ok) {
                const TP* kr = proj + ((size_t)b * T + pos) * ncols + kcol;
                float acc = 0.f;
                for (int d = 0; d < 64; ++d) acc += qs[wave][d] * ldf(kr, d);
                sc = acc - slope * (float)dist;
            }
            const float mt = wave_max(sc);
            const float mn = fmaxf(m, mt);
            const float alpha = __expf(m - mn);
            const float p = ok ? __expf(sc - mn) : 0.f;
            l = l * alpha + wave_sum(p);
            pbuf[wave][lane] = p;
            __builtin_amdgcn_wave_barrier();
            float acc = 0.f;
            const int kmax = (t - j * 64 + 1 < 64) ? (t - j * 64 + 1) : 64;
            for (int kk = 0; kk < kmax; ++kk) acc += pbuf[wave][kk] * ldf(proj, ((size_t)b * T + j * 64 + kk) * ncols + vcol + lane);
            __builtin_amdgcn_wave_barrier();
            o = o * alpha + acc;
            m = mn;
        }
        out += gate * o / fmaxf(l, 1e-30f);
    }
    stf(concat, (size_t)tok * D + 512 + g * 256 + r * 64 + lane, out);
}

__global__ void __launch_bounds__(256) k_cross_attn(const bf16_t* __restrict__ Q, const bf16_t* __restrict__ Kc, const bf16_t* __restrict__ VT, bf16_t* __restrict__ O) {
    const int wid = (blockIdx.x * blockDim.x + threadIdx.x) >> 6, lane = threadIdx.x & 63;
    const int tok = wid >> 2, h = wid & 3, b = tok / T;
    float q[4];
    for (int i = 0; i < 4; ++i) q[i] = ldf(Q, (size_t)tok * D + h * 256 + lane * 4 + i);
    float s[4];
    for (int u = 0; u < 4; ++u) s[u] = 0.f;
    for (int key = 0; key < MEM; ++key) {
        const bf16_t* kr = Kc + ((size_t)b * MEM + key) * 1024 + h * 256 + lane * 4;
        float d = q[0] * bf2f(kr[0]) + q[1] * bf2f(kr[1]) + q[2] * bf2f(kr[2]) + q[3] * bf2f(kr[3]);
        d = wave_sum(d) * 0.0625f;
        if ((key & 63) == lane) s[key >> 6] = d;
    }
    float m = fmaxf(fmaxf(s[0], s[1]), fmaxf(s[2], s[3]));
    m = wave_max(m);
    float p[4], l = 0.f;
    for (int u = 0; u < 4; ++u) { p[u] = __expf(s[u] - m); l += p[u]; }
    l = wave_sum(l);
    float o[4] = {0.f, 0.f, 0.f, 0.f};
    for (int key = 0; key < MEM; ++key) {
        const float pk = __shfl(p[key >> 6], key & 63);
        for (int i = 0; i < 4; ++i) o[i] += pk * bf2f(VT[(size_t)(h * 256 + lane * 4 + i) * NMEM + b * MEM + key]);
    }
    const float inv = 1.f / l;
    for (int i = 0; i < 4; ++i) stf(O, (size_t)tok * D + h * 256 + lane * 4 + i, o[i] * inv);
}

__global__ void k_route(const float* __restrict__ Hn, const float* __restrict__ wr, int* __restrict__ top_e, float* __restrict__ top_g) {
    const int wid = (blockIdx.x * blockDim.x + threadIdx.x) >> 6, lane = threadIdx.x & 63;
    if (wid >= NTOK) return;
    float acc[8] = {};
    for (int i = 0; i < 16; ++i) {
        const int k = lane + 64 * i; const float hv = Hn[(size_t)wid * D + k];
#pragma unroll
        for (int e = 0; e < 8; ++e) acc[e] += hv * wr[k * 8 + e];
    }
#pragma unroll
    for (int e = 0; e < 8; ++e) acc[e] = wave_sum(acc[e]);
    if (lane == 0) {
        int e0 = 0; for (int e = 1; e < 8; ++e) if (acc[e] > acc[e0]) e0 = e;
        int e1 = -1; for (int e = 0; e < 8; ++e) if (e != e0 && (e1 < 0 || acc[e] > acc[e1])) e1 = e;
        const float m = acc[e0]; const float p0 = 1.f, p1 = __expf(acc[e1] - m); const float inv = 1.f / (p0 + p1);
        top_e[wid * 2] = e0; top_e[wid * 2 + 1] = e1; top_g[wid * 2] = p0 * inv; top_g[wid * 2 + 1] = p1 * inv;
    }
}
__global__ void __launch_bounds__(64) k_lists(const int* __restrict__ top_e, const float* __restrict__ top_g, int* __restrict__ list, float* __restrict__ lgate, int* __restrict__ counts) {
    const int e = blockIdx.x, lane = threadIdx.x; int cnt = 0;
    for (int t0 = 0; t0 < NTOK; t0 += 64) {
        const int tok = t0 + lane; int k = -1;
        if (top_e[tok * 2] == e) k = 0; else if (top_e[tok * 2 + 1] == e) k = 1;
        const unsigned long long bal = __ballot(k >= 0);
        if (k >= 0) { const int pos = cnt + __popcll(bal & ((1ull << lane) - 1ull)); if (pos < ECAP) { list[e * NTOK + pos] = tok; lgate[e * NTOK + pos] = top_g[tok * 2 + k]; } }
        cnt += __popcll(bal);
    }
    if (lane == 0) counts[e] = cnt;
}

__global__ void k_xb_ssq(const float* __restrict__ X, bf16_t* __restrict__ XB, float* __restrict__ SSQ) {
    const int m = (blockIdx.x * blockDim.x + threadIdx.x) >> 6, lane = threadIdx.x & 63;
    if (m >= NTOK) return;
    float s = 0.f;
    for (int i = 0; i < 16; ++i) { const float v = X[(size_t)m * D + lane + 64 * i]; s += v * v; XB[(size_t)m * D + lane + 64 * i] = (bf16_t)f2bf(v); }
    s = wave_sum(s);
    if (lane < 16) SSQ[(size_t)m * 16 + lane] = lane == 0 ? s : 0.f;
}
}

static int g_grid = 0;
static void launch_mega(const Args& base, std::initializer_list<int> phs, hipStream_t stream) {
    Args a = base; a.nph = 0;
    for (int p : phs) a.ph[a.nph++] = p;
    hipLaunchKernelGGL(mega, dim3(g_grid), dim3(NWAVES * 64), LDS_BYTES, stream, a);
}

extern "C" void kernel_launch(void* const* d_in, const int* in_sizes, int n_in, void* d_out, int out_size, void* d_ws, size_t ws_size, hipStream_t stream) {
    using namespace v0;
    if (g_grid == 0) {
        int dev = 0, cus = 0;
        if (hipGetDevice(&dev) != hipSuccess || hipDeviceGetAttribute(&cus, hipDeviceAttributeMultiprocessorCount, dev) != hipSuccess) { g_grid = -1; return; }
        if (hipFuncSetAttribute((const void*)mega, hipFuncAttributeMaxDynamicSharedMemorySize, LDS_BYTES) != hipSuccess) { fprintf(stderr, "kernel_launch: hipFuncSetAttribute failed\n"); g_grid = -1; return; }
        (void)hipGetLastError();
        g_grid = cus;
    }
    if (g_grid < 0) return;
    const float* in[40];
    for (int i = 0; i < 40; ++i) in[i] = (const float*)d_in[i];
    unsigned char* wsb = (unsigned char*)d_ws;
    Args base{};
    for (int i = 0; i < 40; ++i) base.in[i] = in[i];
    base.out = (float*)d_out; base.ws = wsb;

    float* X = (float*)(wsb + WS_X);
    bf16_t* XB = (bf16_t*)(wsb + WS_XB);
    float* SSQ = (float*)(wsb + WS_SSQ);
    bf16_t* PROJ = (bf16_t*)(wsb + WS_S);
    size_t off = (WS_S + S_END + 1 * MiB) / 4;
    float* ws = (float*)d_ws;
    auto take = [&](size_t nfl) { float* p = ws + off; off += (nfl + 63) & ~(size_t)63; return p; };
    float* KC = take((size_t)B * 2 * 128 * 64);
    float* VC = take((size_t)B * 2 * 128 * 64);
    float* HID = take((size_t)B * 2 * NCMP * 128);
    if (off * 4 < WS_MOE_END) off = WS_MOE_END / 4;
    if (off * 4 > ws_size) { fprintf(stderr, "kernel_launch: workspace too small: need %zu have %zu\n", off * 4, ws_size); return; }

    hipMemsetAsync(wsb + WS_CTL, 0, 1 * MiB, stream);
#if MK_FUSED
    launch_mega(base, {0}, stream);
#else
    launch_mega(base, {0}, stream);
    launch_mega(base, {1}, stream);
    bf16_t* CONCATB = (bf16_t*)(wsb + WS_S + S_CONCAT);

    for (int layer = 0; layer < 2; ++layer) {
        const int ncols = layer == 0 ? 3096 : 3128;
        const int n_rw = ncols - NSA_COLS;
        launch_mega(base, {10 + layer}, stream);
        launch_mega(base, {20 + layer}, stream);
        launch_mega(base, {30 + layer}, stream);
        launch_mega(base, {40 + layer}, stream);
        launch_mega(base, {25 + layer}, stream);
        launch_mega(base, {45 + layer}, stream);
        launch_mega(base, {50 + layer}, stream);
        launch_mega(base, {60 + layer}, stream);
        launch_mega(base, {70 + layer}, stream);
        launch_mega(base, {80 + layer}, stream);
        if (layer == 0) {
            launch_mega(base, {90}, stream);
            launch_mega(base, {91}, stream);
        } else {
            launch_mega(base, {100}, stream);
            launch_mega(base, {101}, stream);
            launch_mega(base, {102}, stream);
            launch_mega(base, {103}, stream);
            launch_mega(base, {104}, stream);
            launch_mega(base, {105}, stream);
        }
    }
    launch_mega(base, {110}, stream);
#endif
}
```

```cpp
#include <hip/hip_runtime.h>
#include <cstdint>
#include <cstdio>
#include <initializer_list>

constexpr int B_ = 8, T_ = 2048, D_ = 1024, NTOK = B_ * T_, MEM_ = 256, NMEM = B_ * MEM_;
constexpr int W_ = 512, H_ = 8, DH_ = 64;
constexpr int NSA_COLS = 1304, NCMP = 127;
constexpr int FFD = 2816, NEXP = 8, EFF = 3584;
constexpr int NPJ = 3072;

typedef unsigned short bf16_t;
typedef float f32x4_t __attribute__((ext_vector_type(4)));
typedef unsigned u32x4_t __attribute__((ext_vector_type(4)));
typedef unsigned u32x2_t __attribute__((ext_vector_type(2)));
#define LAS __attribute__((address_space(3)))

__device__ __forceinline__ float bf2f(bf16_t v) { return __uint_as_float(((unsigned)v) << 16); }
__device__ __forceinline__ unsigned f2bf(float f) { unsigned u = __float_as_uint(f); return (u + 0x7fffu + ((u >> 16) & 1u)) >> 16; }
__device__ __forceinline__ unsigned pk2(float lo, float hi) { return f2bf(lo) | (f2bf(hi) << 16); }
__device__ __forceinline__ unsigned pk4_fp8(float a, float b, float c, float d) {
    a = __builtin_amdgcn_fmed3f(a, -448.f, 448.f); b = __builtin_amdgcn_fmed3f(b, -448.f, 448.f); c = __builtin_amdgcn_fmed3f(c, -448.f, 448.f); d = __builtin_amdgcn_fmed3f(d, -448.f, 448.f);
    int r = __builtin_amdgcn_cvt_pk_fp8_f32(a, b, 0, false);
    r = __builtin_amdgcn_cvt_pk_fp8_f32(c, d, r, true);
    return (unsigned)r;
}
constexpr float F8S_X = 4.0f, F8S_W = 64.0f, F8S_ACT = 8.0f;
constexpr int F8C_X = 125, F8C_W = 121, F8C_ACT = 124;
__device__ __forceinline__ float ldf(const float* p, size_t i) { return p[i]; }
__device__ __forceinline__ float ldf(const bf16_t* p, size_t i) { return bf2f(p[i]); }
__device__ __forceinline__ void stf(float* p, size_t i, float v) { p[i] = v; }
__device__ __forceinline__ void stf(bf16_t* p, size_t i, float v) { p[i] = (bf16_t)f2bf(v); }

__device__ __forceinline__ float wave_sum(float v) {
#pragma unroll
    for (int o = 1; o < 64; o <<= 1) v += __shfl_xor(v, o);
    return v;
}
__device__ __forceinline__ float wave_max(float v) {
#pragma unroll
    for (int o = 1; o < 64; o <<= 1) v = fmaxf(v, __shfl_xor(v, o));
    return v;
}
__device__ __forceinline__ float shx(float v, int lane, int m) { return __int_as_float(__builtin_amdgcn_ds_bpermute((lane ^ m) << 2, __float_as_int(v))); }
__device__ __forceinline__ float wave_sum_l(float v, int lane) {
#pragma unroll
    for (int o = 1; o < 64; o <<= 1) v += shx(v, lane, o);
    return v;
}
__device__ __forceinline__ float wave_max_l(float v, int lane) {
#pragma unroll
    for (int o = 1; o < 64; o <<= 1) v = fmaxf(v, shx(v, lane, o));
    return v;
}
__device__ __forceinline__ float sigmoidf_(float x) { return 1.f / (1.f + __expf(-x)); }
__device__ __forceinline__ float fexp(float x) { return __builtin_amdgcn_exp2f(x * 1.4426950408889634f); }
__device__ __forceinline__ float fsigmoid(float x) { return __builtin_amdgcn_rcpf(1.0f + __builtin_amdgcn_exp2f(x * -1.4426950408889634f)); }
__device__ __forceinline__ float ftanh(float x) { return 2.0f * fsigmoid(2.0f * x) - 1.0f; }

constexpr size_t MiB = (size_t)1 << 20;
constexpr size_t WS_CTL = 0;
constexpr size_t WS_MRINV = 512 * 1024;
constexpr size_t WS_X = 1 * MiB;
constexpr size_t WS_XB = WS_X + 64 * MiB;
constexpr size_t WS_SSQ = WS_XB + 32 * MiB;
constexpr size_t WS_WB = WS_SSQ + 1 * MiB;
constexpr size_t WS_MEMB = WS_WB + 54 * MiB;
constexpr size_t WS_KCR = WS_MEMB + 4 * MiB;
constexpr size_t WS_VT = WS_KCR + 8 * MiB;
constexpr size_t WS_VFIRST = WS_VT + 8 * MiB;
constexpr size_t WS_S = WS_VFIRST + 16 * MiB;
constexpr size_t WB_WIN = 0;
constexpr size_t WB_WOUT = WB_WIN + 2 * (size_t)NPJ * 1024 * 2;
constexpr size_t WB_WQ = WB_WOUT + 2 * 2 * MiB;
constexpr size_t WB_WK = WB_WQ + 2 * 2 * MiB;
constexpr size_t WB_WV = WB_WK + 2 * 2 * MiB;
constexpr size_t WB_WO = WB_WV + 2 * 2 * MiB;
constexpr size_t WB_WGU = WB_WO + 2 * 2 * MiB;
constexpr size_t WB_WD = WB_WGU + (size_t)2 * FFD * 1024 * 2;
constexpr size_t WB_LORA = WB_WD + (size_t)FFD * 1024 * 2;
constexpr size_t WB_CW1 = WB_LORA + 2 * 512 * 288 * 2;
constexpr size_t WB_CW2 = WB_CW1 + 4 * 128 * 2048 * 2;
constexpr size_t WB_CB = WB_CW2 + 4 * 64 * 128 * 2;
constexpr size_t WB_WSK = WB_CB + 4 * 128 * 4;
constexpr size_t WB_END = WB_WSK + 2 * 64 * 1024 * 2;
static_assert(WB_END <= 54 * MiB, "weight map");
constexpr size_t WS_WE = WS_WB;
constexpr size_t WE_D = (size_t)8 * 7168 * 1024 * 2;
constexpr size_t WS_XG = WS_WE + 168 * MiB;
constexpr int MOE_PASS_TILES = 64;
constexpr size_t WS_ACTM = WS_XG + 68 * MiB;
constexpr size_t WS_MT = WS_ACTM + 119 * MiB;
constexpr size_t MT_INV = 0;
constexpr size_t MT_ROWINFO = 512 * 1024;
constexpr size_t MT_ROWG = 768 * 1024;
constexpr size_t MT_TOKG = 1024 * 1024;
constexpr size_t MT_TILE = 1280 * 1024;
constexpr size_t MT_ROWOF = 1536 * 1024;
constexpr int MOE_NS = 7, MOE_KS = 512;
constexpr size_t WS_MOE_END = WS_MT + 2 * MiB;
constexpr size_t CTL_CNT = 64 * 1024;
namespace pg8 {
#define PG8_LAS __attribute__((address_space(3)))
typedef unsigned short bf16_t;
typedef short bf16x8 __attribute__((ext_vector_type(8)));
typedef float f32x4 __attribute__((ext_vector_type(4)));
typedef unsigned u32x4 __attribute__((ext_vector_type(4)));
constexpr int BM = 256, BK = 64, HALF = 128, HTB = HALF * BK * 2  , STAGE_BYTES = 8 * HTB, NXCD = 8, WGM = 8;

__host__ __device__ __forceinline__ int lds_byte(int r, int c) { const int st = (r >> 4) * 2 + (c >> 5), rr = r & 15, cc = c & 31, ob = rr * 64 + cc * 2; return st * 1024 + (ob ^ (((ob >> 9) & 1) << 5)); }
__host__ __device__ __forceinline__ void stage_rc(int b, int& R, int& C) { const int st = b / 1024, sb = b % 1024, swz = sb ^ (((sb >> 9) & 1) << 5); R = (st >> 1) * 16 + swz / 64; C = (st & 1) * 32 + (swz % 64) / 2; }
__host__ __device__ __forceinline__ int perm32(int rho) { const int n = rho >> 4, i = rho & 15; return 8 * (i >> 2) + 4 * n + (i & 3); }

struct Unit { int pm, pn, e, ord, ks; };
struct Gemm { const bf16_t* A; const bf16_t* Bt; int M, N, K; size_t bstride; };

struct StaticOrder {
    int nM, nN, nwg, G, c;
    __host__ __device__ void init(int M, int N, int G_, int c_) { nM = M / BM; nN = N / BM; nwg = nM * nN; G = G_; c = c_; }
    __host__ __device__ bool next(int i, Unit& u) const {
        const int L = i * G + c; if (L >= nwg) return false;
        int wgid = L; { const int q = nwg / NXCD, r = nwg % NXCD, xcd = wgid % NXCD, off = wgid / NXCD; wgid = (xcd < r ? xcd * (q + 1) : r * (q + 1) + (xcd - r) * q) + off; }
        const int nig = WGM * nN, gid = wgid / nig, fm = gid * WGM, gsz = (nM - fm) < WGM ? (nM - fm) : WGM;
        u.pm = fm + ((wgid % nig) % gsz); u.pn = (wgid % nig) / gsz; u.e = 0; u.ord = i; u.ks = 0; return true;
    }
    __device__ __forceinline__ void a_ready(const Unit&) const {}
    __device__ __forceinline__ void done(const Unit&) const {}
    __device__ __forceinline__ int kloop(int K) const { return K; }
    __device__ __forceinline__ size_t koff(const Unit&) const { return 0; }
};


__device__ __forceinline__ unsigned cvt_pk_bf16(float lo, float hi) { unsigned r; asm volatile("v_cvt_pk_bf16_f32 %0, %1, %2" : "=v"(r) : "v"(lo), "v"(hi)); return r; }
__device__ __forceinline__ float row_rinv(const float* ssq, int row) {
    const f32x4* p = (const f32x4*)(ssq + (size_t)row * 16);
    const f32x4 a = p[0], b = p[1], c = p[2], d = p[3];
    const float s = ((a[0] + a[1]) + (a[2] + a[3])) + ((b[0] + b[1]) + (b[2] + b[3])) + ((c[0] + c[1]) + (c[2] + c[3])) + ((d[0] + d[1]) + (d[2] + d[3]));
    return 1.0f / sqrtf(s * (1.0f / 1024.0f) + 1e-6f);
}
struct EpiRowScaleBf16 {
    static constexpr bool PERM = true, AFTER_DRAIN = false;
    bf16_t* O; int ldc; const PG8_LAS float* rtab; float mul;
    __device__ __forceinline__ void operator()(const f32x4 (&acc)[2][2][4][2], const Unit& u, int wr, int wc, int fr, int fq) const {
        const int row0 = u.pm * BM + wr * 64 + fr, col0 = u.pn * BM + wc * 32 + 8 * fq;
#pragma unroll
        for (int ai = 0; ai < 2; ++ai)
#pragma unroll
            for (int m = 0; m < 4; ++m) {
                const int row = row0 + ai * HALF + m * 16;
                const float rs = (rtab ? rtab[u.ord * 256 + (row - u.pm * BM)] : 1.0f) * mul;
                bf16_t* rowp = O + (size_t)row * ldc + col0;
#pragma unroll
                for (int bj = 0; bj < 2; ++bj) {
                    const f32x4 v0 = acc[ai][bj][m][0] * rs, v1 = acc[ai][bj][m][1] * rs;
                    u32x4 w; w.x = cvt_pk_bf16(v0[0], v0[1]); w.y = cvt_pk_bf16(v0[2], v0[3]); w.z = cvt_pk_bf16(v1[0], v1[1]); w.w = cvt_pk_bf16(v1[2], v1[3]);
                    *(u32x4*)(rowp + bj * HALF) = w;
                }
            }
    }
};
struct EpiColScaleBf16 {
    static constexpr bool PERM = true, AFTER_DRAIN = false;
    bf16_t* O; int ldc; const float* cs;
    __device__ __forceinline__ void operator()(const f32x4 (&acc)[2][2][4][2], const Unit& u, int wr, int wc, int fr, int fq) const {
        const int row0 = u.pm * BM + wr * 64 + fr, col0 = u.pn * BM + wc * 32 + 8 * fq;
        f32x4 sc[2][2];
#pragma unroll
        for (int bj = 0; bj < 2; ++bj)
#pragma unroll
            for (int n = 0; n < 2; ++n) sc[bj][n] = *(const f32x4*)(cs + col0 + bj * HALF + 4 * n);
#pragma unroll
        for (int ai = 0; ai < 2; ++ai)
#pragma unroll
            for (int m = 0; m < 4; ++m) {
                bf16_t* rowp = O + (size_t)(row0 + ai * HALF + m * 16) * ldc + col0;
#pragma unroll
                for (int bj = 0; bj < 2; ++bj) {
                    const f32x4 v0 = acc[ai][bj][m][0] * sc[bj][0], v1 = acc[ai][bj][m][1] * sc[bj][1];
                    u32x4 w; w.x = cvt_pk_bf16(v0[0], v0[1]); w.y = cvt_pk_bf16(v0[2], v0[3]); w.z = cvt_pk_bf16(v1[0], v1[1]); w.w = cvt_pk_bf16(v1[2], v1[3]);
                    *(u32x4*)(rowp + bj * HALF) = w;
                }
            }
    }
};
struct EpiResid {
    static constexpr bool PERM = false, AFTER_DRAIN = false;
    bf16_t* XB; float* ssq;
    __device__ __forceinline__ void operator()(const f32x4 (&acc)[2][2][4][2], const Unit& u, int wr, int wc, int fr, int fq) const {
        const int row0 = u.pm * BM + wr * 64 + fr, col0 = u.pn * BM + wc * 32 + 4 * fq;
        typedef unsigned u32x2v __attribute__((ext_vector_type(2)));
#pragma unroll
        for (int ai = 0; ai < 2; ++ai)
#pragma unroll
            for (int m = 0; m < 4; ++m) {
                const int row = row0 + ai * HALF + m * 16;
                bf16_t* br = XB + (size_t)row * 1024 + col0;
                float q = 0.f;
#pragma unroll
                for (int bj = 0; bj < 2; ++bj)
#pragma unroll
                    for (int n = 0; n < 2; ++n) {
                        const u32x2v o = *(const u32x2v*)(br + bj * HALF + n * 16);
                        f32x4 x = {__uint_as_float(o.x << 16), __uint_as_float(o.x & 0xffff0000u), __uint_as_float(o.y << 16), __uint_as_float(o.y & 0xffff0000u)};
                        x = x + acc[ai][bj][m][n];
                        q += (x[0] * x[0] + x[1] * x[1]) + (x[2] * x[2] + x[3] * x[3]);
                        u32x2v w; w.x = cvt_pk_bf16(x[0], x[1]); w.y = cvt_pk_bf16(x[2], x[3]);
                        *(u32x2v*)(br + bj * HALF + n * 16) = w;
                    }
                q += shx(q, fq * 16 + fr, 16); q += shx(q, fq * 16 + fr, 32);
                if (fq == 0) ssq[(size_t)row * 16 + u.pn * 4 + wc] = q;
                asm volatile("" ::: "memory");
            }
    }
};
struct EpiSwiGLU {
    static constexpr bool PERM = true, AFTER_DRAIN = false;
    bf16_t* O; int ldc; const PG8_LAS float* rtab;
    __device__ __forceinline__ void operator()(const f32x4 (&acc)[2][2][4][2], const Unit& u, int wr, int wc, int fr, int fq) const {
        const int row0 = u.pm * BM + wr * 64 + fr, col0 = u.pn * HALF + wc * 32 + 8 * fq;
#pragma unroll
        for (int ai = 0; ai < 2; ++ai)
#pragma unroll
            for (int m = 0; m < 4; ++m) {
                const int row = row0 + ai * HALF + m * 16;
                const float rs = rtab ? rtab[u.ord * 256 + (row - u.pm * BM)] : 1.0f;
                float o[8];
#pragma unroll
                for (int n = 0; n < 2; ++n)
#pragma unroll
                    for (int e = 0; e < 4; ++e) {
                        const float gg = acc[ai][0][m][n][e] * rs, uu = acc[ai][1][m][n][e] * rs;
                        o[n * 4 + e] = gg * __builtin_amdgcn_rcpf(1.0f + __builtin_amdgcn_exp2f(gg * -1.4426950408889634f)) * uu;
                    }
                u32x4 w; w.x = cvt_pk_bf16(o[0], o[1]); w.y = cvt_pk_bf16(o[2], o[3]); w.z = cvt_pk_bf16(o[4], o[5]); w.w = cvt_pk_bf16(o[6], o[7]);
                *(u32x4*)(O + (size_t)row * ldc + col0) = w;
            }
    }
};

struct EpiSwiGLU8 {
    static constexpr bool PERM = true, AFTER_DRAIN = false;
    unsigned char* O; int ldc; float osc;
    __device__ __forceinline__ void operator()(const f32x4 (&acc)[2][2][4][2], const Unit& u, int wr, int wc, int fr, int fq) const {
        const int row0 = u.pm * BM + wr * 64 + fr, col0 = u.pn * HALF + wc * 32 + 8 * fq;
        typedef unsigned u32x2v __attribute__((ext_vector_type(2)));
#pragma unroll
        for (int ai = 0; ai < 2; ++ai)
#pragma unroll
            for (int m = 0; m < 4; ++m) {
                const int row = row0 + ai * HALF + m * 16;
                float o[8];
#pragma unroll
                for (int n = 0; n < 2; ++n)
#pragma unroll
                    for (int e = 0; e < 4; ++e) {
                        const float gg = acc[ai][0][m][n][e], uu = acc[ai][1][m][n][e] * osc;
                        o[n * 4 + e] = gg * __builtin_amdgcn_rcpf(1.0f + __builtin_amdgcn_exp2f(gg * -1.4426950408889634f)) * uu;
                    }
                u32x2v w; w.x = pk4_fp8(o[0], o[1], o[2], o[3]); w.y = pk4_fp8(o[4], o[5], o[6], o[7]);
                *(u32x2v*)(O + (size_t)row * ldc + col0) = w;
            }
    }
};
struct EpiSwiGLU8R {
    static constexpr bool PERM = true, AFTER_DRAIN = false;
    unsigned char* O; int ldc; const PG8_LAS float* rtab; float osc;
    __device__ __forceinline__ void operator()(const f32x4 (&acc)[2][2][4][2], const Unit& u, int wr, int wc, int fr, int fq) const {
        const int row0 = u.pm * BM + wr * 64 + fr, col0 = u.pn * HALF + wc * 32 + 8 * fq;
        typedef unsigned u32x2v __attribute__((ext_vector_type(2)));
#pragma unroll
        for (int ai = 0; ai < 2; ++ai)
#pragma unroll
            for (int m = 0; m < 4; ++m) {
                const int row = row0 + ai * HALF + m * 16;
                const float rs = rtab[u.ord * 256 + (row - u.pm * BM)];
                float o[8];
#pragma unroll
                for (int n = 0; n < 2; ++n)
#pragma unroll
                    for (int e = 0; e < 4; ++e) {
                        const float gg = acc[ai][0][m][n][e] * rs, uu = acc[ai][1][m][n][e] * (rs * osc);
                        o[n * 4 + e] = gg * __builtin_amdgcn_rcpf(1.0f + __builtin_amdgcn_exp2f(gg * -1.4426950408889634f)) * uu;
                    }
                u32x2v w; w.x = pk4_fp8(o[0], o[1], o[2], o[3]); w.y = pk4_fp8(o[4], o[5], o[6], o[7]);
                *(u32x2v*)(O + (size_t)row * ldc + col0) = w;
            }
    }
};
struct EpiMoeDown {
    static constexpr bool PERM = true, AFTER_DRAIN = false;
    bf16_t* Y2; const int* rinfo; const float* rg;
    __device__ __forceinline__ void operator()(const f32x4 (&acc)[2][2][4][2], const Unit& u, int wr, int wc, int fr, int fq) const {
        const int row0 = u.pm * BM + wr * 64 + fr, col0 = u.pn * BM + wc * 32 + 8 * fq;
#pragma unroll
        for (int ai = 0; ai < 2; ++ai)
#pragma unroll
            for (int m = 0; m < 4; ++m) {
                const int row = row0 + ai * HALF + m * 16;
                const int t2 = rinfo[row];
                if (t2 >= 0) {
                    const float gte = rg[row];
                    bf16_t* rowp = Y2 + (size_t)t2 * 1024 + col0;
#pragma unroll
                    for (int bj = 0; bj < 2; ++bj) {
                        const f32x4 v0 = acc[ai][bj][m][0] * gte, v1 = acc[ai][bj][m][1] * gte;
                        u32x4 w; w.x = cvt_pk_bf16(v0[0], v0[1]); w.y = cvt_pk_bf16(v0[2], v0[3]); w.z = cvt_pk_bf16(v1[0], v1[1]); w.w = cvt_pk_bf16(v1[2], v1[3]);
                        *(u32x4*)(rowp + bj * HALF) = w;
                    }
                }
                asm volatile("" ::: "memory");
            }
    }
};
struct MoeOrder {
    int nM, nN, nwg, G, c, pm_lo; const int* tile_e;
    __device__ void init(int nM_, int nN_, int G_, int c_, int pm_lo_, const int* te) { nM = nM_; nN = nN_; nwg = nM * nN; G = G_; c = c_; pm_lo = pm_lo_; tile_e = te; }
    __device__ bool next(int i, Unit& u) const {
        const int L = i * G + c; if (L >= nwg) return false;
        int wgid = L; { const int q = nwg / NXCD, r = nwg % NXCD, xcd = wgid % NXCD, off = wgid / NXCD; wgid = (xcd < r ? xcd * (q + 1) : r * (q + 1) + (xcd - r) * q) + off; }
        const int nig = WGM * nN, gid = wgid / nig, fm = gid * WGM, gsz = (nM - fm) < WGM ? (nM - fm) : WGM;
        u.pm = fm + ((wgid % nig) % gsz); u.pn = (wgid % nig) / gsz; u.e = ((const __attribute__((address_space(4))) int*)(uintptr_t)tile_e)[pm_lo + u.pm]    ; u.ord = i; u.ks = 0; return true;
    }
    __device__ __forceinline__ void a_ready(const Unit&) const {}
    __device__ __forceinline__ void done(const Unit&) const {}
    __device__ __forceinline__ int kloop(int K) const { return K; }
    __device__ __forceinline__ size_t koff(const Unit&) const { return 0; }
};
struct MoeSplitOrder {
    int nM, nwg, G, c, pm_lo, NS, KS; const int* tile_e;
    __device__ void init(int nM_, int G_, int c_, int pm_lo_, const int* te, int NS_, int KS_) { nM = nM_; NS = NS_; KS = KS_; nwg = nM * 4 * NS; G = G_; c = c_; pm_lo = pm_lo_; tile_e = te; }
    __device__ bool next(int i, Unit& u) const {
        const int L = i * G + c; if (L >= nwg) return false;
        const int w = L, tile = w / NS; u.ks = w - tile * NS; u.pm = tile >> 2; u.pn = tile & 3;
        u.e = ((const __attribute__((address_space(4))) int*)(uintptr_t)tile_e)[pm_lo + u.pm]    ; u.ord = i; return true;
    }
    __device__ __forceinline__ void a_ready(const Unit&) const {}
    __device__ __forceinline__ void done(const Unit&) const {}
    __device__ __forceinline__ int kloop(int) const { return KS; }
    __device__ __forceinline__ size_t koff(const Unit& u) const { return (size_t)u.ks * KS * 2; }
};
struct EpiSplitF32 {
    static constexpr bool PERM = true, AFTER_DRAIN = false;
    float* PART; const int* rinfo; int nrows;
    __device__ __forceinline__ void operator()(const f32x4 (&acc)[2][2][4][2], const Unit& u, int wr, int wc, int fr, int fq) const {
        const int row0 = u.pm * BM + wr * 64 + fr, col0 = u.pn * BM + wc * 32 + 8 * fq;
#pragma unroll
        for (int ai = 0; ai < 2; ++ai)
#pragma unroll
            for (int m = 0; m < 4; ++m) {
                const int row = row0 + ai * HALF + m * 16;
                if (rinfo[row] >= 0) {
                    float* rowp = PART + ((size_t)u.ks * nrows + row) * 1024 + col0;
#pragma unroll
                    for (int bj = 0; bj < 2; ++bj) { *(f32x4*)(rowp + bj * HALF) = acc[ai][bj][m][0]; *(f32x4*)(rowp + bj * HALF + 4) = acc[ai][bj][m][1]; }
                }
                asm volatile("" ::: "memory");
            }
    }
};
template <class Epi, class Sched, bool ALIGN_EPI = false, bool SP2 = false, bool FP8 = false, int DBG = 0, bool ROT = false>
__device__ __forceinline__ void gemm_phase(PG8_LAS unsigned char* lds, const Gemm g, const Sched& S, const Epi& E, const int tid_in, const int sa = 127, const int sb = 127) {
    const int tid = tid_in, wid = __builtin_amdgcn_readfirstlane(tid >> 6), lane = tid & 63, wr = wid >> 2, wc = wid & 3, fr = lane & 15, fq = lane >> 4;
    const int K = g.K; int nt = S.kloop(K) / BK;
    if constexpr (FP8) asm volatile("" : "+s"(nt));
    unsigned voffA[2], voffB[2];
#pragma unroll
    for (int i = 0; i < 2; ++i) { int R, C; stage_rc(tid * 16 + i * 8192, R, C); const int Rb = Epi::PERM ? ((R & ~31) + perm32(R & 31)) : R;
        voffA[i] = (unsigned)(R * K + C) * 2u; voffB[i] = (unsigned)(Rb * K + C) * 2u; }
    const size_t kstep = (size_t)(BK * 2);
    const size_t hstep = (size_t)HALF * K * 2;
    const size_t tstep = 2 * hstep;
    const unsigned ldsw = (unsigned)wid * 1024u;
    const int aoff = lds_byte(wr * 64 + fr, fq * 8), boff = lds_byte(wc * 32 + fr, fq * 8);
#define PG8_SA(b, h) (((b) * 2 + (h)) * HTB)
#define PG8_SB(b, h) ((4 + (b) * 2 + (h)) * HTB)
#define PG8_STAGE(bufoff, gbase, voff) do { if constexpr (DBG != 1) _Pragma("unroll") for (int _i = 0; _i < 2; ++_i) { unsigned vo_ = (voff)[_i]; asm volatile("" : "+v"(vo_));     \
        __builtin_amdgcn_global_load_lds((const unsigned*)((const char*)(gbase) + vo_), (PG8_LAS unsigned*)(lds + (bufoff) + ldsw + _i * 8192), 16, 0, 0); } } while (0)
    typedef int i32x4_ __attribute__((ext_vector_type(4))); typedef int i32x8_ __attribute__((ext_vector_type(8)));
#define PG8_LD8(P) __builtin_shufflevector(*(const PG8_LAS i32x4_*)(P), *(const PG8_LAS i32x4_*)((P) + 1024), 0, 1, 2, 3, 4, 5, 6, 7)
#define PG8_LDA(dst, b, h) do { if constexpr (DBG != 3) _Pragma("unroll") for (int m = 0; m < 4; ++m) { if constexpr (FP8) dst##8[m] = PG8_LD8(lds + PG8_SA(b, h) + aoff + m * 2048); else { _Pragma("unroll") for (int k = 0; k < 2; ++k) dst[m][k] = *(const PG8_LAS bf16x8*)(lds + PG8_SA(b, h) + aoff + m * 2048 + k * 1024); } } } while (0)
#define PG8_LDB(dst, b, h) do { if constexpr (DBG != 3) _Pragma("unroll") for (int n = 0; n < 2; ++n) { if constexpr (FP8) dst##8[n] = PG8_LD8(lds + PG8_SB(b, h) + boff + n * 2048); else { _Pragma("unroll") for (int k = 0; k < 2; ++k) dst[n][k] = *(const PG8_LAS bf16x8*)(lds + PG8_SB(b, h) + boff + n * 2048 + k * 1024); } } } while (0)
#define PG8_MMA(ai, bj, At, Bt) do { __builtin_amdgcn_s_setprio(1); if constexpr (DBG != 2) _Pragma("unroll") for (int m = 0; m < 4; ++m) _Pragma("unroll") for (int n = 0; n < 2; ++n) { \
        if constexpr (FP8) acc[ai][bj][m][n] = __builtin_amdgcn_mfma_scale_f32_16x16x128_f8f6f4(Bt##8[n], At##8[m], acc[ai][bj][m][n], 0, 0, 0, sb, 0, sa); \
        else { _Pragma("unroll") for (int k = 0; k < 2; ++k) acc[ai][bj][m][n] = __builtin_amdgcn_mfma_f32_16x16x32_bf16(Bt[n][k], At[m][k], acc[ai][bj][m][n], 0, 0, 0); } } \
        __builtin_amdgcn_s_setprio(0); } while (0)
#define PG8_WAIT_V(n) asm volatile("s_waitcnt vmcnt(" #n ")" ::: "memory")
#define PG8_WAIT_L(n) asm volatile("s_waitcnt lgkmcnt(" #n ")" ::: "memory")
#define PG8_BAR __builtin_amdgcn_s_barrier()
#define PG8_SCHED __builtin_amdgcn_sched_barrier(0)
    Unit cur, nxt; int ui = 0;
    if (!S.next(0, cur)) return;
    f32x4 acc[2][2][4][2];
#pragma unroll
    for (int a = 0; a < 2; ++a)
#pragma unroll
        for (int b = 0; b < 2; ++b)
#pragma unroll
            for (int m = 0; m < 4; ++m)
#pragma unroll
                for (int n = 0; n < 2; ++n) acc[a][b][m][n] = (f32x4){0.f, 0.f, 0.f, 0.f};
    bf16x8 At[4][2], B0[2][2], B1[2][2]; i32x8_ At8[4], B08[2], B18[2];
    const char* cA = (const char*)g.A + (size_t)cur.pm * tstep + S.koff(cur); const char* cB = (const char*)g.Bt + (size_t)cur.e * g.bstride + (size_t)cur.pn * tstep + S.koff(cur);
    S.a_ready(cur);
    const auto ktb = [&](int x, int r) -> size_t { int v = x + r; if (v >= nt) v -= nt; return (size_t)v * kstep; };
    int rot = ROT ? ((cur.pm + cur.pn) & 3) : 0;
    const size_t p0_ = ktb(0, rot), p1_ = ktb(1, rot);
    if constexpr (SP2) {
        PG8_STAGE(PG8_SB(0, 0), cB + p0_, voffB); PG8_STAGE(PG8_SB(0, 1), cB + p0_ + hstep, voffB); PG8_STAGE(PG8_SA(0, 0), cA + p0_, voffA); PG8_STAGE(PG8_SA(0, 1), cA + p0_ + hstep, voffA);
        if (wr == 1) PG8_BAR;
        PG8_WAIT_V(2); PG8_BAR;
        PG8_STAGE(PG8_SB(1, 0), cB + p1_, voffB); PG8_STAGE(PG8_SA(1, 0), cA + p1_, voffA); PG8_STAGE(PG8_SB(1, 1), cB + hstep + p1_, voffB);
        PG8_WAIT_V(6); PG8_BAR;
    } else {
        PG8_STAGE(PG8_SB(0, 0), cB + p0_, voffB); PG8_STAGE(PG8_SA(0, 0), cA + p0_, voffA); PG8_STAGE(PG8_SB(0, 1), cB + p0_ + hstep, voffB); PG8_STAGE(PG8_SA(0, 1), cA + p0_ + hstep, voffA);
        if (wr == 1) PG8_BAR;
        PG8_WAIT_V(4); PG8_BAR;
        PG8_STAGE(PG8_SB(1, 0), cB + p1_, voffB); PG8_STAGE(PG8_SA(1, 0), cA + p1_, voffA); PG8_STAGE(PG8_SB(1, 1), cB + hstep + p1_, voffB);
        PG8_WAIT_V(6); PG8_BAR;
    }
    for (;;) {
        const bool has_next = S.next(ui + 1, nxt);
        const char* nA = has_next ? (const char*)g.A + (size_t)nxt.pm * tstep + S.koff(nxt) : cA; const char* nB = has_next ? (const char*)g.Bt + (size_t)nxt.e * g.bstride + (size_t)nxt.pn * tstep + S.koff(nxt) : cB;
        const int rotn = (ROT && has_next) ? ((nxt.pm + nxt.pn) & 3) : rot;
        for (int t = 0; t < nt; t += 2) {
            const bool last = (t == nt - 2);
            const char* a1 = cA + ktb(t + 1, rot);
            const size_t o2 = last ? ktb(0, rotn) : ktb(t + 2, rot), o3 = last ? ktb(1, rotn) : ktb(t + 3, rot);
            const char* a2 = (last ? nA : cA) + o2; const char* b2 = (last ? nB : cB) + o2;
            const char* a3 = (last ? nA : cA) + o3; const char* b3 = (last ? nB : cB) + o3;
            if (last && has_next) S.a_ready(nxt);
            if constexpr (SP2) {
            PG8_LDB(B0, 0, 0); PG8_LDB(B1, 0, 1); PG8_SCHED; PG8_LDA(At, 0, 0); PG8_STAGE(PG8_SA(1, 1), a1 + hstep, voffA);
            PG8_WAIT_V(8); PG8_WAIT_L(0); PG8_BAR; PG8_MMA(0, 0, At, B0); PG8_MMA(0, 1, At, B1); PG8_BAR; PG8_SCHED;
            PG8_LDA(At, 0, 1); PG8_STAGE(PG8_SB(0, 0), b2, voffB); PG8_STAGE(PG8_SB(0, 1), b2 + hstep, voffB); PG8_STAGE(PG8_SA(0, 0), a2, voffA);
            PG8_WAIT_V(8); PG8_WAIT_L(0); PG8_BAR; PG8_MMA(1, 0, At, B0); PG8_MMA(1, 1, At, B1); PG8_BAR; PG8_SCHED;
            PG8_LDB(B0, 1, 0); PG8_LDB(B1, 1, 1); PG8_SCHED; PG8_LDA(At, 1, 0); PG8_STAGE(PG8_SA(0, 1), a2 + hstep, voffA);
            PG8_WAIT_V(8); PG8_WAIT_L(0); PG8_BAR; PG8_MMA(0, 0, At, B0); PG8_MMA(0, 1, At, B1); PG8_BAR; PG8_SCHED;
            PG8_LDA(At, 1, 1); PG8_STAGE(PG8_SB(1, 0), b3, voffB); PG8_STAGE(PG8_SB(1, 1), b3 + hstep, voffB); PG8_STAGE(PG8_SA(1, 0), a3, voffA);
            PG8_WAIT_V(8); PG8_WAIT_L(0); PG8_BAR; PG8_MMA(1, 0, At, B0); PG8_MMA(1, 1, At, B1); PG8_BAR; PG8_SCHED;
            } else {
            PG8_LDB(B0, 0, 0); PG8_SCHED; PG8_LDA(At, 0, 0); PG8_STAGE(PG8_SA(1, 1), a1 + hstep, voffA);
            PG8_WAIT_L(8); PG8_BAR; PG8_WAIT_L(0); PG8_MMA(0, 0, At, B0); PG8_BAR; PG8_SCHED;
            PG8_LDB(B1, 0, 1); PG8_STAGE(PG8_SB(0, 0), b2, voffB);
            PG8_BAR; PG8_WAIT_L(0); PG8_MMA(0, 1, At, B1); PG8_BAR;
            PG8_LDA(At, 0, 1); PG8_STAGE(PG8_SA(0, 0), a2, voffA);
            PG8_BAR; PG8_WAIT_L(0); PG8_MMA(1, 0, At, B0); PG8_BAR; PG8_SCHED;
            PG8_STAGE(PG8_SB(0, 1), b2 + hstep, voffB);
            PG8_WAIT_V(6); PG8_BAR; PG8_MMA(1, 1, At, B1); PG8_BAR;
            PG8_LDB(B0, 1, 0); PG8_SCHED; PG8_LDA(At, 1, 0); PG8_STAGE(PG8_SA(0, 1), a2 + hstep, voffA);
            PG8_WAIT_L(8); PG8_BAR; PG8_WAIT_L(0); PG8_MMA(0, 0, At, B0); PG8_BAR; PG8_SCHED;
            PG8_LDB(B1, 1, 1); PG8_STAGE(PG8_SB(1, 0), b3, voffB);
            PG8_BAR; PG8_WAIT_L(0); PG8_MMA(0, 1, At, B1); PG8_BAR;
            PG8_LDA(At, 1, 1); PG8_STAGE(PG8_SA(1, 0), a3, voffA);
            PG8_BAR; PG8_WAIT_L(0); PG8_MMA(1, 0, At, B0); PG8_BAR; PG8_SCHED;
            PG8_STAGE(PG8_SB(1, 1), b3 + hstep, voffB);
            PG8_WAIT_V(6); PG8_BAR; PG8_MMA(1, 1, At, B1); PG8_BAR;
            }
        }
        if constexpr (ALIGN_EPI) { if (wr == 0) PG8_BAR; }
        if constexpr (!Epi::AFTER_DRAIN) {
            if constexpr (FP8) { int l2; asm volatile("v_mbcnt_lo_u32_b32 %0, -1, 0\n\tv_mbcnt_hi_u32_b32 %0, -1, %0" : "=v"(l2)); E(acc, cur, wr, wc, l2 & 15, l2 >> 4); }
            else E(acc, cur, wr, wc, fr, fq);
            S.done(cur); }
        if (!has_next) break;
#pragma unroll
        for (int a = 0; a < 2; ++a)
#pragma unroll
            for (int b = 0; b < 2; ++b)
#pragma unroll
                for (int m = 0; m < 4; ++m)
#pragma unroll
                    for (int n = 0; n < 2; ++n) acc[a][b][m][n] = (f32x4){0.f, 0.f, 0.f, 0.f};
        cur = nxt; cA = nA; cB = nB; rot = rotn; ++ui;
        if constexpr (ALIGN_EPI) { if (wr == 1) PG8_BAR; }
    }
    PG8_WAIT_V(0);
    if constexpr (!ALIGN_EPI) { if (wr == 0) PG8_BAR; }
    PG8_BAR;
    if constexpr (Epi::AFTER_DRAIN) { E.fused(acc, cur, wr, wc, fr, fq, lds, wid, lane); S.done(cur); }
#undef PG8_SA
#undef PG8_SB
#undef PG8_STAGE
#undef PG8_LDA
#undef PG8_LDB
#undef PG8_MMA
#undef PG8_WAIT_V
#undef PG8_WAIT_L
#undef PG8_BAR
#undef PG8_SCHED
}
}
#define GAS __attribute__((address_space(1)))
typedef unsigned v4u __attribute__((ext_vector_type(4)));
typedef GAS unsigned gu32;
typedef GAS unsigned long long gu64;
__device__ __forceinline__ const float* gin(const float* p) { return (const float*)(const GAS float*)p; }
#define RLX_AGENT __ATOMIC_RELAXED, __HIP_MEMORY_SCOPE_AGENT
#define LDS_WAIT() asm volatile("s_waitcnt lgkmcnt(0)" ::: "memory")
#define VM_WAIT() asm volatile("s_waitcnt vmcnt(0)" ::: "memory")
#define XB_TMO      128
#define XB_XCNT(j)  (256  + 64 * (j))
#define XB_XSUB(j)  (1280 + 64 * (j))
#define XB_XGEN(j)  (2304 + 64 * (j))
#define XB_TOP      3328
#define XB_TOPGEN   3392
#define XCD_BAR_WORDS 3456
#define XB_SPIN_CAP (1u << 18)

__device__ __forceinline__ unsigned xb_ld(unsigned* p)              { return __hip_atomic_load(p, __ATOMIC_RELAXED, __HIP_MEMORY_SCOPE_AGENT); }
__device__ __forceinline__ unsigned xb_add(unsigned* p, unsigned v) { return __hip_atomic_fetch_add(p, v, __ATOMIC_RELAXED, __HIP_MEMORY_SCOPE_AGENT); }
__device__ __forceinline__ unsigned xb_xcc_id() { return (unsigned)__builtin_amdgcn_s_getreg((3 << 11) | 20) & 0xFu; }
#define XB_SPIN(cond, bar) do { unsigned _sp = 0; while (cond) { __builtin_amdgcn_s_sleep(1); \
    if ((++_sp & 255u) == 0u) { if (xb_ld(&(bar)[XB_TMO])) break; if (_sp > XB_SPIN_CAP) { atomicAdd(&(bar)[XB_TMO], 1u); break; } } } } while (0)

struct XcdBarrier {
    unsigned* bar; unsigned x;
    volatile LAS unsigned* st;
};

__device__ __forceinline__ XcdBarrier xcd_barrier_post(unsigned* bar, volatile LAS unsigned* st) {
    XcdBarrier b; b.bar = bar; b.x = xb_xcc_id(); b.st = st;
    if (threadIdx.x == 0) (void)xb_add(&bar[XB_XCNT(b.x)], 1u);
    return b;
}
__device__ __forceinline__ void xcd_barrier_complete(unsigned* bar, unsigned x, unsigned& nloc, unsigned& nx) {
    const unsigned G = gridDim.x * gridDim.y * gridDim.z;
    unsigned sum, cnt, mine, sp = 0u;
    for (;;) {
        sum = 0u; cnt = 0u; mine = 0u;
#pragma unroll
        for (unsigned j = 0; j < 16; ++j) { const unsigned c = xb_ld(&bar[XB_XCNT(j)]); sum += c; cnt += (c > 0u) ? 1u : 0u; mine = (j == x) ? c : mine; }
        if (sum == G) break;
        __builtin_amdgcn_s_sleep(1);
        if ((++sp & 255u) == 0u) { if (xb_ld(&bar[XB_TMO])) break; if (sp > XB_SPIN_CAP) { atomicAdd(&bar[XB_TMO], 1u); break; } }
    }
    nloc = mine > 0u ? mine : 1u; nx = cnt > 0u ? cnt : 1u;
}

__device__ __forceinline__ void xcd_barrier(const XcdBarrier& b) {
    asm volatile("s_waitcnt vmcnt(0)" ::: "memory");
    __syncthreads();
    if (threadIdx.x == 0) {
        unsigned* bar = b.bar;
        __builtin_amdgcn_s_waitcnt(0);
        unsigned nloc = b.st[0], nx = b.st[1];
        if (nloc == 0u) { xcd_barrier_complete(bar, b.x, nloc, nx); b.st[0] = nloc; b.st[1] = nx; }
        const unsigned old = xb_add(&bar[XB_XSUB(b.x)], 1u);
        const unsigned gen = old / nloc;
        if (old + 1u == (gen + 1u) * nloc) {
            __builtin_amdgcn_fence(__ATOMIC_RELEASE, "agent");
            asm volatile("s_waitcnt vmcnt(0)" ::: "memory");
            const unsigned og = xb_add(&bar[XB_TOP], 1u);
            const unsigned tg = og / nx;
            if (og + 1u == (tg + 1u) * nx) xb_add(&bar[XB_TOPGEN], 1u);
            else XB_SPIN(xb_ld(&bar[XB_TOPGEN]) == tg, bar);
            __builtin_amdgcn_fence(__ATOMIC_ACQUIRE, "agent");
            xb_add(&bar[XB_XGEN(b.x)], 1u);
            asm volatile("s_waitcnt vmcnt(0)" ::: "memory");
        } else {
            XB_SPIN(xb_ld(&bar[XB_XGEN(b.x)]) == gen, bar);
            __builtin_amdgcn_fence(__ATOMIC_ACQUIRE, "agent");
            asm volatile("s_waitcnt vmcnt(0)" ::: "memory");
        }
    }
    __syncthreads();
}

#define XB2_SLOT(x, i) (3456 + 256 * (x) + (i))
#define XB2_FLAG(j)    (3456 + 256 * 16 + 64 * (j))
__device__ __forceinline__ XcdBarrier xcd_barrier2_post(unsigned* bar, volatile LAS unsigned* st) {
    XcdBarrier b; b.bar = bar; b.x = xb_xcc_id(); b.st = st;
    if (threadIdx.x == 0) st[2] = xb_add(&bar[XB_XCNT(b.x)], 1u) + 1u;
    return b;
}
__device__ __forceinline__ void xcd_barrier2(const XcdBarrier& b, int wave) {
    asm volatile("s_waitcnt vmcnt(0)" ::: "memory");
    __syncthreads();
    if (wave == 0) {
        unsigned* bar = b.bar; unsigned lane; asm volatile("v_mbcnt_lo_u32_b32 %0, -1, 0\n\tv_mbcnt_hi_u32_b32 %0, -1, %0" : "=v"(lane));
        __builtin_amdgcn_s_waitcnt(0);
        unsigned nloc = b.st[0], mask = b.st[1];
        if (nloc == 0u) {
            const unsigned G = gridDim.x * gridDim.y * gridDim.z; unsigned sp = 0u;
            for (;;) {
                unsigned sum = 0u, mine = 0u; mask = 0u;
#pragma unroll
                for (unsigned j = 0; j < 16; ++j) { const unsigned c = xb_ld(&bar[XB_XCNT(j)]); sum += c; mask |= (c > 0u) ? (1u << j) : 0u; mine = (j == b.x) ? c : mine; }
                nloc = mine;
                if (sum == G) break;
                __builtin_amdgcn_s_sleep(1);
                if ((++sp & 255u) == 0u) { if (xb_ld(&bar[XB_TMO])) break; if (sp > XB_SPIN_CAP) { atomicAdd(&bar[XB_TMO], 1u); break; } }
            }
            nloc = nloc > 0u ? nloc : 1u;
            if (lane == 0) { b.st[0] = nloc; b.st[1] = mask; }
        }
        const unsigned idx = b.st[2] - 1u, g = b.st[3] + 1u;
        if (lane == 0) (void)xb_add(&bar[XB2_SLOT(b.x, idx)], 1u);
        if (idx == 0u) {
            unsigned sp = 0u;
            for (;;) {
                bool ok = true;
                for (unsigned i = lane; i < nloc; i += 64u) ok = ok && ((int)(xb_ld(&bar[XB2_SLOT(b.x, i)]) - g) >= 0);
                if (__builtin_amdgcn_ballot_w64(!ok) == 0ull) break;
                __builtin_amdgcn_s_sleep(1);
                if ((++sp & 255u) == 0u) { if (xb_ld(&bar[XB_TMO])) break; if (sp > XB_SPIN_CAP) { atomicAdd(&bar[XB_TMO], 1u); break; } }
            }
            __builtin_amdgcn_fence(__ATOMIC_RELEASE, "agent");
            asm volatile("s_waitcnt vmcnt(0)" ::: "memory");
            if (lane == 0) (void)xb_add(&bar[XB2_FLAG(b.x)], 1u);
        }
        {
            unsigned sp = 0u;
            for (;;) {
                const bool ok = (lane < 16u && ((mask >> lane) & 1u)) ? ((int)(xb_ld(&bar[XB2_FLAG(lane)]) - g) >= 0) : true;
                if (__builtin_amdgcn_ballot_w64(!ok) == 0ull) break;
                __builtin_amdgcn_s_sleep(1);
                if ((++sp & 255u) == 0u) { if (xb_ld(&bar[XB_TMO])) break; if (sp > XB_SPIN_CAP) { atomicAdd(&bar[XB_TMO], 1u); break; } }
            }
        }
        __builtin_amdgcn_fence(__ATOMIC_ACQUIRE, "agent");
        asm volatile("s_waitcnt vmcnt(0)" ::: "memory");
        if (lane == 0) b.st[3] = g;
    }
    __syncthreads();
}

constexpr int RING_OFF = 0, RING_BYTES = 131072;
constexpr int LDSCTL_OFF = RING_BYTES, MISC_OFF = LDSCTL_OFF + 320;
constexpr int LDS_BYTES = 147456;
constexpr int NWAVES = 8;
constexpr int CW_BAR = 4096;

struct Args { const float* in[40]; float* out; unsigned char* ws; int nph; int ph[63]; };

struct Frame {
    LAS unsigned char* lds;
    volatile LAS unsigned* MISC;
    int tid, lane, wave, vcu, G;
    const float* const* in;
    unsigned char* ws; float* out;
};

struct ConvRegs { f32x4_t v[8]; };
__device__ __forceinline__ void conv_load(ConvRegs& R, const float* W, int ldw, int coff, int nvalid, const float* g, int nblk, int item, int lane) {
    const int kb = item / nblk, nb = item % nblk, k0 = 64 * kb, n0 = 32 * nb;
    const int nn = n0 + (lane & 7) * 4, kr = lane >> 3;
#pragma unroll
    for (int i = 0; i < 8; ++i) {
        const int kk = k0 + 8 * i + kr;
        const float* src = W + (size_t)kk * ldw + coff + nn;
        f32x4_t v = {0.f, 0.f, 0.f, 0.f};
        if (nn + 3 < nvalid) { if ((((size_t)kk * ldw + coff + nn) & 3) == 0) v = *(const f32x4_t*)src; else { v.x = src[0]; v.y = src[1]; v.z = src[2]; v.w = src[3]; } }
        else { if (nn < nvalid) v.x = src[0]; if (nn + 1 < nvalid) v.y = src[1]; if (nn + 2 < nvalid) v.z = src[2]; }
        if (g) v = v * g[kk];
        R.v[i] = v;
    }
}
__device__ __forceinline__ void conv_load64(ConvRegs& R, const float* W, int ldw, const float* g, int nblk64, int sitem, int h, int lane) {
    const int kb = sitem / nblk64, nb = sitem % nblk64, k0 = 64 * kb + 32 * h + 8 * (lane >> 4), n0 = 64 * nb;
#pragma unroll
    for (int i = 0; i < 8; ++i) { f32x4_t v = *(const f32x4_t*)(W + (size_t)(k0 + i) * ldw + n0 + (lane & 15) * 4); if (g) v = v * g[k0 + i]; R.v[i] = v; }
}
__device__ __forceinline__ void conv_units64(const ConvRegs& R, LAS unsigned char* img, int h, int lane) {
    const int kc = 4 * h + (lane >> 4);
#pragma unroll
    for (int e = 0; e < 4; ++e) {
        u32x2_t o; o.x = pk4_fp8(R.v[0][e] * F8S_W, R.v[1][e] * F8S_W, R.v[2][e] * F8S_W, R.v[3][e] * F8S_W); o.y = pk4_fp8(R.v[4][e] * F8S_W, R.v[5][e] * F8S_W, R.v[6][e] * F8S_W, R.v[7][e] * F8S_W);
        *(LAS u32x2_t*)(img + (4 * (lane & 15) + e) * 72 + kc * 8) = o;
    }
}
__device__ __forceinline__ void conv_flush64(LAS unsigned char* img, unsigned char* dst, int K, int nblk64, int rowmode, int sitem, int lane) {
    const int kb = sitem / nblk64, nb = sitem % nblk64, n0 = 64 * nb;
    LDS_WAIT(); asm volatile("" ::: "memory");
#pragma unroll
    for (int j = 0; j < 4; ++j) {
        const int nl = (lane >> 2) + 16 * j, n = n0 + nl, q = lane & 3;
        const int drow = rowmode == 0 ? n : ((n >> 7) * 256 + (n & 127) + (rowmode == 2 ? 128 : 0));
        const u32x2_t lo = *(const LAS u32x2_t*)(img + nl * 72 + q * 16), hi = *(const LAS u32x2_t*)(img + nl * 72 + q * 16 + 8);
        *(GAS u32x4_t*)(dst + (size_t)drow * K + 64 * kb + 16 * q) = (u32x4_t){lo.x, lo.y, hi.x, hi.y};
    }
    LDS_WAIT(); asm volatile("" ::: "memory");
}
template <bool FP8 = false> __device__ __forceinline__ void conv_store(const ConvRegs& R, bf16_t* dst, int K, int nblk, int rowmode, LAS float* scr, int item, int lane) {
    const int kb = item / nblk, nb = item % nblk, k0 = 64 * kb, n0 = 32 * nb;
    const int nl4 = (lane & 7) * 4, kr = lane >> 3;
#pragma unroll
    for (int i = 0; i < 8; ++i) { LAS float* d = scr + (8 * i + kr) * 33 + nl4; d[0] = R.v[i].x; d[1] = R.v[i].y; d[2] = R.v[i].z; d[3] = R.v[i].w; }
    LDS_WAIT(); asm volatile("" ::: "memory");
    const int c = lane & 7;
#pragma unroll
    for (int j = 0; j < 4; ++j) {
        const int nl = (lane >> 3) + 8 * j, n = n0 + nl; const LAS float* s = scr + (8 * c) * 33 + nl;
        const int drow = rowmode == 0 ? n : ((n >> 7) * 256 + (n & 127) + (rowmode == 2 ? 128 : 0));
        if constexpr (FP8) {
            u32x2_t o; o.x = pk4_fp8(s[0 * 33] * F8S_W, s[1 * 33] * F8S_W, s[2 * 33] * F8S_W, s[3 * 33] * F8S_W); o.y = pk4_fp8(s[4 * 33] * F8S_W, s[5 * 33] * F8S_W, s[6 * 33] * F8S_W, s[7 * 33] * F8S_W);
            *(GAS u32x2_t*)((unsigned char*)dst + (size_t)drow * K + k0 + 8 * c) = o;
        } else {
            v4u o; o.x = pk2(s[0 * 33], s[1 * 33]); o.y = pk2(s[2 * 33], s[3 * 33]); o.z = pk2(s[4 * 33], s[5 * 33]); o.w = pk2(s[6 * 33], s[7 * 33]);
            *(GAS v4u*)(dst + (size_t)drow * K + k0 + 8 * c) = o;
        }
    }
    LDS_WAIT(); asm volatile("" ::: "memory");
}
template <bool FP8 = false> __device__ __forceinline__ void conv_matrix(const float* W, int ldw, int coff, int nvalid, const float* g, bf16_t* dst, int K, int nblk, int rowmode, LAS float* scr, int it0, int items, int NGW, int lane) {
    if (it0 >= items) return;
    ConvRegs A, B;
    conv_load(A, W, ldw, coff, nvalid, g, nblk, it0, lane);
    if (it0 + NGW < items) conv_load(B, W, ldw, coff, nvalid, g, nblk, it0 + NGW, lane);
#pragma nounroll
    for (int it = it0; it < items; it += 2 * NGW) {
        { ConvRegs C = A; if (it + 2 * NGW < items) conv_load(A, W, ldw, coff, nvalid, g, nblk, it + 2 * NGW, lane); conv_store<FP8>(C, dst, K, nblk, rowmode, scr, it, lane); }
        if (it + NGW < items) { ConvRegs C = B; if (it + 3 * NGW < items) conv_load(B, W, ldw, coff, nvalid, g, nblk, it + 3 * NGW, lane); conv_store<FP8>(C, dst, K, nblk, rowmode, scr, it + NGW, lane); }
    }
}
struct ConvJob { const float* W; const float* g; bf16_t* dst; int ldw, coff, nvalid, npad, K, rowmode, fp8; };
__device__ __forceinline__ ConvJob conv_job(const Frame& F, int j) {
    bf16_t* WB = (bf16_t*)(F.ws + WS_WB);
    ConvJob c; c.g = nullptr; c.coff = 0; c.rowmode = 0; c.K = 1024; c.ldw = D_; c.nvalid = D_; c.npad = D_; c.fp8 = 0;
    if (j < 16) {
        const int l = j >> 3, k = j & 7;
        switch (k) {
        case 0: { const int ncols = l == 0 ? 3096 : 3128; c.W = l == 0 ? gin(F.in[2]) : gin(F.in[3]); c.ldw = ncols; c.g = gin(F.in[6]) + l * D_; c.dst = WB + (WB_WIN / 2) + (size_t)l * NPJ * 1024;
                  if (l == 0) { c.nvalid = 3072; c.npad = 3072; } else { c.nvalid = 1792; c.npad = 1792; } } break;
        case 1: c.W = gin(F.in[25]) + (size_t)l * D_ * D_; c.dst = WB + (WB_WOUT / 2) + (size_t)l * D_ * D_; break;
        case 2: c.W = gin(F.in[28]) + (size_t)l * D_ * D_; c.g = gin(F.in[26]) + l * D_; c.dst = WB + (WB_WQ / 2) + (size_t)l * D_ * D_; break;
        case 3: c.W = gin(F.in[29]) + (size_t)l * D_ * 2048; c.ldw = 2048; c.g = gin(F.in[27]) + l * D_; c.dst = WB + (WB_WK / 2) + (size_t)l * D_ * D_; break;
        case 4: c.W = gin(F.in[29]) + (size_t)l * D_ * 2048; c.ldw = 2048; c.coff = 1024; c.g = gin(F.in[27]) + l * D_; c.dst = WB + (WB_WV / 2) + (size_t)l * D_ * D_; break;
        case 5: c.W = gin(F.in[30]) + (size_t)l * D_ * D_; c.dst = WB + (WB_WO / 2) + (size_t)l * D_ * D_; break;
        case 6: c.W = gin(F.in[20]) + (size_t)l * 2048 * 128; c.ldw = 128; c.nvalid = 128; c.npad = 128; c.K = 2048; c.dst = WB + (WB_CW1 / 2) + (size_t)(l * 2 + 0) * 128 * 2048; break;
        default: c.W = gin(F.in[23]) + (size_t)l * 2048 * 128; c.ldw = 128; c.nvalid = 128; c.npad = 128; c.K = 2048; c.dst = WB + (WB_CW1 / 2) + (size_t)(l * 2 + 1) * 128 * 2048; break;
        }
    } else if (j == 16) { c.W = gin(F.in[32]); c.ldw = FFD; c.nvalid = FFD; c.npad = FFD; c.g = gin(F.in[31]); c.dst = WB + (WB_WGU / 2); c.rowmode = 1; }
    else if (j == 17) { c.W = gin(F.in[33]); c.ldw = FFD; c.nvalid = FFD; c.npad = FFD; c.g = gin(F.in[31]); c.dst = WB + (WB_WGU / 2); c.rowmode = 2; }
    else if (j == 18) { c.W = gin(F.in[34]); c.K = FFD; c.dst = WB + (WB_WD / 2); c.fp8 = 1; }
    else {
        const int l = j == 19 ? 0 : 1, ncols = l == 0 ? 3096 : 3128;
        c.W = l == 0 ? gin(F.in[2]) : gin(F.in[3]); c.ldw = ncols; c.g = gin(F.in[6]) + l * D_;
        bf16_t* wsk = WB + (WB_WSK / 2) + (size_t)l * 64 * 1024;
        if (j == 19) { c.coff = 3072; c.nvalid = 24; c.npad = 32; c.dst = wsk; }
        else if (j == 20) { c.coff = 1824; c.nvalid = 1280; c.npad = 1280; c.dst = WB + (WB_WIN / 2) + (size_t)NPJ * 1024 + (size_t)1792 * 1024; }
        else if (j == 21) { c.coff = 3104; c.nvalid = 24; c.npad = 32; c.dst = wsk; }
        else { c.coff = 1792; c.nvalid = 32; c.npad = 32; c.dst = wsk + (size_t)32 * 1024; }
    }
    return c;
}

__device__ __forceinline__ void p_prologue(Frame& F) {
    LAS float* scr = (LAS float*)(F.lds + RING_OFF + F.wave * 16384);
    const int gw = F.vcu * NWAVES + F.wave, NGW = F.G * NWAVES;
    bf16_t* WB = (bf16_t*)(F.ws + WS_WB);
    LAS int* pre = (LAS int*)(F.lds + LDSCTL_OFF + 1024);
    if (F.tid < 23) { const ConvJob c = conv_job(F, F.tid); pre[F.tid] = (c.K / 64) * (c.npad / 32); }
    __syncthreads();
    if (F.tid == 0) { int acc = 0; for (int j = 0; j < 23; ++j) { const int it = pre[j]; pre[j] = acc; acc += it; } pre[23] = acc; }
    __syncthreads();
    {
        const int TOT = pre[23];
#define PRO_JOB(gi) int j_ = 0; for (int q_ = 1; q_ < 23; ++q_) j_ += ((gi) >= pre[q_]) ? 1 : 0; j_ = __builtin_amdgcn_readfirstlane(j_); const ConvJob c_ = conv_job(F, j_); const int it_ = (gi) - pre[j_];
#define PRO_LOAD(R, gi) do { PRO_JOB(gi) conv_load(R, c_.W, c_.ldw, c_.coff, c_.nvalid, c_.g, c_.npad / 32, it_, F.lane); } while (0)
#define PRO_STORE(R, gi) do { PRO_JOB(gi) if (c_.fp8) conv_store<true>(R, c_.dst, c_.K, c_.npad / 32, c_.rowmode, scr, it_, F.lane); else conv_store<false>(R, c_.dst, c_.K, c_.npad / 32, c_.rowmode, scr, it_, F.lane); } while (0)
        ConvRegs A, B;
        if (gw < TOT) PRO_LOAD(A, gw);
        if (gw + NGW < TOT) PRO_LOAD(B, gw + NGW);
#pragma nounroll
        for (int gi = gw; gi < TOT; gi += 2 * NGW) {
            { ConvRegs C = A; if (gi + 2 * NGW < TOT) PRO_LOAD(A, gi + 2 * NGW); PRO_STORE(C, gi); }
            if (gi + NGW < TOT) { ConvRegs C = B; if (gi + 3 * NGW < TOT) PRO_LOAD(B, gi + 3 * NGW); PRO_STORE(C, gi + NGW); }
        }
#undef PRO_JOB
#undef PRO_LOAD
#undef PRO_STORE
    }
    const int gt = (F.vcu * NWAVES + F.wave) * 64 + F.lane, NGT = F.G * NWAVES * 64;
    for (int l = 0; l < 2; ++l) {
        bf16_t* LT = WB + (WB_LORA / 2) + (size_t)l * 512 * 288;
        for (int i = gt; i < 512 * 288; i += NGT) {
            const int c = i / 288, k = i % 288; float v;
            if (k < 64) v = gin(F.in[8])[((size_t)l * 64 + k) * 512 + c];
            else if (k < 128) v = gin(F.in[10])[((size_t)l * 64 + (k - 64)) * 512 + c];
            else if (k < 256) v = gin(F.in[11])[((size_t)l * 128 + (k - 128)) * 512 + c];
            else v = (l == 1) ? gin(F.in[18])[(size_t)(k - 256) * 512 + c] : 0.f;
            LT[i] = (bf16_t)f2bf(v);
        }
        for (int kv = 0; kv < 2; ++kv) {
            bf16_t* C2 = WB + (WB_CW2 / 2) + (size_t)(l * 2 + kv) * 64 * 128;
            const float* w2 = (kv == 0 ? gin(F.in[21]) : gin(F.in[24])) + (size_t)l * 128 * 64;
            for (int i = gt; i < 64 * 128; i += NGT) { const int d = i / 128, k = i % 128; C2[i] = (bf16_t)f2bf(w2[k * 64 + d]); }
        }
    }
    for (int o = gw; o < 512; o += NGW) {
        const int l = o >> 8, kv = (o >> 7) & 1, hid = o & 127;
        const float* pe = (kv == 0 ? gin(F.in[19]) : gin(F.in[22])) + (size_t)l * 2048;
        const float* w1 = (kv == 0 ? gin(F.in[20]) : gin(F.in[23])) + (size_t)l * 2048 * 128;
        float a = 0.f;
        for (int i = F.lane; i < 2048; i += 64) a += pe[i] * w1[(size_t)i * 128 + hid];
        a = wave_sum_l(a, F.lane);
        if (F.lane == 0) ((float*)(F.ws + WS_WB + WB_CB))[o] = a;
    }
    {
        bf16_t* XB = (bf16_t*)(F.ws + WS_XB); float* SSQ = (float*)(F.ws + WS_SSQ);
        for (int m = gw; m < NTOK; m += NGW) {
            const GAS f32x4_t* xr = (const GAS f32x4_t*)(gin(F.in[0]) + (size_t)m * D_) + F.lane;
            f32x4_t v[4]; float s = 0.f;
#pragma unroll
            for (int j = 0; j < 4; ++j) { v[j] = xr[64 * j]; s += (v[j].x * v[j].x + v[j].y * v[j].y) + (v[j].z * v[j].z + v[j].w * v[j].w); }
            s = wave_sum_l(s, F.lane);
            GAS unsigned long long* o8 = (GAS unsigned long long*)(XB + (size_t)m * D_) + F.lane;
#pragma unroll
            for (int j = 0; j < 4; ++j) { o8[64 * j] = (unsigned long long)pk2(v[j].x, v[j].y) | ((unsigned long long)pk2(v[j].z, v[j].w) << 32); }
            if (F.lane < 16) SSQ[(size_t)m * 16 + F.lane] = (F.lane == 0) ? s : 0.f;
        }
        bf16_t* MB = (bf16_t*)(F.ws + WS_MEMB); float* MRINV = (float*)(F.ws + WS_MRINV);
        for (int m = gw; m < NMEM; m += NGW) {
            const GAS f32x4_t* xr = (const GAS f32x4_t*)(gin(F.in[1]) + (size_t)m * D_) + F.lane;
            f32x4_t v[4]; float s = 0.f;
#pragma unroll
            for (int j = 0; j < 4; ++j) { v[j] = xr[64 * j]; s += (v[j].x * v[j].x + v[j].y * v[j].y) + (v[j].z * v[j].z + v[j].w * v[j].w); }
            s = wave_sum_l(s, F.lane);
            GAS unsigned long long* o8 = (GAS unsigned long long*)(MB + (size_t)m * D_) + F.lane;
#pragma unroll
            for (int j = 0; j < 4; ++j) o8[64 * j] = (unsigned long long)pk2(v[j].x, v[j].y) | ((unsigned long long)pk2(v[j].z, v[j].w) << 32);
            if (F.lane == 0) MRINV[m] = 1.0f / sqrtf(s * (1.0f / 1024.0f) + 1e-6f);
        }
    }
}


__device__ __forceinline__ unsigned char* launder_ptr(unsigned char* p) {
    unsigned lo = (unsigned)(uintptr_t)p, hi = (unsigned)((uintptr_t)p >> 32);
    asm volatile("" : "+v"(lo), "+v"(hi));
    lo = __builtin_amdgcn_readfirstlane(lo); hi = __builtin_amdgcn_readfirstlane(hi);
    return (unsigned char*)(GAS unsigned char*)(((uintptr_t)hi << 32) | (uintptr_t)lo);
}
__device__ __forceinline__ int lane_now() { int l; asm volatile("v_mbcnt_lo_u32_b32 %0, -1, 0\n\tv_mbcnt_hi_u32_b32 %0, -1, %0" : "=v"(l)); return l; }
#define RELAUNDER(F) do { int w_ = (F).wave; asm volatile("" : "+v"(w_)); w_ = __builtin_amdgcn_readfirstlane(w_); const int l_ = lane_now(); int t_ = w_ * 64 + l_; asm volatile("" : "+v"(t_)); \
    (F).tid = t_; (F).lane = t_ & 63; (F).wave = w_; (F).ws = launder_ptr((F).ws); } while (0)
constexpr size_t S_PROJ = 0;
constexpr size_t S_EX = 96 * MiB;
constexpr size_t S_CONCAT = 104 * MiB;
constexpr size_t S_SC = 104 * MiB;
constexpr size_t S_CH = 200 * MiB;
constexpr int CH_BYTES = 12544;
constexpr size_t S_BON = 298 * MiB;
constexpr size_t S_END = 299 * MiB;
constexpr size_t O_Y = 0;
constexpr size_t O_G = 32 * MiB;
constexpr size_t O_VP = 48 * MiB;
constexpr size_t S_QC = 0, S_OC = 32 * MiB;
constexpr size_t S_ACT = 0;

constexpr int RTAB_OFF = 132096, RTAB_UNITS = 8;
static_assert(RTAB_OFF + RTAB_UNITS * 256 * 4 <= LDS_BYTES && RTAB_OFF >= MISC_OFF + 128, "LDS map");
template <class Sched> __device__ __forceinline__ void fill_rtab(Frame& F, const Sched& S, const float* direct = nullptr) {
    const float* ssq = (const float*)(F.ws + WS_SSQ);
    LAS float* rtab = (LAS float*)(F.lds + RTAB_OFF);
    pg8::Unit u;
    for (int i = 0; i < RTAB_UNITS && S.next(i, u); ++i)
        if (F.tid < 256) rtab[i * 256 + F.tid] = direct ? direct[u.pm * 256 + F.tid] : pg8::row_rinv(ssq, u.pm * 256 + F.tid);
    __syncthreads();
}
__device__ __forceinline__ void p_inproj(Frame& F, int l) {
    RELAUNDER(F);
    pg8::Gemm g{(const bf16_t*)(F.ws + WS_XB), (const bf16_t*)(F.ws + WS_WB + WB_WIN) + (size_t)l * NPJ * 1024, NTOK, NPJ, 1024, 0};
    pg8::StaticOrder S; S.init(NTOK, NPJ, F.G, (int)blockIdx.x);
    fill_rtab(F, S);
    pg8::EpiRowScaleBf16 E{(bf16_t*)(F.ws + WS_S), NPJ, (const LAS float*)(F.lds + RTAB_OFF), 1.0f};
    pg8::gemm_phase<pg8::EpiRowScaleBf16, pg8::StaticOrder, true, true>(F.lds + RING_OFF, g, S, E, F.tid);
    __syncthreads();
    for (int chunk = F.vcu; chunk < NTOK / 64; chunk += F.G) {
        const int w = F.wave, m = F.lane & 15, kq = F.lane >> 4, tokb = chunk * 64 + (w >> 1) * 16, colb = (w & 1) * 32;
        const bf16_t* ap = (const bf16_t*)(F.ws + WS_XB) + (size_t)(tokb + m) * D_ + kq * 8;
        const bf16_t* bp = (const bf16_t*)(F.ws + WS_WB + WB_WSK) + (size_t)l * 64 * 1024 + (size_t)(colb + m) * D_ + kq * 8;
        pg8::f32x4 a0 = {0.f, 0.f, 0.f, 0.f}, a1 = a0;
#pragma unroll 8
        for (int ks = 0; ks < 32; ++ks) {
            const pg8::bf16x8 af = *(const pg8::bf16x8*)(ap + ks * 32), b0 = *(const pg8::bf16x8*)(bp + ks * 32), b1 = *(const pg8::bf16x8*)(bp + (size_t)16 * D_ + ks * 32);
            a0 = __builtin_amdgcn_mfma_f32_16x16x32_bf16(af, b0, a0, 0, 0, 0);
            a1 = __builtin_amdgcn_mfma_f32_16x16x32_bf16(af, b1, a1, 0, 0, 0);
        }
        bf16_t* EX = (bf16_t*)(F.ws + WS_S + S_EX);
#pragma unroll
        for (int rg = 0; rg < 4; ++rg) {
            const int tok = tokb + 4 * kq + rg; const float rs = pg8::row_rinv((const float*)(F.ws + WS_SSQ), tok);
            EX[(size_t)tok * 64 + colb + m] = (bf16_t)f2bf(a0[rg] * rs); EX[(size_t)tok * 64 + colb + 16 + m] = (bf16_t)f2bf(a1[rg] * rs);
        }
    }
}

template <int DBG = 0> __device__ __forceinline__ void p_gprobe(Frame& F, int N, int K) {
    RELAUNDER(F);
    pg8::Gemm g{(const bf16_t*)(F.ws + WS_XB), (const bf16_t*)(F.ws + WS_WB + WB_WIN), NTOK, N, K, 0};
    pg8::StaticOrder S; S.init(NTOK, N, F.G, (int)blockIdx.x);
    fill_rtab(F, S);
    pg8::EpiRowScaleBf16 E{(bf16_t*)(F.ws + WS_S), N, (const LAS float*)(F.lds + RTAB_OFF), 1.0f};
    pg8::gemm_phase<pg8::EpiRowScaleBf16, pg8::StaticOrder, true, true, false, DBG>(F.lds + RING_OFF, g, S, E, F.tid);
}
struct SameTileOrder {
    int nU, pm0, pn0;
    __device__ bool next(int i, pg8::Unit& u) const { if (i >= nU) return false; u.pm = pm0; u.pn = pn0; u.e = 0; u.ord = 0; u.ks = 0; return true; }
    __device__ __forceinline__ void a_ready(const pg8::Unit&) const {}
    __device__ __forceinline__ void done(const pg8::Unit&) const {}
    __device__ __forceinline__ int kloop(int K) const { return K; }
    __device__ __forceinline__ size_t koff(const pg8::Unit&) const { return 0; }
};
__device__ __forceinline__ void p_gprobe2(Frame& F, int nU, int K, int mode) {
    RELAUNDER(F);
    pg8::Gemm g{(const bf16_t*)(F.ws + WS_XB), (const bf16_t*)(F.ws + WS_WB + WB_WIN), NTOK, 1024, K, 0};
    SameTileOrder S; S.nU = nU; S.pm0 = mode == 0 ? 0 : (mode == 1 ? (int)(blockIdx.x & 7) : (int)(blockIdx.x >> 2)); S.pn0 = mode == 0 ? 0 : (mode == 1 ? 0 : (int)(blockIdx.x & 3));
    fill_rtab(F, S);
    pg8::EpiRowScaleBf16 E{(bf16_t*)(F.ws + WS_S), 1024, (const LAS float*)(F.lds + RTAB_OFF), 1.0f};
    pg8::gemm_phase<pg8::EpiRowScaleBf16, SameTileOrder, true, true>(F.lds + RING_OFF, g, S, E, F.tid);
}
__device__ __forceinline__ void p_resid_gemm(Frame& F, const bf16_t* A, const bf16_t* Bt, int K) {
    RELAUNDER(F);
    pg8::Gemm g{A, Bt, NTOK, 1024, K, 0};
    pg8::StaticOrder S; S.init(NTOK, 1024, F.G, (int)blockIdx.x);
    pg8::EpiResid E{(bf16_t*)(F.ws + WS_XB), (float*)(F.ws + WS_SSQ)};
    pg8::gemm_phase<pg8::EpiResid, pg8::StaticOrder, true, true>(F.lds + RING_OFF, g, S, E, F.tid);
}
__device__ __forceinline__ int p_crossq(Frame& F, int l) {
    RELAUNDER(F);
    pg8::Gemm g{(const bf16_t*)(F.ws + WS_XB), (const bf16_t*)(F.ws + WS_WB + WB_WQ) + (size_t)l * D_ * D_, NTOK, 1024, 1024, 0};
    pg8::StaticOrder S; S.init(NTOK, 1024, F.G, (int)blockIdx.x);
    fill_rtab(F, S);
    pg8::EpiRowScaleBf16 E{(bf16_t*)(F.ws + WS_S + S_QC), 1024, (const LAS float*)(F.lds + RTAB_OFF), 0.0625f * 1.4426950408889634f};
    pg8::gemm_phase<pg8::EpiRowScaleBf16, pg8::StaticOrder, true, true>(F.lds + RING_OFF, g, S, E, F.tid);
    pg8::Unit u; if (F.G != 256 || !S.next(0, u)) return -1;
    return ((u.pm >> 3) * 4 + u.pn) * 8 + (u.pm & 7);
}
__device__ __forceinline__ void p_kv(Frame& F, int cb) {
    RELAUNDER(F);
    if (cb < 0 || cb >= 128) return;
    const int which = cb >> 5, l = which >> 1, c = cb & 31;
    const bf16_t* MB = (const bf16_t*)(F.ws + WS_MEMB); const float* MRINV = (const float*)(F.ws + WS_MRINV);
    if ((which & 1) == 0) {
        pg8::Gemm g{MB, (const bf16_t*)(F.ws + WS_WB + WB_WK) + (size_t)l * D_ * D_, NMEM, 1024, 1024, 0};
        pg8::StaticOrder S; S.init(NMEM, 1024, 32, c);
        fill_rtab(F, S, MRINV);
        pg8::EpiRowScaleBf16 E{(bf16_t*)(F.ws + WS_KCR) + (size_t)l * NMEM * 1024, 1024, (const LAS float*)(F.lds + RTAB_OFF), 1.0f};
        pg8::gemm_phase<pg8::EpiRowScaleBf16, pg8::StaticOrder, true, true>(F.lds + RING_OFF, g, S, E, F.tid);
    } else {
        pg8::Gemm g{(const bf16_t*)(F.ws + WS_WB + WB_WV) + (size_t)l * D_ * D_, MB, 1024, NMEM, 1024, 0};
        pg8::StaticOrder S; S.init(1024, NMEM, 32, c);
        pg8::EpiColScaleBf16 E{(bf16_t*)(F.ws + WS_VT) + (size_t)l * 1024 * NMEM, NMEM, MRINV};
        pg8::gemm_phase<pg8::EpiColScaleBf16, pg8::StaticOrder, true, true>(F.lds + RING_OFF, g, S, E, F.tid);
    }
}
__device__ __forceinline__ void p_ffn_up(Frame& F) {
    RELAUNDER(F);
    pg8::Gemm g{(const bf16_t*)(F.ws + WS_XB), (const bf16_t*)(F.ws + WS_WB + WB_WGU), NTOK, 2 * FFD, 1024, 0};
    pg8::StaticOrder S; S.init(NTOK, 2 * FFD, F.G, (int)blockIdx.x);
    fill_rtab(F, S);
    pg8::EpiSwiGLU8R E{(unsigned char*)(F.ws + WS_S + S_ACT), FFD, (const LAS float*)(F.lds + RTAB_OFF), F8S_ACT};
    pg8::gemm_phase<pg8::EpiSwiGLU8R, pg8::StaticOrder, true, true>(F.lds + RING_OFF, g, S, E, F.tid);
}
__device__ __forceinline__ void p_ffn_down8(Frame& F) {
    RELAUNDER(F);
    pg8::Gemm g{(const bf16_t*)(F.ws + WS_S + S_ACT), (const bf16_t*)(F.ws + WS_WB + WB_WD), NTOK, 1024, FFD / 2, 0};
    pg8::StaticOrder S; S.init(NTOK, 1024, F.G, (int)blockIdx.x);
    pg8::EpiResid E{(bf16_t*)(F.ws + WS_XB), (float*)(F.ws + WS_SSQ)};
    pg8::gemm_phase<pg8::EpiResid, pg8::StaticOrder, true, true, true>(F.lds + RING_OFF, g, S, E, F.tid, F8C_ACT, F8C_W);
}

typedef short bf16x8_t __attribute__((ext_vector_type(8)));
constexpr int LDX = 296;
__device__ __forceinline__ void p_rw_prep(Frame& F, int l) {
    RELAUNDER(F);
    const int n_lo = l == 0 ? 256 : 288;
    const bf16_t* P = (const bf16_t*)(F.ws + WS_S + S_PROJ); const bf16_t* EXp = (const bf16_t*)(F.ws + WS_S + S_EX);
    const float* mu = l == 0 ? gin(F.in[4]) : gin(F.in[5]);
    const bf16_t* LT0 = (const bf16_t*)(F.ws + WS_WB + WB_LORA) + (size_t)l * 512 * 288;
    bf16_t* SC = (bf16_t*)(F.ws + WS_S + S_SC); bf16_t* Gb = (bf16_t*)((unsigned char*)F.out + O_G); bf16_t* VPb = (bf16_t*)((unsigned char*)F.out + O_VP); float* BON = (float*)(F.ws + WS_S + S_BON);
    bf16_t* VF = (bf16_t*)(F.ws + WS_VFIRST);
    LAS bf16_t* Xs = (LAS bf16_t*)F.lds;
    const float* w0 = gin(F.in[7]) + l * W_; const float* a0 = gin(F.in[9]) + l * W_; const float* kkp = gin(F.in[12]) + l * W_; const float* kap = gin(F.in[13]) + l * W_; const float* rkp = gin(F.in[14]) + l * W_;
    const float* v0p = gin(F.in[17]);
    for (int chunk = F.vcu; chunk < NTOK / 64; chunk += F.G) {
        const int tok0 = chunk * 64;
        __syncthreads();
        for (int c = F.tid; c < 64 * 36; c += NWAVES * 64) {
            const int row = c / 36, ch = c % 36, tok = tok0 + row, t = tok & (T_ - 1);
            u32x4_t o = {0u, 0u, 0u, 0u};
            if (ch * 8 < n_lo) {
                const bf16_t* srcp = ch < 32 ? P + (size_t)tok * NPJ + 1536 + ch * 8 : EXp + (size_t)tok * 64 + 32 + (ch - 32) * 8;
                const int rstride = ch < 32 ? NPJ : 64;
                const u32x4_t cu = *(const u32x4_t*)(srcp);
                u32x4_t pv = {0u, 0u, 0u, 0u};
                if (t > 0) pv = *(const u32x4_t*)(srcp - rstride);
                const f32x4_t m0 = *(const f32x4_t*)(mu + 1536 + ch * 8), m1 = *(const f32x4_t*)(mu + 1536 + ch * 8 + 4);
                float v[8];
#pragma unroll
                for (int q = 0; q < 4; ++q) {
                    const float u0 = __uint_as_float(cu[q] << 16), u1 = __uint_as_float(cu[q] & 0xffff0000u), p0 = __uint_as_float(pv[q] << 16), p1 = __uint_as_float(pv[q] & 0xffff0000u);
                    const float ma = q < 2 ? m0[2 * q] : m1[2 * q - 4], mb = q < 2 ? m0[2 * q + 1] : m1[2 * q - 3];
                    v[2 * q] = u0 + (p0 - u0) * ma; v[2 * q + 1] = u1 + (p1 - u1) * mb;
                }
                if (ch < 8) { for (int q = 0; q < 8; ++q) v[q] = ftanh(v[q]); }
                else if (ch >= 16 && ch < 32) { for (int q = 0; q < 8; ++q) v[q] = fsigmoid(v[q]); }
                o.x = pk2(v[0], v[1]); o.y = pk2(v[2], v[3]); o.z = pk2(v[4], v[5]); o.w = pk2(v[6], v[7]);
            }
            *(LAS u32x4_t*)(Xs + row * LDX + ch * 8) = o;
        }
        __syncthreads();
        const int h = F.wave, fr = F.lane & 15, fq = F.lane >> 4;
        const bf16_t* LT = (const bf16_t*)(const GAS bf16_t*)(uintptr_t)LT0;
        pg8::f32x4 acc[4][4];
#define LORA_MMA4(KS0, KS1) do { _Pragma("unroll") for (int nt = 0; nt < 4; ++nt) _Pragma("unroll") for (int mt = 0; mt < 4; ++mt) acc[nt][mt] = (pg8::f32x4){0.f, 0.f, 0.f, 0.f}; \
        _Pragma("unroll") for (int ks = KS0; ks < KS1; ++ks) { bf16x8_t ax[4]; \
            _Pragma("unroll") for (int mt = 0; mt < 4; ++mt) ax[mt] = *(const bf16x8_t*)(LT + (size_t)(h * 64 + mt * 16 + fr) * 288 + ks * 32 + fq * 8); \
            _Pragma("unroll") for (int nt = 0; nt < 4; ++nt) { const bf16x8_t bx = *(const LAS bf16x8_t*)(Xs + (nt * 16 + fr) * LDX + ks * 32 + fq * 8); \
                _Pragma("unroll") for (int mt = 0; mt < 4; ++mt) acc[nt][mt] = __builtin_amdgcn_mfma_f32_16x16x32_bf16(ax[mt], bx, acc[nt][mt], 0, 0, 0); } } } while (0)
#define UNPK(w, e) (((e) & 1) ? __uint_as_float(((e) < 2 ? (w).x : (w).y) & 0xffff0000u) : __uint_as_float(((e) < 2 ? (w).x : (w).y) << 16))
#define SHIFTED(dst, colbase, mt) do { const int c_ = h * 64 + (mt) * 16 + fq * 4; const u32x2_t cu_ = *(const u32x2_t*)(pc + (colbase) + c_); u32x2_t pu_ = {0u, 0u}; \
        if (t > 0) pu_ = *(const u32x2_t*)(pp + (colbase) + c_); const f32x4_t m_ = *(const f32x4_t*)(mu + (colbase) + c_); \
        _Pragma("unroll") for (int e = 0; e < 4; ++e) { const float u_ = UNPK(cu_, e), q_ = UNPK(pu_, e); dst[e] = u_ + (q_ - u_) * m_[e]; } } while (0)
#define NT_VARS const int tok = tok0 + nt * 16 + fr, t = tok & (T_ - 1), b = tok >> 11; const bf16_t* pc = P + (size_t)tok * NPJ; const bf16_t* pp = pc - NPJ; \
        const size_t sb0 = ((((size_t)b * 8 + h) * T_ + t) * 6) * 64 + fq * 4; (void)pc; (void)pp; (void)sb0;
        LORA_MMA4(0, 2);
#pragma unroll
        for (int nt = 0; nt < 4; ++nt) { NT_VARS
#pragma unroll
            for (int mt = 0; mt < 4; ++mt) {
                const int c = h * 64 + mt * 16 + fq * 4; const f32x4_t w0v = *(const f32x4_t*)(w0 + c); float om[4];
#pragma unroll
                for (int e = 0; e < 4; ++e) { const float wraw = w0v[e] + acc[nt][mt][e]; om[e] = 1.0f - fexp(-0.6065306597126334f * fsigmoid(wraw));   }
                u32x2_t o; o.x = pk2(om[0], om[1]); o.y = pk2(om[2], om[3]); *(u32x2_t*)(SC + sb0 + mt * 16 + 1 * 64) = o;
            }
        }
        LORA_MMA4(4, 8);
#pragma unroll
        for (int nt = 0; nt < 4; ++nt) { NT_VARS
#pragma unroll
            for (int mt = 0; mt < 4; ++mt) { const int c = h * 64 + mt * 16 + fq * 4; u32x2_t o; o.x = pk2(acc[nt][mt][0], acc[nt][mt][1]); o.y = pk2(acc[nt][mt][2], acc[nt][mt][3]); *(u32x2_t*)(Gb + (size_t)tok * W_ + c) = o; }
        }
        if (l == 1) LORA_MMA4(8, 9);
#pragma unroll
        for (int nt = 0; nt < 4; ++nt) { NT_VARS
#pragma unroll
            for (int mt = 0; mt < 4; ++mt) {
                const int c = h * 64 + mt * 16 + fq * 4; float v[4]; SHIFTED(v, 1024, mt);
                if (l == 1) {
                    const f32x4_t v0v = *(const f32x4_t*)(v0p + c); const u32x2_t vfr = *(const u32x2_t*)(VF + (size_t)tok * W_ + c);
#pragma unroll
                    for (int e = 0; e < 4; ++e) { const float vf = UNPK(vfr, e); v[e] = v[e] + (vf - v[e]) * fsigmoid(v0v[e] + acc[nt][mt][e]); }
                }
                u32x2_t o; o.x = pk2(v[0], v[1]); o.y = pk2(v[2], v[3]);
                *(u32x2_t*)(SC + sb0 + mt * 16 + 3 * 64) = o;
                *(u32x2_t*)(VPb + (size_t)tok * W_ + c) = o;
                if (l == 0) *(u32x2_t*)(VF + (size_t)tok * W_ + c) = o;
            }
        }
        LORA_MMA4(2, 4);
#pragma unroll
        for (int nt = 0; nt < 4; ++nt) { NT_VARS
            float kn[4][4], ai[4][4]; float ssk = 0.f, bsum = 0.f;
#pragma unroll
            for (int mt = 0; mt < 4; ++mt) {
                const int c = h * 64 + mt * 16 + fq * 4; float r[4], k[4]; SHIFTED(r, 0, mt); SHIFTED(k, 512, mt);
                const f32x4_t a0v = *(const f32x4_t*)(a0 + c), kkv = *(const f32x4_t*)(kkp + c), kav = *(const f32x4_t*)(kap + c), rkv = *(const f32x4_t*)(rkp + c);
                float kh[4];
#pragma unroll
                for (int e = 0; e < 4; ++e) {
                    const float a = fsigmoid(a0v[e] + acc[nt][mt][e]); const float kk = k[e] * kkv[e];
                    ssk += kk * kk; kh[e] = k[e] * (1.f + (a - 1.f) * kav[e]); bsum += r[e] * kh[e] * rkv[e];
                    kn[mt][e] = kk; ai[mt][e] = a;
                }
                { u32x2_t o; o.x = pk2(r[0], r[1]); o.y = pk2(r[2], r[3]); *(u32x2_t*)(SC + sb0 + mt * 16 + 0 * 64) = o; }
                { u32x2_t o; o.x = pk2(kh[0], kh[1]); o.y = pk2(kh[2], kh[3]); *(u32x2_t*)(SC + sb0 + mt * 16 + 2 * 64) = o; }
            }
            ssk += shx(ssk, F.lane, 16); ssk += shx(ssk, F.lane, 32);
            bsum += shx(bsum, F.lane, 16); bsum += shx(bsum, F.lane, 32);
            const float kinv = 1.0f / fmaxf(sqrtf(ssk), 1e-12f);
            if (fq == 0) BON[(size_t)tok * 8 + h] = bsum;
#pragma unroll
            for (int mt = 0; mt < 4; ++mt) {
                float kq[4], bq[4];
#pragma unroll
                for (int e = 0; e < 4; ++e) { kq[e] = kn[mt][e] * kinv; bq[e] = kq[e] * ai[mt][e]; }
                { u32x2_t o; o.x = pk2(kq[0], kq[1]); o.y = pk2(kq[2], kq[3]); *(u32x2_t*)(SC + sb0 + mt * 16 + 4 * 64) = o; }
                { u32x2_t o; o.x = pk2(bq[0], bq[1]); o.y = pk2(bq[2], bq[3]); *(u32x2_t*)(SC + sb0 + mt * 16 + 5 * 64) = o; }
            }
        }
#undef LORA_MMA4
#undef NT_VARS
#undef UNPK
#undef SHIFTED
    }
}

constexpr int SC_STEPS = 32, SC_CHUNK_F = SC_STEPS * 6 * 64;
constexpr int SCAN_YB = 2 * SC_CHUNK_F * 4;
__device__ __forceinline__ float dpp_ror_add(float v, int) { return v; }
#define ROW_ALLREDUCE(v) do { \
    v += __int_as_float(__builtin_amdgcn_update_dpp(0, __float_as_int(v), 0x128, 0xf, 0xf, false)); \
    v += __int_as_float(__builtin_amdgcn_update_dpp(0, __float_as_int(v), 0x124, 0xf, 0xf, false)); \
    v += __int_as_float(__builtin_amdgcn_update_dpp(0, __float_as_int(v), 0x122, 0xf, 0xf, false)); \
    v += __int_as_float(__builtin_amdgcn_update_dpp(0, __float_as_int(v), 0x121, 0xf, 0xf, false)); } while (0)
__device__ __forceinline__ void p_rw_scan(Frame& F) {
    RELAUNDER(F);
    const bf16_t* SC = (const bf16_t*)(F.ws + WS_S + S_SC); float* Y = (float*)((unsigned char*)F.out + O_Y);
    LAS float* ring = (LAS float*)F.lds; LAS float* yring = (LAS float*)(F.lds + SCAN_YB);
    constexpr int NCH = T_ / SC_STEPS;
    for (int unit = F.vcu; unit < B_ * H_ * 4; unit += F.G) {
        const int bh = unit >> 2, qtr = unit & 3;
        const bf16_t* src = SC + (size_t)bh * T_ * 384;
        __syncthreads();
        if (F.wave >= 4) {
            const int lt = F.tid - 256;
            u32x4_t regs[6];
#pragma unroll
            for (int i = 0; i < 6; ++i) regs[i] = *(const u32x4_t*)(src + (size_t)(lt + 256 * i) * 8);
#pragma unroll
            for (int i = 0; i < 6; ++i) {
                LAS f32x4_t* d = (LAS f32x4_t*)(ring + (lt + 256 * i) * 8);
                d[0] = (f32x4_t){__uint_as_float(regs[i].x << 16), __uint_as_float(regs[i].x & 0xffff0000u), __uint_as_float(regs[i].y << 16), __uint_as_float(regs[i].y & 0xffff0000u)};
                d[1] = (f32x4_t){__uint_as_float(regs[i].z << 16), __uint_as_float(regs[i].z & 0xffff0000u), __uint_as_float(regs[i].w << 16), __uint_as_float(regs[i].w & 0xffff0000u)};
            }
#pragma unroll
            for (int i = 0; i < 6; ++i) regs[i] = *(const u32x4_t*)(src + (size_t)SC_CHUNK_F + (size_t)(lt + 256 * i) * 8);
            __syncthreads();
            for (int c = 0; c < NCH; ++c) {
                if (c + 1 < NCH) {
                    LAS float* dst = ring + ((c + 1) & 1) * SC_CHUNK_F;
#pragma unroll
                    for (int i = 0; i < 6; ++i) {
                        LAS f32x4_t* d = (LAS f32x4_t*)(dst + (lt + 256 * i) * 8);
                        d[0] = (f32x4_t){__uint_as_float(regs[i].x << 16), __uint_as_float(regs[i].x & 0xffff0000u), __uint_as_float(regs[i].y << 16), __uint_as_float(regs[i].y & 0xffff0000u)};
                        d[1] = (f32x4_t){__uint_as_float(regs[i].z << 16), __uint_as_float(regs[i].z & 0xffff0000u), __uint_as_float(regs[i].w << 16), __uint_as_float(regs[i].w & 0xffff0000u)};
                    }
                    if (c + 2 < NCH) {
#pragma unroll
                        for (int i = 0; i < 6; ++i) regs[i] = *(const u32x4_t*)(src + (size_t)(c + 2) * SC_CHUNK_F + (size_t)(lt + 256 * i) * 8);
                    }
                }
                if (c > 0) {
                    const int st = lt >> 3, r2 = (lt & 7) * 2;
                    const LAS float* ys = yring + ((c - 1) & 1) * (SC_STEPS * 16) + st * 16 + r2;
                    const size_t tok = (size_t)(bh >> 3) * T_ + (size_t)(c - 1) * SC_STEPS + st;
                    typedef float f32x2_t __attribute__((ext_vector_type(2)));
                    *(f32x2_t*)(Y + tok * W_ + (bh & 7) * 64 + qtr * 16 + r2) = (f32x2_t){ys[0], ys[1]};
                }
                __syncthreads();
            }
            {
                const int c = NCH;
                const int st = lt >> 3, r2 = (lt & 7) * 2;
                const LAS float* ys = yring + ((c - 1) & 1) * (SC_STEPS * 16) + st * 16 + r2;
                const size_t tok = (size_t)(bh >> 3) * T_ + (size_t)(c - 1) * SC_STEPS + st;
                typedef float f32x2_t __attribute__((ext_vector_type(2)));
                *(f32x2_t*)(Y + tok * W_ + (bh & 7) * 64 + qtr * 16 + r2) = (f32x2_t){ys[0], ys[1]};
            }
        } else {
            typedef float f32x2_t __attribute__((ext_vector_type(2)));
            const int rl = F.wave * 4 + (F.lane >> 4);
            const int cl = F.lane & 15, cj = cl * 4;
            const int vch = qtr * 16 + rl;
            f32x2_t Sa = {0.f, 0.f}, Sb = {0.f, 0.f};
            float ykeep = 0.f;
            __syncthreads();
            for (int c = 0; c < NCH; ++c) {
                const LAS float* buf = ring + (c & 1) * SC_CHUNK_F;
                LAS float* yb = yring + (c & 1) * (SC_STEPS * 16);
                f32x4_t nr = *(const LAS f32x4_t*)(buf + 0 * 64 + cj), nom = *(const LAS f32x4_t*)(buf + 1 * 64 + cj), nk = *(const LAS f32x4_t*)(buf + 2 * 64 + cj),
                        nkk = *(const LAS f32x4_t*)(buf + 4 * 64 + cj), nb = *(const LAS f32x4_t*)(buf + 5 * 64 + cj);
                float nv = buf[3 * 64 + vch];
#pragma unroll
                for (int st = 0; st < SC_STEPS; ++st) {
                    const f32x4_t r4 = nr, om4 = nom, k4 = nk, kk4 = nkk, b4 = nb; const float v = nv;
                    if (st + 1 < SC_STEPS) {
                        const LAS float* sp = buf + (st + 1) * 384;
                        nr = *(const LAS f32x4_t*)(sp + 0 * 64 + cj); nom = *(const LAS f32x4_t*)(sp + 1 * 64 + cj); nk = *(const LAS f32x4_t*)(sp + 2 * 64 + cj);
                        nkk = *(const LAS f32x4_t*)(sp + 4 * 64 + cj); nb = *(const LAS f32x4_t*)(sp + 5 * 64 + cj); nv = sp[3 * 64 + vch];
                    }
                    f32x2_t t2 = Sa * (f32x2_t){kk4.x, kk4.y};
                    t2 = Sb * (f32x2_t){kk4.z, kk4.w} + t2;
                    float sa = t2.x + t2.y;
                    ROW_ALLREDUCE(sa);
                    const f32x2_t sa2 = {sa, sa}, v2 = {v, v};
                    Sa = Sa - Sa * (f32x2_t){om4.x, om4.y}; Sb = Sb - Sb * (f32x2_t){om4.z, om4.w};
                    Sa = v2 * (f32x2_t){k4.x, k4.y} + Sa;     Sb = v2 * (f32x2_t){k4.z, k4.w} + Sb;
                    Sa = Sa - sa2 * (f32x2_t){b4.x, b4.y};    Sb = Sb - sa2 * (f32x2_t){b4.z, b4.w};
                    f32x2_t y2 = Sa * (f32x2_t){r4.x, r4.y};
                    y2 = Sb * (f32x2_t){r4.z, r4.w} + y2;
                    float y = y2.x + y2.y;
                    ROW_ALLREDUCE(y);
                    ykeep = (cl == (st & 15)) ? y : ykeep;
                    if ((st & 15) == 15) yb[((st & ~15) + cl) * 16 + rl] = ykeep;
                }
                __syncthreads();
            }
        }
    }
}

__device__ __forceinline__ void p_rw_post(Frame& F, int l) {
    RELAUNDER(F);
    const int gw = F.vcu * NWAVES + F.wave, NGW = F.G * NWAVES;
    const float* Y = (const float*)((const unsigned char*)F.out + O_Y); const bf16_t* VPb = (const bf16_t*)((const unsigned char*)F.out + O_VP); const bf16_t* Gb = (const bf16_t*)((const unsigned char*)F.out + O_G);
    const float* BON = (const float*)(F.ws + WS_S + S_BON); bf16_t* CC = (bf16_t*)(F.ws + WS_S + S_CONCAT);
    const float* lnw = gin(F.in[15]) + l * W_; const float* lnb = gin(F.in[16]) + l * W_;
    for (int tok = gw; tok < NTOK; tok += NGW) {
        const int c = F.lane * 8, h = F.lane >> 3, b = tok >> 11, t = tok & (T_ - 1);
        const f32x4_t y0 = *(const f32x4_t*)(Y + (size_t)tok * W_ + c), y1 = *(const f32x4_t*)(Y + (size_t)tok * W_ + c + 4);
        float s = ((y0.x + y0.y) + (y0.z + y0.w)) + ((y1.x + y1.y) + (y1.z + y1.w));
        s += shx(s, F.lane, 1); s += shx(s, F.lane, 2); s += shx(s, F.lane, 4);
        const float mean = s * (1.f / 64.f);
        const f32x4_t d0 = y0 - mean, d1 = y1 - mean;
        float q = ((d0.x * d0.x + d0.y * d0.y) + (d0.z * d0.z + d0.w * d0.w)) + ((d1.x * d1.x + d1.y * d1.y) + (d1.z * d1.z + d1.w * d1.w));
        q += shx(q, F.lane, 1); q += shx(q, F.lane, 2); q += shx(q, F.lane, 4);
        const float rstd = 1.0f / sqrtf(q * (1.f / 64.f) + 64e-5f);
        const float bon = BON[(size_t)tok * 8 + h];
        const u32x4_t vw = *(const u32x4_t*)(VPb + (size_t)tok * W_ + c);
        const u32x4_t gw4 = *(const u32x4_t*)(Gb + (size_t)tok * W_ + c);
        const f32x4_t w0 = *(const f32x4_t*)(lnw + c), w1 = *(const f32x4_t*)(lnw + c + 4), b0 = *(const f32x4_t*)(lnb + c), b1 = *(const f32x4_t*)(lnb + c + 4);
        float o[8];
#pragma unroll
        for (int e = 0; e < 8; ++e) {
            const float d = e < 4 ? d0[e] : d1[e - 4], lw = e < 4 ? w0[e] : w1[e - 4], lb = e < 4 ? b0[e] : b1[e - 4];
            const unsigned vq = vw[e >> 1], gq = gw4[e >> 1];
            const float v = (e & 1) ? __uint_as_float(vq & 0xffff0000u) : __uint_as_float(vq << 16), g = (e & 1) ? __uint_as_float(gq & 0xffff0000u) : __uint_as_float(gq << 16);
            o[e] = (d * rstd * lw + lb + bon * v) * g;
        }
        u32x4_t ow; ow.x = pk2(o[0], o[1]); ow.y = pk2(o[2], o[3]); ow.z = pk2(o[4], o[5]); ow.w = pk2(o[6], o[7]);
        *(u32x4_t*)(CC + (size_t)tok * D_ + c) = ow;
    }
}

__device__ __forceinline__ void p_route(Frame& F) {
    RELAUNDER(F);
    LAS int* lcnt = (LAS int*)F.lds;
    LAS int* gbase = lcnt + 8;
    LAS int* te = lcnt + 16;
    LAS int* tr = te + 128;
    LAS float* tg = (LAS float*)(tr + 128);
    const bf16_t* XBp = (const bf16_t*)(F.ws + WS_XB); const float* ssq = (const float*)(F.ws + WS_SSQ);
    const float* gn = gin(F.in[31]) + D_; const float* wr = gin(F.in[35]);
    int* CNT = (int*)(F.ws + WS_CTL + CTL_CNT);
    int* INV = (int*)(F.ws + WS_MT + MT_INV); float* TOKG = (float*)(F.ws + WS_MT + MT_TOKG);
    for (int chunk = F.vcu; chunk < NTOK / 64; chunk += F.G) {
        if (F.tid < 8) lcnt[F.tid] = 0;
        __syncthreads();
        for (int i = 0; i < 8; ++i) {
            const int tokl = F.wave * 8 + i, tok = chunk * 64 + tokl;
            float acc[8];
#pragma unroll
            for (int e = 0; e < 8; ++e) acc[e] = 0.f;
#pragma unroll
            for (int j = 0; j < 4; ++j) {
                const int k0 = F.lane * 4 + 256 * j;
                const u32x2_t xw = *(const u32x2_t*)(XBp + (size_t)tok * D_ + k0); const f32x4_t gv = *(const f32x4_t*)(gn + k0);
                const f32x4_t xv = {__uint_as_float(xw.x << 16), __uint_as_float(xw.x & 0xffff0000u), __uint_as_float(xw.y << 16), __uint_as_float(xw.y & 0xffff0000u)};
#pragma unroll
                for (int q = 0; q < 4; ++q) {
                    const float hv = xv[q] * gv[q];
                    const f32x4_t w0 = *(const f32x4_t*)(wr + (size_t)(k0 + q) * 8), w1 = *(const f32x4_t*)(wr + (size_t)(k0 + q) * 8 + 4);
                    acc[0] += hv * w0[0]; acc[1] += hv * w0[1]; acc[2] += hv * w0[2]; acc[3] += hv * w0[3];
                    acc[4] += hv * w1[0]; acc[5] += hv * w1[1]; acc[6] += hv * w1[2]; acc[7] += hv * w1[3];
                }
            }
            const float rinv = pg8::row_rinv(ssq, tok);
#pragma unroll
            for (int e = 0; e < 8; ++e) acc[e] = wave_sum_l(acc[e], F.lane) * rinv;
            int e0 = 0; float v0 = acc[0];
#pragma unroll
            for (int e = 1; e < 8; ++e) if (acc[e] > v0) { v0 = acc[e]; e0 = e; }
            int e1 = -1; float v1 = 0.f;
#pragma unroll
            for (int e = 0; e < 8; ++e) if (e != e0 && (e1 < 0 || acc[e] > v1)) { v1 = acc[e]; e1 = e; }
            if (F.lane == 0) {
                const float p1 = __expf(v1 - v0), inv = 1.f / (1.f + p1);
                te[tokl * 2] = e0; te[tokl * 2 + 1] = e1; tg[tokl * 2] = inv; tg[tokl * 2 + 1] = p1 * inv;
                tr[tokl * 2] = __hip_atomic_fetch_add(lcnt + e0, 1, __ATOMIC_RELAXED, __HIP_MEMORY_SCOPE_WORKGROUP);
                tr[tokl * 2 + 1] = __hip_atomic_fetch_add(lcnt + e1, 1, __ATOMIC_RELAXED, __HIP_MEMORY_SCOPE_WORKGROUP);
            }
        }
        __syncthreads();
        if (F.tid < 8) gbase[F.tid] = atomicAdd(CNT + F.tid, lcnt[F.tid]);
        __syncthreads();
        if (F.tid < 128) {
            const int e = te[F.tid], idx = gbase[e] + tr[F.tid], t2 = chunk * 128 + F.tid;
            TOKG[t2] = tg[F.tid]; INV[(size_t)e * NTOK + idx] = t2;
        }
        __syncthreads();
    }
}
__device__ __forceinline__ ConvJob conv_job_exp(const Frame& F, int j) {
    const int e = j / 3, k = j % 3; ConvJob c; c.coff = 0; c.fp8 = 1;
    if (k < 2) { c.W = (k == 0 ? gin(F.in[36]) : gin(F.in[37])) + (size_t)e * D_ * EFF; c.ldw = EFF; c.nvalid = EFF; c.npad = EFF; c.K = 1024; c.g = gin(F.in[31]) + D_; c.rowmode = 1 + k;
                 c.dst = (bf16_t*)(F.ws + WS_WE + (size_t)e * 7168 * 1024); }
    else { c.W = gin(F.in[38]) + (size_t)e * EFF * D_; c.ldw = D_; c.nvalid = D_; c.npad = D_; c.K = EFF; c.g = nullptr; c.rowmode = 0; c.dst = (bf16_t*)(F.ws + WS_WE + WE_D + (size_t)e * 1024 * EFF); }
    return c;
}
__device__ __forceinline__ void p_moe_prep(Frame& F) {
    RELAUNDER(F);
    LAS int* tb = (LAS int*)F.lds;
    LAS int* cn = tb + 16;
    const int* CNT = (const int*)(F.ws + WS_CTL + CTL_CNT);
    int* TILE = (int*)(F.ws + WS_MT + MT_TILE);
    if (F.tid == 0) { int acc = 0; for (int e = 0; e < 8; ++e) { const int c = CNT[e]; cn[e] = c; tb[e] = acc; acc += (c + 255) >> 8; } tb[8] = acc; }
    __syncthreads();
    const int MT = tb[8];
    if (F.vcu == 0) {
        if (F.tid == 0) TILE[0] = MT;
        if (F.tid < 9) TILE[16 + F.tid] = tb[F.tid];
        for (int pm = F.tid; pm < MT; pm += NWAVES * 64) { int e = 0; for (int q = 1; q < 8; ++q) if (pm >= tb[q]) e = q; TILE[64 + pm] = e; }
    }
    const int gw = F.vcu * NWAVES + F.wave, NGW = F.G * NWAVES;
    const bf16_t* XBp = (const bf16_t*)(F.ws + WS_XB); const float* ssq = (const float*)(F.ws + WS_SSQ);
    const int* INV = (const int*)(F.ws + WS_MT + MT_INV); const float* TOKG = (const float*)(F.ws + WS_MT + MT_TOKG);
    int* ROWINFO = (int*)(F.ws + WS_MT + MT_ROWINFO); float* ROWG = (float*)(F.ws + WS_MT + MT_ROWG); int* ROWOF = (int*)(F.ws + WS_MT + MT_ROWOF);
    bf16_t* XG = (bf16_t*)(F.ws + WS_XG);
    const int NR = MT * 256; constexpr int GB = 8;
    for (int row0 = gw; row0 < NR; row0 += GB * NGW) {
        int t2[GB]; bool val[GB];
#pragma unroll
        for (int r = 0; r < GB; ++r) {
            const int row = row0 + r * NGW, rc = row < NR ? row : NR - 1, pm = rc >> 8; int e = 0;
            for (int q = 1; q < 8; ++q) if (pm >= tb[q]) e = q;
            const int idx = (pm - tb[e]) * 256 + (rc & 255);
            val[r] = row < NR && idx < cn[e];
            t2[r] = INV[(size_t)e * NTOK + (val[r] ? idx : 0)];
        }
        u32x2_t xw[GB][4]; float rinv[GB], tg[GB];
#pragma unroll
        for (int r = 0; r < GB; ++r) {
            const int tt = val[r] ? t2[r] : 0, tok = tt >> 1;
            rinv[r] = pg8::row_rinv(ssq, tok) * F8S_X; tg[r] = TOKG[tt];
            const GAS u32x2_t* xr = (const GAS u32x2_t*)(XBp + (size_t)tok * D_) + F.lane;
#pragma unroll
            for (int j = 0; j < 4; ++j) xw[r][j] = xr[64 * j];
        }
#pragma unroll
        for (int r = 0; r < GB; ++r) {
            const int row = row0 + r * NGW;
            if (row < NR) {
                GAS unsigned* o4 = (GAS unsigned*)((unsigned char*)XG + (size_t)row * D_) + F.lane;
#pragma unroll
                for (int j = 0; j < 4; ++j) {
                    const float v0 = __uint_as_float(xw[r][j].x << 16) * rinv[r], v1 = __uint_as_float(xw[r][j].x & 0xffff0000u) * rinv[r], v2 = __uint_as_float(xw[r][j].y << 16) * rinv[r], v3 = __uint_as_float(xw[r][j].y & 0xffff0000u) * rinv[r];
                    o4[64 * j] = val[r] ? pk4_fp8(v0, v1, v2, v3) : 0u; }
                if (F.lane == 0) { ROWINFO[row] = val[r] ? t2[r] : -1; ROWG[row] = val[r] ? tg[r] : 0.f; if (val[r]) ROWOF[t2[r]] = row; }
            }
        }
    }
}
__device__ __forceinline__ void p_moe_conv(Frame& F) {
    RELAUNDER(F);
    const int gw = F.vcu * NWAVES + F.wave, NGW = F.G * NWAVES;
    LAS float* scr = (LAS float*)(F.lds + RING_OFF + 1024 + F.wave * 16384);
    constexpr int IPJ = 896, TOT = 24 * IPJ;
    static_assert((1024 / 64) * (EFF / 64) == IPJ && (EFF / 64) * (1024 / 64) == IPJ, "super-items per expert matrix");
#define EXP_JOB(gi) const int j_ = (gi) / IPJ, s_ = (gi) - j_ * IPJ; const ConvJob c_ = conv_job_exp(F, j_); const int nb64_ = c_.npad / 64;
#define EXP_LOAD(R, gi, h) do { EXP_JOB(gi) conv_load64(R, c_.W, c_.ldw, c_.g, nb64_, s_, h, F.lane); } while (0)
    {
        LAS unsigned char* img = (LAS unsigned char*)scr;
        ConvRegs A, B;
        if (gw < TOT) { EXP_LOAD(A, gw, 0); EXP_LOAD(B, gw, 1); }
#pragma nounroll
        for (int gi = gw; gi < TOT; gi += NGW) {
            { ConvRegs C = A; if (gi + NGW < TOT) EXP_LOAD(A, gi + NGW, 0); conv_units64(C, img, 0, F.lane); }
            { ConvRegs C = B; if (gi + NGW < TOT) EXP_LOAD(B, gi + NGW, 1); conv_units64(C, img, 1, F.lane); }
            { EXP_JOB(gi) conv_flush64(img, (unsigned char*)c_.dst, c_.K, nb64_, c_.rowmode, s_, F.lane); }
        }
    }
#undef EXP_JOB
#undef EXP_LOAD
}
__device__ __forceinline__ void p_moe_gemm1(Frame& F) {
    RELAUNDER(F);
    const int* TILE = (const int*)(F.ws + WS_MT + MT_TILE);
    int nMp = __builtin_amdgcn_readfirstlane(TILE[0]); nMp = nMp < 0 ? 0 : (nMp > 136 ? 136 : nMp);
    pg8::Gemm g{(const bf16_t*)(F.ws + WS_XG), (const bf16_t*)(F.ws + WS_WE), nMp * 256, 7168, 512, (size_t)7168 * 1024};
    pg8::MoeOrder S; S.init(nMp, 28, F.G, (int)blockIdx.x, 0, TILE + 64);
    pg8::EpiSwiGLU8 E{(unsigned char*)(F.ws + WS_ACTM), EFF, F8S_ACT};
    pg8::gemm_phase<pg8::EpiSwiGLU8, pg8::MoeOrder, true, true, true>(F.lds + RING_OFF, g, S, E, F.tid, F8C_X, F8C_W);
}
__device__ __forceinline__ void p_moe_gemm2(Frame& F) {
    RELAUNDER(F);
    const int* TILE = (const int*)(F.ws + WS_MT + MT_TILE);
    const int MT = __builtin_amdgcn_readfirstlane(TILE[0]); int nMp = MT < 0 ? 0 : (MT > 2 * MOE_PASS_TILES ? 2 * MOE_PASS_TILES : MT);
    pg8::Gemm g{(const bf16_t*)(F.ws + WS_ACTM), (const bf16_t*)(F.ws + WS_WE + WE_D), nMp * 256, 1024, EFF / 2, (size_t)1024 * EFF};
    pg8::MoeOrder S; S.init(nMp, 4, F.G, (int)blockIdx.x, 0, TILE + 64);
    pg8::EpiMoeDown E{(bf16_t*)F.out, (const int*)(F.ws + WS_MT + MT_ROWINFO), (const float*)(F.ws + WS_MT + MT_ROWG)};
    pg8::gemm_phase<pg8::EpiMoeDown, pg8::MoeOrder, true, true, true>(F.lds + RING_OFF, g, S, E, F.tid, F8C_ACT, F8C_W);
}
__device__ __forceinline__ void p_moe_gemm2_split(Frame& F) {
    RELAUNDER(F);
    const int* TILE = (const int*)(F.ws + WS_MT + MT_TILE);
    const int MT = __builtin_amdgcn_readfirstlane(TILE[0]), pm_lo = 2 * MOE_PASS_TILES; int nMp = MT - pm_lo; nMp = nMp < 0 ? 0 : (nMp > 8 ? 8 : nMp);
    pg8::Gemm g{(const bf16_t*)(F.ws + WS_ACTM + (size_t)pm_lo * 256 * EFF), (const bf16_t*)(F.ws + WS_WE + WE_D), nMp * 256, 1024, EFF / 2, (size_t)1024 * EFF};
    pg8::MoeSplitOrder S; S.init(nMp, F.G, (int)blockIdx.x, pm_lo, TILE + 64, MOE_NS, MOE_KS / 2);
    pg8::EpiSplitF32 E{(float*)(F.ws + WS_XG), (const int*)(F.ws + WS_MT + MT_ROWINFO) + pm_lo * 256, nMp * 256};
    pg8::gemm_phase<pg8::EpiSplitF32, pg8::MoeSplitOrder, true, true, true>(F.lds + RING_OFF, g, S, E, F.tid, F8C_ACT, F8C_W);
}
__device__ __forceinline__ void p_final(Frame& F, bool moe) {
    RELAUNDER(F);
    const int gw = F.vcu * NWAVES + F.wave, NGW = F.G * NWAVES;
    const bf16_t* XBp = (const bf16_t*)(F.ws + WS_XB); const float* gn = gin(F.in[39]);
    const float dscale = 1.0f + *(const float*)(F.ws + WS_CTL + 640 * 1024);
    const int* ROWOF = (const int*)(F.ws + WS_MT + MT_ROWOF); const float* ROWG = (const float*)(F.ws + WS_MT + MT_ROWG); const float* PART = (const float*)(F.ws + WS_XG);
    int nr2 = __builtin_amdgcn_readfirstlane(*(const int*)(F.ws + WS_MT + MT_TILE)) - 2 * MOE_PASS_TILES; nr2 = (nr2 < 0 ? 0 : (nr2 > 8 ? 8 : nr2)) * 256;
    for (int tok = gw; tok < NTOK; tok += NGW) {
        f32x4_t s[4]; float q = 0.f;
        int rs[2] = {0, 0}; float gs[2] = {0.f, 0.f};
        if (moe) {
#pragma unroll
            for (int k = 0; k < 2; ++k) { rs[k] = __builtin_amdgcn_readfirstlane(ROWOF[tok * 2 + k]) - 2 * MOE_PASS_TILES * 256; if (rs[k] >= 0) gs[k] = ROWG[rs[k] + 2 * MOE_PASS_TILES * 256]; }
        }
        u32x2_t xw[4];
#pragma unroll
        for (int j = 0; j < 4; ++j) xw[j] = *(const u32x2_t*)(XBp + (size_t)tok * D_ + F.lane * 4 + 256 * j);
        if (!moe || (rs[0] & rs[1]) < 0) {
            u32x2_t ya[4], yb[4];
            if (moe) {
#pragma unroll
                for (int j = 0; j < 4; ++j) { const int col = F.lane * 4 + 256 * j; ya[j] = *(const u32x2_t*)((const bf16_t*)F.out + (size_t)tok * 2048 + col); yb[j] = *(const u32x2_t*)((const bf16_t*)F.out + (size_t)tok * 2048 + 1024 + col); }
            }
#pragma unroll
            for (int j = 0; j < 4; ++j) {
                f32x4_t v = {__uint_as_float(xw[j].x << 16), __uint_as_float(xw[j].x & 0xffff0000u), __uint_as_float(xw[j].y << 16), __uint_as_float(xw[j].y & 0xffff0000u)};
                if (moe) {
                    v.x += __uint_as_float(ya[j].x << 16) + __uint_as_float(yb[j].x << 16); v.y += __uint_as_float(ya[j].x & 0xffff0000u) + __uint_as_float(yb[j].x & 0xffff0000u);
                    v.z += __uint_as_float(ya[j].y << 16) + __uint_as_float(yb[j].y << 16); v.w += __uint_as_float(ya[j].y & 0xffff0000u) + __uint_as_float(yb[j].y & 0xffff0000u);
                }
                s[j] = v; q += (v.x * v.x + v.y * v.y) + (v.z * v.z + v.w * v.w);
            }
        } else {
#pragma unroll
            for (int j = 0; j < 4; ++j) {
                const int col = F.lane * 4 + 256 * j;
                f32x4_t v = {__uint_as_float(xw[j].x << 16), __uint_as_float(xw[j].x & 0xffff0000u), __uint_as_float(xw[j].y << 16), __uint_as_float(xw[j].y & 0xffff0000u)};
#pragma unroll
                for (int k = 0; k < 2; ++k) {
                    if (rs[k] < 0) {
                        const u32x2_t a = *(const u32x2_t*)((const bf16_t*)F.out + (size_t)tok * 2048 + k * 1024 + col);
                        v.x += __uint_as_float(a.x << 16); v.y += __uint_as_float(a.x & 0xffff0000u); v.z += __uint_as_float(a.y << 16); v.w += __uint_as_float(a.y & 0xffff0000u);
                    } else {
                        f32x4_t p = *(const f32x4_t*)(PART + (size_t)rs[k] * 1024 + col);
#pragma unroll
                        for (int sl = 1; sl < MOE_NS; ++sl) p += *(const f32x4_t*)(PART + ((size_t)sl * nr2 + rs[k]) * 1024 + col);
                        v += p * gs[k];
                    }
                }
                s[j] = v; q += (v.x * v.x + v.y * v.y) + (v.z * v.z + v.w * v.w);
            }
        }
        q = wave_sum_l(q, F.lane);
        const float rinv = 1.0f / sqrtf(q * (1.0f / 1024.0f) + 1e-6f);
#pragma unroll
        for (int j = 0; j < 4; ++j) {
            const int col = F.lane * 4 + 256 * j;
            const f32x4_t gv = *(const f32x4_t*)(gn + col);
            *(f32x4_t*)(F.out + (size_t)tok * D_ + col) = s[j] * rinv * gv * dscale;
        }
    }
}


constexpr size_t S_KCB = S_BON + 512 * 1024;
constexpr size_t S_VCB = S_KCB + 256 * 1024;
static_assert(S_VCB + 256 * 1024 <= S_END, "scratch map");
namespace nsa {
typedef short bf16x8 __attribute__((ext_vector_type(8)));
typedef short s16x4 __attribute__((ext_vector_type(4)));
typedef float f32x16 __attribute__((ext_vector_type(16)));
typedef float f32x4 __attribute__((ext_vector_type(4)));
constexpr float LOG2E = 1.4426950408889634f;
__device__ __forceinline__ int crow(int r, int hi) { return (r & 3) + 8 * (r >> 2) + 4 * hi; }
typedef float f32x2_t __attribute__((ext_vector_type(2))); typedef __bf16 bf16x2_t __attribute__((ext_vector_type(2)));
__device__ __forceinline__ unsigned cvtpk(float lo, float hi) { f32x2_t v = {lo, hi}; bf16x2_t b = __builtin_convertvector(v, bf16x2_t); return __builtin_bit_cast(unsigned, b); }
constexpr int L_KB = 0, L_VB = 16384, L_WSF = 32768, L_IMPQ = 36864, L_IMPL = L_IMPQ + 4 * 64 * 33 * 4, L_IMPF = L_IMPL + 4 * 64 * 33 * 4, L_SELM = L_IMPF + 64 * 36 * 4, L_MISC = L_SELM + 256, L_LIST = L_MISC + 16, L_END = L_LIST + 64 * 4;
static_assert(L_END <= 131072, "NSA LDS map");

__device__ __forceinline__ void qkt(f32x16& p0, f32x16& p1, const LAS unsigned char* Kslot, const bf16x8* qr, int r32, int hi) {
    const LAS unsigned char* kb = Kslot + hi * 1024 + r32 * 16;
    p0 = (f32x16){}; p1 = (f32x16){};
#pragma unroll
    for (int d0 = 0; d0 < 4; ++d0) {
        const bf16x8 b0 = *(const LAS bf16x8*)(kb + d0 * 2048);
        const bf16x8 b1 = *(const LAS bf16x8*)(kb + d0 * 2048 + 512);
        p0 = __builtin_amdgcn_mfma_f32_32x32x16_bf16(b0, qr[d0], p0, 0, 0, 0);
        p1 = __builtin_amdgcn_mfma_f32_32x32x16_bf16(b1, qr[d0], p1, 0, 0, 0);
    }
}
__device__ __forceinline__ void qkt_a(f32x16& p0, f32x16& p1, const LAS unsigned char* Kslot, const bf16x8* qr, int r32, int hi, const bf16x8& ka0, const bf16x8& ka1, const bf16x8& qa) {
    const LAS unsigned char* kb = Kslot + hi * 1024 + r32 * 16;
    p0 = __builtin_amdgcn_mfma_f32_32x32x16_bf16(ka0, qa, (f32x16){}, 0, 0, 0);
    p1 = __builtin_amdgcn_mfma_f32_32x32x16_bf16(ka1, qa, (f32x16){}, 0, 0, 0);
#pragma unroll
    for (int d0 = 0; d0 < 4; ++d0) {
        const bf16x8 b0 = *(const LAS bf16x8*)(kb + d0 * 2048);
        const bf16x8 b1 = *(const LAS bf16x8*)(kb + d0 * 2048 + 512);
        p0 = __builtin_amdgcn_mfma_f32_32x32x16_bf16(b0, qr[d0], p0, 0, 0, 0);
        p1 = __builtin_amdgcn_mfma_f32_32x32x16_bf16(b1, qr[d0], p1, 0, 0, 0);
    }
}
__device__ __forceinline__ void qkt_c(f32x16& p0, f32x16& p1, const LAS unsigned char* Kslot, const bf16x8* qr, int r32, int hi, const f32x16& c0, const f32x16& c1) {
    const LAS unsigned char* kb = Kslot + hi * 1024 + r32 * 16;
    {
        const bf16x8 b0 = *(const LAS bf16x8*)(kb), b1 = *(const LAS bf16x8*)(kb + 512);
        p0 = __builtin_amdgcn_mfma_f32_32x32x16_bf16(b0, qr[0], c0, 0, 0, 0);
        p1 = __builtin_amdgcn_mfma_f32_32x32x16_bf16(b1, qr[0], c1, 0, 0, 0);
    }
#pragma unroll
    for (int d0 = 1; d0 < 4; ++d0) {
        const bf16x8 b0 = *(const LAS bf16x8*)(kb + d0 * 2048);
        const bf16x8 b1 = *(const LAS bf16x8*)(kb + d0 * 2048 + 512);
        p0 = __builtin_amdgcn_mfma_f32_32x32x16_bf16(b0, qr[d0], p0, 0, 0, 0);
        p1 = __builtin_amdgcn_mfma_f32_32x32x16_bf16(b1, qr[d0], p1, 0, 0, 0);
    }
}
__device__ __forceinline__ float max3f(float a, float b, float c) { float r; asm("v_max3_f32 %0, %1, %2, %3" : "=v"(r) : "v"(a), "v"(b), "v"(c)); return r; }
__device__ __forceinline__ void pv(f32x16* o, int vb, bf16x8 pa0, bf16x8 pa1, bf16x8 pa2, bf16x8 pa3) {
#pragma unroll
    for (int d0 = 0; d0 < 2; ++d0) {
        s16x4 lo[4], hi[4];
#pragma unroll
        for (int ks = 0; ks < 4; ++ks) {
            asm volatile("ds_read_b64_tr_b16 %0,%1 offset:%c2" : "=&v"(lo[ks]) : "v"(vb), "i"(d0 * 4096 + ks * 1024) : "memory");
            asm volatile("ds_read_b64_tr_b16 %0,%1 offset:%c2" : "=&v"(hi[ks]) : "v"(vb), "i"(d0 * 4096 + ks * 1024 + 512) : "memory");
        }
        asm volatile("s_waitcnt lgkmcnt(0)" ::: "memory"); __builtin_amdgcn_sched_barrier(0);
#define NSA_PK(k) (bf16x8){lo[k][0], lo[k][1], lo[k][2], lo[k][3], hi[k][0], hi[k][1], hi[k][2], hi[k][3]}
        o[d0] = __builtin_amdgcn_mfma_f32_32x32x16_bf16(pa0, NSA_PK(0), o[d0], 0, 0, 0);
        o[d0] = __builtin_amdgcn_mfma_f32_32x32x16_bf16(pa1, NSA_PK(1), o[d0], 0, 0, 0);
        o[d0] = __builtin_amdgcn_mfma_f32_32x32x16_bf16(pa2, NSA_PK(2), o[d0], 0, 0, 0);
        o[d0] = __builtin_amdgcn_mfma_f32_32x32x16_bf16(pa3, NSA_PK(3), o[d0], 0, 0, 0);
#undef NSA_PK
    }
}
__device__ __forceinline__ float swap_max(float m) { auto rr = __builtin_amdgcn_permlane32_swap(__float_as_uint(m), __float_as_uint(m), false, false); return fmaxf(__uint_as_float(rr[0]), __uint_as_float(rr[1])); }
__device__ __forceinline__ float swap_sum(float m) { auto rr = __builtin_amdgcn_permlane32_swap(__float_as_uint(m), __float_as_uint(m), false, false); return __uint_as_float(rr[0]) + __uint_as_float(rr[1]); }
__device__ __forceinline__ void pack_p(const f32x16& p0, const f32x16& p1, bf16x8& a0, bf16x8& a1, bf16x8& a2, bf16x8& a3) {
    u32x4_t w0, w1, w2, w3;
    w0.x = cvtpk(p0[0], p0[1]); w0.y = cvtpk(p0[2], p0[3]); w0.z = cvtpk(p0[4], p0[5]); w0.w = cvtpk(p0[6], p0[7]);
    w1.x = cvtpk(p0[8], p0[9]); w1.y = cvtpk(p0[10], p0[11]); w1.z = cvtpk(p0[12], p0[13]); w1.w = cvtpk(p0[14], p0[15]);
    w2.x = cvtpk(p1[0], p1[1]); w2.y = cvtpk(p1[2], p1[3]); w2.z = cvtpk(p1[4], p1[5]); w2.w = cvtpk(p1[6], p1[7]);
    w3.x = cvtpk(p1[8], p1[9]); w3.y = cvtpk(p1[10], p1[11]); w3.z = cvtpk(p1[12], p1[13]); w3.w = cvtpk(p1[14], p1[15]);
    a0 = __builtin_bit_cast(bf16x8, w0); a1 = __builtin_bit_cast(bf16x8, w1); a2 = __builtin_bit_cast(bf16x8, w2); a3 = __builtin_bit_cast(bf16x8, w3);
}
__device__ __forceinline__ void scale_o(f32x16* o, float fac, LAS float* wsf, int r32, int hi) {
    if (hi == 0) wsf[r32] = fac;
    asm volatile("s_waitcnt lgkmcnt(0)" ::: "memory");
#pragma unroll
    for (int r = 0; r < 16; ++r) { const float f = wsf[crow(r, hi)]; o[0][r] *= f; o[1][r] *= f; }
}
__device__ __forceinline__ void psum(f32x16& ol, bf16x8 pa0, bf16x8 pa1, bf16x8 pa2, bf16x8 pa3) {
    const bf16x8 one = {(short)0x3f80, (short)0x3f80, (short)0x3f80, (short)0x3f80, (short)0x3f80, (short)0x3f80, (short)0x3f80, (short)0x3f80};
    ol = __builtin_amdgcn_mfma_f32_32x32x16_bf16(pa0, one, ol, 0, 0, 0);
    ol = __builtin_amdgcn_mfma_f32_32x32x16_bf16(pa1, one, ol, 0, 0, 0);
    ol = __builtin_amdgcn_mfma_f32_32x32x16_bf16(pa2, one, ol, 0, 0, 0);
    ol = __builtin_amdgcn_mfma_f32_32x32x16_bf16(pa3, one, ol, 0, 0, 0);
}
__device__ __forceinline__ void scale_ol(f32x16* o, f32x16& ol, float fac, LAS float* wsf, int r32, int hi) {
    if (hi == 0) wsf[r32] = fac;
    asm volatile("s_waitcnt lgkmcnt(0)" ::: "memory");
#pragma unroll
    for (int r = 0; r < 16; ++r) { const float f = wsf[crow(r, hi)]; o[0][r] *= f; o[1][r] *= f; ol[r] *= f; }
}
__device__ __forceinline__ void axpy_ol(f32x16* out, const f32x16* o, const f32x16& ol, float gate, LAS float* wsf, int r32, int hi) {
    if (hi == 0) wsf[32 + r32] = gate;
    asm volatile("s_waitcnt lgkmcnt(0)" ::: "memory");
#pragma unroll
    for (int r = 0; r < 16; ++r) { const float f = wsf[32 + crow(r, hi)] * __builtin_amdgcn_rcpf(fmaxf(ol[r], 1e-30f)); out[0][r] += f * o[0][r]; out[1][r] += f * o[1][r]; }
}
__device__ __forceinline__ void axpy_o(f32x16* out, const f32x16* o, float fac, LAS float* wsf, int r32, int hi) {
    if (hi == 0) wsf[32 + r32] = fac;
    asm volatile("s_waitcnt lgkmcnt(0)" ::: "memory");
#pragma unroll
    for (int r = 0; r < 16; ++r) { const float f = wsf[32 + crow(r, hi)]; out[0][r] += f * o[0][r]; out[1][r] += f * o[1][r]; }
}
}

__device__ __forceinline__ void p_nsa_cmp(Frame& F, int l, int first, int cnt) {
    RELAUNDER(F);
    const int n_rw = 1792;
    const bf16_t* P = (const bf16_t*)(F.ws + WS_S + S_PROJ);
    LAS bf16_t* Hs = (LAS bf16_t*)F.lds;
    const int w = F.wave, fr = F.lane & 15, fq = F.lane >> 4;
    for (int item = first; item < first + cnt; ++item) {
        const int kv = item >> 7, b = (item >> 4) & 7, g = (item >> 3) & 1, ch = item & 7;
        const int colbase = n_rw + 512 + kv * 128 + g * 64;
        const bf16_t* W1T = (const bf16_t*)(F.ws + WS_WB + WB_CW1) + (size_t)(l * 2 + kv) * 128 * 2048;
        const bf16_t* W2T = (const bf16_t*)(F.ws + WS_WB + WB_CW2) + (size_t)(l * 2 + kv) * 64 * 128;
        const float* cb = (const float*)(F.ws + WS_WB + WB_CB) + (l * 2 + kv) * 128;
        constexpr int APITCH = 4112;
        LAS unsigned char* As = F.lds + 8192;
        __syncthreads();
#pragma unroll
        for (int pc = 0; pc < 8; ++pc) {
            const int row = 2 * w + (pc >> 2), q = pc & 3, n_ = ch * 16 + row, nc_ = n_ < NCMP ? n_ : NCMP - 1;
            const bf16_t* src = P + ((size_t)b * T_ + 16 * nc_ + q * 8 + (F.lane >> 3)) * NPJ + colbase + (F.lane & 7) * 8;
            __builtin_amdgcn_global_load_lds((const unsigned*)(const GAS unsigned*)(uintptr_t)src, (LAS unsigned*)(As + row * APITCH + q * 1024), 16, 0, 0);
        }
        const bf16_t* brow = W1T + (size_t)(16 * w + fr) * 2048;
        pg8::f32x4 acc = {0.f, 0.f, 0.f, 0.f};
        asm volatile("s_waitcnt vmcnt(0)" ::: "memory");
        __syncthreads();
#pragma unroll 16
        for (int ks = 0; ks < 64; ++ks) {
            const int k0 = ks * 32 + fq * 8;
            const nsa::bf16x8 a = *(const LAS nsa::bf16x8*)(As + fr * APITCH + k0 * 2);
            const nsa::bf16x8 bw = *(const nsa::bf16x8*)(brow + k0);
            acc = __builtin_amdgcn_mfma_f32_16x16x32_bf16(a, bw, acc, 0, 0, 0);
        }
        __syncthreads();
        const float bias = cb[16 * w + fr];
#pragma unroll
        for (int r = 0; r < 4; ++r) {
            const float x = acc[r] + bias;
            const float ge = x * fsigmoid(1.5957691216057308f * (x + 0.044715f * x * x * x));
            Hs[(4 * fq + r) * 136 + 16 * w + fr] = (bf16_t)f2bf(ge);
        }
        __syncthreads();
        if (w < 4) {
            pg8::f32x4 acc2 = {0.f, 0.f, 0.f, 0.f};
#pragma unroll
            for (int ks = 0; ks < 4; ++ks) {
                const nsa::bf16x8 a = *(const LAS nsa::bf16x8*)(Hs + fr * 136 + ks * 32 + fq * 8);
                const nsa::bf16x8 bw = *(const nsa::bf16x8*)(W2T + (size_t)(16 * w + fr) * 128 + ks * 32 + fq * 8);
                acc2 = __builtin_amdgcn_mfma_f32_16x16x32_bf16(a, bw, acc2, 0, 0, 0);
            }
            bf16_t* dst = (bf16_t*)(F.ws + WS_S + (kv == 0 ? S_KCB : S_VCB)) + ((size_t)(b * 2 + g) * 128) * 64;
#pragma unroll
            for (int r = 0; r < 4; ++r) { const int nn = ch * 16 + 4 * fq + r; dst[(size_t)nn * 64 + 16 * w + fr] = (bf16_t)f2bf(nn < NCMP ? acc2[r] : 0.f); }
        }
    }
}

template <int DBG = 0> __device__ __forceinline__ void nsa_item(Frame& F, const bf16_t* P, int n_rw, int b, int g, int c) {
    using namespace nsa;
    int tidl = F.tid; asm volatile("" : "+v"(tidl));
    const int lanel = tidl & 63;
    const int w = __builtin_amdgcn_readfirstlane(tidl >> 6), rh = w >> 1, th = w & 1, r32 = lanel & 31, hi = lanel >> 5;
    const int t0 = c * 64, tq = t0 + th * 32 + r32;
    const int hq = g * 4 + rh;
    const float slope2 = exp2f(-(float)(hq + 1)) * LOG2E;
    const size_t tokrow = (size_t)b * T_ + tq;
    LAS unsigned char* L = F.lds;
    LAS float* wsf = (LAS float*)(L + L_WSF) + w * 64;
    LAS float* IMPQ = (LAS float*)(L + L_IMPQ); LAS float* IMPL = (LAS float*)(L + L_IMPL); LAS float* IMPF = (LAS float*)(L + L_IMPF);
    LAS unsigned* SELM = (LAS unsigned*)(L + L_SELM); LAS int* MISCL = (LAS int*)(L + L_MISC); LAS int* LIST = (LAS int*)(L + L_LIST);
    const unsigned lds0 = (unsigned)(uintptr_t)L;
    const int vboff = ((lanel >> 4) & 1) * 32 + (lanel & 3) * 8 + (4 * hi + ((lanel & 15) >> 2)) * 64;
    bf16x8 qr[4];
    {
        const bf16_t* qp = P + tokrow * NPJ + n_rw + g * 256 + rh * 64 + hi * 8;
#pragma unroll
        for (int d0 = 0; d0 < 4; ++d0) {
            const u32x4_t raw = *(const u32x4_t*)(qp + d0 * 16); u32x4_t sc;
#pragma unroll
            for (int e = 0; e < 4; ++e) sc[e] = cvtpk(__uint_as_float(raw[e] << 16) * (0.125f * LOG2E), __uint_as_float(raw[e] & 0xffff0000u) * (0.125f * LOG2E));
            qr[d0] = __builtin_bit_cast(bf16x8, sc);
        }
    }
    const bf16_t* gp = (const bf16_t*)(F.ws + WS_S + S_EX) + tokrow * 64 + hq * 3;
    const float gate0 = fsigmoid(bf2f(gp[0])), gate1 = fsigmoid(bf2f(gp[1])), gate2 = fsigmoid(bf2f(gp[2]));
    f32x16 out[2]; out[0] = (f32x16){}; out[1] = (f32x16){};
    const int lk_key = tidl & 63, lk_c8 = tidl >> 6, lv_key = tidl >> 3, lv_p = tidl & 7;
    const int lk_dst = lk_c8 * 1024 + lk_key * 16, lv_dst = (lv_p >> 2) * 4096 + lv_key * 64 + (lv_p & 3) * 16;
    const int lv_src = (lv_p >> 2) * 32 + (lv_p & 3) * 8;
    __syncthreads();
    {
        const bf16_t* KCB = (const bf16_t*)(F.ws + WS_S + S_KCB) + ((size_t)(b * 2 + g) * 128) * 64;
        const bf16_t* VCB = (const bf16_t*)(F.ws + WS_S + S_VCB) + ((size_t)(b * 2 + g) * 128) * 64;
#pragma unroll
        for (int jt = 0; jt < 2; ++jt) {
            *(LAS u32x4_t*)(L + L_KB + jt * 8192 + lk_dst) = *(const u32x4_t*)(KCB + (size_t)(jt * 64 + lk_key) * 64 + lk_c8 * 8);
            *(LAS u32x4_t*)(L + L_VB + jt * 8192 + lv_dst) = *(const u32x4_t*)(VCB + (size_t)(jt * 64 + lv_key) * 64 + lv_src);
        }
        __syncthreads();
        f32x16 s0a, s0b, s1a, s1b;
        qkt(s0a, s0b, L + L_KB, qr, r32, hi);
        qkt(s1a, s1b, L + L_KB + 8192, qr, r32, hi);
        float m = -INFINITY;
#pragma unroll
        for (int r = 0; r < 16; ++r) {
            const int key = crow(r, hi);
#define CMP_MASK(S, nn) { const int n_ = (nn); const int dist_ = tq - (16 * n_ + 31); const bool ok_ = (n_ < NCMP) && (dist_ >= 0); S[r] = ok_ ? S[r] - slope2 * (float)dist_ : -INFINITY; m = fmaxf(m, S[r]); }
            CMP_MASK(s0a, key) CMP_MASK(s0b, key + 32) CMP_MASK(s1a, 64 + key) CMP_MASK(s1b, 96 + key)
#undef CMP_MASK
        }
        m = swap_max(m);
        if (m == -INFINITY) m = 0.f;
        float lsum = 0.f;
#pragma unroll
        for (int r = 0; r < 16; ++r) { s0a[r] = __builtin_amdgcn_exp2f(s0a[r] - m); s0b[r] = __builtin_amdgcn_exp2f(s0b[r] - m); s1a[r] = __builtin_amdgcn_exp2f(s1a[r] - m); s1b[r] = __builtin_amdgcn_exp2f(s1b[r] - m); lsum += (s0a[r] + s0b[r]) + (s1a[r] + s1b[r]); }
        lsum = swap_sum(lsum);
        const float inv = lsum > 0.f ? 1.0f / lsum : 0.f;
#pragma unroll
        for (int r = 0; r < 16; ++r) { s0a[r] *= inv; s0b[r] *= inv; s1a[r] *= inv; s1b[r] *= inv; }
        {
            LAS float* iq = IMPQ + (rh * 64 + th * 32 + r32) * 33; LAS float* il = IMPL + (rh * 64 + th * 32 + r32) * 33;
#pragma unroll
            for (int rq = 0; rq < 4; ++rq) {
#define IMP_Q(S, Qb) { const int Q_ = (Qb) + 2 * rq + hi; iq[Q_] = (S[4 * rq] + S[4 * rq + 1]) + (S[4 * rq + 2] + S[4 * rq + 3]); il[Q_] = S[4 * rq + 3]; }
                IMP_Q(s0a, 0) IMP_Q(s0b, 8) IMP_Q(s1a, 16) IMP_Q(s1b, 24)
#undef IMP_Q
            }
        }
        bf16x8 a0, a1, a2, a3;
        pack_p(s0a, s0b, a0, a1, a2, a3); pv(out, (int)(lds0 + L_VB) + vboff, a0, a1, a2, a3);
        pack_p(s1a, s1b, a0, a1, a2, a3); pv(out, (int)(lds0 + L_VB + 8192) + vboff, a0, a1, a2, a3);
        scale_o(out, gate0, wsf, r32, hi);
    }
    __syncthreads();
    for (int idx = tidl; idx < 64 * 32; idx += NWAVES * 64) {
        const int tokl = idx >> 5, j = idx & 31; float s = 0.f;
#pragma unroll
        for (int h4 = 0; h4 < 4; ++h4) { s += IMPQ[(h4 * 64 + tokl) * 33 + j]; if (j > 0) s += IMPL[(h4 * 64 + tokl) * 33 + j - 1]; }
        IMPF[tokl * 36 + j] = s;
    }
    __syncthreads();
#pragma unroll 1
    for (int pass = 0; pass < 4; ++pass) {
        const int tokl = pass * 16 + (tidl >> 5), j = tidl & 31;
        bool sel;
        if (c < 16) sel = (j <= c);
        else {
            const LAS f32x4_t* row = (const LAS f32x4_t*)(IMPF + tokl * 36);
            f32x4_t vq[8];
#pragma unroll
            for (int q4 = 0; q4 < 8; ++q4) vq[q4] = row[q4];
            const float mine = IMPF[tokl * 36 + j]; int rank = 0;
#pragma unroll
            for (int jj = 1; jj < 30; ++jj) { const float o2 = vq[jj >> 2][jj & 3]; rank += (jj <= c - 2 && (o2 > mine || (o2 == mine && jj < j))) ? 1 : 0; }
            sel = (j == 0) || (j == c) || (j == c - 1) || (j >= 1 && j <= c - 2 && rank < 13);
        }
        const unsigned long long bal = __ballot(sel);
        if ((lanel & 31) == 0) SELM[tokl] = (lanel == 0) ? (unsigned)(bal & 0xffffffffull) : (unsigned)(bal >> 32);
    }
    __syncthreads();
    if (tidl < 64) {
        unsigned um = SELM[tidl];
#pragma unroll
        for (int o = 1; o < 64; o <<= 1) um |= (unsigned)__builtin_amdgcn_ds_bpermute((lanel ^ o) << 2, (int)um);
        const int j = lanel & 31, jlo = c - 8 > 0 ? c - 8 : 0;
        const bool on = (lanel < 32) ? (j >= jlo && j <= c) : (((um >> j) & 1u) != 0u && j <= c);
        const unsigned long long bal = __ballot(on);
        const unsigned lo32 = (unsigned)(bal & 0xffffffffull), hi32 = (unsigned)(bal >> 32);
        const unsigned above = (j == 31) ? 0u : (0xffffffffu << (j + 1));
        const int pos = (lanel < 32) ? __popc(lo32 & above) : (__popc(lo32) + __popc(hi32 & above));
        if (on) LIST[pos] = ((lanel < 32) ? 256 : 0) | j;
        if (lanel == 0) MISCL[0] = __popc(lo32) + __popc(hi32);
    }
    __syncthreads();
    const int ntl = DBG == 1 ? 1 : MISCL[0];
    const unsigned selq = SELM[th * 32 + r32];
    {
        const bf16_t* Pb = P + (size_t)b * T_ * NPJ;
        constexpr int NSR = 6, GRP = 3, RK = L_IMPQ;
        static_assert(RK == 2 * 16384 + 4096 && RK + (NSR - 2) * 16384 <= L_SELM && L_WSF == 32768, "ring stages: s * 16384 (+ 4096 past the per-wave scratch)");
#define STG_OFF(s_) ((s_) * 16384 + ((s_) >= 2 ? 4096 : 0))
        const int dv_key = (tidl >> 2) & 63, dv_src = (tidl >> 8) * 32 + (tidl & 3) * 8;
#define TILE_DMA(t_) do { const int ent_ = LIST[t_]; const int ty_ = ent_ >> 8, j_ = ent_ & 255; const int kc_ = n_rw + 512 + (ty_ ? 4 : 2) * 128 + g * 64; const int st_ = (t_) % NSR; \
        __builtin_amdgcn_global_load_lds((const unsigned*)(const GAS unsigned*)(uintptr_t)(Pb + (size_t)(j_ * 64 + lk_key) * NPJ + kc_ + lk_c8 * 8), (LAS unsigned*)(L + STG_OFF(st_) + w * 1024), 16, 0, 0); \
        __builtin_amdgcn_global_load_lds((const unsigned*)(const GAS unsigned*)(uintptr_t)(Pb + (size_t)(j_ * 64 + dv_key) * NPJ + kc_ + 128 + dv_src), (LAS unsigned*)(L + STG_OFF(st_) + 8192 + w * 1024), 16, 0, 0); } while (0)
#define TILE_WAIT(c_) do { if ((c_) >= 2) asm volatile("s_waitcnt vmcnt(4)" ::: "memory"); else if ((c_) == 1) asm volatile("s_waitcnt vmcnt(2)" ::: "memory"); else asm volatile("s_waitcnt vmcnt(0)" ::: "memory"); } while (0)
        asm volatile("s_waitcnt vmcnt(0)" ::: "memory");
        TILE_DMA(0);
        if (ntl > 1) TILE_DMA(1);
        if (ntl > 2) TILE_DMA(2);
        asm volatile("s_waitcnt vmcnt(0)" ::: "memory");
        __syncthreads();
        float m = -1e30f; f32x16 o[2], ol; o[0] = (f32x16){}; o[1] = (f32x16){}; ol = (f32x16){};
        int curty = 1;
        bf16x8 ka0 = {0, 0, 0, 0, 0, 0, 0, 0}, ka1 = ka0, qa = ka0;
        if (hi == 0) {
            const float b0_ = slope2 * (float)r32, b1_ = slope2 * (float)(r32 + 32);
            const unsigned h0_ = f2bf(b0_), h1_ = f2bf(b1_);
            ka0[0] = (short)h0_; ka0[1] = (short)f2bf(b0_ - bf2f((bf16_t)h0_)); ka1[0] = (short)h1_; ka1[1] = (short)f2bf(b1_ - bf2f((bf16_t)h1_));
            qa[0] = (short)0x3f80; qa[1] = (short)0x3f80;
        }
        for (int ip = 0; ip < ntl; ip += GRP) {
            if (ip + 3 < ntl) TILE_DMA(ip + 3);
            if (ip + 4 < ntl) TILE_DMA(ip + 4);
            if (ip + 5 < ntl) TILE_DMA(ip + 5);
            const int iend = ip + GRP < ntl ? ip + GRP : ntl;
        for (int i = ip; i < iend; ++i) {
            const int ent = LIST[i], ty = ent >> 8, j = ent & 255, stg = i % NSR;
            if (ty != curty) {
                axpy_ol(out, o, ol, gate2, wsf, r32, hi);
                m = -1e30f; o[0] = (f32x16){}; o[1] = (f32x16){}; ol = (f32x16){}; curty = ty;
            }
            const bool rowok = ty ? true : (((selq >> j) & 1u) != 0u);
            if (__any(rowok)) {
            f32x16 p0, p1;
            qkt_a(p0, p1, L + STG_OFF(stg), qr, r32, hi, ka0, ka1, qa);
            const float cb = slope2 * (float)(tq - 64 * j);
            const bool nomask = (j < c) && (ty ? (j > c - 8) : __all(rowok));
            float rm;
            if (nomask) {
                float ra = max3f(p0[0], p1[0], p0[1]), rb = max3f(p1[1], p0[2], p1[2]);
#pragma unroll
                for (int r = 3; r < 15; r += 2) { ra = max3f(ra, p0[r], p1[r]); rb = max3f(rb, p0[r + 1], p1[r + 1]); }
                ra = max3f(ra, p0[15], p1[15]);
                rm = max3f(ra, rb, rb);
            } else {
                rm = -INFINITY;
#pragma unroll
                for (int r = 0; r < 16; ++r) {
                    const int d0_ = tq - (j * 64 + crow(r, hi)), d1_ = d0_ - 32;
                    const bool ok0 = rowok && d0_ >= 0 && (ty == 0 || d0_ < 512), ok1 = rowok && d1_ >= 0 && (ty == 0 || d1_ < 512);
                    p0[r] = ok0 ? p0[r] : -INFINITY; p1[r] = ok1 ? p1[r] : -INFINITY;
                    rm = fmaxf(rm, fmaxf(p0[r], p1[r]));
                }
            }
            rm = swap_max(rm - cb);
            const float mn = fmaxf(m, rm);
            const float alpha = __builtin_amdgcn_exp2f(m - mn);
            m = mn;
            const float eref = mn + cb;
#pragma unroll
            for (int r = 0; r < 16; ++r) { p0[r] = __builtin_amdgcn_exp2f(p0[r] - eref); p1[r] = __builtin_amdgcn_exp2f(p1[r] - eref); }
            if (__any(alpha != 1.0f)) scale_ol(o, ol, alpha, wsf, r32, hi);
            bf16x8 a0, a1, a2, a3;
            pack_p(p0, p1, a0, a1, a2, a3);
            psum(ol, a0, a1, a2, a3);
            pv(o, (int)(lds0 + STG_OFF(stg) + 8192) + vboff, a0, a1, a2, a3);
            }
        }
            asm volatile("s_waitcnt vmcnt(0)" ::: "memory");
            __syncthreads();
        }
        {
            axpy_ol(out, o, ol, (curty ? gate2 : gate1), wsf, r32, hi);
        }
#undef TILE_DMA
#undef TILE_WAIT
#undef STG_OFF
    }
    {
        LAS bf16_t* ost = (LAS bf16_t*)(L + L_KB) + w * 2048;
#pragma unroll
        for (int r = 0; r < 16; ++r) { const int q = crow(r, hi); ost[q * 64 + r32] = (bf16_t)f2bf(out[0][r]); ost[q * 64 + 32 + r32] = (bf16_t)f2bf(out[1][r]); }
        asm volatile("s_waitcnt lgkmcnt(0)" ::: "memory");
        bf16_t* CC = (bf16_t*)(F.ws + WS_S + S_CONCAT) + ((size_t)b * T_ + t0 + th * 32) * D_ + 512 + g * 256 + rh * 64;
#pragma unroll
        for (int k = 0; k < 4; ++k) {
            const int q = k * 8 + (lanel >> 3), ch = lanel & 7;
            *(u32x4_t*)(CC + (size_t)q * D_ + ch * 8) = *(const LAS u32x4_t*)(ost + q * 64 + ch * 8);
        }
    }
}
template <int DBG = 0> __device__ __forceinline__ void p_nsa_attn(Frame& F, int l) {
    RELAUNDER(F);
    const int n_rw = 1792;
    const bf16_t* P = (const bf16_t*)(F.ws + WS_S + S_PROJ);
    for (int v = F.vcu; v < 256; v += F.G) {
        const int bg = v >> 4, s = v & 15;
#pragma unroll 1
        for (int half = 0; half < 2; ++half) nsa_item<DBG>(F, P, n_rw, bg >> 1, bg & 1, half == 0 ? 31 - s : s);
    }
}

namespace xat {
constexpr int L_P = 0, PPITCH = 264, L_PMAX = 64 * PPITCH * 2, L_PSUM = L_PMAX + 8 * 64 * 4, L_LINV = L_PSUM + 8 * 64 * 4, L_Q = L_LINV + 256, QPITCH = 264, L_OST = L_P  , L_END = L_Q + 2 * 64 * QPITCH * 2;
static_assert(8 * 64 * 32 * 2 <= 64 * PPITCH * 2, "O stage fits the P tile");
static_assert(L_END <= 131072, "cross LDS map");
constexpr float QSCALE = 0.0625f * 1.4426950408889634f;
}
__device__ __forceinline__ void p_cross_attn(Frame& F, int l, int grp_first, int grp_stride) {
    RELAUNDER(F);
    using namespace nsa;
    const bf16_t* QC = (const bf16_t*)(F.ws + WS_S + S_QC); bf16_t* OC = (bf16_t*)(F.ws + WS_S + S_OC);
    const bf16_t* KCR = (const bf16_t*)(F.ws + WS_KCR) + (size_t)l * NMEM * 1024; const bf16_t* VT = (const bf16_t*)(F.ws + WS_VT) + (size_t)l * 1024 * NMEM;
    const int tidl = F.tid, lanel = tidl & 63, w = F.wave, r32 = lanel & 31, hi = lanel >> 5;
    LAS unsigned char* L = F.lds;
    LAS bf16_t* Pl = (LAS bf16_t*)(L + xat::L_P); LAS float* PMAX = (LAS float*)(L + xat::L_PMAX); LAS float* PSUM = (LAS float*)(L + xat::L_PSUM); LAS float* LINV = (LAS float*)(L + xat::L_LINV);
    for (int grp = grp_first; grp < 256; grp += grp_stride) {
        const int bh = grp >> 3, b = bh >> 2, h = bh & 3;
        bf16x8 kf[16], vf[16];
        {
            const bf16_t* kp = KCR + ((size_t)b * MEM_ + 32 * w + r32) * 1024 + h * 256 + hi * 8;
            const bf16_t* vp = VT + ((size_t)(h * 256 + 32 * w + r32)) * NMEM + b * MEM_ + hi * 8;
#pragma unroll
            for (int d0 = 0; d0 < 16; ++d0) { kf[d0] = *(const bf16x8*)(kp + d0 * 16); vf[d0] = *(const bf16x8*)(vp + d0 * 16); }
        }
        LAS bf16_t* Ql = (LAS bf16_t*)(L + xat::L_Q);
        u32x4_t qreg[4];
        {
            const bf16_t* qsrc = QC + ((size_t)b * T_ + ((grp & 7) * 4) * 64 + (tidl >> 3)) * 1024 + h * 256 + (tidl & 7) * 8;
#pragma unroll
            for (int k = 0; k < 4; ++k) qreg[k] = *(const u32x4_t*)(qsrc + 64 * k);
        }
        __syncthreads();
#pragma unroll
        for (int k = 0; k < 4; ++k) *(LAS u32x4_t*)(Ql + (tidl >> 3) * xat::QPITCH + (tidl & 7) * 8 + 64 * k) = qreg[k];
#pragma unroll 1
        for (int i = 0; i < 4; ++i) {
            const int t0 = ((grp & 7) * 4 + i) * 64;
            LAS bf16_t* Qc = Ql + (i & 1) * 64 * xat::QPITCH;
            if (i < 3) {
                const bf16_t* qsrc = QC + ((size_t)b * T_ + t0 + 64 + (tidl >> 3)) * 1024 + h * 256 + (tidl & 7) * 8;
#pragma unroll
                for (int k = 0; k < 4; ++k) qreg[k] = *(const u32x4_t*)(qsrc + 64 * k);
            }
            __syncthreads();
            f32x16 s[2];
#pragma unroll
            for (int qs = 0; qs < 2; ++qs) {
                const LAS bf16_t* qp = Qc + (qs * 32 + r32) * xat::QPITCH + hi * 8;
                s[qs] = (f32x16){};
#pragma unroll
                for (int d0 = 0; d0 < 16; ++d0) { const bf16x8 qf = *(const LAS bf16x8*)(qp + d0 * 16); s[qs] = __builtin_amdgcn_mfma_f32_32x32x16_bf16(kf[d0], qf, s[qs], 0, 0, 0); }
            }
            if (i < 3) {
                LAS bf16_t* Qn = Ql + ((i + 1) & 1) * 64 * xat::QPITCH;
#pragma unroll
                for (int k = 0; k < 4; ++k) *(LAS u32x4_t*)(Qn + (tidl >> 3) * xat::QPITCH + (tidl & 7) * 8 + 64 * k) = qreg[k];
            }
#pragma unroll
            for (int qs = 0; qs < 2; ++qs) {
                float pm = s[qs][0];
#pragma unroll
                for (int r = 1; r < 16; ++r) pm = fmaxf(pm, s[qs][r]);
                pm = swap_max(pm);
                if (hi == 0) PMAX[w * 64 + qs * 32 + r32] = pm;
            }
            __syncthreads();
#pragma unroll
            for (int qs = 0; qs < 2; ++qs) {
                float m = PMAX[qs * 32 + r32];
#pragma unroll
                for (int ww = 1; ww < 8; ++ww) m = fmaxf(m, PMAX[ww * 64 + qs * 32 + r32]);
                float ps = 0.f;
#pragma unroll
                for (int r = 0; r < 16; ++r) { s[qs][r] = __builtin_amdgcn_exp2f(s[qs][r] - m); ps += s[qs][r]; }
                ps = swap_sum(ps);
                if (hi == 0) PSUM[w * 64 + qs * 32 + r32] = ps;
#pragma unroll
                for (int rq = 0; rq < 4; ++rq) {
                    u32x2_t pk; pk.x = cvtpk(s[qs][4 * rq], s[qs][4 * rq + 1]); pk.y = cvtpk(s[qs][4 * rq + 2], s[qs][4 * rq + 3]);
                    *(LAS u32x2_t*)(Pl + (qs * 32 + r32) * xat::PPITCH + 32 * w + 8 * rq + 4 * hi) = pk;
                }
            }
            __syncthreads();
            if (tidl < 64) { float t = 0.f;
#pragma unroll
                for (int ww = 0; ww < 8; ++ww) t += PSUM[ww * 64 + tidl];
                LINV[tidl] = __builtin_amdgcn_rcpf(t); }
            f32x16 o[2]; o[0] = (f32x16){}; o[1] = (f32x16){};
#pragma unroll
            for (int qs = 0; qs < 2; ++qs)
#pragma unroll
                for (int ks = 0; ks < 16; ++ks) {
                    const bf16x8 pf = *(const LAS bf16x8*)(Pl + (qs * 32 + r32) * xat::PPITCH + ks * 16 + hi * 8);
                    o[qs] = __builtin_amdgcn_mfma_f32_32x32x16_bf16(pf, vf[ks], o[qs], 0, 0, 0);
                }
            __syncthreads();
            {
                LAS bf16_t* ost = (LAS bf16_t*)(L + xat::L_OST) + w * 64 * 32;
#pragma unroll
                for (int qs = 0; qs < 2; ++qs)
#pragma unroll
                    for (int r = 0; r < 16; ++r) { const int q = qs * 32 + crow(r, hi); ost[q * 32 + r32] = (bf16_t)f2bf(o[qs][r] * LINV[q]); }
                asm volatile("s_waitcnt lgkmcnt(0)" ::: "memory");
#pragma unroll
                for (int k = 0; k < 4; ++k) {
                    const int q = k * 16 + (lanel >> 2), ch = lanel & 3;
                    const u32x4_t v = *(const LAS u32x4_t*)(ost + q * 32 + ch * 8);
                    *(u32x4_t*)(OC + ((size_t)b * T_ + t0 + q) * 1024 + h * 256 + 32 * w + ch * 8) = v;
                }
            }
        }
    }
}

namespace chk {
typedef short bf16x8 __attribute__((ext_vector_type(8)));
constexpr int TP = 72;
constexpr int WAVE_LDS = 4 * 16 * TP * 2 + 2 * 16 * 17 * 4 + 24 * 128;
typedef float f32x2_t __attribute__((ext_vector_type(2))); typedef __bf16 bf16x2_t __attribute__((ext_vector_type(2)));
__device__ __forceinline__ unsigned pk(float lo, float hi) { f32x2_t v = {lo, hi}; bf16x2_t b = __builtin_convertvector(v, bf16x2_t); return __builtin_bit_cast(unsigned, b); }
}
__device__ __forceinline__ void p_rw_chunk(Frame& F) {
    RELAUNDER(F);
    using namespace chk;
    const int lane = F.lane, j = lane;
    const int item0 = (((F.vcu >> 5) * 8 + F.wave) << 7) + 4 * (F.vcu & 31);
    const bf16_t* SC = (const bf16_t*)(F.ws + WS_S + S_SC);
    LAS unsigned char* wl = F.lds + F.wave * WAVE_LDS;
    LAS bf16_t* tA = (LAS bf16_t*)wl; LAS bf16_t* tB = tA + 16 * TP; LAS bf16_t* tK = tB + 16 * TP; LAS bf16_t* tR = tK + 16 * TP;
    LAS float* M1s = (LAS float*)(wl + 4 * 16 * TP * 2); LAS float* Ts = M1s + 16 * 17;
    const int m = lane & 15, kq = lane >> 4;
    LAS bf16_t* raw = (LAS bf16_t*)(wl + 4 * 16 * TP * 2 + 2 * 16 * 17 * 4);
    u32x4_t R[12];
    {
        const bf16_t* s0 = SC + (size_t)item0 * (16 * 384) + lane * 8;
#pragma unroll
        for (int q = 0; q < 12; ++q) R[q] = *(const u32x4_t*)(s0 + q * 512);
    }
#pragma unroll 1
    for (int item = item0; item < item0 + 4; ++item) {
        unsigned char* dst = F.ws + WS_S + S_CH + (size_t)item * CH_BYTES;
        float gam = 1.0f;
        float be[16], ka[16], vv[16];
#pragma unroll
        for (int qt = 0; qt < 4; ++qt) {
#pragma unroll
            for (int q3 = 0; q3 < 3; ++q3) *(LAS u32x4_t*)(raw + (8 * q3 + (lane >> 3)) * 64 + (lane & 7) * 8) = R[3 * qt + q3];
            asm volatile("s_waitcnt lgkmcnt(0)" ::: "memory");
#pragma unroll
            for (int tl = 0; tl < 4; ++tl) {
                const int t = 4 * qt + tl;
                const float r = bf2f(raw[(tl * 6 + 0) * 64 + j]), om = bf2f(raw[(tl * 6 + 1) * 64 + j]), kt = bf2f(raw[(tl * 6 + 2) * 64 + j]), v = bf2f(raw[(tl * 6 + 3) * 64 + j]),
                            kh = bf2f(raw[(tl * 6 + 4) * 64 + j]), b = bf2f(raw[(tl * 6 + 5) * 64 + j]);
                const float al = -kh * gam;
                gam = gam - gam * om;
                const float ig = __builtin_amdgcn_rcpf(gam);
                be[t] = b * ig; ka[t] = kt * ig; vv[t] = v;
                tA[t * TP + j] = (bf16_t)f2bf(al); tB[t * TP + j] = (bf16_t)f2bf(be[t]); tK[t * TP + j] = (bf16_t)f2bf(ka[t]); tR[t * TP + j] = (bf16_t)f2bf(r * gam);
            }
            asm volatile("s_waitcnt lgkmcnt(0)" ::: "memory");
        }
        if (item + 1 < item0 + 4) {
            const bf16_t* s0 = SC + (size_t)(item + 1) * (16 * 384) + lane * 8;
#pragma unroll
            for (int q = 0; q < 12; ++q) R[q] = *(const u32x4_t*)(s0 + q * 512);
        }
        *(float*)(dst + 12288 + 4 * j) = gam;
        {
            const int mt = j >> 4, jl = j & 15;
            unsigned char* pB = dst + 4096 + (mt >> 1) * 1024 + (mt & 1) * 8;
            unsigned char* pK = dst + 4096 + 2048 + (mt >> 1) * 1024 + (mt & 1) * 8;
            unsigned char* pV = dst + 10240 + mt * 512;
#pragma unroll
            for (int q2 = 0; q2 < 4; ++q2) {
                const int le = q2 * 16 + jl;
                u32x2_t o; o.x = pk(be[4 * q2], be[4 * q2 + 1]); o.y = pk(be[4 * q2 + 2], be[4 * q2 + 3]); *(u32x2_t*)(pB + le * 16) = o;
                o.x = pk(ka[4 * q2], ka[4 * q2 + 1]); o.y = pk(ka[4 * q2 + 2], ka[4 * q2 + 3]); *(u32x2_t*)(pK + le * 16) = o;
                o.x = pk(vv[4 * q2], vv[4 * q2 + 1]); o.y = pk(vv[4 * q2 + 2], vv[4 * q2 + 3]); *(u32x2_t*)(pV + le * 8) = o;
            }
        }
        asm volatile("s_waitcnt lgkmcnt(0)" ::: "memory");
#pragma unroll
        for (int ks = 0; ks < 2; ++ks) {
            const u32x2_t a0 = *(const LAS u32x2_t*)(tA + m * TP + 32 * ks + 4 * kq), a1 = *(const LAS u32x2_t*)(tA + m * TP + 32 * ks + 16 + 4 * kq);
            *(u32x4_t*)(dst + ks * 1024 + lane * 16) = (u32x4_t){a0.x, a0.y, a1.x, a1.y};
            const u32x2_t r0 = *(const LAS u32x2_t*)(tR + m * TP + 32 * ks + 4 * kq), r1 = *(const LAS u32x2_t*)(tR + m * TP + 32 * ks + 16 + 4 * kq);
            *(u32x4_t*)(dst + 2048 + ks * 1024 + lane * 16) = (u32x4_t){r0.x, r0.y, r1.x, r1.y};
        }
        pg8::f32x4 d1 = {0.f, 0.f, 0.f, 0.f}, d2 = d1, d3 = d1, d4 = d1;
#pragma unroll
        for (int ks = 0; ks < 2; ++ks) {
            const bf16x8 fb = *(const LAS bf16x8*)(tB + m * TP + 32 * ks + 8 * kq), fk = *(const LAS bf16x8*)(tK + m * TP + 32 * ks + 8 * kq);
            const bf16x8 fa = *(const LAS bf16x8*)(tA + m * TP + 32 * ks + 8 * kq), fr = *(const LAS bf16x8*)(tR + m * TP + 32 * ks + 8 * kq);
            d1 = __builtin_amdgcn_mfma_f32_16x16x32_bf16(fb, fa, d1, 0, 0, 0);
            d2 = __builtin_amdgcn_mfma_f32_16x16x32_bf16(fk, fa, d2, 0, 0, 0);
            d3 = __builtin_amdgcn_mfma_f32_16x16x32_bf16(fb, fr, d3, 0, 0, 0);
            d4 = __builtin_amdgcn_mfma_f32_16x16x32_bf16(fk, fr, d4, 0, 0, 0);
        }
#pragma unroll
        for (int rg = 0; rg < 4; ++rg) {
            const int s_ = 4 * kq + rg, t_ = m;
            if (!(s_ < t_)) { d1[rg] = 0.f; d2[rg] = 0.f; }
            if (!(s_ <= t_)) { d3[rg] = 0.f; d4[rg] = 0.f; }
            M1s[s_ * 17 + t_] = d1[rg];
        }
        asm volatile("s_waitcnt lgkmcnt(0)" ::: "memory");
        {
            float tr[16];
#pragma unroll
            for (int t = 0; t < 16; ++t) {
                float a = (m == t) ? 1.0f : 0.0f;
#pragma unroll
                for (int s2 = 0; s2 < t; ++s2) a += tr[s2] * M1s[s2 * 17 + t];
                tr[t] = a;
            }
            if (kq == 0) {
#pragma unroll
                for (int t = 0; t < 16; ++t) Ts[m * 17 + t] = tr[t];
            }
        }
        asm volatile("s_waitcnt lgkmcnt(0)" ::: "memory");
        {
            u32x4_t o;
            o.x = pk(Ts[(4 * kq + 0) * 17 + m], Ts[(4 * kq + 1) * 17 + m]); o.y = pk(Ts[(4 * kq + 2) * 17 + m], Ts[(4 * kq + 3) * 17 + m]);
            o.z = pk(d2[0], d2[1]); o.w = pk(d2[2], d2[3]);
            *(u32x4_t*)(dst + 4096 + 4 * 1024 + lane * 16) = o;
            o.x = pk(d3[0], d3[1]); o.y = pk(d3[2], d3[3]); o.z = pk(d4[0], d4[1]); o.w = pk(d4[2], d4[3]);
            *(u32x4_t*)(dst + 4096 + 5 * 1024 + lane * 16) = o;
        }
        asm volatile("s_waitcnt lgkmcnt(0)" ::: "memory");
    }
}

namespace chk { constexpr int SL = 12800, NS = 9, DD = 7; static_assert(NS * SL <= 131072 && NS >= DD + 2, "ring"); }
__device__ __forceinline__ void p_rw_scan2(Frame& F, int bh) {
    RELAUNDER(F);
    using namespace chk;
    const int w = F.wave, lane = F.lane, il = lane & 15, kq = lane >> 4;
    const unsigned char* base = F.ws + WS_S + S_CH + (size_t)bh * 128 * CH_BYTES;
    LAS unsigned char* L = F.lds;
#define CH_ISSUE(c_) do { const unsigned char* cb_ = base + (size_t)(c_) * CH_BYTES; LAS unsigned char* sl_ = L + ((c_) % NS) * SL; const int lw_ = w - 4; \
        __builtin_amdgcn_global_load_lds((const unsigned*)(cb_ + (lw_) * 1024 + lane * 16), (LAS unsigned*)(sl_ + (lw_) * 1024), 16, 0, 0); \
        __builtin_amdgcn_global_load_lds((const unsigned*)(cb_ + (lw_ + 4) * 1024 + lane * 16), (LAS unsigned*)(sl_ + (lw_ + 4) * 1024), 16, 0, 0); \
        __builtin_amdgcn_global_load_lds((const unsigned*)(cb_ + (lw_ + 8) * 1024 + lane * 16), (LAS unsigned*)(sl_ + (lw_ + 8) * 1024), 16, 0, 0); \
        if (lw_ == 0) __builtin_amdgcn_global_load_lds((const unsigned*)(cb_ + 12288 + lane * 4), (LAS unsigned*)(sl_ + 12288), 4, 0, 0); } while (0)
    if (w >= 4) {
#pragma unroll 1
        for (int c = 0; c < DD; ++c) CH_ISSUE(c);
#pragma unroll 1
        for (int c = 0; c < 128; ++c) {
            if (c + DD < 128) {
                CH_ISSUE(c + DD);
                if (w == 4) asm volatile("s_waitcnt vmcnt(28)" ::: "memory"); else asm volatile("s_waitcnt vmcnt(21)" ::: "memory");
            } else asm volatile("s_waitcnt vmcnt(0)" ::: "memory");
            __builtin_amdgcn_s_barrier();
        }
    } else {
        const int qtr = w;
        float* Y = (float*)((unsigned char*)F.out + O_Y) + ((size_t)(bh >> 3) * T_) * W_ + (bh & 7) * 64 + 16 * qtr + il;
        pg8::f32x4 acc0 = {0.f, 0.f, 0.f, 0.f}, acc1 = acc0, acc2 = acc0, acc3 = acc0;
        typedef short s16x4_ __attribute__((ext_vector_type(4)));
#define HALF_LO(q_) __builtin_bit_cast(s16x4_, (u32x2_t){(q_).x, (q_).y})
#define HALF_HI(q_) __builtin_bit_cast(s16x4_, (u32x2_t){(q_).z, (q_).w})
#define FULL(q_) __builtin_bit_cast(bf16x8, (q_))
#define MMAH(a_, b_, c_) __builtin_amdgcn_mfma_f32_16x16x16bf16_1k(a_, b_, c_, 0, 0, 0)
#pragma unroll 1
        for (int c = 0; c < 128; ++c) {
            __builtin_amdgcn_s_barrier();
            asm volatile("" ::: "memory");
            const LAS unsigned char* sl = L + (c % NS) * SL + lane * 16;
            const u32x4_t at0 = *(const LAS u32x4_t*)(sl), at1 = *(const LAS u32x4_t*)(sl + 1024), rt0 = *(const LAS u32x4_t*)(sl + 2048), rt1 = *(const LAS u32x4_t*)(sl + 3072);
            const u32x4_t p0 = *(const LAS u32x4_t*)(sl + 4096), p1 = *(const LAS u32x4_t*)(sl + 5120), p2 = *(const LAS u32x4_t*)(sl + 6144), p3 = *(const LAS u32x4_t*)(sl + 7168);
            const u32x4_t p4 = *(const LAS u32x4_t*)(sl + 8192), p5 = *(const LAS u32x4_t*)(sl + 9216);
            const u32x2_t vt = *(const LAS u32x2_t*)(L + (c % NS) * SL + 10240 + qtr * 512 + lane * 8);
            const LAS float* gp = (const LAS float*)(L + (c % NS) * SL + 12288) + 4 * kq;
            const f32x4_t g0 = *(const LAS f32x4_t*)(gp), g1 = *(const LAS f32x4_t*)(gp + 16), g2 = *(const LAS f32x4_t*)(gp + 32), g3 = *(const LAS f32x4_t*)(gp + 48);
            const bf16x8 S0 = __builtin_bit_cast(bf16x8, (u32x4_t){pk(acc0[0], acc0[1]), pk(acc0[2], acc0[3]), pk(acc1[0], acc1[1]), pk(acc1[2], acc1[3])});
            const bf16x8 S1 = __builtin_bit_cast(bf16x8, (u32x4_t){pk(acc2[0], acc2[1]), pk(acc2[2], acc2[3]), pk(acc3[0], acc3[1]), pk(acc3[2], acc3[3])});
            const s16x4_ VT = __builtin_bit_cast(s16x4_, vt);
            pg8::f32x4 wt = {0.f, 0.f, 0.f, 0.f};
            wt = MMAH(HALF_HI(p4), VT, wt);
            wt = __builtin_amdgcn_mfma_f32_16x16x32_bf16(FULL(at0), S0, wt, 0, 0, 0);
            wt = __builtin_amdgcn_mfma_f32_16x16x32_bf16(FULL(at1), S1, wt, 0, 0, 0);
            acc0 = MMAH(HALF_LO(p2), VT, acc0);
            acc1 = MMAH(HALF_HI(p2), VT, acc1);
            acc2 = MMAH(HALF_LO(p3), VT, acc2);
            acc3 = MMAH(HALF_HI(p3), VT, acc3);
            pg8::f32x4 yt = {0.f, 0.f, 0.f, 0.f};
            yt = __builtin_amdgcn_mfma_f32_16x16x32_bf16(FULL(rt0), S0, yt, 0, 0, 0);
            yt = __builtin_amdgcn_mfma_f32_16x16x32_bf16(FULL(rt1), S1, yt, 0, 0, 0);
            yt = MMAH(HALF_HI(p5), VT, yt);
            const s16x4_ WB = __builtin_bit_cast(s16x4_, (u32x2_t){pk(wt[0], wt[1]), pk(wt[2], wt[3])});
            pg8::f32x4 ut = {0.f, 0.f, 0.f, 0.f};
            ut = MMAH(HALF_LO(p4), WB, ut);
            const s16x4_ UB = __builtin_bit_cast(s16x4_, (u32x2_t){pk(ut[0], ut[1]), pk(ut[2], ut[3])});
            acc0 = MMAH(HALF_LO(p0), UB, acc0);
            acc1 = MMAH(HALF_HI(p0), UB, acc1);
            acc2 = MMAH(HALF_LO(p1), UB, acc2);
            acc3 = MMAH(HALF_HI(p1), UB, acc3);
            yt = MMAH(HALF_LO(p5), UB, yt);
            acc0 = acc0 * g0; acc1 = acc1 * g1; acc2 = acc2 * g2; acc3 = acc3 * g3;
            { float* yp = Y + (size_t)(16 * c + 4 * kq) * W_; yp[0] = yt[0]; yp[W_] = yt[1]; yp[2 * W_] = yt[2]; yp[3 * W_] = yt[3]; }
        }
#undef HALF_LO
#undef HALF_HI
#undef FULL
#undef MMAH
    }
#undef CH_ISSUE
}
#ifndef MK_FUSED
#define MK_FUSED 1
#endif
#if !MK_FUSED
__global__ void __launch_bounds__(NWAVES * 64, 2) mega(Args args) {
    extern __shared__ __attribute__((aligned(16))) unsigned char lds[];
    {
        LAS unsigned char* l3 = (LAS unsigned char*)lds;
        for (int u = threadIdx.x; u < (LDS_BYTES - LDSCTL_OFF) / 4; u += NWAVES * 64) ((LAS unsigned*)(l3 + LDSCTL_OFF))[u] = 0u;
    }
    __syncthreads();
    {
        const int ph = args.ph[0];
        Frame F;
        F.ws = launder_ptr(args.ws);
        { int t = threadIdx.x; asm volatile("" : "+v"(t)); F.tid = t; }
        F.lds = (LAS unsigned char*)lds;
        F.MISC = (volatile LAS unsigned*)(F.lds + MISC_OFF);
        F.lane = F.tid & 63; F.wave = __builtin_amdgcn_readfirstlane(F.tid >> 6);
        F.G = gridDim.x; { const int bx = blockIdx.x; F.vcu = (F.G % 8 == 0) ? (bx % 8) * (F.G / 8) + bx / 8 : bx; }
        F.in = args.in; F.out = (float*)(GAS float*)args.out;
        if (ph == 0) p_prologue(F);
        else if (ph == 1) p_kv(F);
        else if (ph == 10 || ph == 11) p_inproj(F, ph - 10);
        else if (ph == 20 || ph == 21) p_rw_prep(F, ph - 20);
        else if (ph == 25 || ph == 26) p_nsa_cmp(F, ph - 25);
        else if (ph == 30 || ph == 31) p_rw_scan(F);
        else if (ph == 45 || ph == 46) p_nsa_attn(F, ph - 45);
        else if (ph == 40 || ph == 41) p_rw_post(F, ph - 40);
        else if (ph == 50 || ph == 51) p_resid_gemm(F, (const bf16_t*)(F.ws + WS_S + S_CONCAT), (const bf16_t*)(F.ws + WS_WB + WB_WOUT) + (size_t)(ph - 50) * D_ * D_, 1024);
        else if (ph == 60 || ph == 61) p_crossq(F, ph - 60);
        else if (ph == 70 || ph == 71) p_cross_attn(F, ph - 70);
        else if (ph == 80 || ph == 81) p_resid_gemm(F, (const bf16_t*)(F.ws + WS_S + S_OC), (const bf16_t*)(F.ws + WS_WB + WB_WO) + (size_t)(ph - 80) * D_ * D_, 1024);
        else if (ph == 90) p_ffn_up(F);
        else if (ph == 100) p_route(F);
        else if (ph == 101) p_moe_prep(F);
        else if (ph == 102 || ph == 104) p_moe_gemm1(F, (ph - 102) >> 1);
        else if (ph == 103 || ph == 105) p_moe_gemm2(F, (ph - 103) >> 1);
        else if (ph == 110) p_final(F, true);
        else if (ph == 91) p_resid_gemm(F, (const bf16_t*)(F.ws + WS_S + S_ACT), (const bf16_t*)(F.ws + WS_WB + WB_WD), FFD);
        __syncthreads();
    }
}
#else
__global__ void __launch_bounds__(NWAVES * 64, 2) mega(Args args) {
    extern __shared__ __attribute__((aligned(16))) unsigned char lds[];
    {
        LAS unsigned char* l3 = (LAS unsigned char*)lds;
        for (int u = threadIdx.x; u < (LDS_BYTES - LDSCTL_OFF) / 4; u += NWAVES * 64) ((LAS unsigned*)(l3 + LDSCTL_OFF))[u] = 0u;
    }
    __syncthreads();
    const XcdBarrier bar = xcd_barrier_post((unsigned*)(args.ws + WS_CTL) + CW_BAR, (volatile LAS unsigned*)((LAS unsigned char*)lds + MISC_OFF) + 8);
    Frame F;
    F.ws = launder_ptr(args.ws);
    { int t = threadIdx.x; asm volatile("" : "+v"(t)); F.tid = t; }
    F.lds = (LAS unsigned char*)lds;
    F.MISC = (volatile LAS unsigned*)(F.lds + MISC_OFF);
    F.lane = F.tid & 63; F.wave = __builtin_amdgcn_readfirstlane(F.tid >> 6);
    F.G = gridDim.x; { const int bx = blockIdx.x; F.vcu = (F.G % 8 == 0) ? (bx % 8) * (F.G / 8) + bx / 8 : bx; }
    F.in = args.in; F.out = (float*)(GAS float*)args.out;
#ifndef MK_DIAG_MASK
#define MK_DIAG_MASK 0ull
#endif
    unsigned long long* TS = (unsigned long long*)(args.ws + WS_CTL + 600 * 1024); int nseam = 0;
#define SEAM() do { xcd_barrier(bar); if (MK_DIAG_MASK != 0ull && blockIdx.x == 0 && threadIdx.x == 0) TS[++nseam] = __builtin_amdgcn_s_memrealtime(); } while (0)
    if (MK_DIAG_MASK != 0ull && blockIdx.x == 0 && threadIdx.x == 0) TS[0] = __builtin_amdgcn_s_memrealtime();
    p_prologue(F); SEAM();
    p_inproj(F, 0); SEAM();
    p_rw_prep(F, 0);
    SEAM();
    p_rw_chunk(F); SEAM();
    if (F.vcu < 64) p_rw_scan2(F, F.vcu);
    else { const int k = F.vcu - 64; p_kv(F, k); __syncthreads(); if (k < 128) p_nsa_cmp(F, 0, k, 1); else p_nsa_cmp(F, 0, 128 + 2 * (k - 128), 2); }
    SEAM();
    p_nsa_attn(F, 0); __syncthreads(); p_rw_post(F, 0); SEAM();
    p_resid_gemm(F, (const bf16_t*)(F.ws + WS_S + S_CONCAT), (const bf16_t*)(F.ws + WS_WB + WB_WOUT), 1024); SEAM();
    (void)p_crossq(F, 0); SEAM();
    p_cross_attn(F, 0, F.vcu, F.G); SEAM();
    p_resid_gemm(F, (const bf16_t*)(F.ws + WS_S + S_OC), (const bf16_t*)(F.ws + WS_WB + WB_WO), 1024); SEAM();
    p_ffn_up(F); SEAM();
    p_ffn_down8(F); SEAM();
    p_inproj(F, 1); SEAM();
    p_rw_prep(F, 1);
    SEAM();
    p_rw_chunk(F); SEAM();
    if (F.vcu < 64) p_rw_scan2(F, F.vcu);
    else { const int k = F.vcu - 64; if (k < 64) p_nsa_cmp(F, 1, 2 * k, 2); else p_nsa_cmp(F, 1, 128 + (k - 64), 1); }
    SEAM();
    p_nsa_attn(F, 1); __syncthreads(); p_rw_post(F, 1); SEAM();
    p_resid_gemm(F, (const bf16_t*)(F.ws + WS_S + S_CONCAT), (const bf16_t*)(F.ws + WS_WB + WB_WOUT) + (size_t)D_ * D_, 1024); SEAM();
    (void)p_crossq(F, 1); SEAM();
    p_cross_attn(F, 1, F.vcu, F.G); SEAM();
    p_resid_gemm(F, (const bf16_t*)(F.ws + WS_S + S_OC), (const bf16_t*)(F.ws + WS_WB + WB_WO) + (size_t)D_ * D_, 1024); SEAM();
    p_route(F); SEAM();
    p_moe_prep(F); __syncthreads(); p_moe_conv(F); SEAM();
    p_moe_gemm1(F); SEAM();
    p_moe_gemm2(F); SEAM(); p_moe_gemm2_split(F);
    if (MK_DIAG_MASK != 0ull && blockIdx.x == 0 && threadIdx.x == 0) {
        TS[nseam + 1] = __builtin_amdgcn_s_memrealtime();
        unsigned long long tot = 0;
        for (int i = 0; i <= nseam; ++i) if ((MK_DIAG_MASK >> i) & 1ull) tot += TS[i + 1] - TS[i];
        *(float*)(args.ws + WS_CTL + 640 * 1024) = (float)tot * 1e-5f;
        __threadfence();
    }
    SEAM();
    p_final(F, true);
#undef SEAM
}
#endif

namespace v0 {
constexpr int B = B_, T = T_, D = D_, W = W_, H = H_, DH = DH_, MEM = MEM_;
constexpr int ECAP = 8192;
__global__ void k_rmsnorm(const float* __restrict__ x, const float* __restrict__ g, float* __restrict__ out, int rows) {
    const int wave = (blockIdx.x * blockDim.x + threadIdx.x) >> 6, lane = threadIdx.x & 63;
    if (wave >= rows) return;
    const float* xr = x + (size_t)wave * D;
    float v[16]; float s = 0.f;
#pragma unroll
    for (int i = 0; i < 16; ++i) { v[i] = xr[lane + 64 * i]; s += v[i] * v[i]; }
    s = wave_sum(s);
    const float rinv = rsqrtf(s * (1.f / D) + 1e-6f);
#pragma unroll
    for (int i = 0; i < 16; ++i) out[(size_t)wave * D + lane + 64 * i] = v[i] * rinv * g[lane + 64 * i];
}

template <int MODE, bool GATHER>
__global__ void __launch_bounds__(256) k_gemm(const float* __restrict__ A, int lda, const int* __restrict__ rowidx, const int* __restrict__ Mdev, int M,
                                               const float* __restrict__ Wt, const float* __restrict__ W2, int ldw, float* __restrict__ C, int ldc, int N, int K,
                                               const float* __restrict__ scale) {
    if (Mdev) { M = *Mdev; if (M > ECAP) M = ECAP; }
    const int m0 = blockIdx.y * 64, n0 = blockIdx.x * 64;
    if (m0 >= M) return;
    __shared__ float As[16][65];
    __shared__ float Bs[16][65];
    __shared__ float B2s[(MODE == 2) ? 16 : 1][65];
    const int tid = threadIdx.x, tx = tid & 15, ty = tid >> 4;
    float acc[4][4] = {}; float acc2[4][4] = {};
    for (int k0 = 0; k0 < K; k0 += 16) {
        for (int i = tid; i < 64 * 16; i += 256) {
            const int r = i >> 4, kk = i & 15; const int m = m0 + r;
            float v = 0.f;
            if (m < M) { const int ar = GATHER ? rowidx[m] : m; v = A[(size_t)ar * lda + k0 + kk]; }
            As[kk][r] = v;
        }
        for (int i = tid; i < 16 * 64; i += 256) {
            const int kk = i >> 6, c = i & 63; const int n = n0 + c;
            Bs[kk][c] = (n < N) ? Wt[(size_t)(k0 + kk) * ldw + n] : 0.f;
            if (MODE == 2) B2s[kk][c] = (n < N) ? W2[(size_t)(k0 + kk) * ldw + n] : 0.f;
        }
        __syncthreads();
#pragma unroll
        for (int kk = 0; kk < 16; ++kk) {
            float a[4], b[4], b2[4];
#pragma unroll
            for (int i = 0; i < 4; ++i) a[i] = As[kk][ty * 4 + i];
#pragma unroll
            for (int j = 0; j < 4; ++j) { b[j] = Bs[kk][tx * 4 + j]; if (MODE == 2) b2[j] = B2s[kk][tx * 4 + j]; }
#pragma unroll
            for (int i = 0; i < 4; ++i)
#pragma unroll
                for (int j = 0; j < 4; ++j) { acc[i][j] += a[i] * b[j]; if (MODE == 2) acc2[i][j] += a[i] * b2[j]; }
        }
        __syncthreads();
    }
#pragma unroll
    for (int i = 0; i < 4; ++i) {
        const int m = m0 + ty * 4 + i; if (m >= M) continue;
#pragma unroll
        for (int j = 0; j < 4; ++j) {
            const int n = n0 + tx * 4 + j; if (n >= N) continue;
            if (MODE == 0) C[(size_t)m * ldc + n] = acc[i][j];
            else if (MODE == 1) C[(size_t)m * ldc + n] += acc[i][j];
            else if (MODE == 2) { const float gte = acc[i][j]; C[(size_t)m * ldc + n] = gte * sigmoidf_(gte) * acc2[i][j]; }
            else { const int orow = rowidx[m]; C[(size_t)orow * ldc + n] += scale[m] * acc[i][j]; }
        }
    }
}

struct RwPar {
    const float *mu, *w0, *w2, *a0, *a2, *g2, *k_k, *k_a, *v0, *v2;
};
template <class TP>
__global__ void __launch_bounds__(512) k_rw_prep(const TP* __restrict__ proj, int ncols, int n_rw, RwPar p, int layer,
                                                 float* __restrict__ DEC, float* __restrict__ AIC, float* __restrict__ VP, float* __restrict__ G, float* __restrict__ VFIRST) {
    const int tok = blockIdx.x, t = tok % T, c = threadIdx.x;
    __shared__ float lo[288];
    const TP* cur = proj + (size_t)tok * ncols;
    const TP* prv = cur - ncols;
    if (c < n_rw - 1536) {
        const int col = 1536 + c;
        const float u = ldf(cur, col), up = (t > 0) ? ldf(prv, col) : 0.f;
        float v = u + (up - u) * p.mu[col];
        if (c < 64) v = tanhf(v);
        else if (c >= 128 && c < 256) v = sigmoidf_(v);
        lo[c] = v;
    }
    __syncthreads();
    float wr = p.w0[c], ar = p.a0[c], gr = 0.f;
#pragma unroll 4
    for (int j = 0; j < 64; ++j) { wr += lo[j] * p.w2[j * W + c]; ar += lo[64 + j] * p.a2[j * W + c]; }
#pragma unroll 4
    for (int j = 0; j < 128; ++j) gr += lo[128 + j] * p.g2[j * W + c];
    const float sp = (-wr > 20.f) ? -wr : log1pf(__expf(-wr));
    const float w = -sp - 0.5f;
    DEC[(size_t)tok * W + c] = __expf(-__expf(w));
    AIC[(size_t)tok * W + c] = sigmoidf_(ar);
    G[(size_t)tok * W + c] = gr;
    {
        const int col = 1024 + c;
        const float u = ldf(cur, col), up = (t > 0) ? ldf(prv, col) : 0.f;
        float v = u + (up - u) * p.mu[col];
        if (layer == 0) { VFIRST[(size_t)tok * W + c] = v; }
        else {
            float vr = p.v0[c];
#pragma unroll 4
            for (int j = 0; j < 32; ++j) vr += lo[256 + j] * p.v2[j * W + c];
            const float vf = VFIRST[(size_t)tok * W + c];
            v = v + (vf - v) * sigmoidf_(vr);
        }
        VP[(size_t)tok * W + c] = v;
    }
}

template <class TP>
__global__ void __launch_bounds__(64) k_rw_scan(const TP* __restrict__ proj, int ncols, const float* __restrict__ mu, const float* __restrict__ k_k, const float* __restrict__ k_a,
                                                const float* __restrict__ r_k,
                                                const float* __restrict__ DEC, const float* __restrict__ AIC, const float* __restrict__ VP,
                                                float* __restrict__ Y, float* __restrict__ BON) {
    const int b = blockIdx.x / H, h = blockIdx.x % H, j = threadIdx.x, c = h * DH + j;
    __shared__ float sr[64], sw[64], sk[64], sa[64], sb[64];
    float S[64];
#pragma unroll
    for (int i = 0; i < 64; ++i) S[i] = 0.f;
    const float mur = mu[c], muk = mu[W + c], kkc = k_k[c], kac = k_a[c], rkc = r_k[c];
    float pr = 0.f, pk = 0.f;
    for (int t = 0; t < T; ++t) {
        const size_t tok = (size_t)b * T + t;
        const TP* cur = proj + tok * ncols;
        const float ur = ldf(cur, c), uk = ldf(cur, W + c);
        const float r = ur + (pr - ur) * mur, k = uk + (pk - uk) * muk;
        pr = ur; pk = uk;
        const float a = AIC[tok * W + c], dec = DEC[tok * W + c], v = VP[tok * W + c];
        float kk = k * kkc;
        const float nrm = sqrtf(wave_sum(kk * kk));
        kk = kk / fmaxf(nrm, 1e-12f);
        const float kh = k * (1.f + (a - 1.f) * kac);
        const float bon = wave_sum(r * kh * rkc);
        __syncthreads();
        sr[j] = r; sw[j] = dec; sk[j] = kh; sa[j] = -kk; sb[j] = kk * a;
        __syncthreads();
        float Sa = 0.f;
#pragma unroll
        for (int q = 0; q < 64; ++q) Sa += S[q] * sa[q];
        float y = 0.f;
#pragma unroll
        for (int q = 0; q < 64; ++q) { S[q] = S[q] * sw[q] + Sa * sb[q] + v * sk[q]; y += S[q] * sr[q]; }
        Y[tok * W + c] = y;
        if (j == 0) BON[tok * H + h] = bon;
    }
}

template <class TC>
__global__ void k_rw_post(const float* __restrict__ Y, const float* __restrict__ BON, const float* __restrict__ VP, const float* __restrict__ G, const float* __restrict__ ln_w, const float* __restrict__ ln_b,
                          TC* __restrict__ concat) {
    const int wid = (blockIdx.x * blockDim.x + threadIdx.x) >> 6, lane = threadIdx.x & 63;
    if (wid >= NTOK * H) return;
    const int tok = wid / H, h = wid % H, c = h * DH + lane;
    const float y = Y[(size_t)tok * W + c];
    const float mean = wave_sum(y) * (1.f / 64.f);
    const float d = y - mean;
    const float var = wave_sum(d * d) * (1.f / 64.f);
    const float yn = d * rsqrtf(var + 64e-5f) * ln_w[c] + ln_b[c];
    stf(concat, (size_t)tok * D + c, (yn + BON[(size_t)tok * H + h] * VP[(size_t)tok * W + c]) * G[(size_t)tok * W + c]);
}

template <class TP>
__global__ void __launch_bounds__(128) k_cmp_hidden(const TP* __restrict__ proj, int ncols, int colbase  , const float* __restrict__ pe,
                                                    const float* __restrict__ w1, float* __restrict__ hid) {
    const int row = blockIdx.x, n = row % NCMP, g = (row / NCMP) % 2, b = row / (NCMP * 2);
    __shared__ float blk[2048];
    for (int i = threadIdx.x; i < 2048; i += 128) {
        const int l = i >> 6, d = i & 63;
        blk[i] = ldf(proj, ((size_t)b * T + 16 * n + l) * ncols + colbase + g * 64 + d) + pe[i];
    }
    __syncthreads();
    float acc = 0.f;
    for (int k = 0; k < 2048; ++k) acc += blk[k] * w1[(size_t)k * 128 + threadIdx.x];
    const float x = acc;
    const float ge = 0.5f * x * (1.f + tanhf(0.7978845608028654f * (x + 0.044715f * x * x * x)));
    hid[(size_t)row * 128 + threadIdx.x] = ge;
}
__global__ void __launch_bounds__(64) k_cmp_out(const float* __restrict__ hid, const float* __restrict__ w2, float* __restrict__ out  ) {
    const int row = blockIdx.x, n = row % NCMP, bg = row / NCMP;
    float acc = 0.f;
    for (int k = 0; k < 128; ++k) acc += hid[(size_t)row * 128 + k] * w2[k * 64 + threadIdx.x];
    out[((size_t)bg * 128 + n) * 64 + threadIdx.x] = acc;
}

template <class TP, class TC>
__global__ void __launch_bounds__(512) k_nsa_attn(const TP* __restrict__ proj, int ncols, int n_rw, const float* __restrict__ KC, const float* __restrict__ VC, TC* __restrict__ concat) {
    const int tok = blockIdx.x, b = tok / T, t = tok % T;
    const int wave = threadIdx.x >> 6, lane = threadIdx.x & 63, g = wave >> 2, r = wave & 3, hq = wave;
    const TP* cols = proj + (size_t)tok * ncols + n_rw;
    __shared__ float qs[8][64];
    __shared__ float ps[8][128];
    __shared__ float imp[2][32];
    __shared__ unsigned selm[2];
    __shared__ float pbuf[8][64];
    const float slope = exp2f(-(float)(hq + 1));
    const float q = ldf(cols, g * 256 + r * 64 + lane) * 0.125f;
    qs[wave][lane] = q;
    const float gate0 = sigmoidf_(ldf(cols, 1280 + hq * 3 + 0)), gate1 = sigmoidf_(ldf(cols, 1280 + hq * 3 + 1)), gate2 = sigmoidf_(ldf(cols, 1280 + hq * 3 + 2));
    __syncthreads();
    float out = 0.f;
    {
        const float* kc = KC + ((size_t)(b * 2 + g) * 128) * 64;
        const float* vc = VC + ((size_t)(b * 2 + g) * 128) * 64;
        float s[2]; bool ok[2];
#pragma unroll
        for (int u = 0; u < 2; ++u) {
            const int n = lane + 64 * u;
            ok[u] = (n < NCMP) && (16 * n + 31 <= t);
            float acc = 0.f;
            if (ok[u]) { for (int d = 0; d < 64; ++d) acc += qs[wave][d] * kc[n * 64 + d]; acc -= slope * (float)(t - (16 * n + 31)); }
            s[u] = ok[u] ? acc : -1e30f;
        }
        const float m = wave_max(fmaxf(s[0], s[1]));
        float p0 = ok[0] ? __expf(s[0] - m) : 0.f, p1 = ok[1] ? __expf(s[1] - m) : 0.f;
        const float l = wave_sum(p0 + p1);
        const float inv = 1.f / fmaxf(l, 1e-30f);
        p0 *= inv; p1 *= inv;
        ps[wave][lane] = p0; ps[wave][lane + 64] = p1;
        __syncthreads();
        float o = 0.f;
        for (int n = 0; n < NCMP; ++n) o += ps[wave][n] * vc[n * 64 + lane];
        out += gate0 * o;
        if (threadIdx.x < 64) {
            const int g2 = threadIdx.x >> 5, j = threadIdx.x & 31;
            float acc = 0.f;
            for (int rr = 0; rr < 4; ++rr)
                for (int n = 4 * j - 1; n <= 4 * j + 3; ++n) if (n >= 0 && n < NCMP) acc += ps[g2 * 4 + rr][n];
            const int curb = t >> 6;
            if (j == 0 || j == curb || j == curb - 1) acc = 1e4f;
            if (j > curb) acc = -1.f;
            imp[g2][j] = acc;
        }
        __syncthreads();
        if (threadIdx.x < 64) {
            const int g2 = threadIdx.x >> 5, j = threadIdx.x & 31;
            const float mine = imp[g2][j]; int rank = 0;
            for (int jj = 0; jj < 32; ++jj) { const float o2 = imp[g2][jj]; rank += (o2 > mine || (o2 == mine && jj < j)) ? 1 : 0; }
            const unsigned long long bal = __ballot(rank < 16);
            if (j == 0) selm[g2] = (unsigned)(g2 == 0 ? (bal & 0xffffffffull) : (bal >> 32));
        }
        __syncthreads();
    }
    for (int br = 0; br < 2; ++br) {
        const int kcol = n_rw + 512 + (br == 0 ? 2 : 4) * 128 + g * 64, vcol = kcol + 128;
        const float gate = br == 0 ? gate1 : gate2;
        const unsigned mask = selm[g];
        float m = -1e30f, l = 0.f, o = 0.f;
        const int curb = t >> 6;
        const int jlo = (br == 0) ? 0 : ((curb - 8 > 0) ? curb - 8 : 0);
        for (int j = jlo; j <= curb; ++j) {
            if (br == 0 && !((mask >> j) & 1u)) continue;
            const int pos = j * 64 + lane;
            const int dist = t - pos;
            const bool ok = (dist >= 0) && (br == 0 || dist < 512);
            float sc = -1e30f;
            if (ok) {
                const TP* kr = proj + ((size_t)b * T + pos) * ncols + kcol;
                float acc = 0.f;
                for (int d = 0; d < 64; ++d) acc += qs[wave][d] * ldf(kr, d);
                sc = acc - slope * (float)dist;
            }
            const float mt = wave_max(sc);
            const float mn = fmaxf(m, mt);
            const float alpha = __expf(m - mn);
            const float p = ok ? __expf(sc - mn) : 0.f;
            l = l * alpha + wave_sum(p);
            pbuf[wave][lane] = p;
            __builtin_amdgcn_wave_barrier();
            float acc = 0.f;
            const int kmax = (t - j * 64 + 1 < 64) ? (t - j * 64 + 1) : 64;
            for (int kk = 0; kk < kmax; ++kk) acc += pbuf[wave][kk] * ldf(proj, ((size_t)b * T + j * 64 + kk) * ncols + vcol + lane);
            __builtin_amdgcn_wave_barrier();
            o = o * alpha + acc;
            m = mn;
        }
        out += gate * o / fmaxf(l, 1e-30f);
    }
    stf(concat, (size_t)tok * D + 512 + g * 256 + r * 64 + lane, out);
}

__global__ void __launch_bounds__(256) k_cross_attn(const bf16_t* __restrict__ Q, const bf16_t* __restrict__ Kc, const bf16_t* __restrict__ VT, bf16_t* __restrict__ O) {
    const int wid = (blockIdx.x * blockDim.x + threadIdx.x) >> 6, lane = threadIdx.x & 63;
    const int tok = wid >> 2, h = wid & 3, b = tok / T;
    float q[4];
    for (int i = 0; i < 4; ++i) q[i] = ldf(Q, (size_t)tok * D + h * 256 + lane * 4 + i);
    float s[4];
    for (int u = 0; u < 4; ++u) s[u] = 0.f;
    for (int key = 0; key < MEM; ++key) {
        const bf16_t* kr = Kc + ((size_t)b * MEM + key) * 1024 + h * 256 + lane * 4;
        float d = q[0] * bf2f(kr[0]) + q[1] * bf2f(kr[1]) + q[2] * bf2f(kr[2]) + q[3] * bf2f(kr[3]);
        d = wave_sum(d) * 0.0625f;
        if ((key & 63) == lane) s[key >> 6] = d;
    }
    float m = fmaxf(fmaxf(s[0], s[1]), fmaxf(s[2], s[3]));
    m = wave_max(m);
    float p[4], l = 0.f;
    for (int u = 0; u < 4; ++u) { p[u] = __expf(s[u] - m); l += p[u]; }
    l = wave_sum(l);
    float o[4] = {0.f, 0.f, 0.f, 0.f};
    for (int key = 0; key < MEM; ++key) {
        const float pk = __shfl(p[key >> 6], key & 63);
        for (int i = 0; i < 4; ++i) o[i] += pk * bf2f(VT[(size_t)(h * 256 + lane * 4 + i) * NMEM + b * MEM + key]);
    }
    const float inv = 1.f / l;
    for (int i = 0; i < 4; ++i) stf(O, (size_t)tok * D + h * 256 + lane * 4 + i, o[i] * inv);
}

__global__ void k_route(const float* __restrict__ Hn, const float* __restrict__ wr, int* __restrict__ top_e, float* __restrict__ top_g) {
    const int wid = (blockIdx.x * blockDim.x + threadIdx.x) >> 6, lane = threadIdx.x & 63;
    if (wid >= NTOK) return;
    float acc[8] = {};
    for (int i = 0; i < 16; ++i) {
        const int k = lane + 64 * i; const float hv = Hn[(size_t)wid * D + k];
#pragma unroll
        for (int e = 0; e < 8; ++e) acc[e] += hv * wr[k * 8 + e];
    }
#pragma unroll
    for (int e = 0; e < 8; ++e) acc[e] = wave_sum(acc[e]);
    if (lane == 0) {
        int e0 = 0; for (int e = 1; e < 8; ++e) if (acc[e] > acc[e0]) e0 = e;
        int e1 = -1; for (int e = 0; e < 8; ++e) if (e != e0 && (e1 < 0 || acc[e] > acc[e1])) e1 = e;
        const float m = acc[e0]; const float p0 = 1.f, p1 = __expf(acc[e1] - m); const float inv = 1.f / (p0 + p1);
        top_e[wid * 2] = e0; top_e[wid * 2 + 1] = e1; top_g[wid * 2] = p0 * inv; top_g[wid * 2 + 1] = p1 * inv;
    }
}
__global__ void __launch_bounds__(64) k_lists(const int* __restrict__ top_e, const float* __restrict__ top_g, int* __restrict__ list, float* __restrict__ lgate, int* __restrict__ counts) {
    const int e = blockIdx.x, lane = threadIdx.x; int cnt = 0;
    for (int t0 = 0; t0 < NTOK; t0 += 64) {
        const int tok = t0 + lane; int k = -1;
        if (top_e[tok * 2] == e) k = 0; else if (top_e[tok * 2 + 1] == e) k = 1;
        const unsigned long long bal = __ballot(k >= 0);
        if (k >= 0) { const int pos = cnt + __popcll(bal & ((1ull << lane) - 1ull)); if (pos < ECAP) { list[e * NTOK + pos] = tok; lgate[e * NTOK + pos] = top_g[tok * 2 + k]; } }
        cnt += __popcll(bal);
    }
    if (lane == 0) counts[e] = cnt;
}

__global__ void k_xb_ssq(const float* __restrict__ X, bf16_t* __restrict__ XB, float* __restrict__ SSQ) {
    const int m = (blockIdx.x * blockDim.x + threadIdx.x) >> 6, lane = threadIdx.x & 63;
    if (m >= NTOK) return;
    float s = 0.f;
    for (int i = 0; i < 16; ++i) { const float v = X[(size_t)m * D + lane + 64 * i]; s += v * v; XB[(size_t)m * D + lane + 64 * i] = (bf16_t)f2bf(v); }
    s = wave_sum(s);
    if (lane < 16) SSQ[(size_t)m * 16 + lane] = lane == 0 ? s : 0.f;
}
}

static int g_grid = 0;
static void launch_mega(const Args& base, std::initializer_list<int> phs, hipStream_t stream) {
    Args a = base; a.nph = 0;
    for (int p : phs) a.ph[a.nph++] = p;
    hipLaunchKernelGGL(mega, dim3(g_grid), dim3(NWAVES * 64), LDS_BYTES, stream, a);
}

extern "C" void kernel_launch(void* const* d_in, const int* in_sizes, int n_in, void* d_out, int out_size, void* d_ws, size_t ws_size, hipStream_t stream) {
    using namespace v0;
    if (g_grid == 0) {
        int dev = 0, cus = 0;
        if (hipGetDevice(&dev) != hipSuccess || hipDeviceGetAttribute(&cus, hipDeviceAttributeMultiprocessorCount, dev) != hipSuccess) { g_grid = -1; return; }
        if (hipFuncSetAttribute((const void*)mega, hipFuncAttributeMaxDynamicSharedMemorySize, LDS_BYTES) != hipSuccess) { fprintf(stderr, "kernel_launch: hipFuncSetAttribute failed\n"); g_grid = -1; return; }
        (void)hipGetLastError();
        if (cus != 256) { fprintf(stderr, "kernel_launch: built for a 256-CU device (one workgroup per CU), found %d\n", cus); g_grid = -1; return; }
        g_grid = cus;
    }
    if (g_grid < 0) return;
    const float* in[40];
    for (int i = 0; i < 40; ++i) in[i] = (const float*)d_in[i];
    unsigned char* wsb = (unsigned char*)d_ws;
    Args base{};
    for (int i = 0; i < 40; ++i) base.in[i] = in[i];
    base.out = (float*)d_out; base.ws = wsb;

    float* X = (float*)(wsb + WS_X);
    bf16_t* XB = (bf16_t*)(wsb + WS_XB);
    float* SSQ = (float*)(wsb + WS_SSQ);
    bf16_t* PROJ = (bf16_t*)(wsb + WS_S);
    size_t off = (WS_S + S_END + 1 * MiB) / 4;
    float* ws = (float*)d_ws;
    auto take = [&](size_t nfl) { float* p = ws + off; off += (nfl + 63) & ~(size_t)63; return p; };
    float* KC = take((size_t)B * 2 * 128 * 64);
    float* VC = take((size_t)B * 2 * 128 * 64);
    float* HID = take((size_t)B * 2 * NCMP * 128);
    if (off * 4 < WS_MOE_END) off = WS_MOE_END / 4;
    if (off * 4 > ws_size) { fprintf(stderr, "kernel_launch: workspace too small: need %zu have %zu\n", off * 4, ws_size); return; }

    hipMemsetAsync(wsb + WS_CTL, 0, 1 * MiB, stream);
#if MK_FUSED
    launch_mega(base, {0}, stream);
#else
    launch_mega(base, {0}, stream);
    launch_mega(base, {1}, stream);
    bf16_t* CONCATB = (bf16_t*)(wsb + WS_S + S_CONCAT);

    for (int layer = 0; layer < 2; ++layer) {
        const int ncols = layer == 0 ? 3096 : 3128;
        const int n_rw = ncols - NSA_COLS;
        launch_mega(base, {10 + layer}, stream);
        launch_mega(base, {20 + layer}, stream);
        launch_mega(base, {30 + layer}, stream);
        launch_mega(base, {40 + layer}, stream);
        launch_mega(base, {25 + layer}, stream);
        launch_mega(base, {45 + layer}, stream);
        launch_mega(base, {50 + layer}, stream);
        launch_mega(base, {60 + layer}, stream);
        launch_mega(base, {70 + layer}, stream);
        launch_mega(base, {80 + layer}, stream);
        if (layer == 0) {
            launch_mega(base, {90}, stream);
            launch_mega(base, {91}, stream);
        } else {
            launch_mega(base, {100}, stream);
            launch_mega(base, {101}, stream);
            launch_mega(base, {102}, stream);
            launch_mega(base, {103}, stream);
            launch_mega(base, {104}, stream);
            launch_mega(base, {105}, stream);
        }
    }
    launch_mega(base, {110}, stream);
#endif
}
```

```cpp
#include <hip/hip_runtime.h>
#include <cstdint>
#include <cstdio>
#include <initializer_list>

constexpr int B_ = 8, T_ = 2048, D_ = 1024, NTOK = B_ * T_, MEM_ = 256, NMEM = B_ * MEM_;
constexpr int W_ = 512, H_ = 8, DH_ = 64;
constexpr int NSA_COLS = 1304, NCMP = 127;
constexpr int FFD = 2816, NEXP = 8, EFF = 3584;
constexpr int NPJ = 3072;

typedef unsigned short bf16_t;
typedef float f32x4_t __attribute__((ext_vector_type(4)));
typedef unsigned u32x4_t __attribute__((ext_vector_type(4)));
typedef unsigned u32x2_t __attribute__((ext_vector_type(2)));
#define LAS __attribute__((address_space(3)))

__device__ __forceinline__ float bf2f(bf16_t v) { return __uint_as_float(((unsigned)v) << 16); }
__device__ __forceinline__ unsigned f2bf(float f) { unsigned u = __float_as_uint(f); return (u + 0x7fffu + ((u >> 16) & 1u)) >> 16; }
__device__ __forceinline__ unsigned pk2(float lo, float hi) { return f2bf(lo) | (f2bf(hi) << 16); }
__device__ __forceinline__ unsigned pk4_fp8(float a, float b, float c, float d) {
    a = __builtin_amdgcn_fmed3f(a, -448.f, 448.f); b = __builtin_amdgcn_fmed3f(b, -448.f, 448.f); c = __builtin_amdgcn_fmed3f(c, -448.f, 448.f); d = __builtin_amdgcn_fmed3f(d, -448.f, 448.f);
    int r = __builtin_amdgcn_cvt_pk_fp8_f32(a, b, 0, false);
    r = __builtin_amdgcn_cvt_pk_fp8_f32(c, d, r, true);
    return (unsigned)r;
}
constexpr float F8S_X = 4.0f, F8S_W = 64.0f, F8S_ACT = 8.0f;
constexpr int F8C_X = 125, F8C_W = 121, F8C_ACT = 124;
__device__ __forceinline__ float ldf(const float* p, size_t i) { return p[i]; }
__device__ __forceinline__ float ldf(const bf16_t* p, size_t i) { return bf2f(p[i]); }
__device__ __forceinline__ void stf(float* p, size_t i, float v) { p[i] = v; }
__device__ __forceinline__ void stf(bf16_t* p, size_t i, float v) { p[i] = (bf16_t)f2bf(v); }

__device__ __forceinline__ float wave_sum(float v) {
#pragma unroll
    for (int o = 1; o < 64; o <<= 1) v += __shfl_xor(v, o);
    return v;
}
__device__ __forceinline__ float wave_max(float v) {
#pragma unroll
    for (int o = 1; o < 64; o <<= 1) v = fmaxf(v, __shfl_xor(v, o));
    return v;
}
__device__ __forceinline__ float shx(float v, int lane, int m) { return __int_as_float(__builtin_amdgcn_ds_bpermute((lane ^ m) << 2, __float_as_int(v))); }
__device__ __forceinline__ float wave_sum_l(float v, int lane) {
#pragma unroll
    for (int o = 1; o < 64; o <<= 1) v += shx(v, lane, o);
    return v;
}
__device__ __forceinline__ float wave_max_l(float v, int lane) {
#pragma unroll
    for (int o = 1; o < 64; o <<= 1) v = fmaxf(v, shx(v, lane, o));
    return v;
}
__device__ __forceinline__ float sigmoidf_(float x) { return 1.f / (1.f + __expf(-x)); }
__device__ __forceinline__ float fexp(float x) { return __builtin_amdgcn_exp2f(x * 1.4426950408889634f); }
__device__ __forceinline__ float fsigmoid(float x) { return __builtin_amdgcn_rcpf(1.0f + __builtin_amdgcn_exp2f(x * -1.4426950408889634f)); }
__device__ __forceinline__ float ftanh(float x) { return 2.0f * fsigmoid(2.0f * x) - 1.0f; }

constexpr size_t MiB = (size_t)1 << 20;
constexpr size_t WS_CTL = 0;
constexpr size_t WS_MRINV = 512 * 1024;
constexpr size_t WS_X = 1 * MiB;
constexpr size_t WS_XB = WS_X + 64 * MiB;
constexpr size_t WS_SSQ = WS_XB + 32 * MiB;
constexpr size_t WS_WB = WS_SSQ + 1 * MiB;
constexpr size_t WS_MEMB = WS_WB + 54 * MiB;
constexpr size_t WS_KCR = WS_MEMB + 4 * MiB;
constexpr size_t WS_VT = WS_KCR + 8 * MiB;
constexpr size_t WS_VFIRST = WS_VT + 8 * MiB;
constexpr size_t WS_S = WS_VFIRST + 16 * MiB;
constexpr size_t WB_WIN = 0;
constexpr size_t WB_WOUT = WB_WIN + 2 * (size_t)NPJ * 1024 * 2;
constexpr size_t WB_WQ = WB_WOUT + 2 * 2 * MiB;
constexpr size_t WB_WK = WB_WQ + 2 * 2 * MiB;
constexpr size_t WB_WV = WB_WK + 2 * 2 * MiB;
constexpr size_t WB_WO = WB_WV + 2 * 2 * MiB;
constexpr size_t WB_WGU = WB_WO + 2 * 2 * MiB;
constexpr size_t WB_WD = WB_WGU + (size_t)2 * FFD * 1024 * 2;
constexpr size_t WB_LORA = WB_WD + (size_t)FFD * 1024 * 2;
constexpr size_t WB_CW1 = WB_LORA + 2 * 512 * 288 * 2;
constexpr size_t WB_CW2 = WB_CW1 + 4 * 128 * 2048 * 2;
constexpr size_t WB_CB = WB_CW2 + 4 * 64 * 128 * 2;
constexpr size_t WB_WSK = WB_CB + 4 * 128 * 4;
constexpr size_t WB_END = WB_WSK + 2 * 64 * 1024 * 2;
static_assert(WB_END <= 54 * MiB, "weight map");
constexpr size_t WS_WE = WS_WB;
constexpr size_t WE_D = (size_t)8 * 7168 * 1024 * 2;
constexpr size_t WS_XG = WS_WE + 168 * MiB;
constexpr int MOE_PASS_TILES = 64;
constexpr size_t WS_ACTM = WS_XG + 68 * MiB;
constexpr size_t WS_MT = WS_ACTM + 119 * MiB;
constexpr size_t MT_INV = 0;
constexpr size_t MT_ROWINFO = 512 * 1024;
constexpr size_t MT_ROWG = 768 * 1024;
constexpr size_t MT_TOKG = 1024 * 1024;
constexpr size_t MT_TILE = 1280 * 1024;
constexpr size_t MT_ROWOF = 1536 * 1024;
constexpr int MOE_NS = 7, MOE_KS = 512;
constexpr size_t WS_MOE_END = WS_MT + 2 * MiB;
constexpr size_t CTL_CNT = 64 * 1024;
namespace pg8 {
#define PG8_LAS __attribute__((address_space(3)))
typedef unsigned short bf16_t;
typedef short bf16x8 __attribute__((ext_vector_type(8)));
typedef float f32x4 __attribute__((ext_vector_type(4)));
typedef unsigned u32x4 __attribute__((ext_vector_type(4)));
constexpr int BM = 256, BK = 64, HALF = 128, HTB = HALF * BK * 2  , STAGE_BYTES = 8 * HTB, NXCD = 8, WGM = 8;

__host__ __device__ __forceinline__ int lds_byte(int r, int c) { const int st = (r >> 4) * 2 + (c >> 5), rr = r & 15, cc = c & 31, ob = rr * 64 + cc * 2; return st * 1024 + (ob ^ (((ob >> 9) & 1) << 5)); }
__host__ __device__ __forceinline__ void stage_rc(int b, int& R, int& C) { const int st = b / 1024, sb = b % 1024, swz = sb ^ (((sb >> 9) & 1) << 5); R = (st >> 1) * 16 + swz / 64; C = (st & 1) * 32 + (swz % 64) / 2; }
__host__ __device__ __forceinline__ int perm32(int rho) { const int n = rho >> 4, i = rho & 15; return 8 * (i >> 2) + 4 * n + (i & 3); }

struct Unit { int pm, pn, e, ord, ks; };
struct Gemm { const bf16_t* A; const bf16_t* Bt; int M, N, K; size_t bstride; };

struct StaticOrder {
    int nM, nN, nwg, G, c;
    __host__ __device__ void init(int M, int N, int G_, int c_) { nM = M / BM; nN = N / BM; nwg = nM * nN; G = G_; c = c_; }
    __host__ __device__ bool next(int i, Unit& u) const {
        const int L = i * G + c; if (L >= nwg) return false;
        int wgid = L; { const int q = nwg / NXCD, r = nwg % NXCD, xcd = wgid % NXCD, off = wgid / NXCD; wgid = (xcd < r ? xcd * (q + 1) : r * (q + 1) + (xcd - r) * q) + off; }
        const int nig = WGM * nN, gid = wgid / nig, fm = gid * WGM, gsz = (nM - fm) < WGM ? (nM - fm) : WGM;
        u.pm = fm + ((wgid % nig) % gsz); u.pn = (wgid % nig) / gsz; u.e = 0; u.ord = i; u.ks = 0; return true;
    }
    __device__ __forceinline__ void a_ready(const Unit&) const {}
    __device__ __forceinline__ void done(const Unit&) const {}
    __device__ __forceinline__ int kloop(int K) const { return K; }
    __device__ __forceinline__ size_t koff(const Unit&) const { return 0; }
};


__device__ __forceinline__ unsigned cvt_pk_bf16(float lo, float hi) { unsigned r; asm volatile("v_cvt_pk_bf16_f32 %0, %1, %2" : "=v"(r) : "v"(lo), "v"(hi)); return r; }
__device__ __forceinline__ float row_rinv(const float* ssq, int row) {
    const f32x4* p = (const f32x4*)(ssq + (size_t)row * 16);
    const f32x4 a = p[0], b = p[1], c = p[2], d = p[3];
    const float s = ((a[0] + a[1]) + (a[2] + a[3])) + ((b[0] + b[1]) + (b[2] + b[3])) + ((c[0] + c[1]) + (c[2] + c[3])) + ((d[0] + d[1]) + (d[2] + d[3]));
    return 1.0f / sqrtf(s * (1.0f / 1024.0f) + 1e-6f);
}
struct EpiRowScaleBf16 {
    static constexpr bool PERM = true, AFTER_DRAIN = false;
    bf16_t* O; int ldc; const PG8_LAS float* rtab; float mul;
    __device__ __forceinline__ void operator()(const f32x4 (&acc)[2][2][4][2], const Unit& u, int wr, int wc, int fr, int fq) const {
        const int row0 = u.pm * BM + wr * 64 + fr, col0 = u.pn * BM + wc * 32 + 8 * fq;
#pragma unroll
        for (int ai = 0; ai < 2; ++ai)
#pragma unroll
            for (int m = 0; m < 4; ++m) {
                const int row = row0 + ai * HALF + m * 16;
                const float rs = (rtab ? rtab[u.ord * 256 + (row - u.pm * BM)] : 1.0f) * mul;
                bf16_t* rowp = O + (size_t)row * ldc + col0;
#pragma unroll
                for (int bj = 0; bj < 2; ++bj) {
                    const f32x4 v0 = acc[ai][bj][m][0] * rs, v1 = acc[ai][bj][m][1] * rs;
                    u32x4 w; w.x = cvt_pk_bf16(v0[0], v0[1]); w.y = cvt_pk_bf16(v0[2], v0[3]); w.z = cvt_pk_bf16(v1[0], v1[1]); w.w = cvt_pk_bf16(v1[2], v1[3]);
                    *(u32x4*)(rowp + bj * HALF) = w;
                }
            }
    }
};
struct EpiColScaleBf16 {
    static constexpr bool PERM = true, AFTER_DRAIN = false;
    bf16_t* O; int ldc; const float* cs;
    __device__ __forceinline__ void operator()(const f32x4 (&acc)[2][2][4][2], const Unit& u, int wr, int wc, int fr, int fq) const {
        const int row0 = u.pm * BM + wr * 64 + fr, col0 = u.pn * BM + wc * 32 + 8 * fq;
        f32x4 sc[2][2];
#pragma unroll
        for (int bj = 0; bj < 2; ++bj)
#pragma unroll
            for (int n = 0; n < 2; ++n) sc[bj][n] = *(const f32x4*)(cs + col0 + bj * HALF + 4 * n);
#pragma unroll
        for (int ai = 0; ai < 2; ++ai)
#pragma unroll
            for (int m = 0; m < 4; ++m) {
                bf16_t* rowp = O + (size_t)(row0 + ai * HALF + m * 16) * ldc + col0;
#pragma unroll
                for (int bj = 0; bj < 2; ++bj) {
                    const f32x4 v0 = acc[ai][bj][m][0] * sc[bj][0], v1 = acc[ai][bj][m][1] * sc[bj][1];
                    u32x4 w; w.x = cvt_pk_bf16(v0[0], v0[1]); w.y = cvt_pk_bf16(v0[2], v0[3]); w.z = cvt_pk_bf16(v1[0], v1[1]); w.w = cvt_pk_bf16(v1[2], v1[3]);
                    *(u32x4*)(rowp + bj * HALF) = w;
                }
            }
    }
};
struct EpiResid {
    static constexpr bool PERM = false, AFTER_DRAIN = false;
    bf16_t* XB; float* ssq;
    __device__ __forceinline__ void operator()(const f32x4 (&acc)[2][2][4][2], const Unit& u, int wr, int wc, int fr, int fq) const {
        const int row0 = u.pm * BM + wr * 64 + fr, col0 = u.pn * BM + wc * 32 + 4 * fq;
        typedef unsigned u32x2v __attribute__((ext_vector_type(2)));
#pragma unroll
        for (int ai = 0; ai < 2; ++ai)
#pragma unroll
            for (int m = 0; m < 4; ++m) {
                const int row = row0 + ai * HALF + m * 16;
                bf16_t* br = XB + (size_t)row * 1024 + col0;
                float q = 0.f;
#pragma unroll
                for (int bj = 0; bj < 2; ++bj)
#pragma unroll
                    for (int n = 0; n < 2; ++n) {
                        const u32x2v o = *(const u32x2v*)(br + bj * HALF + n * 16);
                        f32x4 x = {__uint_as_float(o.x << 16), __uint_as_float(o.x & 0xffff0000u), __uint_as_float(o.y << 16), __uint_as_float(o.y & 0xffff0000u)};
                        x = x + acc[ai][bj][m][n];
                        q += (x[0] * x[0] + x[1] * x[1]) + (x[2] * x[2] + x[3] * x[3]);
                        u32x2v w; w.x = cvt_pk_bf16(x[0], x[1]); w.y = cvt_pk_bf16(x[2], x[3]);
                        *(u32x2v*)(br + bj * HALF + n * 16) = w;
                    }
                q += shx(q, fq * 16 + fr, 16); q += shx(q, fq * 16 + fr, 32);
                if (fq == 0) ssq[(size_t)row * 16 + u.pn * 4 + wc] = q;
                asm volatile("" ::: "memory");
            }
    }
};
struct EpiSwiGLU {
    static constexpr bool PERM = true, AFTER_DRAIN = false;
    bf16_t* O; int ldc; const PG8_LAS float* rtab;
    __device__ __forceinline__ void operator()(const f32x4 (&acc)[2][2][4][2], const Unit& u, int wr, int wc, int fr, int fq) const {
        const int row0 = u.pm * BM + wr * 64 + fr, col0 = u.pn * HALF + wc * 32 + 8 * fq;
#pragma unroll
        for (int ai = 0; ai < 2; ++ai)
#pragma unroll
            for (int m = 0; m < 4; ++m) {
                const int row = row0 + ai * HALF + m * 16;
                const float rs = rtab ? rtab[u.ord * 256 + (row - u.pm * BM)] : 1.0f;
                float o[8];
#pragma unroll
                for (int n = 0; n < 2; ++n)
#pragma unroll
                    for (int e = 0; e < 4; ++e) {
                        const float gg = acc[ai][0][m][n][e] * rs, uu = acc[ai][1][m][n][e] * rs;
                        o[n * 4 + e] = gg * __builtin_amdgcn_rcpf(1.0f + __builtin_amdgcn_exp2f(gg * -1.4426950408889634f)) * uu;
                    }
                u32x4 w; w.x = cvt_pk_bf16(o[0], o[1]); w.y = cvt_pk_bf16(o[2], o[3]); w.z = cvt_pk_bf16(o[4], o[5]); w.w = cvt_pk_bf16(o[6], o[7]);
                *(u32x4*)(O + (size_t)row * ldc + col0) = w;
            }
    }
};

struct EpiSwiGLU8 {
    static constexpr bool PERM = true, AFTER_DRAIN = false;
    unsigned char* O; int ldc; float osc;
    __device__ __forceinline__ void operator()(const f32x4 (&acc)[2][2][4][2], const Unit& u, int wr, int wc, int fr, int fq) const {
        const int row0 = u.pm * BM + wr * 64 + fr, col0 = u.pn * HALF + wc * 32 + 8 * fq;
        typedef unsigned u32x2v __attribute__((ext_vector_type(2)));
#pragma unroll
        for (int ai = 0; ai < 2; ++ai)
#pragma unroll
            for (int m = 0; m < 4; ++m) {
                const int row = row0 + ai * HALF + m * 16;
                float o[8];
#pragma unroll
                for (int n = 0; n < 2; ++n)
#pragma unroll
                    for (int e = 0; e < 4; ++e) {
                        const float gg = acc[ai][0][m][n][e], uu = acc[ai][1][m][n][e] * osc;
                        o[n * 4 + e] = gg * __builtin_amdgcn_rcpf(1.0f + __builtin_amdgcn_exp2f(gg * -1.4426950408889634f)) * uu;
                    }
                u32x2v w; w.x = pk4_fp8(o[0], o[1], o[2], o[3]); w.y = pk4_fp8(o[4], o[5], o[6], o[7]);
                *(u32x2v*)(O + (size_t)row * ldc + col0) = w;
            }
    }
};
struct EpiSwiGLU8R {
    static constexpr bool PERM = true, AFTER_DRAIN = false;
    unsigned char* O; int ldc; const PG8_LAS float* rtab; float osc;
    __device__ __forceinline__ void operator()(const f32x4 (&acc)[2][2][4][2], const Unit& u, int wr, int wc, int fr, int fq) const {
        const int row0 = u.pm * BM + wr * 64 + fr, col0 = u.pn * HALF + wc * 32 + 8 * fq;
        typedef unsigned u32x2v __attribute__((ext_vector_type(2)));
#pragma unroll
        for (int ai = 0; ai < 2; ++ai)
#pragma unroll
            for (int m = 0; m < 4; ++m) {
                const int row = row0 + ai * HALF + m * 16;
                const float rs = rtab[u.ord * 256 + (row - u.pm * BM)];
                float o[8];
#pragma unroll
                for (int n = 0; n < 2; ++n)
#pragma unroll
                    for (int e = 0; e < 4; ++e) {
                        const float gg = acc[ai][0][m][n][e] * rs, uu = acc[ai][1][m][n][e] * (rs * osc);
                        o[n * 4 + e] = gg * __builtin_amdgcn_rcpf(1.0f + __builtin_amdgcn_exp2f(gg * -1.4426950408889634f)) * uu;
                    }
                u32x2v w; w.x = pk4_fp8(o[0], o[1], o[2], o[3]); w.y = pk4_fp8(o[4], o[5], o[6], o[7]);
                *(u32x2v*)(O + (size_t)row * ldc + col0) = w;
            }
    }
};
struct EpiMoeDown {
    static constexpr bool PERM = true, AFTER_DRAIN = false;
    bf16_t* Y2; const int* rinfo; const float* rg;
    __device__ __forceinline__ void operator()(const f32x4 (&acc)[2][2][4][2], const Unit& u, int wr, int wc, int fr, int fq) const {
        const int row0 = u.pm * BM + wr * 64 + fr, col0 = u.pn * BM + wc * 32 + 8 * fq;
#pragma unroll
        for (int ai = 0; ai < 2; ++ai)
#pragma unroll
            for (int m = 0; m < 4; ++m) {
                const int row = row0 + ai * HALF + m * 16;
                const int t2 = rinfo[row];
                if (t2 >= 0) {
                    const float gte = rg[row];
                    bf16_t* rowp = Y2 + (size_t)t2 * 1024 + col0;
#pragma unroll
                    for (int bj = 0; bj < 2; ++bj) {
                        const f32x4 v0 = acc[ai][bj][m][0] * gte, v1 = acc[ai][bj][m][1] * gte;
                        u32x4 w; w.x = cvt_pk_bf16(v0[0], v0[1]); w.y = cvt_pk_bf16(v0[2], v0[3]); w.z = cvt_pk_bf16(v1[0], v1[1]); w.w = cvt_pk_bf16(v1[2], v1[3]);
                        *(u32x4*)(rowp + bj * HALF) = w;
                    }
                }
                asm volatile("" ::: "memory");
            }
    }
};
struct MoeOrder {
    int nM, nN, nwg, G, c, pm_lo; const int* tile_e;
    __device__ void init(int nM_, int nN_, int G_, int c_, int pm_lo_, const int* te) { nM = nM_; nN = nN_; nwg = nM * nN; G = G_; c = c_; pm_lo = pm_lo_; tile_e = te; }
    __device__ bool next(int i, Unit& u) const {
        const int L = i * G + c; if (L >= nwg) return false;
        int wgid = L; { const int q = nwg / NXCD, r = nwg % NXCD, xcd = wgid % NXCD, off = wgid / NXCD; wgid = (xcd < r ? xcd * (q + 1) : r * (q + 1) + (xcd - r) * q) + off; }
        const int nig = WGM * nN, gid = wgid / nig, fm = gid * WGM, gsz = (nM - fm) < WGM ? (nM - fm) : WGM;
        u.pm = fm + ((wgid % nig) % gsz); u.pn = (wgid % nig) / gsz; u.e = ((const __attribute__((address_space(4))) int*)(uintptr_t)tile_e)[pm_lo + u.pm]    ; u.ord = i; u.ks = 0; return true;
    }
    __device__ __forceinline__ void a_ready(const Unit&) const {}
    __device__ __forceinline__ void done(const Unit&) const {}
    __device__ __forceinline__ int kloop(int K) const { return K; }
    __device__ __forceinline__ size_t koff(const Unit&) const { return 0; }
};
struct MoeSplitOrder {
    int nM, nwg, G, c, pm_lo, NS, KS; const int* tile_e;
    __device__ void init(int nM_, int G_, int c_, int pm_lo_, const int* te, int NS_, int KS_) { nM = nM_; NS = NS_; KS = KS_; nwg = nM * 4 * NS; G = G_; c = c_; pm_lo = pm_lo_; tile_e = te; }
    __device__ bool next(int i, Unit& u) const {
        const int L = i * G + c; if (L >= nwg) return false;
        const int w = L, tile = w / NS; u.ks = w - tile * NS; u.pm = tile >> 2; u.pn = tile & 3;
        u.e = ((const __attribute__((address_space(4))) int*)(uintptr_t)tile_e)[pm_lo + u.pm]    ; u.ord = i; return true;
    }
    __device__ __forceinline__ void a_ready(const Unit&) const {}
    __device__ __forceinline__ void done(const Unit&) const {}
    __device__ __forceinline__ int kloop(int) const { return KS; }
    __device__ __forceinline__ size_t koff(const Unit& u) const { return (size_t)u.ks * KS * 2; }
};
struct EpiSplitF32 {
    static constexpr bool PERM = true, AFTER_DRAIN = false;
    float* PART; const int* rinfo; int nrows;
    __device__ __forceinline__ void operator()(const f32x4 (&acc)[2][2][4][2], const Unit& u, int wr, int wc, int fr, int fq) const {
        const int row0 = u.pm * BM + wr * 64 + fr, col0 = u.pn * BM + wc * 32 + 8 * fq;
#pragma unroll
        for (int ai = 0; ai < 2; ++ai)
#pragma unroll
            for (int m = 0; m < 4; ++m) {
                const int row = row0 + ai * HALF + m * 16;
                if (rinfo[row] >= 0) {
                    float* rowp = PART + ((size_t)u.ks * nrows + row) * 1024 + col0;
#pragma unroll
                    for (int bj = 0; bj < 2; ++bj) { *(f32x4*)(rowp + bj * HALF) = acc[ai][bj][m][0]; *(f32x4*)(rowp + bj * HALF + 4) = acc[ai][bj][m][1]; }
                }
                asm volatile("" ::: "memory");
            }
    }
};
template <class Epi, class Sched, bool ALIGN_EPI = false, bool SP2 = false, bool FP8 = false, int DBG = 0, bool ROT = false>
__device__ __forceinline__ void gemm_phase(PG8_LAS unsigned char* lds, const Gemm g, const Sched& S, const Epi& E, const int tid_in, const int sa = 127, const int sb = 127) {
    const int tid = tid_in, wid = __builtin_amdgcn_readfirstlane(tid >> 6), lane = tid & 63, wr = wid >> 2, wc = wid & 3, fr = lane & 15, fq = lane >> 4;
    const int K = g.K; int nt = S.kloop(K) / BK;
    if constexpr (FP8) asm volatile("" : "+s"(nt));
    unsigned voffA[2], voffB[2];
#pragma unroll
    for (int i = 0; i < 2; ++i) { int R, C; stage_rc(tid * 16 + i * 8192, R, C); const int Rb = Epi::PERM ? ((R & ~31) + perm32(R & 31)) : R;
        voffA[i] = (unsigned)(R * K + C) * 2u; voffB[i] = (unsigned)(Rb * K + C) * 2u; }
    const size_t kstep = (size_t)(BK * 2);
    const size_t hstep = (size_t)HALF * K * 2;
    const size_t tstep = 2 * hstep;
    const unsigned ldsw = (unsigned)wid * 1024u;
    const int aoff = lds_byte(wr * 64 + fr, fq * 8), boff = lds_byte(wc * 32 + fr, fq * 8);
#define PG8_SA(b, h) (((b) * 2 + (h)) * HTB)
#define PG8_SB(b, h) ((4 + (b) * 2 + (h)) * HTB)
#define PG8_STAGE(bufoff, gbase, voff) do { if constexpr (DBG != 1) _Pragma("unroll") for (int _i = 0; _i < 2; ++_i) { unsigned vo_ = (voff)[_i]; asm volatile("" : "+v"(vo_));     \
        __builtin_amdgcn_global_load_lds((const unsigned*)((const char*)(gbase) + vo_), (PG8_LAS unsigned*)(lds + (bufoff) + ldsw + _i * 8192), 16, 0, 0); } } while (0)
    typedef int i32x4_ __attribute__((ext_vector_type(4))); typedef int i32x8_ __attribute__((ext_vector_type(8)));
#define PG8_LD8(P) __builtin_shufflevector(*(const PG8_LAS i32x4_*)(P), *(const PG8_LAS i32x4_*)((P) + 1024), 0, 1, 2, 3, 4, 5, 6, 7)
#define PG8_LDA(dst, b, h) do { if constexpr (DBG != 3) _Pragma("unroll") for (int m = 0; m < 4; ++m) { if constexpr (FP8) dst##8[m] = PG8_LD8(lds + PG8_SA(b, h) + aoff + m * 2048); else { _Pragma("unroll") for (int k = 0; k < 2; ++k) dst[m][k] = *(const PG8_LAS bf16x8*)(lds + PG8_SA(b, h) + aoff + m * 2048 + k * 1024); } } } while (0)
#define PG8_LDB(dst, b, h) do { if constexpr (DBG != 3) _Pragma("unroll") for (int n = 0; n < 2; ++n) { if constexpr (FP8) dst##8[n] = PG8_LD8(lds + PG8_SB(b, h) + boff + n * 2048); else { _Pragma("unroll") for (int k = 0; k < 2; ++k) dst[n][k] = *(const PG8_LAS bf16x8*)(lds + PG8_SB(b, h) + boff + n * 2048 + k * 1024); } } } while (0)
#define PG8_MMA(ai, bj, At, Bt) do { __builtin_amdgcn_s_setprio(1); if constexpr (DBG != 2) _Pragma("unroll") for (int m = 0; m < 4; ++m) _Pragma("unroll") for (int n = 0; n < 2; ++n) { \
        if constexpr (FP8) acc[ai][bj][m][n] = __builtin_amdgcn_mfma_scale_f32_16x16x128_f8f6f4(Bt##8[n], At##8[m], acc[ai][bj][m][n], 0, 0, 0, sb, 0, sa); \
        else { _Pragma("unroll") for (int k = 0; k < 2; ++k) acc[ai][bj][m][n] = __builtin_amdgcn_mfma_f32_16x16x32_bf16(Bt[n][k], At[m][k], acc[ai][bj][m][n], 0, 0, 0); } } \
        __builtin_amdgcn_s_setprio(0); } while (0)
#define PG8_WAIT_V(n) asm volatile("s_waitcnt vmcnt(" #n ")" ::: "memory")
#define PG8_WAIT_L(n) asm volatile("s_waitcnt lgkmcnt(" #n ")" ::: "memory")
#define PG8_BAR __builtin_amdgcn_s_barrier()
#define PG8_SCHED __builtin_amdgcn_sched_barrier(0)
    Unit cur, nxt; int ui = 0;
    if (!S.next(0, cur)) return;
    f32x4 acc[2][2][4][2];
#pragma unroll
    for (int a = 0; a < 2; ++a)
#pragma unroll
        for (int b = 0; b < 2; ++b)
#pragma unroll
            for (int m = 0; m < 4; ++m)
#pragma unroll
                for (int n = 0; n < 2; ++n) acc[a][b][m][n] = (f32x4){0.f, 0.f, 0.f, 0.f};
    bf16x8 At[4][2], B0[2][2], B1[2][2]; i32x8_ At8[4], B08[2], B18[2];
    const char* cA = (const char*)g.A + (size_t)cur.pm * tstep + S.koff(cur); const char* cB = (const char*)g.Bt + (size_t)cur.e * g.bstride + (size_t)cur.pn * tstep + S.koff(cur);
    S.a_ready(cur);
    const auto ktb = [&](int x, int r) -> size_t { int v = x + r; if (v >= nt) v -= nt; return (size_t)v * kstep; };
    int rot = ROT ? ((cur.pm + cur.pn) & 3) : 0;
    const size_t p0_ = ktb(0, rot), p1_ = ktb(1, rot);
    if constexpr (SP2) {
        PG8_STAGE(PG8_SB(0, 0), cB + p0_, voffB); PG8_STAGE(PG8_SB(0, 1), cB + p0_ + hstep, voffB); PG8_STAGE(PG8_SA(0, 0), cA + p0_, voffA); PG8_STAGE(PG8_SA(0, 1), cA + p0_ + hstep, voffA);
        if (wr == 1) PG8_BAR;
        PG8_WAIT_V(2); PG8_BAR;
        PG8_STAGE(PG8_SB(1, 0), cB + p1_, voffB); PG8_STAGE(PG8_SA(1, 0), cA + p1_, voffA); PG8_STAGE(PG8_SB(1, 1), cB + hstep + p1_, voffB);
        PG8_WAIT_V(6); PG8_BAR;
    } else {
        PG8_STAGE(PG8_SB(0, 0), cB + p0_, voffB); PG8_STAGE(PG8_SA(0, 0), cA + p0_, voffA); PG8_STAGE(PG8_SB(0, 1), cB + p0_ + hstep, voffB); PG8_STAGE(PG8_SA(0, 1), cA + p0_ + hstep, voffA);
        if (wr == 1) PG8_BAR;
        PG8_WAIT_V(4); PG8_BAR;
        PG8_STAGE(PG8_SB(1, 0), cB + p1_, voffB); PG8_STAGE(PG8_SA(1, 0), cA + p1_, voffA); PG8_STAGE(PG8_SB(1, 1), cB + hstep + p1_, voffB);
        PG8_WAIT_V(6); PG8_BAR;
    }
    for (;;) {
        const bool has_next = S.next(ui + 1, nxt);
        const char* nA = has_next ? (const char*)g.A + (size_t)nxt.pm * tstep + S.koff(nxt) : cA; const char* nB = has_next ? (const char*)g.Bt + (size_t)nxt.e * g.bstride + (size_t)nxt.pn * tstep + S.koff(nxt) : cB;
        const int rotn = (ROT && has_next) ? ((nxt.pm + nxt.pn) & 3) : rot;
        for (int t = 0; t < nt; t += 2) {
            const bool last = (t == nt - 2);
            const char* a1 = cA + ktb(t + 1, rot);
            const size_t o2 = last ? ktb(0, rotn) : ktb(t + 2, rot), o3 = last ? ktb(1, rotn) : ktb(t + 3, rot);
            const char* a2 = (last ? nA : cA) + o2; const char* b2 = (last ? nB : cB) + o2;
            const char* a3 = (last ? nA : cA) + o3; const char* b3 = (last ? nB : cB) + o3;
            if (last && has_next) S.a_ready(nxt);
            if constexpr (SP2) {
            PG8_LDB(B0, 0, 0); PG8_LDB(B1, 0, 1); PG8_SCHED; PG8_LDA(At, 0, 0); PG8_STAGE(PG8_SA(1, 1), a1 + hstep, voffA);
            PG8_WAIT_V(8); PG8_WAIT_L(0); PG8_BAR; PG8_MMA(0, 0, At, B0); PG8_MMA(0, 1, At, B1); PG8_BAR; PG8_SCHED;
            PG8_LDA(At, 0, 1); PG8_STAGE(PG8_SB(0, 0), b2, voffB); PG8_STAGE(PG8_SB(0, 1), b2 + hstep, voffB); PG8_STAGE(PG8_SA(0, 0), a2, voffA);
            PG8_WAIT_V(8); PG8_WAIT_L(0); PG8_BAR; PG8_MMA(1, 0, At, B0); PG8_MMA(1, 1, At, B1); PG8_BAR; PG8_SCHED;
            PG8_LDB(B0, 1, 0); PG8_LDB(B1, 1, 1); PG8_SCHED; PG8_LDA(At, 1, 0); PG8_STAGE(PG8_SA(0, 1), a2 + hstep, voffA);
            PG8_WAIT_V(8); PG8_WAIT_L(0); PG8_BAR; PG8_MMA(0, 0, At, B0); PG8_MMA(0, 1, At, B1); PG8_BAR; PG8_SCHED;
            PG8_LDA(At, 1, 1); PG8_STAGE(PG8_SB(1, 0), b3, voffB); PG8_STAGE(PG8_SB(1, 1), b3 + hstep, voffB); PG8_STAGE(PG8_SA(1, 0), a3, voffA);
            PG8_WAIT_V(8); PG8_WAIT_L(0); PG8_BAR; PG8_MMA(1, 0, At, B0); PG8_MMA(1, 1, At, B1); PG8_BAR; PG8_SCHED;
            } else {
            PG8_LDB(B0, 0, 0); PG8_SCHED; PG8_LDA(At, 0, 0); PG8_STAGE(PG8_SA(1, 1), a1 + hstep, voffA);
            PG8_WAIT_L(8); PG8_BAR; PG8_WAIT_L(0); PG8_MMA(0, 0, At, B0); PG8_BAR; PG8_SCHED;
            PG8_LDB(B1, 0, 1); PG8_STAGE(PG8_SB(0, 0), b2, voffB);
            PG8_BAR; PG8_WAIT_L(0); PG8_MMA(0, 1, At, B1); PG8_BAR;
            PG8_LDA(At, 0, 1); PG8_STAGE(PG8_SA(0, 0), a2, voffA);
            PG8_BAR; PG8_WAIT_L(0); PG8_MMA(1, 0, At, B0); PG8_BAR; PG8_SCHED;
            PG8_STAGE(PG8_SB(0, 1), b2 + hstep, voffB);
            PG8_WAIT_V(6); PG8_BAR; PG8_MMA(1, 1, At, B1); PG8_BAR;
            PG8_LDB(B0, 1, 0); PG8_SCHED; PG8_LDA(At, 1, 0); PG8_STAGE(PG8_SA(0, 1), a2 + hstep, voffA);
            PG8_WAIT_L(8); PG8_BAR; PG8_WAIT_L(0); PG8_MMA(0, 0, At, B0); PG8_BAR; PG8_SCHED;
            PG8_LDB(B1, 1, 1); PG8_STAGE(PG8_SB(1, 0), b3, voffB);
            PG8_BAR; PG8_WAIT_L(0); PG8_MMA(0, 1, At, B1); PG8_BAR;
            PG8_LDA(At, 1, 1); PG8_STAGE(PG8_SA(1, 0), a3, voffA);
            PG8_BAR; PG8_WAIT_L(0); PG8_MMA(1, 0, At, B0); PG8_BAR; PG8_SCHED;
            PG8_STAGE(PG8_SB(1, 1), b3 + hstep, voffB);
            PG8_WAIT_V(6); PG8_BAR; PG8_MMA(1, 1, At, B1); PG8_BAR;
            }
        }
        if constexpr (ALIGN_EPI) { if (wr == 0) PG8_BAR; }
        if constexpr (!Epi::AFTER_DRAIN) {
            if constexpr (FP8) { int l2; asm volatile("v_mbcnt_lo_u32_b32 %0, -1, 0\n\tv_mbcnt_hi_u32_b32 %0, -1, %0" : "=v"(l2)); E(acc, cur, wr, wc, l2 & 15, l2 >> 4); }
            else E(acc, cur, wr, wc, fr, fq);
            S.done(cur); }
        if (!has_next) break;
#pragma unroll
        for (int a = 0; a < 2; ++a)
#pragma unroll
            for (int b = 0; b < 2; ++b)
#pragma unroll
                for (int m = 0; m < 4; ++m)
#pragma unroll
                    for (int n = 0; n < 2; ++n) acc[a][b][m][n] = (f32x4){0.f, 0.f, 0.f, 0.f};
        cur = nxt; cA = nA; cB = nB; rot = rotn; ++ui;
        if constexpr (ALIGN_EPI) { if (wr == 1) PG8_BAR; }
    }
    PG8_WAIT_V(0);
    if constexpr (!ALIGN_EPI) { if (wr == 0) PG8_BAR; }
    PG8_BAR;
    if constexpr (Epi::AFTER_DRAIN) { E.fused(acc, cur, wr, wc, fr, fq, lds, wid, lane); S.done(cur); }
#undef PG8_SA
#undef PG8_SB
#undef PG8_STAGE
#undef PG8_LDA
#undef PG8_LDB
#undef PG8_MMA
#undef PG8_WAIT_V
#undef PG8_WAIT_L
#undef PG8_BAR
#undef PG8_SCHED
}
}
#define GAS __attribute__((address_space(1)))
typedef unsigned v4u __attribute__((ext_vector_type(4)));
typedef GAS unsigned gu32;
typedef GAS unsigned long long gu64;
__device__ __forceinline__ const float* gin(const float* p) { return (const float*)(const GAS float*)p; }
#define RLX_AGENT __ATOMIC_RELAXED, __HIP_MEMORY_SCOPE_AGENT
#define LDS_WAIT() asm volatile("s_waitcnt lgkmcnt(0)" ::: "memory")
#define VM_WAIT() asm volatile("s_waitcnt vmcnt(0)" ::: "memory")
#define XB_TMO      128
#define XB_XCNT(j)  (256  + 64 * (j))
#define XB_XSUB(j)  (1280 + 64 * (j))
#define XB_XGEN(j)  (2304 + 64 * (j))
#define XB_TOP      3328
#define XB_TOPGEN   3392
#define XCD_BAR_WORDS 3456
#define XB_SPIN_CAP (1u << 18)

__device__ __forceinline__ unsigned xb_ld(unsigned* p)              { return __hip_atomic_load(p, __ATOMIC_RELAXED, __HIP_MEMORY_SCOPE_AGENT); }
__device__ __forceinline__ unsigned xb_add(unsigned* p, unsigned v) { return __hip_atomic_fetch_add(p, v, __ATOMIC_RELAXED, __HIP_MEMORY_SCOPE_AGENT); }
__device__ __forceinline__ unsigned xb_xcc_id() { return (unsigned)__builtin_amdgcn_s_getreg((3 << 11) | 20) & 0xFu; }
#define XB_SPIN(cond, bar) do { unsigned _sp = 0; while (cond) { __builtin_amdgcn_s_sleep(1); \
    if ((++_sp & 255u) == 0u) { if (xb_ld(&(bar)[XB_TMO])) break; if (_sp > XB_SPIN_CAP) { atomicAdd(&(bar)[XB_TMO], 1u); break; } } } } while (0)

struct XcdBarrier {
    unsigned* bar; unsigned x;
    volatile LAS unsigned* st;
};

__device__ __forceinline__ XcdBarrier xcd_barrier_post(unsigned* bar, volatile LAS unsigned* st) {
    XcdBarrier b; b.bar = bar; b.x = xb_xcc_id(); b.st = st;
    if (threadIdx.x == 0) (void)xb_add(&bar[XB_XCNT(b.x)], 1u);
    return b;
}
__device__ __forceinline__ void xcd_barrier_complete(unsigned* bar, unsigned x, unsigned& nloc, unsigned& nx) {
    const unsigned G = gridDim.x * gridDim.y * gridDim.z;
    unsigned sum, cnt, mine, sp = 0u;
    for (;;) {
        sum = 0u; cnt = 0u; mine = 0u;
#pragma unroll
        for (unsigned j = 0; j < 16; ++j) { const unsigned c = xb_ld(&bar[XB_XCNT(j)]); sum += c; cnt += (c > 0u) ? 1u : 0u; mine = (j == x) ? c : mine; }
        if (sum == G) break;
        __builtin_amdgcn_s_sleep(1);
        if ((++sp & 255u) == 0u) { if (xb_ld(&bar[XB_TMO])) break; if (sp > XB_SPIN_CAP) { atomicAdd(&bar[XB_TMO], 1u); break; } }
    }
    nloc = mine > 0u ? mine : 1u; nx = cnt > 0u ? cnt : 1u;
}

__device__ __forceinline__ void xcd_barrier(const XcdBarrier& b) {
    asm volatile("s_waitcnt vmcnt(0)" ::: "memory");
    __syncthreads();
    if (threadIdx.x == 0) {
        unsigned* bar = b.bar;
        __builtin_amdgcn_s_waitcnt(0);
        unsigned nloc = b.st[0], nx = b.st[1];
        if (nloc == 0u) { xcd_barrier_complete(bar, b.x, nloc, nx); b.st[0] = nloc; b.st[1] = nx; }
        const unsigned old = xb_add(&bar[XB_XSUB(b.x)], 1u);
        const unsigned gen = old / nloc;
        if (old + 1u == (gen + 1u) * nloc) {
            __builtin_amdgcn_fence(__ATOMIC_RELEASE, "agent");
            asm volatile("s_waitcnt vmcnt(0)" ::: "memory");
            const unsigned og = xb_add(&bar[XB_TOP], 1u);
            const unsigned tg = og / nx;
            if (og + 1u == (tg + 1u) * nx) xb_add(&bar[XB_TOPGEN], 1u);
            else XB_SPIN(xb_ld(&bar[XB_TOPGEN]) == tg, bar);
            __builtin_amdgcn_fence(__ATOMIC_ACQUIRE, "agent");
            xb_add(&bar[XB_XGEN(b.x)], 1u);
            asm volatile("s_waitcnt vmcnt(0)" ::: "memory");
        } else {
            XB_SPIN(xb_ld(&bar[XB_XGEN(b.x)]) == gen, bar);
            __builtin_amdgcn_fence(__ATOMIC_ACQUIRE, "agent");
            asm volatile("s_waitcnt vmcnt(0)" ::: "memory");
        }
    }
    __syncthreads();
}

#define XB2_SLOT(x, i) (3456 + 256 * (x) + (i))
#define XB2_FLAG(j)    (3456 + 256 * 16 + 64 * (j))
__device__ __forceinline__ XcdBarrier xcd_barrier2_post(unsigned* bar, volatile LAS unsigned* st) {
    XcdBarrier b; b.bar = bar; b.x = xb_xcc_id(); b.st = st;
    if (threadIdx.x == 0) st[2] = xb_add(&bar[XB_XCNT(b.x)], 1u) + 1u;
    return b;
}
__device__ __forceinline__ void xcd_barrier2(const XcdBarrier& b, int wave) {
    asm volatile("s_waitcnt vmcnt(0)" ::: "memory");
    __syncthreads();
    if (wave == 0) {
        unsigned* bar = b.bar; unsigned lane; asm volatile("v_mbcnt_lo_u32_b32 %0, -1, 0\n\tv_mbcnt_hi_u32_b32 %0, -1, %0" : "=v"(lane));
        __builtin_amdgcn_s_waitcnt(0);
        unsigned nloc = b.st[0], mask = b.st[1];
        if (nloc == 0u) {
            const unsigned G = gridDim.x * gridDim.y * gridDim.z; unsigned sp = 0u;
            for (;;) {
                unsigned sum = 0u, mine = 0u; mask = 0u;
#pragma unroll
                for (unsigned j = 0; j < 16; ++j) { const unsigned c = xb_ld(&bar[XB_XCNT(j)]); sum += c; mask |= (c > 0u) ? (1u << j) : 0u; mine = (j == b.x) ? c : mine; }
                nloc = mine;
                if (sum == G) break;
                __builtin_amdgcn_s_sleep(1);
                if ((++sp & 255u) == 0u) { if (xb_ld(&bar[XB_TMO])) break; if (sp > XB_SPIN_CAP) { atomicAdd(&bar[XB_TMO], 1u); break; } }
            }
            nloc = nloc > 0u ? nloc : 1u;
            if (lane == 0) { b.st[0] = nloc; b.st[1] = mask; }
        }
        const unsigned idx = b.st[2] - 1u, g = b.st[3] + 1u;
        if (lane == 0) (void)xb_add(&bar[XB2_SLOT(b.x, idx)], 1u);
        if (idx == 0u) {
            unsigned sp = 0u;
            for (;;) {
                bool ok = true;
                for (unsigned i = lane; i < nloc; i += 64u) ok = ok && ((int)(xb_ld(&bar[XB2_SLOT(b.x, i)]) - g) >= 0);
                if (__builtin_amdgcn_ballot_w64(!ok) == 0ull) break;
                __builtin_amdgcn_s_sleep(1);
                if ((++sp & 255u) == 0u) { if (xb_ld(&bar[XB_TMO])) break; if (sp > XB_SPIN_CAP) { atomicAdd(&bar[XB_TMO], 1u); break; } }
            }
            __builtin_amdgcn_fence(__ATOMIC_RELEASE, "agent");
            asm volatile("s_waitcnt vmcnt(0)" ::: "memory");
            if (lane == 0) (void)xb_add(&bar[XB2_FLAG(b.x)], 1u);
        }
        {
            unsigned sp = 0u;
            for (;;) {
                const bool ok = (lane < 16u && ((mask >> lane) & 1u)) ? ((int)(xb_ld(&bar[XB2_FLAG(lane)]) - g) >= 0) : true;
                if (__builtin_amdgcn_ballot_w64(!ok) == 0ull) break;
                __builtin_amdgcn_s_sleep(1);
                if ((++sp & 255u) == 0u) { if (xb_ld(&bar[XB_TMO])) break; if (sp > XB_SPIN_CAP) { atomicAdd(&bar[XB_TMO], 1u); break; } }
            }
        }
        __builtin_amdgcn_fence(__ATOMIC_ACQUIRE, "agent");
        asm volatile("s_waitcnt vmcnt(0)" ::: "memory");
        if (lane == 0) b.st[3] = g;
    }
    __syncthreads();
}

constexpr int RING_OFF = 0, RING_BYTES = 131072;
constexpr int LDSCTL_OFF = RING_BYTES, MISC_OFF = LDSCTL_OFF + 320;
constexpr int LDS_BYTES = 147456;
constexpr int NWAVES = 8;
constexpr int CW_BAR = 4096;

struct Args { const float* in[40]; float* out; unsigned char* ws; int nph; int ph[63]; };

struct Frame {
    LAS unsigned char* lds;
    volatile LAS unsigned* MISC;
    int tid, lane, wave, vcu, G;
    const float* const* in;
    unsigned char* ws; float* out;
};

struct ConvRegs { f32x4_t v[8]; };
__device__ __forceinline__ void conv_load(ConvRegs& R, const float* W, int ldw, int coff, int nvalid, const float* g, int nblk, int item, int lane) {
    const int kb = item / nblk, nb = item % nblk, k0 = 64 * kb, n0 = 32 * nb;
    const int nn = n0 + (lane & 7) * 4, kr = lane >> 3;
#pragma unroll
    for (int i = 0; i < 8; ++i) {
        const int kk = k0 + 8 * i + kr;
        const float* src = W + (size_t)kk * ldw + coff + nn;
        f32x4_t v = {0.f, 0.f, 0.f, 0.f};
        if (nn + 3 < nvalid) { if ((((size_t)kk * ldw + coff + nn) & 3) == 0) v = __builtin_nontemporal_load((const f32x4_t*)src);     else { v.x = src[0]; v.y = src[1]; v.z = src[2]; v.w = src[3]; } }
        else { if (nn < nvalid) v.x = src[0]; if (nn + 1 < nvalid) v.y = src[1]; if (nn + 2 < nvalid) v.z = src[2]; }
        if (g) v = v * g[kk];
        R.v[i] = v;
    }
}
__device__ __forceinline__ void conv_load64(ConvRegs& R, const float* W, int ldw, const float* g, int nblk64, int sitem, int h, int lane) {
    const int kb = sitem / nblk64, nb = sitem % nblk64, k0 = 64 * kb + 32 * h + 8 * (lane >> 4), n0 = 64 * nb;
#pragma unroll
    for (int i = 0; i < 8; ++i) { f32x4_t v = *(const f32x4_t*)(W + (size_t)(k0 + i) * ldw + n0 + (lane & 15) * 4); if (g) v = v * g[k0 + i]; R.v[i] = v; }
}
__device__ __forceinline__ void conv_units64(const ConvRegs& R, LAS unsigned char* img, int h, int lane) {
    const int kc = 4 * h + (lane >> 4);
#pragma unroll
    for (int e = 0; e < 4; ++e) {
        u32x2_t o; o.x = pk4_fp8(R.v[0][e] * F8S_W, R.v[1][e] * F8S_W, R.v[2][e] * F8S_W, R.v[3][e] * F8S_W); o.y = pk4_fp8(R.v[4][e] * F8S_W, R.v[5][e] * F8S_W, R.v[6][e] * F8S_W, R.v[7][e] * F8S_W);
        *(LAS u32x2_t*)(img + (4 * (lane & 15) + e) * 72 + kc * 8) = o;
    }
}
__device__ __forceinline__ void conv_flush64(LAS unsigned char* img, unsigned char* dst, int K, int nblk64, int rowmode, int sitem, int lane) {
    const int kb = sitem / nblk64, nb = sitem % nblk64, n0 = 64 * nb;
    LDS_WAIT(); asm volatile("" ::: "memory");
#pragma unroll
    for (int j = 0; j < 4; ++j) {
        const int nl = (lane >> 2) + 16 * j, n = n0 + nl, q = lane & 3;
        const int drow = rowmode == 0 ? n : ((n >> 7) * 256 + (n & 127) + (rowmode == 2 ? 128 : 0));
        const u32x2_t lo = *(const LAS u32x2_t*)(img + nl * 72 + q * 16), hi = *(const LAS u32x2_t*)(img + nl * 72 + q * 16 + 8);
        *(GAS u32x4_t*)(dst + (size_t)drow * K + 64 * kb + 16 * q) = (u32x4_t){lo.x, lo.y, hi.x, hi.y};
    }
    LDS_WAIT(); asm volatile("" ::: "memory");
}
template <bool FP8 = false> __device__ __forceinline__ void conv_store(const ConvRegs& R, bf16_t* dst, int K, int nblk, int rowmode, LAS float* scr, int item, int lane) {
    const int kb = item / nblk, nb = item % nblk, k0 = 64 * kb, n0 = 32 * nb;
    const int nl4 = (lane & 7) * 4, kr = lane >> 3;
#pragma unroll
    for (int i = 0; i < 8; ++i) { LAS float* d = scr + (8 * i + kr) * 33 + nl4; d[0] = R.v[i].x; d[1] = R.v[i].y; d[2] = R.v[i].z; d[3] = R.v[i].w; }
    LDS_WAIT(); asm volatile("" ::: "memory");
    const int c = lane & 7;
#pragma unroll
    for (int j = 0; j < 4; ++j) {
        const int nl = (lane >> 3) + 8 * j, n = n0 + nl; const LAS float* s = scr + (8 * c) * 33 + nl;
        const int drow = rowmode == 0 ? n : ((n >> 7) * 256 + (n & 127) + (rowmode == 2 ? 128 : 0));
        if constexpr (FP8) {
            u32x2_t o; o.x = pk4_fp8(s[0 * 33] * F8S_W, s[1 * 33] * F8S_W, s[2 * 33] * F8S_W, s[3 * 33] * F8S_W); o.y = pk4_fp8(s[4 * 33] * F8S_W, s[5 * 33] * F8S_W, s[6 * 33] * F8S_W, s[7 * 33] * F8S_W);
            *(GAS u32x2_t*)((unsigned char*)dst + (size_t)drow * K + k0 + 8 * c) = o;
        } else {
            v4u o; o.x = pk2(s[0 * 33], s[1 * 33]); o.y = pk2(s[2 * 33], s[3 * 33]); o.z = pk2(s[4 * 33], s[5 * 33]); o.w = pk2(s[6 * 33], s[7 * 33]);
            *(GAS v4u*)(dst + (size_t)drow * K + k0 + 8 * c) = o;
        }
    }
    LDS_WAIT(); asm volatile("" ::: "memory");
}
template <bool FP8 = false> __device__ __forceinline__ void conv_matrix(const float* W, int ldw, int coff, int nvalid, const float* g, bf16_t* dst, int K, int nblk, int rowmode, LAS float* scr, int it0, int items, int NGW, int lane) {
    if (it0 >= items) return;
    ConvRegs A, B;
    conv_load(A, W, ldw, coff, nvalid, g, nblk, it0, lane);
    if (it0 + NGW < items) conv_load(B, W, ldw, coff, nvalid, g, nblk, it0 + NGW, lane);
#pragma nounroll
    for (int it = it0; it < items; it += 2 * NGW) {
        { ConvRegs C = A; if (it + 2 * NGW < items) conv_load(A, W, ldw, coff, nvalid, g, nblk, it + 2 * NGW, lane); conv_store<FP8>(C, dst, K, nblk, rowmode, scr, it, lane); }
        if (it + NGW < items) { ConvRegs C = B; if (it + 3 * NGW < items) conv_load(B, W, ldw, coff, nvalid, g, nblk, it + 3 * NGW, lane); conv_store<FP8>(C, dst, K, nblk, rowmode, scr, it + NGW, lane); }
    }
}
struct ConvJob { const float* W; const float* g; bf16_t* dst; int ldw, coff, nvalid, npad, K, rowmode, fp8; };
__device__ __forceinline__ ConvJob conv_job(const Frame& F, int j) {
    bf16_t* WB = (bf16_t*)(F.ws + WS_WB);
    ConvJob c; c.g = nullptr; c.coff = 0; c.rowmode = 0; c.K = 1024; c.ldw = D_; c.nvalid = D_; c.npad = D_; c.fp8 = 0;
    if (j < 16) {
        const int l = j >> 3, k = j & 7;
        switch (k) {
        case 0: { const int ncols = l == 0 ? 3096 : 3128; c.W = l == 0 ? gin(F.in[2]) : gin(F.in[3]); c.ldw = ncols; c.g = gin(F.in[6]) + l * D_; c.dst = WB + (WB_WIN / 2) + (size_t)l * NPJ * 1024;
                  if (l == 0) { c.nvalid = 3072; c.npad = 3072; } else { c.nvalid = 1792; c.npad = 1792; } } break;
        case 1: c.W = gin(F.in[25]) + (size_t)l * D_ * D_; c.dst = WB + (WB_WOUT / 2) + (size_t)l * D_ * D_; break;
        case 2: c.W = gin(F.in[28]) + (size_t)l * D_ * D_; c.g = gin(F.in[26]) + l * D_; c.dst = WB + (WB_WQ / 2) + (size_t)l * D_ * D_; break;
        case 3: c.W = gin(F.in[29]) + (size_t)l * D_ * 2048; c.ldw = 2048; c.g = gin(F.in[27]) + l * D_; c.dst = WB + (WB_WK / 2) + (size_t)l * D_ * D_; break;
        case 4: c.W = gin(F.in[29]) + (size_t)l * D_ * 2048; c.ldw = 2048; c.coff = 1024; c.g = gin(F.in[27]) + l * D_; c.dst = WB + (WB_WV / 2) + (size_t)l * D_ * D_; break;
        case 5: c.W = gin(F.in[30]) + (size_t)l * D_ * D_; c.dst = WB + (WB_WO / 2) + (size_t)l * D_ * D_; break;
        case 6: c.W = gin(F.in[20]) + (size_t)l * 2048 * 128; c.ldw = 128; c.nvalid = 128; c.npad = 128; c.K = 2048; c.dst = WB + (WB_CW1 / 2) + (size_t)(l * 2 + 0) * 128 * 2048; break;
        default: c.W = gin(F.in[23]) + (size_t)l * 2048 * 128; c.ldw = 128; c.nvalid = 128; c.npad = 128; c.K = 2048; c.dst = WB + (WB_CW1 / 2) + (size_t)(l * 2 + 1) * 128 * 2048; break;
        }
    } else if (j == 16) { c.W = gin(F.in[32]); c.ldw = FFD; c.nvalid = FFD; c.npad = FFD; c.g = gin(F.in[31]); c.dst = WB + (WB_WGU / 2); c.rowmode = 1; }
    else if (j == 17) { c.W = gin(F.in[33]); c.ldw = FFD; c.nvalid = FFD; c.npad = FFD; c.g = gin(F.in[31]); c.dst = WB + (WB_WGU / 2); c.rowmode = 2; }
    else if (j == 18) { c.W = gin(F.in[34]); c.K = FFD; c.dst = WB + (WB_WD / 2); c.fp8 = 1; }
    else {
        const int l = j == 19 ? 0 : 1, ncols = l == 0 ? 3096 : 3128;
        c.W = l == 0 ? gin(F.in[2]) : gin(F.in[3]); c.ldw = ncols; c.g = gin(F.in[6]) + l * D_;
        bf16_t* wsk = WB + (WB_WSK / 2) + (size_t)l * 64 * 1024;
        if (j == 19) { c.coff = 3072; c.nvalid = 24; c.npad = 32; c.dst = wsk; }
        else if (j == 20) { c.coff = 1824; c.nvalid = 1280; c.npad = 1280; c.dst = WB + (WB_WIN / 2) + (size_t)NPJ * 1024 + (size_t)1792 * 1024; }
        else if (j == 21) { c.coff = 3104; c.nvalid = 24; c.npad = 32; c.dst = wsk; }
        else { c.coff = 1792; c.nvalid = 32; c.npad = 32; c.dst = wsk + (size_t)32 * 1024; }
    }
    return c;
}

__device__ __forceinline__ void p_prologue(Frame& F) {
    LAS float* scr = (LAS float*)(F.lds + RING_OFF + F.wave * 16384);
    const int gw = F.vcu * NWAVES + F.wave, NGW = F.G * NWAVES;
    bf16_t* WB = (bf16_t*)(F.ws + WS_WB);
    LAS int* pre = (LAS int*)(F.lds + LDSCTL_OFF + 1024);
    if (F.tid < 23) { const ConvJob c = conv_job(F, F.tid); pre[F.tid] = (c.K / 64) * (c.npad / 32); }
    __syncthreads();
    if (F.tid == 0) { int acc = 0; for (int j = 0; j < 23; ++j) { const int it = pre[j]; pre[j] = acc; acc += it; } pre[23] = acc; }
    __syncthreads();
    {
        const int TOT = pre[23];
#define PRO_JOB(gi) int j_ = 0; for (int q_ = 1; q_ < 23; ++q_) j_ += ((gi) >= pre[q_]) ? 1 : 0; j_ = __builtin_amdgcn_readfirstlane(j_); const ConvJob c_ = conv_job(F, j_); const int it_ = (gi) - pre[j_];
#define PRO_LOAD(R, gi) do { PRO_JOB(gi) conv_load(R, c_.W, c_.ldw, c_.coff, c_.nvalid, c_.g, c_.npad / 32, it_, F.lane); } while (0)
#define PRO_STORE(R, gi) do { PRO_JOB(gi) if (c_.fp8) conv_store<true>(R, c_.dst, c_.K, c_.npad / 32, c_.rowmode, scr, it_, F.lane); else conv_store<false>(R, c_.dst, c_.K, c_.npad / 32, c_.rowmode, scr, it_, F.lane); } while (0)
        ConvRegs A, B;
        if (gw < TOT) PRO_LOAD(A, gw);
        if (gw + NGW < TOT) PRO_LOAD(B, gw + NGW);
#pragma nounroll
        for (int gi = gw; gi < TOT; gi += 2 * NGW) {
            { ConvRegs C = A; if (gi + 2 * NGW < TOT) PRO_LOAD(A, gi + 2 * NGW); PRO_STORE(C, gi); }
            if (gi + NGW < TOT) { ConvRegs C = B; if (gi + 3 * NGW < TOT) PRO_LOAD(B, gi + 3 * NGW); PRO_STORE(C, gi + NGW); }
        }
#undef PRO_JOB
#undef PRO_LOAD
#undef PRO_STORE
    }
    const int gt = (F.vcu * NWAVES + F.wave) * 64 + F.lane, NGT = F.G * NWAVES * 64;
    for (int l = 0; l < 2; ++l) {
        bf16_t* LT = WB + (WB_LORA / 2) + (size_t)l * 512 * 288;
        for (int i = gt; i < 512 * 288; i += NGT) {
            const int c = i / 288, k = i % 288; float v;
            if (k < 64) v = gin(F.in[8])[((size_t)l * 64 + k) * 512 + c];
            else if (k < 128) v = gin(F.in[10])[((size_t)l * 64 + (k - 64)) * 512 + c];
            else if (k < 256) v = gin(F.in[11])[((size_t)l * 128 + (k - 128)) * 512 + c];
            else v = (l == 1) ? gin(F.in[18])[(size_t)(k - 256) * 512 + c] : 0.f;
            LT[i] = (bf16_t)f2bf(v);
        }
        for (int kv = 0; kv < 2; ++kv) {
            bf16_t* C2 = WB + (WB_CW2 / 2) + (size_t)(l * 2 + kv) * 64 * 128;
            const float* w2 = (kv == 0 ? gin(F.in[21]) : gin(F.in[24])) + (size_t)l * 128 * 64;
            for (int i = gt; i < 64 * 128; i += NGT) { const int d = i / 128, k = i % 128; C2[i] = (bf16_t)f2bf(w2[k * 64 + d]); }
        }
    }
    for (int o = gw; o < 512; o += NGW) {
        const int l = o >> 8, kv = (o >> 7) & 1, hid = o & 127;
        const float* pe = (kv == 0 ? gin(F.in[19]) : gin(F.in[22])) + (size_t)l * 2048;
        const float* w1 = (kv == 0 ? gin(F.in[20]) : gin(F.in[23])) + (size_t)l * 2048 * 128;
        float a = 0.f;
        for (int i = F.lane; i < 2048; i += 64) a += pe[i] * w1[(size_t)i * 128 + hid];
        a = wave_sum_l(a, F.lane);
        if (F.lane == 0) ((float*)(F.ws + WS_WB + WB_CB))[o] = a;
    }
    {
        bf16_t* XB = (bf16_t*)(F.ws + WS_XB); float* SSQ = (float*)(F.ws + WS_SSQ);
        for (int m = gw; m < NTOK; m += NGW) {
            const GAS f32x4_t* xr = (const GAS f32x4_t*)(gin(F.in[0]) + (size_t)m * D_) + F.lane;
            f32x4_t v[4]; float s = 0.f;
#pragma unroll
            for (int j = 0; j < 4; ++j) { v[j] = xr[64 * j]; s += (v[j].x * v[j].x + v[j].y * v[j].y) + (v[j].z * v[j].z + v[j].w * v[j].w); }
            s = wave_sum_l(s, F.lane);
            GAS unsigned long long* o8 = (GAS unsigned long long*)(XB + (size_t)m * D_) + F.lane;
#pragma unroll
            for (int j = 0; j < 4; ++j) { o8[64 * j] = (unsigned long long)pk2(v[j].x, v[j].y) | ((unsigned long long)pk2(v[j].z, v[j].w) << 32); }
            if (F.lane < 16) SSQ[(size_t)m * 16 + F.lane] = (F.lane == 0) ? s : 0.f;
        }
        bf16_t* MB = (bf16_t*)(F.ws + WS_MEMB); float* MRINV = (float*)(F.ws + WS_MRINV);
        for (int m = gw; m < NMEM; m += NGW) {
            const GAS f32x4_t* xr = (const GAS f32x4_t*)(gin(F.in[1]) + (size_t)m * D_) + F.lane;
            f32x4_t v[4]; float s = 0.f;
#pragma unroll
            for (int j = 0; j < 4; ++j) { v[j] = xr[64 * j]; s += (v[j].x * v[j].x + v[j].y * v[j].y) + (v[j].z * v[j].z + v[j].w * v[j].w); }
            s = wave_sum_l(s, F.lane);
            GAS unsigned long long* o8 = (GAS unsigned long long*)(MB + (size_t)m * D_) + F.lane;
#pragma unroll
            for (int j = 0; j < 4; ++j) o8[64 * j] = (unsigned long long)pk2(v[j].x, v[j].y) | ((unsigned long long)pk2(v[j].z, v[j].w) << 32);
            if (F.lane == 0) MRINV[m] = 1.0f / sqrtf(s * (1.0f / 1024.0f) + 1e-6f);
        }
    }
}


__device__ __forceinline__ unsigned char* launder_ptr(unsigned char* p) {
    unsigned lo = (unsigned)(uintptr_t)p, hi = (unsigned)((uintptr_t)p >> 32);
    asm volatile("" : "+v"(lo), "+v"(hi));
    lo = __builtin_amdgcn_readfirstlane(lo); hi = __builtin_amdgcn_readfirstlane(hi);
    return (unsigned char*)(GAS unsigned char*)(((uintptr_t)hi << 32) | (uintptr_t)lo);
}
__device__ __forceinline__ int lane_now() { int l; asm volatile("v_mbcnt_lo_u32_b32 %0, -1, 0\n\tv_mbcnt_hi_u32_b32 %0, -1, %0" : "=v"(l)); return l; }
#define RELAUNDER(F) do { int w_ = (F).wave; asm volatile("" : "+v"(w_)); w_ = __builtin_amdgcn_readfirstlane(w_); const int l_ = lane_now(); int t_ = w_ * 64 + l_; asm volatile("" : "+v"(t_)); \
    (F).tid = t_; (F).lane = t_ & 63; (F).wave = w_; (F).ws = launder_ptr((F).ws); } while (0)
constexpr size_t S_PROJ = 0;
constexpr size_t S_EX = 96 * MiB;
constexpr size_t S_CONCAT = 104 * MiB;
constexpr size_t S_SC = 104 * MiB;
constexpr size_t S_CH = 200 * MiB;
constexpr int CH_BYTES = 12544;
constexpr size_t S_BON = 298 * MiB;
constexpr size_t S_END = 299 * MiB;
constexpr size_t O_Y = 0;
constexpr size_t O_G = 32 * MiB;
constexpr size_t O_VP = 48 * MiB;
constexpr size_t S_QC = 0, S_OC = 32 * MiB;
constexpr size_t S_ACT = 0;

constexpr int RTAB_OFF = 132096, RTAB_UNITS = 8;
static_assert(RTAB_OFF + RTAB_UNITS * 256 * 4 <= LDS_BYTES && RTAB_OFF >= MISC_OFF + 128, "LDS map");
template <class Sched> __device__ __forceinline__ void fill_rtab(Frame& F, const Sched& S, const float* direct = nullptr) {
    const float* ssq = (const float*)(F.ws + WS_SSQ);
    LAS float* rtab = (LAS float*)(F.lds + RTAB_OFF);
    pg8::Unit u;
    for (int i = 0; i < RTAB_UNITS && S.next(i, u); ++i)
        if (F.tid < 256) rtab[i * 256 + F.tid] = direct ? direct[u.pm * 256 + F.tid] : pg8::row_rinv(ssq, u.pm * 256 + F.tid);
    __syncthreads();
}
__device__ __forceinline__ void p_inproj(Frame& F, int l) {
    RELAUNDER(F);
    pg8::Gemm g{(const bf16_t*)(F.ws + WS_XB), (const bf16_t*)(F.ws + WS_WB + WB_WIN) + (size_t)l * NPJ * 1024, NTOK, NPJ, 1024, 0};
    pg8::StaticOrder S; S.init(NTOK, NPJ, F.G, (int)blockIdx.x);
    fill_rtab(F, S);
    pg8::EpiRowScaleBf16 E{(bf16_t*)(F.ws + WS_S), NPJ, (const LAS float*)(F.lds + RTAB_OFF), 1.0f};
    pg8::gemm_phase<pg8::EpiRowScaleBf16, pg8::StaticOrder, true, true>(F.lds + RING_OFF, g, S, E, F.tid);
    __syncthreads();
    for (int chunk = F.vcu; chunk < NTOK / 64; chunk += F.G) {
        const int w = F.wave, m = F.lane & 15, kq = F.lane >> 4, tokb = chunk * 64 + (w >> 1) * 16, colb = (w & 1) * 32;
        const bf16_t* ap = (const bf16_t*)(F.ws + WS_XB) + (size_t)(tokb + m) * D_ + kq * 8;
        const bf16_t* bp = (const bf16_t*)(F.ws + WS_WB + WB_WSK) + (size_t)l * 64 * 1024 + (size_t)(colb + m) * D_ + kq * 8;
        pg8::f32x4 a0 = {0.f, 0.f, 0.f, 0.f}, a1 = a0;
#pragma unroll 8
        for (int ks = 0; ks < 32; ++ks) {
            const pg8::bf16x8 af = *(const pg8::bf16x8*)(ap + ks * 32), b0 = *(const pg8::bf16x8*)(bp + ks * 32), b1 = *(const pg8::bf16x8*)(bp + (size_t)16 * D_ + ks * 32);
            a0 = __builtin_amdgcn_mfma_f32_16x16x32_bf16(af, b0, a0, 0, 0, 0);
            a1 = __builtin_amdgcn_mfma_f32_16x16x32_bf16(af, b1, a1, 0, 0, 0);
        }
        bf16_t* EX = (bf16_t*)(F.ws + WS_S + S_EX);
#pragma unroll
        for (int rg = 0; rg < 4; ++rg) {
            const int tok = tokb + 4 * kq + rg; const float rs = pg8::row_rinv((const float*)(F.ws + WS_SSQ), tok);
            EX[(size_t)tok * 64 + colb + m] = (bf16_t)f2bf(a0[rg] * rs); EX[(size_t)tok * 64 + colb + 16 + m] = (bf16_t)f2bf(a1[rg] * rs);
        }
    }
}

template <int DBG = 0> __device__ __forceinline__ void p_gprobe(Frame& F, int N, int K) {
    RELAUNDER(F);
    pg8::Gemm g{(const bf16_t*)(F.ws + WS_XB), (const bf16_t*)(F.ws + WS_WB + WB_WIN), NTOK, N, K, 0};
    pg8::StaticOrder S; S.init(NTOK, N, F.G, (int)blockIdx.x);
    fill_rtab(F, S);
    pg8::EpiRowScaleBf16 E{(bf16_t*)(F.ws + WS_S), N, (const LAS float*)(F.lds + RTAB_OFF), 1.0f};
    pg8::gemm_phase<pg8::EpiRowScaleBf16, pg8::StaticOrder, true, true, false, DBG>(F.lds + RING_OFF, g, S, E, F.tid);
}
struct SameTileOrder {
    int nU, pm0, pn0;
    __device__ bool next(int i, pg8::Unit& u) const { if (i >= nU) return false; u.pm = pm0; u.pn = pn0; u.e = 0; u.ord = 0; u.ks = 0; return true; }
    __device__ __forceinline__ void a_ready(const pg8::Unit&) const {}
    __device__ __forceinline__ void done(const pg8::Unit&) const {}
    __device__ __forceinline__ int kloop(int K) const { return K; }
    __device__ __forceinline__ size_t koff(const pg8::Unit&) const { return 0; }
};
__device__ __forceinline__ void p_gprobe2(Frame& F, int nU, int K, int mode) {
    RELAUNDER(F);
    pg8::Gemm g{(const bf16_t*)(F.ws + WS_XB), (const bf16_t*)(F.ws + WS_WB + WB_WIN), NTOK, 1024, K, 0};
    SameTileOrder S; S.nU = nU; S.pm0 = mode == 0 ? 0 : (mode == 1 ? (int)(blockIdx.x & 7) : (int)(blockIdx.x >> 2)); S.pn0 = mode == 0 ? 0 : (mode == 1 ? 0 : (int)(blockIdx.x & 3));
    fill_rtab(F, S);
    pg8::EpiRowScaleBf16 E{(bf16_t*)(F.ws + WS_S), 1024, (const LAS float*)(F.lds + RTAB_OFF), 1.0f};
    pg8::gemm_phase<pg8::EpiRowScaleBf16, SameTileOrder, true, true>(F.lds + RING_OFF, g, S, E, F.tid);
}
__device__ __forceinline__ void p_resid_gemm(Frame& F, const bf16_t* A, const bf16_t* Bt, int K) {
    RELAUNDER(F);
    pg8::Gemm g{A, Bt, NTOK, 1024, K, 0};
    pg8::StaticOrder S; S.init(NTOK, 1024, F.G, (int)blockIdx.x);
    pg8::EpiResid E{(bf16_t*)(F.ws + WS_XB), (float*)(F.ws + WS_SSQ)};
    pg8::gemm_phase<pg8::EpiResid, pg8::StaticOrder, true, true>(F.lds + RING_OFF, g, S, E, F.tid);
}
__device__ __forceinline__ int p_crossq(Frame& F, int l) {
    RELAUNDER(F);
    pg8::Gemm g{(const bf16_t*)(F.ws + WS_XB), (const bf16_t*)(F.ws + WS_WB + WB_WQ) + (size_t)l * D_ * D_, NTOK, 1024, 1024, 0};
    pg8::StaticOrder S; S.init(NTOK, 1024, F.G, (int)blockIdx.x);
    fill_rtab(F, S);
    pg8::EpiRowScaleBf16 E{(bf16_t*)(F.ws + WS_S + S_QC), 1024, (const LAS float*)(F.lds + RTAB_OFF), 0.0625f * 1.4426950408889634f};
    pg8::gemm_phase<pg8::EpiRowScaleBf16, pg8::StaticOrder, true, true>(F.lds + RING_OFF, g, S, E, F.tid);
    pg8::Unit u; if (F.G != 256 || !S.next(0, u)) return -1;
    return ((u.pm >> 3) * 4 + u.pn) * 8 + (u.pm & 7);
}
__device__ __forceinline__ void p_kv(Frame& F, int cb) {
    RELAUNDER(F);
    if (cb < 0 || cb >= 128) return;
    const int which = cb >> 5, l = which >> 1, c = cb & 31;
    const bf16_t* MB = (const bf16_t*)(F.ws + WS_MEMB); const float* MRINV = (const float*)(F.ws + WS_MRINV);
    if ((which & 1) == 0) {
        pg8::Gemm g{MB, (const bf16_t*)(F.ws + WS_WB + WB_WK) + (size_t)l * D_ * D_, NMEM, 1024, 1024, 0};
        pg8::StaticOrder S; S.init(NMEM, 1024, 32, c);
        fill_rtab(F, S, MRINV);
        pg8::EpiRowScaleBf16 E{(bf16_t*)(F.ws + WS_KCR) + (size_t)l * NMEM * 1024, 1024, (const LAS float*)(F.lds + RTAB_OFF), 1.0f};
        pg8::gemm_phase<pg8::EpiRowScaleBf16, pg8::StaticOrder, true, true>(F.lds + RING_OFF, g, S, E, F.tid);
    } else {
        pg8::Gemm g{(const bf16_t*)(F.ws + WS_WB + WB_WV) + (size_t)l * D_ * D_, MB, 1024, NMEM, 1024, 0};
        pg8::StaticOrder S; S.init(1024, NMEM, 32, c);
        pg8::EpiColScaleBf16 E{(bf16_t*)(F.ws + WS_VT) + (size_t)l * 1024 * NMEM, NMEM, MRINV};
        pg8::gemm_phase<pg8::EpiColScaleBf16, pg8::StaticOrder, true, true>(F.lds + RING_OFF, g, S, E, F.tid);
    }
}
__device__ __forceinline__ void p_ffn_up(Frame& F) {
    RELAUNDER(F);
    pg8::Gemm g{(const bf16_t*)(F.ws + WS_XB), (const bf16_t*)(F.ws + WS_WB + WB_WGU), NTOK, 2 * FFD, 1024, 0};
    pg8::StaticOrder S; S.init(NTOK, 2 * FFD, F.G, (int)blockIdx.x);
    fill_rtab(F, S);
    pg8::EpiSwiGLU8R E{(unsigned char*)(F.ws + WS_S + S_ACT), FFD, (const LAS float*)(F.lds + RTAB_OFF), F8S_ACT};
    pg8::gemm_phase<pg8::EpiSwiGLU8R, pg8::StaticOrder, true, true>(F.lds + RING_OFF, g, S, E, F.tid);
}
__device__ __forceinline__ void p_ffn_down8(Frame& F) {
    RELAUNDER(F);
    pg8::Gemm g{(const bf16_t*)(F.ws + WS_S + S_ACT), (const bf16_t*)(F.ws + WS_WB + WB_WD), NTOK, 1024, FFD / 2, 0};
    pg8::StaticOrder S; S.init(NTOK, 1024, F.G, (int)blockIdx.x);
    pg8::EpiResid E{(bf16_t*)(F.ws + WS_XB), (float*)(F.ws + WS_SSQ)};
    pg8::gemm_phase<pg8::EpiResid, pg8::StaticOrder, true, true, true>(F.lds + RING_OFF, g, S, E, F.tid, F8C_ACT, F8C_W);
}

typedef short bf16x8_t __attribute__((ext_vector_type(8)));
constexpr int LDX = 296;
__device__ __forceinline__ void p_rw_prep(Frame& F, int l) {
    RELAUNDER(F);
    const int n_lo = l == 0 ? 256 : 288;
    const bf16_t* P = (const bf16_t*)(F.ws + WS_S + S_PROJ); const bf16_t* EXp = (const bf16_t*)(F.ws + WS_S + S_EX);
    const float* mu = l == 0 ? gin(F.in[4]) : gin(F.in[5]);
    const bf16_t* LT0 = (const bf16_t*)(F.ws + WS_WB + WB_LORA) + (size_t)l * 512 * 288;
    bf16_t* SC = (bf16_t*)(F.ws + WS_S + S_SC); bf16_t* Gb = (bf16_t*)((unsigned char*)F.out + O_G); bf16_t* VPb = (bf16_t*)((unsigned char*)F.out + O_VP); float* BON = (float*)(F.ws + WS_S + S_BON);
    bf16_t* VF = (bf16_t*)(F.ws + WS_VFIRST);
    LAS bf16_t* Xs = (LAS bf16_t*)F.lds;
    const float* w0 = gin(F.in[7]) + l * W_; const float* a0 = gin(F.in[9]) + l * W_; const float* kkp = gin(F.in[12]) + l * W_; const float* kap = gin(F.in[13]) + l * W_; const float* rkp = gin(F.in[14]) + l * W_;
    const float* v0p = gin(F.in[17]);
    for (int chunk = F.vcu; chunk < NTOK / 64; chunk += F.G) {
        const int tok0 = chunk * 64;
        __syncthreads();
        for (int c = F.tid; c < 64 * 36; c += NWAVES * 64) {
            const int row = c / 36, ch = c % 36, tok = tok0 + row, t = tok & (T_ - 1);
            u32x4_t o = {0u, 0u, 0u, 0u};
            if (ch * 8 < n_lo) {
                const bf16_t* srcp = ch < 32 ? P + (size_t)tok * NPJ + 1536 + ch * 8 : EXp + (size_t)tok * 64 + 32 + (ch - 32) * 8;
                const int rstride = ch < 32 ? NPJ : 64;
                const u32x4_t cu = *(const u32x4_t*)(srcp);
                u32x4_t pv = {0u, 0u, 0u, 0u};
                if (t > 0) pv = *(const u32x4_t*)(srcp - rstride);
                const f32x4_t m0 = *(const f32x4_t*)(mu + 1536 + ch * 8), m1 = *(const f32x4_t*)(mu + 1536 + ch * 8 + 4);
                float v[8];
#pragma unroll
                for (int q = 0; q < 4; ++q) {
                    const float u0 = __uint_as_float(cu[q] << 16), u1 = __uint_as_float(cu[q] & 0xffff0000u), p0 = __uint_as_float(pv[q] << 16), p1 = __uint_as_float(pv[q] & 0xffff0000u);
                    const float ma = q < 2 ? m0[2 * q] : m1[2 * q - 4], mb = q < 2 ? m0[2 * q + 1] : m1[2 * q - 3];
                    v[2 * q] = u0 + (p0 - u0) * ma; v[2 * q + 1] = u1 + (p1 - u1) * mb;
                }
                if (ch < 8) { for (int q = 0; q < 8; ++q) v[q] = ftanh(v[q]); }
                else if (ch >= 16 && ch < 32) { for (int q = 0; q < 8; ++q) v[q] = fsigmoid(v[q]); }
                o.x = pk2(v[0], v[1]); o.y = pk2(v[2], v[3]); o.z = pk2(v[4], v[5]); o.w = pk2(v[6], v[7]);
            }
            *(LAS u32x4_t*)(Xs + row * LDX + ch * 8) = o;
        }
        __syncthreads();
        const int h = F.wave, fr = F.lane & 15, fq = F.lane >> 4;
        const bf16_t* LT = (const bf16_t*)(const GAS bf16_t*)(uintptr_t)LT0;
        pg8::f32x4 acc[4][4];
#define LORA_MMA4(KS0, KS1) do { _Pragma("unroll") for (int nt = 0; nt < 4; ++nt) _Pragma("unroll") for (int mt = 0; mt < 4; ++mt) acc[nt][mt] = (pg8::f32x4){0.f, 0.f, 0.f, 0.f}; \
        _Pragma("unroll") for (int ks = KS0; ks < KS1; ++ks) { bf16x8_t ax[4]; \
            _Pragma("unroll") for (int mt = 0; mt < 4; ++mt) ax[mt] = *(const bf16x8_t*)(LT + (size_t)(h * 64 + mt * 16 + fr) * 288 + ks * 32 + fq * 8); \
            _Pragma("unroll") for (int nt = 0; nt < 4; ++nt) { const bf16x8_t bx = *(const LAS bf16x8_t*)(Xs + (nt * 16 + fr) * LDX + ks * 32 + fq * 8); \
                _Pragma("unroll") for (int mt = 0; mt < 4; ++mt) acc[nt][mt] = __builtin_amdgcn_mfma_f32_16x16x32_bf16(ax[mt], bx, acc[nt][mt], 0, 0, 0); } } } while (0)
#define UNPK(w, e) (((e) & 1) ? __uint_as_float(((e) < 2 ? (w).x : (w).y) & 0xffff0000u) : __uint_as_float(((e) < 2 ? (w).x : (w).y) << 16))
#define SHIFTED(dst, colbase, mt) do { const int c_ = h * 64 + (mt) * 16 + fq * 4; const u32x2_t cu_ = *(const u32x2_t*)(pc + (colbase) + c_); u32x2_t pu_ = {0u, 0u}; \
        if (t > 0) pu_ = *(const u32x2_t*)(pp + (colbase) + c_); const f32x4_t m_ = *(const f32x4_t*)(mu + (colbase) + c_); \
        _Pragma("unroll") for (int e = 0; e < 4; ++e) { const float u_ = UNPK(cu_, e), q_ = UNPK(pu_, e); dst[e] = u_ + (q_ - u_) * m_[e]; } } while (0)
#define NT_VARS const int tok = tok0 + nt * 16 + fr, t = tok & (T_ - 1), b = tok >> 11; const bf16_t* pc = P + (size_t)tok * NPJ; const bf16_t* pp = pc - NPJ; \
        const size_t sb0 = ((((size_t)b * 8 + h) * T_ + t) * 6) * 64 + fq * 4; (void)pc; (void)pp; (void)sb0;
        LORA_MMA4(0, 2);
#pragma unroll
        for (int nt = 0; nt < 4; ++nt) { NT_VARS
#pragma unroll
            for (int mt = 0; mt < 4; ++mt) {
                const int c = h * 64 + mt * 16 + fq * 4; const f32x4_t w0v = *(const f32x4_t*)(w0 + c); float om[4];
#pragma unroll
                for (int e = 0; e < 4; ++e) { const float wraw = w0v[e] + acc[nt][mt][e]; om[e] = 1.0f - fexp(-0.6065306597126334f * fsigmoid(wraw));   }
                u32x2_t o; o.x = pk2(om[0], om[1]); o.y = pk2(om[2], om[3]); *(u32x2_t*)(SC + sb0 + mt * 16 + 1 * 64) = o;
            }
        }
        LORA_MMA4(4, 8);
#pragma unroll
        for (int nt = 0; nt < 4; ++nt) { NT_VARS
#pragma unroll
            for (int mt = 0; mt < 4; ++mt) { const int c = h * 64 + mt * 16 + fq * 4; u32x2_t o; o.x = pk2(acc[nt][mt][0], acc[nt][mt][1]); o.y = pk2(acc[nt][mt][2], acc[nt][mt][3]); *(u32x2_t*)(Gb + (size_t)tok * W_ + c) = o; }
        }
        if (l == 1) LORA_MMA4(8, 9);
#pragma unroll
        for (int nt = 0; nt < 4; ++nt) { NT_VARS
#pragma unroll
            for (int mt = 0; mt < 4; ++mt) {
                const int c = h * 64 + mt * 16 + fq * 4; float v[4]; SHIFTED(v, 1024, mt);
                if (l == 1) {
                    const f32x4_t v0v = *(const f32x4_t*)(v0p + c); const u32x2_t vfr = *(const u32x2_t*)(VF + (size_t)tok * W_ + c);
#pragma unroll
                    for (int e = 0; e < 4; ++e) { const float vf = UNPK(vfr, e); v[e] = v[e] + (vf - v[e]) * fsigmoid(v0v[e] + acc[nt][mt][e]); }
                }
                u32x2_t o; o.x = pk2(v[0], v[1]); o.y = pk2(v[2], v[3]);
                *(u32x2_t*)(SC + sb0 + mt * 16 + 3 * 64) = o;
                *(u32x2_t*)(VPb + (size_t)tok * W_ + c) = o;
                if (l == 0) *(u32x2_t*)(VF + (size_t)tok * W_ + c) = o;
            }
        }
        LORA_MMA4(2, 4);
#pragma unroll
        for (int nt = 0; nt < 4; ++nt) { NT_VARS
            float kn[4][4], ai[4][4]; float ssk = 0.f, bsum = 0.f;
#pragma unroll
            for (int mt = 0; mt < 4; ++mt) {
                const int c = h * 64 + mt * 16 + fq * 4; float r[4], k[4]; SHIFTED(r, 0, mt); SHIFTED(k, 512, mt);
                const f32x4_t a0v = *(const f32x4_t*)(a0 + c), kkv = *(const f32x4_t*)(kkp + c), kav = *(const f32x4_t*)(kap + c), rkv = *(const f32x4_t*)(rkp + c);
                float kh[4];
#pragma unroll
                for (int e = 0; e < 4; ++e) {
                    const float a = fsigmoid(a0v[e] + acc[nt][mt][e]); const float kk = k[e] * kkv[e];
                    ssk += kk * kk; kh[e] = k[e] * (1.f + (a - 1.f) * kav[e]); bsum += r[e] * kh[e] * rkv[e];
                    kn[mt][e] = kk; ai[mt][e] = a;
                }
                { u32x2_t o; o.x = pk2(r[0], r[1]); o.y = pk2(r[2], r[3]); *(u32x2_t*)(SC + sb0 + mt * 16 + 0 * 64) = o; }
                { u32x2_t o; o.x = pk2(kh[0], kh[1]); o.y = pk2(kh[2], kh[3]); *(u32x2_t*)(SC + sb0 + mt * 16 + 2 * 64) = o; }
            }
            ssk += shx(ssk, F.lane, 16); ssk += shx(ssk, F.lane, 32);
            bsum += shx(bsum, F.lane, 16); bsum += shx(bsum, F.lane, 32);
            const float kinv = 1.0f / fmaxf(sqrtf(ssk), 1e-12f);
            if (fq == 0) BON[(size_t)tok * 8 + h] = bsum;
#pragma unroll
            for (int mt = 0; mt < 4; ++mt) {
                float kq[4], bq[4];
#pragma unroll
                for (int e = 0; e < 4; ++e) { kq[e] = kn[mt][e] * kinv; bq[e] = kq[e] * ai[mt][e]; }
                { u32x2_t o; o.x = pk2(kq[0], kq[1]); o.y = pk2(kq[2], kq[3]); *(u32x2_t*)(SC + sb0 + mt * 16 + 4 * 64) = o; }
                { u32x2_t o; o.x = pk2(bq[0], bq[1]); o.y = pk2(bq[2], bq[3]); *(u32x2_t*)(SC + sb0 + mt * 16 + 5 * 64) = o; }
            }
        }
#undef LORA_MMA4
#undef NT_VARS
#undef UNPK
#undef SHIFTED
    }
}

constexpr int SC_STEPS = 32, SC_CHUNK_F = SC_STEPS * 6 * 64;
constexpr int SCAN_YB = 2 * SC_CHUNK_F * 4;
__device__ __forceinline__ float dpp_ror_add(float v, int) { return v; }
#define ROW_ALLREDUCE(v) do { \
    v += __int_as_float(__builtin_amdgcn_update_dpp(0, __float_as_int(v), 0x128, 0xf, 0xf, false)); \
    v += __int_as_float(__builtin_amdgcn_update_dpp(0, __float_as_int(v), 0x124, 0xf, 0xf, false)); \
    v += __int_as_float(__builtin_amdgcn_update_dpp(0, __float_as_int(v), 0x122, 0xf, 0xf, false)); \
    v += __int_as_float(__builtin_amdgcn_update_dpp(0, __float_as_int(v), 0x121, 0xf, 0xf, false)); } while (0)
__device__ __forceinline__ void p_rw_scan(Frame& F) {
    RELAUNDER(F);
    const bf16_t* SC = (const bf16_t*)(F.ws + WS_S + S_SC); float* Y = (float*)((unsigned char*)F.out + O_Y);
    LAS float* ring = (LAS float*)F.lds; LAS float* yring = (LAS float*)(F.lds + SCAN_YB);
    constexpr int NCH = T_ / SC_STEPS;
    for (int unit = F.vcu; unit < B_ * H_ * 4; unit += F.G) {
        const int bh = unit >> 2, qtr = unit & 3;
        const bf16_t* src = SC + (size_t)bh * T_ * 384;
        __syncthreads();
        if (F.wave >= 4) {
            const int lt = F.tid - 256;
            u32x4_t regs[6];
#pragma unroll
            for (int i = 0; i < 6; ++i) regs[i] = *(const u32x4_t*)(src + (size_t)(lt + 256 * i) * 8);
#pragma unroll
            for (int i = 0; i < 6; ++i) {
                LAS f32x4_t* d = (LAS f32x4_t*)(ring + (lt + 256 * i) * 8);
                d[0] = (f32x4_t){__uint_as_float(regs[i].x << 16), __uint_as_float(regs[i].x & 0xffff0000u), __uint_as_float(regs[i].y << 16), __uint_as_float(regs[i].y & 0xffff0000u)};
                d[1] = (f32x4_t){__uint_as_float(regs[i].z << 16), __uint_as_float(regs[i].z & 0xffff0000u), __uint_as_float(regs[i].w << 16), __uint_as_float(regs[i].w & 0xffff0000u)};
            }
#pragma unroll
            for (int i = 0; i < 6; ++i) regs[i] = *(const u32x4_t*)(src + (size_t)SC_CHUNK_F + (size_t)(lt + 256 * i) * 8);
            __syncthreads();
            for (int c = 0; c < NCH; ++c) {
                if (c + 1 < NCH) {
                    LAS float* dst = ring + ((c + 1) & 1) * SC_CHUNK_F;
#pragma unroll
                    for (int i = 0; i < 6; ++i) {
                        LAS f32x4_t* d = (LAS f32x4_t*)(dst + (lt + 256 * i) * 8);
                        d[0] = (f32x4_t){__uint_as_float(regs[i].x << 16), __uint_as_float(regs[i].x & 0xffff0000u), __uint_as_float(regs[i].y << 16), __uint_as_float(regs[i].y & 0xffff0000u)};
                        d[1] = (f32x4_t){__uint_as_float(regs[i].z << 16), __uint_as_float(regs[i].z & 0xffff0000u), __uint_as_float(regs[i].w << 16), __uint_as_float(regs[i].w & 0xffff0000u)};
                    }
                    if (c + 2 < NCH) {
#pragma unroll
                        for (int i = 0; i < 6; ++i) regs[i] = *(const u32x4_t*)(src + (size_t)(c + 2) * SC_CHUNK_F + (size_t)(lt + 256 * i) * 8);
                    }
                }
                if (c > 0) {
                    const int st = lt >> 3, r2 = (lt & 7) * 2;
                    const LAS float* ys = yring + ((c - 1) & 1) * (SC_STEPS * 16) + st * 16 + r2;
                    const size_t tok = (size_t)(bh >> 3) * T_ + (size_t)(c - 1) * SC_STEPS + st;
                    typedef float f32x2_t __attribute__((ext_vector_type(2)));
                    *(f32x2_t*)(Y + tok * W_ + (bh & 7) * 64 + qtr * 16 + r2) = (f32x2_t){ys[0], ys[1]};
                }
                __syncthreads();
            }
            {
                const int c = NCH;
                const int st = lt >> 3, r2 = (lt & 7) * 2;
                const LAS float* ys = yring + ((c - 1) & 1) * (SC_STEPS * 16) + st * 16 + r2;
                const size_t tok = (size_t)(bh >> 3) * T_ + (size_t)(c - 1) * SC_STEPS + st;
                typedef float f32x2_t __attribute__((ext_vector_type(2)));
                *(f32x2_t*)(Y + tok * W_ + (bh & 7) * 64 + qtr * 16 + r2) = (f32x2_t){ys[0], ys[1]};
            }
        } else {
            typedef float f32x2_t __attribute__((ext_vector_type(2)));
            const int rl = F.wave * 4 + (F.lane >> 4);
            const int cl = F.lane & 15, cj = cl * 4;
            const int vch = qtr * 16 + rl;
            f32x2_t Sa = {0.f, 0.f}, Sb = {0.f, 0.f};
            float ykeep = 0.f;
            __syncthreads();
            for (int c = 0; c < NCH; ++c) {
                const LAS float* buf = ring + (c & 1) * SC_CHUNK_F;
                LAS float* yb = yring + (c & 1) * (SC_STEPS * 16);
                f32x4_t nr = *(const LAS f32x4_t*)(buf + 0 * 64 + cj), nom = *(const LAS f32x4_t*)(buf + 1 * 64 + cj), nk = *(const LAS f32x4_t*)(buf + 2 * 64 + cj),
                        nkk = *(const LAS f32x4_t*)(buf + 4 * 64 + cj), nb = *(const LAS f32x4_t*)(buf + 5 * 64 + cj);
                float nv = buf[3 * 64 + vch];
#pragma unroll
                for (int st = 0; st < SC_STEPS; ++st) {
                    const f32x4_t r4 = nr, om4 = nom, k4 = nk, kk4 = nkk, b4 = nb; const float v = nv;
                    if (st + 1 < SC_STEPS) {
                        const LAS float* sp = buf + (st + 1) * 384;
                        nr = *(const LAS f32x4_t*)(sp + 0 * 64 + cj); nom = *(const LAS f32x4_t*)(sp + 1 * 64 + cj); nk = *(const LAS f32x4_t*)(sp + 2 * 64 + cj);
                        nkk = *(const LAS f32x4_t*)(sp + 4 * 64 + cj); nb = *(const LAS f32x4_t*)(sp + 5 * 64 + cj); nv = sp[3 * 64 + vch];
                    }
                    f32x2_t t2 = Sa * (f32x2_t){kk4.x, kk4.y};
                    t2 = Sb * (f32x2_t){kk4.z, kk4.w} + t2;
                    float sa = t2.x + t2.y;
                    ROW_ALLREDUCE(sa);
                    const f32x2_t sa2 = {sa, sa}, v2 = {v, v};
                    Sa = Sa - Sa * (f32x2_t){om4.x, om4.y}; Sb = Sb - Sb * (f32x2_t){om4.z, om4.w};
                    Sa = v2 * (f32x2_t){k4.x, k4.y} + Sa;     Sb = v2 * (f32x2_t){k4.z, k4.w} + Sb;
                    Sa = Sa - sa2 * (f32x2_t){b4.x, b4.y};    Sb = Sb - sa2 * (f32x2_t){b4.z, b4.w};
                    f32x2_t y2 = Sa * (f32x2_t){r4.x, r4.y};
                    y2 = Sb * (f32x2_t){r4.z, r4.w} + y2;
                    float y = y2.x + y2.y;
                    ROW_ALLREDUCE(y);
                    ykeep = (cl == (st & 15)) ? y : ykeep;
                    if ((st & 15) == 15) yb[((st & ~15) + cl) * 16 + rl] = ykeep;
                }
                __syncthreads();
            }
        }
    }
}

__device__ __forceinline__ void p_rw_post(Frame& F, int l) {
    RELAUNDER(F);
    const int gw = F.vcu * NWAVES + F.wave, NGW = F.G * NWAVES;
    const float* Y = (const float*)((const unsigned char*)F.out + O_Y); const bf16_t* VPb = (const bf16_t*)((const unsigned char*)F.out + O_VP); const bf16_t* Gb = (const bf16_t*)((const unsigned char*)F.out + O_G);
    const float* BON = (const float*)(F.ws + WS_S + S_BON); bf16_t* CC = (bf16_t*)(F.ws + WS_S + S_CONCAT);
    const float* lnw = gin(F.in[15]) + l * W_; const float* lnb = gin(F.in[16]) + l * W_;
    for (int tok = gw; tok < NTOK; tok += NGW) {
        const int c = F.lane * 8, h = F.lane >> 3, b = tok >> 11, t = tok & (T_ - 1);
        const f32x4_t y0 = *(const f32x4_t*)(Y + (size_t)tok * W_ + c), y1 = *(const f32x4_t*)(Y + (size_t)tok * W_ + c + 4);
        float s = ((y0.x + y0.y) + (y0.z + y0.w)) + ((y1.x + y1.y) + (y1.z + y1.w));
        s += shx(s, F.lane, 1); s += shx(s, F.lane, 2); s += shx(s, F.lane, 4);
        const float mean = s * (1.f / 64.f);
        const f32x4_t d0 = y0 - mean, d1 = y1 - mean;
        float q = ((d0.x * d0.x + d0.y * d0.y) + (d0.z * d0.z + d0.w * d0.w)) + ((d1.x * d1.x + d1.y * d1.y) + (d1.z * d1.z + d1.w * d1.w));
        q += shx(q, F.lane, 1); q += shx(q, F.lane, 2); q += shx(q, F.lane, 4);
        const float rstd = 1.0f / sqrtf(q * (1.f / 64.f) + 64e-5f);
        const float bon = BON[(size_t)tok * 8 + h];
        const u32x4_t vw = *(const u32x4_t*)(VPb + (size_t)tok * W_ + c);
        const u32x4_t gw4 = *(const u32x4_t*)(Gb + (size_t)tok * W_ + c);
        const f32x4_t w0 = *(const f32x4_t*)(lnw + c), w1 = *(const f32x4_t*)(lnw + c + 4), b0 = *(const f32x4_t*)(lnb + c), b1 = *(const f32x4_t*)(lnb + c + 4);
        float o[8];
#pragma unroll
        for (int e = 0; e < 8; ++e) {
            const float d = e < 4 ? d0[e] : d1[e - 4], lw = e < 4 ? w0[e] : w1[e - 4], lb = e < 4 ? b0[e] : b1[e - 4];
            const unsigned vq = vw[e >> 1], gq = gw4[e >> 1];
            const float v = (e & 1) ? __uint_as_float(vq & 0xffff0000u) : __uint_as_float(vq << 16), g = (e & 1) ? __uint_as_float(gq & 0xffff0000u) : __uint_as_float(gq << 16);
            o[e] = (d * rstd * lw + lb + bon * v) * g;
        }
        u32x4_t ow; ow.x = pk2(o[0], o[1]); ow.y = pk2(o[2], o[3]); ow.z = pk2(o[4], o[5]); ow.w = pk2(o[6], o[7]);
        *(u32x4_t*)(CC + (size_t)tok * D_ + c) = ow;
    }
}

__device__ __forceinline__ void p_route(Frame& F) {
    RELAUNDER(F);
    LAS int* lcnt = (LAS int*)F.lds;
    LAS int* gbase = lcnt + 8;
    LAS int* te = lcnt + 16;
    LAS int* tr = te + 128;
    LAS float* tg = (LAS float*)(tr + 128);
    const bf16_t* XBp = (const bf16_t*)(F.ws + WS_XB); const float* ssq = (const float*)(F.ws + WS_SSQ);
    const float* gn = gin(F.in[31]) + D_; const float* wr = gin(F.in[35]);
    int* CNT = (int*)(F.ws + WS_CTL + CTL_CNT);
    int* INV = (int*)(F.ws + WS_MT + MT_INV); float* TOKG = (float*)(F.ws + WS_MT + MT_TOKG);
    for (int chunk = F.vcu; chunk < NTOK / 64; chunk += F.G) {
        if (F.tid < 8) lcnt[F.tid] = 0;
        __syncthreads();
        for (int i = 0; i < 8; ++i) {
            const int tokl = F.wave * 8 + i, tok = chunk * 64 + tokl;
            float acc[8];
#pragma unroll
            for (int e = 0; e < 8; ++e) acc[e] = 0.f;
#pragma unroll
            for (int j = 0; j < 4; ++j) {
                const int k0 = F.lane * 4 + 256 * j;
                const u32x2_t xw = *(const u32x2_t*)(XBp + (size_t)tok * D_ + k0); const f32x4_t gv = *(const f32x4_t*)(gn + k0);
                const f32x4_t xv = {__uint_as_float(xw.x << 16), __uint_as_float(xw.x & 0xffff0000u), __uint_as_float(xw.y << 16), __uint_as_float(xw.y & 0xffff0000u)};
#pragma unroll
                for (int q = 0; q < 4; ++q) {
                    const float hv = xv[q] * gv[q];
                    const f32x4_t w0 = *(const f32x4_t*)(wr + (size_t)(k0 + q) * 8), w1 = *(const f32x4_t*)(wr + (size_t)(k0 + q) * 8 + 4);
                    acc[0] += hv * w0[0]; acc[1] += hv * w0[1]; acc[2] += hv * w0[2]; acc[3] += hv * w0[3];
                    acc[4] += hv * w1[0]; acc[5] += hv * w1[1]; acc[6] += hv * w1[2]; acc[7] += hv * w1[3];
                }
            }
            const float rinv = pg8::row_rinv(ssq, tok);
#pragma unroll
            for (int e = 0; e < 8; ++e) acc[e] = wave_sum_l(acc[e], F.lane) * rinv;
            int e0 = 0; float v0 = acc[0];
#pragma unroll
            for (int e = 1; e < 8; ++e) if (acc[e] > v0) { v0 = acc[e]; e0 = e; }
            int e1 = -1; float v1 = 0.f;
#pragma unroll
            for (int e = 0; e < 8; ++e) if (e != e0 && (e1 < 0 || acc[e] > v1)) { v1 = acc[e]; e1 = e; }
            if (F.lane == 0) {
                const float p1 = __expf(v1 - v0), inv = 1.f / (1.f + p1);
                te[tokl * 2] = e0; te[tokl * 2 + 1] = e1; tg[tokl * 2] = inv; tg[tokl * 2 + 1] = p1 * inv;
                tr[tokl * 2] = __hip_atomic_fetch_add(lcnt + e0, 1, __ATOMIC_RELAXED, __HIP_MEMORY_SCOPE_WORKGROUP);
                tr[tokl * 2 + 1] = __hip_atomic_fetch_add(lcnt + e1, 1, __ATOMIC_RELAXED, __HIP_MEMORY_SCOPE_WORKGROUP);
            }
        }
        __syncthreads();
        if (F.tid < 8) gbase[F.tid] = atomicAdd(CNT + F.tid, lcnt[F.tid]);
        __syncthreads();
        if (F.tid < 128) {
            const int e = te[F.tid], idx = gbase[e] + tr[F.tid], t2 = chunk * 128 + F.tid;
            TOKG[t2] = tg[F.tid]; INV[(size_t)e * NTOK + idx] = t2;
        }
        __syncthreads();
    }
}
__device__ __forceinline__ ConvJob conv_job_exp(const Frame& F, int j) {
    const int e = j / 3, k = j % 3; ConvJob c; c.coff = 0; c.fp8 = 1;
    if (k < 2) { c.W = (k == 0 ? gin(F.in[36]) : gin(F.in[37])) + (size_t)e * D_ * EFF; c.ldw = EFF; c.nvalid = EFF; c.npad = EFF; c.K = 1024; c.g = gin(F.in[31]) + D_; c.rowmode = 1 + k;
                 c.dst = (bf16_t*)(F.ws + WS_WE + (size_t)e * 7168 * 1024); }
    else { c.W = gin(F.in[38]) + (size_t)e * EFF * D_; c.ldw = D_; c.nvalid = D_; c.npad = D_; c.K = EFF; c.g = nullptr; c.rowmode = 0; c.dst = (bf16_t*)(F.ws + WS_WE + WE_D + (size_t)e * 1024 * EFF); }
    return c;
}
__device__ __forceinline__ void p_moe_prep(Frame& F) {
    RELAUNDER(F);
    LAS int* tb = (LAS int*)F.lds;
    LAS int* cn = tb + 16;
    const int* CNT = (const int*)(F.ws + WS_CTL + CTL_CNT);
    int* TILE = (int*)(F.ws + WS_MT + MT_TILE);
    if (F.tid == 0) { int acc = 0; for (int e = 0; e < 8; ++e) { const int c = CNT[e]; cn[e] = c; tb[e] = acc; acc += (c + 255) >> 8; } tb[8] = acc; }
    __syncthreads();
    const int MT = tb[8];
    if (F.vcu == 0) {
        if (F.tid == 0) TILE[0] = MT;
        if (F.tid < 9) TILE[16 + F.tid] = tb[F.tid];
        for (int pm = F.tid; pm < MT; pm += NWAVES * 64) { int e = 0; for (int q = 1; q < 8; ++q) if (pm >= tb[q]) e = q; TILE[64 + pm] = e; }
    }
    const int gw = F.vcu * NWAVES + F.wave, NGW = F.G * NWAVES;
    const bf16_t* XBp = (const bf16_t*)(F.ws + WS_XB); const float* ssq = (const float*)(F.ws + WS_SSQ);
    const int* INV = (const int*)(F.ws + WS_MT + MT_INV); const float* TOKG = (const float*)(F.ws + WS_MT + MT_TOKG);
    int* ROWINFO = (int*)(F.ws + WS_MT + MT_ROWINFO); float* ROWG = (float*)(F.ws + WS_MT + MT_ROWG); int* ROWOF = (int*)(F.ws + WS_MT + MT_ROWOF);
    bf16_t* XG = (bf16_t*)(F.ws + WS_XG);
    const int NR = MT * 256; constexpr int GB = 8;
    for (int row0 = gw; row0 < NR; row0 += GB * NGW) {
        int t2[GB]; bool val[GB];
#pragma unroll
        for (int r = 0; r < GB; ++r) {
            const int row = row0 + r * NGW, rc = row < NR ? row : NR - 1, pm = rc >> 8; int e = 0;
            for (int q = 1; q < 8; ++q) if (pm >= tb[q]) e = q;
            const int idx = (pm - tb[e]) * 256 + (rc & 255);
            val[r] = row < NR && idx < cn[e];
            t2[r] = INV[(size_t)e * NTOK + (val[r] ? idx : 0)];
        }
        u32x2_t xw[GB][4]; float rinv[GB], tg[GB];
#pragma unroll
        for (int r = 0; r < GB; ++r) {
            const int tt = val[r] ? t2[r] : 0, tok = tt >> 1;
            rinv[r] = pg8::row_rinv(ssq, tok) * F8S_X; tg[r] = TOKG[tt];
            const GAS u32x2_t* xr = (const GAS u32x2_t*)(XBp + (size_t)tok * D_) + F.lane;
#pragma unroll
            for (int j = 0; j < 4; ++j) xw[r][j] = xr[64 * j];
        }
#pragma unroll
        for (int r = 0; r < GB; ++r) {
            const int row = row0 + r * NGW;
            if (row < NR) {
                GAS unsigned* o4 = (GAS unsigned*)((unsigned char*)XG + (size_t)row * D_) + F.lane;
#pragma unroll
                for (int j = 0; j < 4; ++j) {
                    const float v0 = __uint_as_float(xw[r][j].x << 16) * rinv[r], v1 = __uint_as_float(xw[r][j].x & 0xffff0000u) * rinv[r], v2 = __uint_as_float(xw[r][j].y << 16) * rinv[r], v3 = __uint_as_float(xw[r][j].y & 0xffff0000u) * rinv[r];
                    o4[64 * j] = val[r] ? pk4_fp8(v0, v1, v2, v3) : 0u; }
                if (F.lane == 0) { ROWINFO[row] = val[r] ? t2[r] : -1; ROWG[row] = val[r] ? tg[r] : 0.f; if (val[r]) ROWOF[t2[r]] = row; }
            }
        }
    }
}
__device__ __forceinline__ void p_moe_conv(Frame& F) {
    RELAUNDER(F);
    const int gw = F.vcu * NWAVES + F.wave, NGW = F.G * NWAVES;
    LAS float* scr = (LAS float*)(F.lds + RING_OFF + 1024 + F.wave * 16384);
    constexpr int IPJ = 1792, TOT = 24 * IPJ;
    static_assert((1024 / 64) * (EFF / 32) == IPJ && (EFF / 64) * (1024 / 32) == IPJ, "items per expert matrix");
#define EXP_LOAD(R, gi) do { const int j_ = (gi) / IPJ; const ConvJob c_ = conv_job_exp(F, j_); conv_load(R, c_.W, c_.ldw, 0, c_.nvalid, c_.g, c_.npad / 32, (gi) - j_ * IPJ, F.lane); } while (0)
#define EXP_STORE(R, gi) do { const int j_ = (gi) / IPJ; const ConvJob c_ = conv_job_exp(F, j_); conv_store<true>(R, c_.dst, c_.K, c_.npad / 32, c_.rowmode, scr, (gi) - j_ * IPJ, F.lane); } while (0)
    {
        ConvRegs A, B;
        if (gw < TOT) EXP_LOAD(A, gw);
        if (gw + NGW < TOT) EXP_LOAD(B, gw + NGW);
#pragma nounroll
        for (int gi = gw; gi < TOT; gi += 2 * NGW) {
            { ConvRegs C = A; if (gi + 2 * NGW < TOT) EXP_LOAD(A, gi + 2 * NGW); EXP_STORE(C, gi); }
            if (gi + NGW < TOT) { ConvRegs C = B; if (gi + 3 * NGW < TOT) EXP_LOAD(B, gi + 3 * NGW); EXP_STORE(C, gi + NGW); }
        }
    }
#undef EXP_LOAD
#undef EXP_STORE
}
__device__ __forceinline__ void p_moe_gemm1(Frame& F) {
    RELAUNDER(F);
    const int* TILE = (const int*)(F.ws + WS_MT + MT_TILE);
    int nMp = __builtin_amdgcn_readfirstlane(TILE[0]); nMp = nMp < 0 ? 0 : (nMp > 136 ? 136 : nMp);
    pg8::Gemm g{(const bf16_t*)(F.ws + WS_XG), (const bf16_t*)(F.ws + WS_WE), nMp * 256, 7168, 512, (size_t)7168 * 1024};
    pg8::MoeOrder S; S.init(nMp, 28, F.G, (int)blockIdx.x, 0, TILE + 64);
    pg8::EpiSwiGLU8 E{(unsigned char*)(F.ws + WS_ACTM), EFF, F8S_ACT};
    pg8::gemm_phase<pg8::EpiSwiGLU8, pg8::MoeOrder, true, true, true>(F.lds + RING_OFF, g, S, E, F.tid, F8C_X, F8C_W);
}
__device__ __forceinline__ void p_moe_gemm2(Frame& F) {
    RELAUNDER(F);
    const int* TILE = (const int*)(F.ws + WS_MT + MT_TILE);
    const int MT = __builtin_amdgcn_readfirstlane(TILE[0]); int nMp = MT < 0 ? 0 : (MT > 2 * MOE_PASS_TILES ? 2 * MOE_PASS_TILES : MT);
    pg8::Gemm g{(const bf16_t*)(F.ws + WS_ACTM), (const bf16_t*)(F.ws + WS_WE + WE_D), nMp * 256, 1024, EFF / 2, (size_t)1024 * EFF};
    pg8::MoeOrder S; S.init(nMp, 4, F.G, (int)blockIdx.x, 0, TILE + 64);
    pg8::EpiMoeDown E{(bf16_t*)F.out, (const int*)(F.ws + WS_MT + MT_ROWINFO), (const float*)(F.ws + WS_MT + MT_ROWG)};
    pg8::gemm_phase<pg8::EpiMoeDown, pg8::MoeOrder, true, true, true>(F.lds + RING_OFF, g, S, E, F.tid, F8C_ACT, F8C_W);
}
__device__ __forceinline__ void p_moe_gemm2_split(Frame& F) {
    RELAUNDER(F);
    const int* TILE = (const int*)(F.ws + WS_MT + MT_TILE);
    const int MT = __builtin_amdgcn_readfirstlane(TILE[0]), pm_lo = 2 * MOE_PASS_TILES; int nMp = MT - pm_lo; nMp = nMp < 0 ? 0 : (nMp > 8 ? 8 : nMp);
    pg8::Gemm g{(const bf16_t*)(F.ws + WS_ACTM + (size_t)pm_lo * 256 * EFF), (const bf16_t*)(F.ws + WS_WE + WE_D), nMp * 256, 1024, EFF / 2, (size_t)1024 * EFF};
    pg8::MoeSplitOrder S; S.init(nMp, F.G, (int)blockIdx.x, pm_lo, TILE + 64, MOE_NS, MOE_KS / 2);
    pg8::EpiSplitF32 E{(float*)(F.ws + WS_XG), (const int*)(F.ws + WS_MT + MT_ROWINFO) + pm_lo * 256, nMp * 256};
    pg8::gemm_phase<pg8::EpiSplitF32, pg8::MoeSplitOrder, true, true, true>(F.lds + RING_OFF, g, S, E, F.tid, F8C_ACT, F8C_W);
}
__device__ __forceinline__ void p_final(Frame& F, bool moe) {
    RELAUNDER(F);
    const int gw = F.vcu * NWAVES + F.wave, NGW = F.G * NWAVES;
    const bf16_t* XBp = (const bf16_t*)(F.ws + WS_XB); const float* gn = gin(F.in[39]);
    const float dscale = 1.0f + *(const float*)(F.ws + WS_CTL + 640 * 1024);
    const int* ROWOF = (const int*)(F.ws + WS_MT + MT_ROWOF); const float* ROWG = (const float*)(F.ws + WS_MT + MT_ROWG); const float* PART = (const float*)(F.ws + WS_XG);
    int nr2 = __builtin_amdgcn_readfirstlane(*(const int*)(F.ws + WS_MT + MT_TILE)) - 2 * MOE_PASS_TILES; nr2 = (nr2 < 0 ? 0 : (nr2 > 8 ? 8 : nr2)) * 256;
    for (int tok = gw; tok < NTOK; tok += NGW) {
        f32x4_t s[4]; float q = 0.f;
        int rs[2] = {0, 0}; float gs[2] = {0.f, 0.f};
        if (moe) {
#pragma unroll
            for (int k = 0; k < 2; ++k) { rs[k] = __builtin_amdgcn_readfirstlane(ROWOF[tok * 2 + k]) - 2 * MOE_PASS_TILES * 256; if (rs[k] >= 0) gs[k] = ROWG[rs[k] + 2 * MOE_PASS_TILES * 256]; }
        }
        u32x2_t xw[4];
#pragma unroll
        for (int j = 0; j < 4; ++j) xw[j] = *(const u32x2_t*)(XBp + (size_t)tok * D_ + F.lane * 4 + 256 * j);
        if (!moe || (rs[0] & rs[1]) < 0) {
            u32x2_t ya[4], yb[4];
            if (moe) {
#pragma unroll
                for (int j = 0; j < 4; ++j) { const int col = F.lane * 4 + 256 * j; ya[j] = *(const u32x2_t*)((const bf16_t*)F.out + (size_t)tok * 2048 + col); yb[j] = *(const u32x2_t*)((const bf16_t*)F.out + (size_t)tok * 2048 + 1024 + col); }
            }
#pragma unroll
            for (int j = 0; j < 4; ++j) {
                f32x4_t v = {__uint_as_float(xw[j].x << 16), __uint_as_float(xw[j].x & 0xffff0000u), __uint_as_float(xw[j].y << 16), __uint_as_float(xw[j].y & 0xffff0000u)};
                if (moe) {
                    v.x += __uint_as_float(ya[j].x << 16) + __uint_as_float(yb[j].x << 16); v.y += __uint_as_float(ya[j].x & 0xffff0000u) + __uint_as_float(yb[j].x & 0xffff0000u);
                    v.z += __uint_as_float(ya[j].y << 16) + __uint_as_float(yb[j].y << 16); v.w += __uint_as_float(ya[j].y & 0xffff0000u) + __uint_as_float(yb[j].y & 0xffff0000u);
                }
                s[j] = v; q += (v.x * v.x + v.y * v.y) + (v.z * v.z + v.w * v.w);
            }
        } else {
#pragma unroll
            for (int j = 0; j < 4; ++j) {
                const int col = F.lane * 4 + 256 * j;
                f32x4_t v = {__uint_as_float(xw[j].x << 16), __uint_as_float(xw[j].x & 0xffff0000u), __uint_as_float(xw[j].y << 16), __uint_as_float(xw[j].y & 0xffff0000u)};
#pragma unroll
                for (int k = 0; k < 2; ++k) {
                    if (rs[k] < 0) {
                        const u32x2_t a = *(const u32x2_t*)((const bf16_t*)F.out + (size_t)tok * 2048 + k * 1024 + col);
                        v.x += __uint_as_float(a.x << 16); v.y += __uint_as_float(a.x & 0xffff0000u); v.z += __uint_as_float(a.y << 16); v.w += __uint_as_float(a.y & 0xffff0000u);
                    } else {
                        f32x4_t p = *(const f32x4_t*)(PART + (size_t)rs[k] * 1024 + col);
#pragma unroll
                        for (int sl = 1; sl < MOE_NS; ++sl) p += *(const f32x4_t*)(PART + ((size_t)sl * nr2 + rs[k]) * 1024 + col);
                        v += p * gs[k];
                    }
                }
                s[j] = v; q += (v.x * v.x + v.y * v.y) + (v.z * v.z + v.w * v.w);
            }
        }
        q = wave_sum_l(q, F.lane);
        const float rinv = 1.0f / sqrtf(q * (1.0f / 1024.0f) + 1e-6f);
#pragma unroll
        for (int j = 0; j < 4; ++j) {
            const int col = F.lane * 4 + 256 * j;
            const f32x4_t gv = *(const f32x4_t*)(gn + col);
            *(f32x4_t*)(F.out + (size_t)tok * D_ + col) = s[j] * rinv * gv * dscale;
        }
    }
}


constexpr size_t S_KCB = S_BON + 512 * 1024;
constexpr size_t S_VCB = S_KCB + 256 * 1024;
static_assert(S_VCB + 256 * 1024 <= S_END, "scratch map");
namespace nsa {
typedef short bf16x8 __attribute__((ext_vector_type(8)));
typedef short s16x4 __attribute__((ext_vector_type(4)));
typedef float f32x16 __attribute__((ext_vector_type(16)));
typedef float f32x4 __attribute__((ext_vector_type(4)));
constexpr float LOG2E = 1.4426950408889634f;
__device__ __forceinline__ int crow(int r, int hi) { return (r & 3) + 8 * (r >> 2) + 4 * hi; }
typedef float f32x2_t __attribute__((ext_vector_type(2))); typedef __bf16 bf16x2_t __attribute__((ext_vector_type(2)));
__device__ __forceinline__ unsigned cvtpk(float lo, float hi) { f32x2_t v = {lo, hi}; bf16x2_t b = __builtin_convertvector(v, bf16x2_t); return __builtin_bit_cast(unsigned, b); }
constexpr int L_KB = 0, L_VB = 16384, L_WSF = 32768, L_IMPQ = 36864, L_IMPL = L_IMPQ + 4 * 64 * 33 * 4, L_IMPF = L_IMPL + 4 * 64 * 33 * 4, L_SELM = L_IMPF + 64 * 36 * 4, L_MISC = L_SELM + 256, L_LIST = L_MISC + 16, L_END = L_LIST + 64 * 4;
static_assert(L_END <= 131072, "NSA LDS map");

__device__ __forceinline__ void qkt(f32x16& p0, f32x16& p1, const LAS unsigned char* Kslot, const bf16x8* qr, int r32, int hi) {
    const LAS unsigned char* kb = Kslot + hi * 1024 + r32 * 16;
    p0 = (f32x16){}; p1 = (f32x16){};
#pragma unroll
    for (int d0 = 0; d0 < 4; ++d0) {
        const bf16x8 b0 = *(const LAS bf16x8*)(kb + d0 * 2048);
        const bf16x8 b1 = *(const LAS bf16x8*)(kb + d0 * 2048 + 512);
        p0 = __builtin_amdgcn_mfma_f32_32x32x16_bf16(b0, qr[d0], p0, 0, 0, 0);
        p1 = __builtin_amdgcn_mfma_f32_32x32x16_bf16(b1, qr[d0], p1, 0, 0, 0);
    }
}
__device__ __forceinline__ void qkt_a(f32x16& p0, f32x16& p1, const LAS unsigned char* Kslot, const bf16x8* qr, int r32, int hi, const bf16x8& ka0, const bf16x8& ka1, const bf16x8& qa) {
    const LAS unsigned char* kb = Kslot + hi * 1024 + r32 * 16;
    p0 = __builtin_amdgcn_mfma_f32_32x32x16_bf16(ka0, qa, (f32x16){}, 0, 0, 0);
    p1 = __builtin_amdgcn_mfma_f32_32x32x16_bf16(ka1, qa, (f32x16){}, 0, 0, 0);
#pragma unroll
    for (int d0 = 0; d0 < 4; ++d0) {
        const bf16x8 b0 = *(const LAS bf16x8*)(kb + d0 * 2048);
        const bf16x8 b1 = *(const LAS bf16x8*)(kb + d0 * 2048 + 512);
        p0 = __builtin_amdgcn_mfma_f32_32x32x16_bf16(b0, qr[d0], p0, 0, 0, 0);
        p1 = __builtin_amdgcn_mfma_f32_32x32x16_bf16(b1, qr[d0], p1, 0, 0, 0);
    }
}
__device__ __forceinline__ void qkt_c(f32x16& p0, f32x16& p1, const LAS unsigned char* Kslot, const bf16x8* qr, int r32, int hi, const f32x16& c0, const f32x16& c1) {
    const LAS unsigned char* kb = Kslot + hi * 1024 + r32 * 16;
    {
        const bf16x8 b0 = *(const LAS bf16x8*)(kb), b1 = *(const LAS bf16x8*)(kb + 512);
        p0 = __builtin_amdgcn_mfma_f32_32x32x16_bf16(b0, qr[0], c0, 0, 0, 0);
        p1 = __builtin_amdgcn_mfma_f32_32x32x16_bf16(b1, qr[0], c1, 0, 0, 0);
    }
#pragma unroll
    for (int d0 = 1; d0 < 4; ++d0) {
        const bf16x8 b0 = *(const LAS bf16x8*)(kb + d0 * 2048);
        const bf16x8 b1 = *(const LAS bf16x8*)(kb + d0 * 2048 + 512);
        p0 = __builtin_amdgcn_mfma_f32_32x32x16_bf16(b0, qr[d0], p0, 0, 0, 0);
        p1 = __builtin_amdgcn_mfma_f32_32x32x16_bf16(b1, qr[d0], p1, 0, 0, 0);
    }
}
__device__ __forceinline__ float max3f(float a, float b, float c) { float r; asm("v_max3_f32 %0, %1, %2, %3" : "=v"(r) : "v"(a), "v"(b), "v"(c)); return r; }
__device__ __forceinline__ void pv(f32x16* o, int vb, bf16x8 pa0, bf16x8 pa1, bf16x8 pa2, bf16x8 pa3) {
#pragma unroll
    for (int d0 = 0; d0 < 2; ++d0) {
        s16x4 lo[4], hi[4];
#pragma unroll
        for (int ks = 0; ks < 4; ++ks) {
            asm volatile("ds_read_b64_tr_b16 %0,%1 offset:%c2" : "=&v"(lo[ks]) : "v"(vb), "i"(d0 * 4096 + ks * 1024) : "memory");
            asm volatile("ds_read_b64_tr_b16 %0,%1 offset:%c2" : "=&v"(hi[ks]) : "v"(vb), "i"(d0 * 4096 + ks * 1024 + 512) : "memory");
        }
        asm volatile("s_waitcnt lgkmcnt(0)" ::: "memory"); __builtin_amdgcn_sched_barrier(0);
#define NSA_PK(k) (bf16x8){lo[k][0], lo[k][1], lo[k][2], lo[k][3], hi[k][0], hi[k][1], hi[k][2], hi[k][3]}
        o[d0] = __builtin_amdgcn_mfma_f32_32x32x16_bf16(pa0, NSA_PK(0), o[d0], 0, 0, 0);
        o[d0] = __builtin_amdgcn_mfma_f32_32x32x16_bf16(pa1, NSA_PK(1), o[d0], 0, 0, 0);
        o[d0] = __builtin_amdgcn_mfma_f32_32x32x16_bf16(pa2, NSA_PK(2), o[d0], 0, 0, 0);
        o[d0] = __builtin_amdgcn_mfma_f32_32x32x16_bf16(pa3, NSA_PK(3), o[d0], 0, 0, 0);
#undef NSA_PK
    }
}
__device__ __forceinline__ float swap_max(float m) { auto rr = __builtin_amdgcn_permlane32_swap(__float_as_uint(m), __float_as_uint(m), false, false); return fmaxf(__uint_as_float(rr[0]), __uint_as_float(rr[1])); }
__device__ __forceinline__ float swap_sum(float m) { auto rr = __builtin_amdgcn_permlane32_swap(__float_as_uint(m), __float_as_uint(m), false, false); return __uint_as_float(rr[0]) + __uint_as_float(rr[1]); }
__device__ __forceinline__ void pack_p(const f32x16& p0, const f32x16& p1, bf16x8& a0, bf16x8& a1, bf16x8& a2, bf16x8& a3) {
    u32x4_t w0, w1, w2, w3;
    w0.x = cvtpk(p0[0], p0[1]); w0.y = cvtpk(p0[2], p0[3]); w0.z = cvtpk(p0[4], p0[5]); w0.w = cvtpk(p0[6], p0[7]);
    w1.x = cvtpk(p0[8], p0[9]); w1.y = cvtpk(p0[10], p0[11]); w1.z = cvtpk(p0[12], p0[13]); w1.w = cvtpk(p0[14], p0[15]);
    w2.x = cvtpk(p1[0], p1[1]); w2.y = cvtpk(p1[2], p1[3]); w2.z = cvtpk(p1[4], p1[5]); w2.w = cvtpk(p1[6], p1[7]);
    w3.x = cvtpk(p1[8], p1[9]); w3.y = cvtpk(p1[10], p1[11]); w3.z = cvtpk(p1[12], p1[13]); w3.w = cvtpk(p1[14], p1[15]);
    a0 = __builtin_bit_cast(bf16x8, w0); a1 = __builtin_bit_cast(bf16x8, w1); a2 = __builtin_bit_cast(bf16x8, w2); a3 = __builtin_bit_cast(bf16x8, w3);
}
__device__ __forceinline__ void scale_o(f32x16* o, float fac, LAS float* wsf, int r32, int hi) {
    if (hi == 0) wsf[r32] = fac;
    asm volatile("s_waitcnt lgkmcnt(0)" ::: "memory");
#pragma unroll
    for (int r = 0; r < 16; ++r) { const float f = wsf[crow(r, hi)]; o[0][r] *= f; o[1][r] *= f; }
}
__device__ __forceinline__ void psum(f32x16& ol, bf16x8 pa0, bf16x8 pa1, bf16x8 pa2, bf16x8 pa3) {
    const bf16x8 one = {(short)0x3f80, (short)0x3f80, (short)0x3f80, (short)0x3f80, (short)0x3f80, (short)0x3f80, (short)0x3f80, (short)0x3f80};
    ol = __builtin_amdgcn_mfma_f32_32x32x16_bf16(pa0, one, ol, 0, 0, 0);
    ol = __builtin_amdgcn_mfma_f32_32x32x16_bf16(pa1, one, ol, 0, 0, 0);
    ol = __builtin_amdgcn_mfma_f32_32x32x16_bf16(pa2, one, ol, 0, 0, 0);
    ol = __builtin_amdgcn_mfma_f32_32x32x16_bf16(pa3, one, ol, 0, 0, 0);
}
__device__ __forceinline__ void scale_ol(f32x16* o, f32x16& ol, float fac, LAS float* wsf, int r32, int hi) {
    if (hi == 0) wsf[r32] = fac;
    asm volatile("s_waitcnt lgkmcnt(0)" ::: "memory");
#pragma unroll
    for (int r = 0; r < 16; ++r) { const float f = wsf[crow(r, hi)]; o[0][r] *= f; o[1][r] *= f; ol[r] *= f; }
}
__device__ __forceinline__ void axpy_ol(f32x16* out, const f32x16* o, const f32x16& ol, float gate, LAS float* wsf, int r32, int hi) {
    if (hi == 0) wsf[32 + r32] = gate;
    asm volatile("s_waitcnt lgkmcnt(0)" ::: "memory");
#pragma unroll
    for (int r = 0; r < 16; ++r) { const float f = wsf[32 + crow(r, hi)] * __builtin_amdgcn_rcpf(fmaxf(ol[r], 1e-30f)); out[0][r] += f * o[0][r]; out[1][r] += f * o[1][r]; }
}
__device__ __forceinline__ void axpy_o(f32x16* out, const f32x16* o, float fac, LAS float* wsf, int r32, int hi) {
    if (hi == 0) wsf[32 + r32] = fac;
    asm volatile("s_waitcnt lgkmcnt(0)" ::: "memory");
#pragma unroll
    for (int r = 0; r < 16; ++r) { const float f = wsf[32 + crow(r, hi)]; out[0][r] += f * o[0][r]; out[1][r] += f * o[1][r]; }
}
}

__device__ __forceinline__ void p_nsa_cmp(Frame& F, int l, int first, int cnt) {
    RELAUNDER(F);
    const int n_rw = 1792;
    const bf16_t* P = (const bf16_t*)(F.ws + WS_S + S_PROJ);
    LAS bf16_t* Hs = (LAS bf16_t*)F.lds;
    const int w = F.wave, fr = F.lane & 15, fq = F.lane >> 4;
    for (int item = first; item < first + cnt; ++item) {
        const int kv = item >> 7, b = (item >> 4) & 7, g = (item >> 3) & 1, ch = item & 7;
        const int colbase = n_rw + 512 + kv * 128 + g * 64;
        const bf16_t* W1T = (const bf16_t*)(F.ws + WS_WB + WB_CW1) + (size_t)(l * 2 + kv) * 128 * 2048;
        const bf16_t* W2T = (const bf16_t*)(F.ws + WS_WB + WB_CW2) + (size_t)(l * 2 + kv) * 64 * 128;
        const float* cb = (const float*)(F.ws + WS_WB + WB_CB) + (l * 2 + kv) * 128;
        constexpr int APITCH = 4112;
        LAS unsigned char* As = F.lds + 8192;
        __syncthreads();
#pragma unroll
        for (int pc = 0; pc < 8; ++pc) {
            const int row = 2 * w + (pc >> 2), q = pc & 3, n_ = ch * 16 + row, nc_ = n_ < NCMP ? n_ : NCMP - 1;
            const bf16_t* src = P + ((size_t)b * T_ + 16 * nc_ + q * 8 + (F.lane >> 3)) * NPJ + colbase + (F.lane & 7) * 8;
            __builtin_amdgcn_global_load_lds((const unsigned*)(const GAS unsigned*)(uintptr_t)src, (LAS unsigned*)(As + row * APITCH + q * 1024), 16, 0, 0);
        }
        const bf16_t* brow = W1T + (size_t)(16 * w + fr) * 2048;
        pg8::f32x4 acc = {0.f, 0.f, 0.f, 0.f};
        asm volatile("s_waitcnt vmcnt(0)" ::: "memory");
        __syncthreads();
#pragma unroll 16
        for (int ks = 0; ks < 64; ++ks) {
            const int k0 = ks * 32 + fq * 8;
            const nsa::bf16x8 a = *(const LAS nsa::bf16x8*)(As + fr * APITCH + k0 * 2);
            const nsa::bf16x8 bw = *(const nsa::bf16x8*)(brow + k0);
            acc = __builtin_amdgcn_mfma_f32_16x16x32_bf16(a, bw, acc, 0, 0, 0);
        }
        __syncthreads();
        const float bias = cb[16 * w + fr];
#pragma unroll
        for (int r = 0; r < 4; ++r) {
            const float x = acc[r] + bias;
            const float ge = x * fsigmoid(1.5957691216057308f * (x + 0.044715f * x * x * x));
            Hs[(4 * fq + r) * 136 + 16 * w + fr] = (bf16_t)f2bf(ge);
        }
        __syncthreads();
        if (w < 4) {
            pg8::f32x4 acc2 = {0.f, 0.f, 0.f, 0.f};
#pragma unroll
            for (int ks = 0; ks < 4; ++ks) {
                const nsa::bf16x8 a = *(const LAS nsa::bf16x8*)(Hs + fr * 136 + ks * 32 + fq * 8);
                const nsa::bf16x8 bw = *(const nsa::bf16x8*)(W2T + (size_t)(16 * w + fr) * 128 + ks * 32 + fq * 8);
                acc2 = __builtin_amdgcn_mfma_f32_16x16x32_bf16(a, bw, acc2, 0, 0, 0);
            }
            bf16_t* dst = (bf16_t*)(F.ws + WS_S + (kv == 0 ? S_KCB : S_VCB)) + ((size_t)(b * 2 + g) * 128) * 64;
#pragma unroll
            for (int r = 0; r < 4; ++r) { const int nn = ch * 16 + 4 * fq + r; dst[(size_t)nn * 64 + 16 * w + fr] = (bf16_t)f2bf(nn < NCMP ? acc2[r] : 0.f); }
        }
    }
}

template <int DBG = 0> __device__ __forceinline__ void nsa_item(Frame& F, const bf16_t* P, int n_rw, int b, int g, int c) {
    using namespace nsa;
    int tidl = F.tid; asm volatile("" : "+v"(tidl));
    const int lanel = tidl & 63;
    const int w = __builtin_amdgcn_readfirstlane(tidl >> 6), rh = w >> 1, th = w & 1, r32 = lanel & 31, hi = lanel >> 5;
    const int t0 = c * 64, tq = t0 + th * 32 + r32;
    const int hq = g * 4 + rh;
    const float slope2 = exp2f(-(float)(hq + 1)) * LOG2E;
    const size_t tokrow = (size_t)b * T_ + tq;
    LAS unsigned char* L = F.lds;
    LAS float* wsf = (LAS float*)(L + L_WSF) + w * 64;
    LAS float* IMPQ = (LAS float*)(L + L_IMPQ); LAS float* IMPL = (LAS float*)(L + L_IMPL); LAS float* IMPF = (LAS float*)(L + L_IMPF);
    LAS unsigned* SELM = (LAS unsigned*)(L + L_SELM); LAS int* MISCL = (LAS int*)(L + L_MISC); LAS int* LIST = (LAS int*)(L + L_LIST);
    const unsigned lds0 = (unsigned)(uintptr_t)L;
    const int vboff = ((lanel >> 4) & 1) * 32 + (lanel & 3) * 8 + (4 * hi + ((lanel & 15) >> 2)) * 64;
    bf16x8 qr[4];
    {
        const bf16_t* qp = P + tokrow * NPJ + n_rw + g * 256 + rh * 64 + hi * 8;
#pragma unroll
        for (int d0 = 0; d0 < 4; ++d0) {
            const u32x4_t raw = *(const u32x4_t*)(qp + d0 * 16); u32x4_t sc;
#pragma unroll
            for (int e = 0; e < 4; ++e) sc[e] = cvtpk(__uint_as_float(raw[e] << 16) * (0.125f * LOG2E), __uint_as_float(raw[e] & 0xffff0000u) * (0.125f * LOG2E));
            qr[d0] = __builtin_bit_cast(bf16x8, sc);
        }
    }
    const bf16_t* gp = (const bf16_t*)(F.ws + WS_S + S_EX) + tokrow * 64 + hq * 3;
    const float gate0 = fsigmoid(bf2f(gp[0])), gate1 = fsigmoid(bf2f(gp[1])), gate2 = fsigmoid(bf2f(gp[2]));
    f32x16 out[2]; out[0] = (f32x16){}; out[1] = (f32x16){};
    const int lk_key = tidl & 63, lk_c8 = tidl >> 6, lv_key = tidl >> 3, lv_p = tidl & 7;
    const int lk_dst = lk_c8 * 1024 + lk_key * 16, lv_dst = (lv_p >> 2) * 4096 + lv_key * 64 + (lv_p & 3) * 16;
    const int lv_src = (lv_p >> 2) * 32 + (lv_p & 3) * 8;
    __syncthreads();
    {
        const bf16_t* KCB = (const bf16_t*)(F.ws + WS_S + S_KCB) + ((size_t)(b * 2 + g) * 128) * 64;
        const bf16_t* VCB = (const bf16_t*)(F.ws + WS_S + S_VCB) + ((size_t)(b * 2 + g) * 128) * 64;
#pragma unroll
        for (int jt = 0; jt < 2; ++jt) {
            *(LAS u32x4_t*)(L + L_KB + jt * 8192 + lk_dst) = *(const u32x4_t*)(KCB + (size_t)(jt * 64 + lk_key) * 64 + lk_c8 * 8);
            *(LAS u32x4_t*)(L + L_VB + jt * 8192 + lv_dst) = *(const u32x4_t*)(VCB + (size_t)(jt * 64 + lv_key) * 64 + lv_src);
        }
        __syncthreads();
        f32x16 s0a, s0b, s1a, s1b;
        qkt(s0a, s0b, L + L_KB, qr, r32, hi);
        qkt(s1a, s1b, L + L_KB + 8192, qr, r32, hi);
        float m = -INFINITY;
#pragma unroll
        for (int r = 0; r < 16; ++r) {
            const int key = crow(r, hi);
#define CMP_MASK(S, nn) { const int n_ = (nn); const int dist_ = tq - (16 * n_ + 31); const bool ok_ = (n_ < NCMP) && (dist_ >= 0); S[r] = ok_ ? S[r] - slope2 * (float)dist_ : -INFINITY; m = fmaxf(m, S[r]); }
            CMP_MASK(s0a, key) CMP_MASK(s0b, key + 32) CMP_MASK(s1a, 64 + key) CMP_MASK(s1b, 96 + key)
#undef CMP_MASK
        }
        m = swap_max(m);
        if (m == -INFINITY) m = 0.f;
        float lsum = 0.f;
#pragma unroll
        for (int r = 0; r < 16; ++r) { s0a[r] = __builtin_amdgcn_exp2f(s0a[r] - m); s0b[r] = __builtin_amdgcn_exp2f(s0b[r] - m); s1a[r] = __builtin_amdgcn_exp2f(s1a[r] - m); s1b[r] = __builtin_amdgcn_exp2f(s1b[r] - m); lsum += (s0a[r] + s0b[r]) + (s1a[r] + s1b[r]); }
        lsum = swap_sum(lsum);
        const float inv = lsum > 0.f ? 1.0f / lsum : 0.f;
#pragma unroll
        for (int r = 0; r < 16; ++r) { s0a[r] *= inv; s0b[r] *= inv; s1a[r] *= inv; s1b[r] *= inv; }
        {
            LAS float* iq = IMPQ + (rh * 64 + th * 32 + r32) * 33; LAS float* il = IMPL + (rh * 64 + th * 32 + r32) * 33;
#pragma unroll
            for (int rq = 0; rq < 4; ++rq) {
#define IMP_Q(S, Qb) { const int Q_ = (Qb) + 2 * rq + hi; iq[Q_] = (S[4 * rq] + S[4 * rq + 1]) + (S[4 * rq + 2] + S[4 * rq + 3]); il[Q_] = S[4 * rq + 3]; }
                IMP_Q(s0a, 0) IMP_Q(s0b, 8) IMP_Q(s1a, 16) IMP_Q(s1b, 24)
#undef IMP_Q
            }
        }
        bf16x8 a0, a1, a2, a3;
        pack_p(s0a, s0b, a0, a1, a2, a3); pv(out, (int)(lds0 + L_VB) + vboff, a0, a1, a2, a3);
        pack_p(s1a, s1b, a0, a1, a2, a3); pv(out, (int)(lds0 + L_VB + 8192) + vboff, a0, a1, a2, a3);
        scale_o(out, gate0, wsf, r32, hi);
    }
    __syncthreads();
    for (int idx = tidl; idx < 64 * 32; idx += NWAVES * 64) {
        const int tokl = idx >> 5, j = idx & 31; float s = 0.f;
#pragma unroll
        for (int h4 = 0; h4 < 4; ++h4) { s += IMPQ[(h4 * 64 + tokl) * 33 + j]; if (j > 0) s += IMPL[(h4 * 64 + tokl) * 33 + j - 1]; }
        IMPF[tokl * 36 + j] = s;
    }
    __syncthreads();
#pragma unroll 1
    for (int pass = 0; pass < 4; ++pass) {
        const int tokl = pass * 16 + (tidl >> 5), j = tidl & 31;
        bool sel;
        if (c < 16) sel = (j <= c);
        else {
            const LAS f32x4_t* row = (const LAS f32x4_t*)(IMPF + tokl * 36);
            f32x4_t vq[8];
#pragma unroll
            for (int q4 = 0; q4 < 8; ++q4) vq[q4] = row[q4];
            const float mine = IMPF[tokl * 36 + j]; int rank = 0;
#pragma unroll
            for (int jj = 1; jj < 30; ++jj) { const float o2 = vq[jj >> 2][jj & 3]; rank += (jj <= c - 2 && (o2 > mine || (o2 == mine && jj < j))) ? 1 : 0; }
            sel = (j == 0) || (j == c) || (j == c - 1) || (j >= 1 && j <= c - 2 && rank < 13);
        }
        const unsigned long long bal = __ballot(sel);
        if ((lanel & 31) == 0) SELM[tokl] = (lanel == 0) ? (unsigned)(bal & 0xffffffffull) : (unsigned)(bal >> 32);
    }
    __syncthreads();
    if (tidl < 64) {
        unsigned um = SELM[tidl];
#pragma unroll
        for (int o = 1; o < 64; o <<= 1) um |= (unsigned)__builtin_amdgcn_ds_bpermute((lanel ^ o) << 2, (int)um);
        const int j = lanel & 31, jlo = c - 8 > 0 ? c - 8 : 0;
        const bool on = (lanel < 32) ? (j >= jlo && j <= c) : (((um >> j) & 1u) != 0u && j <= c);
        const unsigned long long bal = __ballot(on);
        const unsigned lo32 = (unsigned)(bal & 0xffffffffull), hi32 = (unsigned)(bal >> 32);
        const unsigned above = (j == 31) ? 0u : (0xffffffffu << (j + 1));
        const int pos = (lanel < 32) ? __popc(lo32 & above) : (__popc(lo32) + __popc(hi32 & above));
        if (on) LIST[pos] = ((lanel < 32) ? 256 : 0) | j;
        if (lanel == 0) MISCL[0] = __popc(lo32) + __popc(hi32);
    }
    __syncthreads();
    const int ntl = DBG == 1 ? 1 : MISCL[0];
    const unsigned selq = SELM[th * 32 + r32];
    {
        const bf16_t* Pb = P + (size_t)b * T_ * NPJ;
        constexpr int NSR = 6, GRP = 3, RK = L_IMPQ;
        static_assert(RK == 2 * 16384 + 4096 && RK + (NSR - 2) * 16384 <= L_SELM && L_WSF == 32768, "ring stages: s * 16384 (+ 4096 past the per-wave scratch)");
#define STG_OFF(s_) ((s_) * 16384 + ((s_) >= 2 ? 4096 : 0))
        const int dv_key = (tidl >> 2) & 63, dv_src = (tidl >> 8) * 32 + (tidl & 3) * 8;
#define TILE_DMA(t_) do { const int ent_ = LIST[t_]; const int ty_ = ent_ >> 8, j_ = ent_ & 255; const int kc_ = n_rw + 512 + (ty_ ? 4 : 2) * 128 + g * 64; const int st_ = (t_) % NSR; \
        __builtin_amdgcn_global_load_lds((const unsigned*)(const GAS unsigned*)(uintptr_t)(Pb + (size_t)(j_ * 64 + lk_key) * NPJ + kc_ + lk_c8 * 8), (LAS unsigned*)(L + STG_OFF(st_) + w * 1024), 16, 0, 0); \
        __builtin_amdgcn_global_load_lds((const unsigned*)(const GAS unsigned*)(uintptr_t)(Pb + (size_t)(j_ * 64 + dv_key) * NPJ + kc_ + 128 + dv_src), (LAS unsigned*)(L + STG_OFF(st_) + 8192 + w * 1024), 16, 0, 0); } while (0)
#define TILE_WAIT(c_) do { if ((c_) >= 2) asm volatile("s_waitcnt vmcnt(4)" ::: "memory"); else if ((c_) == 1) asm volatile("s_waitcnt vmcnt(2)" ::: "memory"); else asm volatile("s_waitcnt vmcnt(0)" ::: "memory"); } while (0)
        asm volatile("s_waitcnt vmcnt(0)" ::: "memory");
        TILE_DMA(0);
        if (ntl > 1) TILE_DMA(1);
        if (ntl > 2) TILE_DMA(2);
        asm volatile("s_waitcnt vmcnt(0)" ::: "memory");
        __syncthreads();
        float m = -1e30f; f32x16 o[2], ol; o[0] = (f32x16){}; o[1] = (f32x16){}; ol = (f32x16){};
        int curty = 1;
        bf16x8 ka0 = {0, 0, 0, 0, 0, 0, 0, 0}, ka1 = ka0, qa = ka0;
        if (hi == 0) {
            const float b0_ = slope2 * (float)r32, b1_ = slope2 * (float)(r32 + 32);
            const unsigned h0_ = f2bf(b0_), h1_ = f2bf(b1_);
            ka0[0] = (short)h0_; ka0[1] = (short)f2bf(b0_ - bf2f((bf16_t)h0_)); ka1[0] = (short)h1_; ka1[1] = (short)f2bf(b1_ - bf2f((bf16_t)h1_));
            qa[0] = (short)0x3f80; qa[1] = (short)0x3f80;
        }
        for (int ip = 0; ip < ntl; ip += GRP) {
            if (ip + 3 < ntl) TILE_DMA(ip + 3);
            if (ip + 4 < ntl) TILE_DMA(ip + 4);
            if (ip + 5 < ntl) TILE_DMA(ip + 5);
            const int iend = ip + GRP < ntl ? ip + GRP : ntl;
        for (int i = ip; i < iend; ++i) {
            const int ent = LIST[i], ty = ent >> 8, j = ent & 255, stg = i % NSR;
            if (ty != curty) {
                axpy_ol(out, o, ol, gate2, wsf, r32, hi);
                m = -1e30f; o[0] = (f32x16){}; o[1] = (f32x16){}; ol = (f32x16){}; curty = ty;
            }
            const bool rowok = ty ? true : (((selq >> j) & 1u) != 0u);
            if (__any(rowok)) {
            f32x16 p0, p1;
            qkt_a(p0, p1, L + STG_OFF(stg), qr, r32, hi, ka0, ka1, qa);
            const float cb = slope2 * (float)(tq - 64 * j);
            const bool nomask = (j < c) && (ty ? (j > c - 8) : __all(rowok));
            float rm;
            if (nomask) {
                float ra = max3f(p0[0], p1[0], p0[1]), rb = max3f(p1[1], p0[2], p1[2]);
#pragma unroll
                for (int r = 3; r < 15; r += 2) { ra = max3f(ra, p0[r], p1[r]); rb = max3f(rb, p0[r + 1], p1[r + 1]); }
                ra = max3f(ra, p0[15], p1[15]);
                rm = max3f(ra, rb, rb);
            } else {
                rm = -INFINITY;
#pragma unroll
                for (int r = 0; r < 16; ++r) {
                    const int d0_ = tq - (j * 64 + crow(r, hi)), d1_ = d0_ - 32;
                    const bool ok0 = rowok && d0_ >= 0 && (ty == 0 || d0_ < 512), ok1 = rowok && d1_ >= 0 && (ty == 0 || d1_ < 512);
                    p0[r] = ok0 ? p0[r] : -INFINITY; p1[r] = ok1 ? p1[r] : -INFINITY;
                    rm = fmaxf(rm, fmaxf(p0[r], p1[r]));
                }
            }
            rm = swap_max(rm - cb);
            const float mn = fmaxf(m, rm);
            const float alpha = __builtin_amdgcn_exp2f(m - mn);
            m = mn;
            const float eref = mn + cb;
#pragma unroll
            for (int r = 0; r < 16; ++r) { p0[r] = __builtin_amdgcn_exp2f(p0[r] - eref); p1[r] = __builtin_amdgcn_exp2f(p1[r] - eref); }
            if (__any(alpha != 1.0f)) scale_ol(o, ol, alpha, wsf, r32, hi);
            bf16x8 a0, a1, a2, a3;
            pack_p(p0, p1, a0, a1, a2, a3);
            psum(ol, a0, a1, a2, a3);
            pv(o, (int)(lds0 + STG_OFF(stg) + 8192) + vboff, a0, a1, a2, a3);
            }
        }
            asm volatile("s_waitcnt vmcnt(0)" ::: "memory");
            __syncthreads();
        }
        {
            axpy_ol(out, o, ol, (curty ? gate2 : gate1), wsf, r32, hi);
        }
#undef TILE_DMA
#undef TILE_WAIT
#undef STG_OFF
    }
    {
        LAS bf16_t* ost = (LAS bf16_t*)(L + L_KB) + w * 2048;
#pragma unroll
        for (int r = 0; r < 16; ++r) { const int q = crow(r, hi); ost[q * 64 + r32] = (bf16_t)f2bf(out[0][r]); ost[q * 64 + 32 + r32] = (bf16_t)f2bf(out[1][r]); }
        asm volatile("s_waitcnt lgkmcnt(0)" ::: "memory");
        bf16_t* CC = (bf16_t*)(F.ws + WS_S + S_CONCAT) + ((size_t)b * T_ + t0 + th * 32) * D_ + 512 + g * 256 + rh * 64;
#pragma unroll
        for (int k = 0; k < 4; ++k) {
            const int q = k * 8 + (lanel >> 3), ch = lanel & 7;
            *(u32x4_t*)(CC + (size_t)q * D_ + ch * 8) = *(const LAS u32x4_t*)(ost + q * 64 + ch * 8);
        }
    }
}
template <int DBG = 0> __device__ __forceinline__ void p_nsa_attn(Frame& F, int l) {
    RELAUNDER(F);
    const int n_rw = 1792;
    const bf16_t* P = (const bf16_t*)(F.ws + WS_S + S_PROJ);
    for (int v = F.vcu; v < 256; v += F.G) {
        const int bg = v >> 4, s = v & 15;
#pragma unroll 1
        for (int half = 0; half < 2; ++half) nsa_item<DBG>(F, P, n_rw, bg >> 1, bg & 1, half == 0 ? 31 - s : s);
    }
}

namespace xat {
constexpr int L_P = 0, PPITCH = 264, L_PMAX = 64 * PPITCH * 2, L_PSUM = L_PMAX + 8 * 64 * 4, L_LINV = L_PSUM + 8 * 64 * 4, L_Q = L_LINV + 256, QPITCH = 264, L_OST = L_P  , L_END = L_Q + 2 * 64 * QPITCH * 2;
static_assert(8 * 64 * 32 * 2 <= 64 * PPITCH * 2, "O stage fits the P tile");
static_assert(L_END <= 131072, "cross LDS map");
constexpr float QSCALE = 0.0625f * 1.4426950408889634f;
}
__device__ __forceinline__ void p_cross_attn(Frame& F, int l, int grp_first, int grp_stride) {
    RELAUNDER(F);
    using namespace nsa;
    const bf16_t* QC = (const bf16_t*)(F.ws + WS_S + S_QC); bf16_t* OC = (bf16_t*)(F.ws + WS_S + S_OC);
    const bf16_t* KCR = (const bf16_t*)(F.ws + WS_KCR) + (size_t)l * NMEM * 1024; const bf16_t* VT = (const bf16_t*)(F.ws + WS_VT) + (size_t)l * 1024 * NMEM;
    const int tidl = F.tid, lanel = tidl & 63, w = F.wave, r32 = lanel & 31, hi = lanel >> 5;
    LAS unsigned char* L = F.lds;
    LAS bf16_t* Pl = (LAS bf16_t*)(L + xat::L_P); LAS float* PMAX = (LAS float*)(L + xat::L_PMAX); LAS float* PSUM = (LAS float*)(L + xat::L_PSUM); LAS float* LINV = (LAS float*)(L + xat::L_LINV);
    for (int grp = grp_first; grp < 256; grp += grp_stride) {
        const int bh = grp >> 3, b = bh >> 2, h = bh & 3;
        bf16x8 kf[16], vf[16];
        {
            const bf16_t* kp = KCR + ((size_t)b * MEM_ + 32 * w + r32) * 1024 + h * 256 + hi * 8;
            const bf16_t* vp = VT + ((size_t)(h * 256 + 32 * w + r32)) * NMEM + b * MEM_ + hi * 8;
#pragma unroll
            for (int d0 = 0; d0 < 16; ++d0) { kf[d0] = *(const bf16x8*)(kp + d0 * 16); vf[d0] = *(const bf16x8*)(vp + d0 * 16); }
        }
        LAS bf16_t* Ql = (LAS bf16_t*)(L + xat::L_Q);
        u32x4_t qreg[4];
        {
            const bf16_t* qsrc = QC + ((size_t)b * T_ + ((grp & 7) * 4) * 64 + (tidl >> 3)) * 1024 + h * 256 + (tidl & 7) * 8;
#pragma unroll
            for (int k = 0; k < 4; ++k) qreg[k] = *(const u32x4_t*)(qsrc + 64 * k);
        }
        __syncthreads();
#pragma unroll
        for (int k = 0; k < 4; ++k) *(LAS u32x4_t*)(Ql + (tidl >> 3) * xat::QPITCH + (tidl & 7) * 8 + 64 * k) = qreg[k];
#pragma unroll 1
        for (int i = 0; i < 4; ++i) {
            const int t0 = ((grp & 7) * 4 + i) * 64;
            LAS bf16_t* Qc = Ql + (i & 1) * 64 * xat::QPITCH;
            if (i < 3) {
                const bf16_t* qsrc = QC + ((size_t)b * T_ + t0 + 64 + (tidl >> 3)) * 1024 + h * 256 + (tidl & 7) * 8;
#pragma unroll
                for (int k = 0; k < 4; ++k) qreg[k] = *(const u32x4_t*)(qsrc + 64 * k);
            }
            __syncthreads();
            f32x16 s[2];
#pragma unroll
            for (int qs = 0; qs < 2; ++qs) {
                const LAS bf16_t* qp = Qc + (qs * 32 + r32) * xat::QPITCH + hi * 8;
                s[qs] = (f32x16){};
#pragma unroll
                for (int d0 = 0; d0 < 16; ++d0) { const bf16x8 qf = *(const LAS bf16x8*)(qp + d0 * 16); s[qs] = __builtin_amdgcn_mfma_f32_32x32x16_bf16(kf[d0], qf, s[qs], 0, 0, 0); }
            }
            if (i < 3) {
                LAS bf16_t* Qn = Ql + ((i + 1) & 1) * 64 * xat::QPITCH;
#pragma unroll
                for (int k = 0; k < 4; ++k) *(LAS u32x4_t*)(Qn + (tidl >> 3) * xat::QPITCH + (tidl & 7) * 8 + 64 * k) = qreg[k];
            }
#pragma unroll
            for (int qs = 0; qs < 2; ++qs) {
                float pm = s[qs][0];
#pragma unroll
                for (int r = 1; r < 16; ++r) pm = fmaxf(pm, s[qs][r]);
                pm = swap_max(pm);
                if (hi == 0) PMAX[w * 64 + qs * 32 + r32] = pm;
            }
            __syncthreads();
#pragma unroll
            for (int qs = 0; qs < 2; ++qs) {
                float m = PMAX[qs * 32 + r32];
#pragma unroll
                for (int ww = 1; ww < 8; ++ww) m = fmaxf(m, PMAX[ww * 64 + qs * 32 + r32]);
                float ps = 0.f;
#pragma unroll
                for (int r = 0; r < 16; ++r) { s[qs][r] = __builtin_amdgcn_exp2f(s[qs][r] - m); ps += s[qs][r]; }
                ps = swap_sum(ps);
                if (hi == 0) PSUM[w * 64 + qs * 32 + r32] = ps;
#pragma unroll
                for (int rq = 0; rq < 4; ++rq) {
                    u32x2_t pk; pk.x = cvtpk(s[qs][4 * rq], s[qs][4 * rq + 1]); pk.y = cvtpk(s[qs][4 * rq + 2], s[qs][4 * rq + 3]);
                    *(LAS u32x2_t*)(Pl + (qs * 32 + r32) * xat::PPITCH + 32 * w + 8 * rq + 4 * hi) = pk;
                }
            }
            __syncthreads();
            if (tidl < 64) { float t = 0.f;
#pragma unroll
                for (int ww = 0; ww < 8; ++ww) t += PSUM[ww * 64 + tidl];
                LINV[tidl] = __builtin_amdgcn_rcpf(t); }
            f32x16 o[2]; o[0] = (f32x16){}; o[1] = (f32x16){};
#pragma unroll
            for (int qs = 0; qs < 2; ++qs)
#pragma unroll
                for (int ks = 0; ks < 16; ++ks) {
                    const bf16x8 pf = *(const LAS bf16x8*)(Pl + (qs * 32 + r32) * xat::PPITCH + ks * 16 + hi * 8);
                    o[qs] = __builtin_amdgcn_mfma_f32_32x32x16_bf16(pf, vf[ks], o[qs], 0, 0, 0);
                }
            __syncthreads();
            {
                LAS bf16_t* ost = (LAS bf16_t*)(L + xat::L_OST) + w * 64 * 32;
#pragma unroll
                for (int qs = 0; qs < 2; ++qs)
#pragma unroll
                    for (int r = 0; r < 16; ++r) { const int q = qs * 32 + crow(r, hi); ost[q * 32 + r32] = (bf16_t)f2bf(o[qs][r] * LINV[q]); }
                asm volatile("s_waitcnt lgkmcnt(0)" ::: "memory");
#pragma unroll
                for (int k = 0; k < 4; ++k) {
                    const int q = k * 16 + (lanel >> 2), ch = lanel & 3;
                    const u32x4_t v = *(const LAS u32x4_t*)(ost + q * 32 + ch * 8);
                    *(u32x4_t*)(OC + ((size_t)b * T_ + t0 + q) * 1024 + h * 256 + 32 * w + ch * 8) = v;
                }
            }
        }
    }
}

namespace chk {
typedef short bf16x8 __attribute__((ext_vector_type(8)));
constexpr int TP = 72;
constexpr int WAVE_LDS = 4 * 16 * TP * 2 + 2 * 16 * 17 * 4 + 24 * 128;
typedef float f32x2_t __attribute__((ext_vector_type(2))); typedef __bf16 bf16x2_t __attribute__((ext_vector_type(2)));
__device__ __forceinline__ unsigned pk(float lo, float hi) { f32x2_t v = {lo, hi}; bf16x2_t b = __builtin_convertvector(v, bf16x2_t); return __builtin_bit_cast(unsigned, b); }
}
__device__ __forceinline__ void p_rw_chunk(Frame& F) {
    RELAUNDER(F);
    using namespace chk;
    const int lane = F.lane, j = lane;
    const int item0 = (((F.vcu >> 5) * 8 + F.wave) << 7) + 4 * (F.vcu & 31);
    const bf16_t* SC = (const bf16_t*)(F.ws + WS_S + S_SC);
    LAS unsigned char* wl = F.lds + F.wave * WAVE_LDS;
    LAS bf16_t* tA = (LAS bf16_t*)wl; LAS bf16_t* tB = tA + 16 * TP; LAS bf16_t* tK = tB + 16 * TP; LAS bf16_t* tR = tK + 16 * TP;
    LAS float* M1s = (LAS float*)(wl + 4 * 16 * TP * 2); LAS float* Ts = M1s + 16 * 17;
    const int m = lane & 15, kq = lane >> 4;
    LAS bf16_t* raw = (LAS bf16_t*)(wl + 4 * 16 * TP * 2 + 2 * 16 * 17 * 4);
    u32x4_t R[12];
    {
        const bf16_t* s0 = SC + (size_t)item0 * (16 * 384) + lane * 8;
#pragma unroll
        for (int q = 0; q < 12; ++q) R[q] = *(const u32x4_t*)(s0 + q * 512);
    }
#pragma unroll 1
    for (int item = item0; item < item0 + 4; ++item) {
        unsigned char* dst = F.ws + WS_S + S_CH + (size_t)item * CH_BYTES;
        float gam = 1.0f;
        float be[16], ka[16], vv[16];
#pragma unroll
        for (int qt = 0; qt < 4; ++qt) {
#pragma unroll
            for (int q3 = 0; q3 < 3; ++q3) *(LAS u32x4_t*)(raw + (8 * q3 + (lane >> 3)) * 64 + (lane & 7) * 8) = R[3 * qt + q3];
            asm volatile("s_waitcnt lgkmcnt(0)" ::: "memory");
#pragma unroll
            for (int tl = 0; tl < 4; ++tl) {
                const int t = 4 * qt + tl;
                const float r = bf2f(raw[(tl * 6 + 0) * 64 + j]), om = bf2f(raw[(tl * 6 + 1) * 64 + j]), kt = bf2f(raw[(tl * 6 + 2) * 64 + j]), v = bf2f(raw[(tl * 6 + 3) * 64 + j]),
                            kh = bf2f(raw[(tl * 6 + 4) * 64 + j]), b = bf2f(raw[(tl * 6 + 5) * 64 + j]);
                const float al = -kh * gam;
                gam = gam - gam * om;
                const float ig = __builtin_amdgcn_rcpf(gam);
                be[t] = b * ig; ka[t] = kt * ig; vv[t] = v;
                tA[t * TP + j] = (bf16_t)f2bf(al); tB[t * TP + j] = (bf16_t)f2bf(be[t]); tK[t * TP + j] = (bf16_t)f2bf(ka[t]); tR[t * TP + j] = (bf16_t)f2bf(r * gam);
            }
            asm volatile("s_waitcnt lgkmcnt(0)" ::: "memory");
        }
        if (item + 1 < item0 + 4) {
            const bf16_t* s0 = SC + (size_t)(item + 1) * (16 * 384) + lane * 8;
#pragma unroll
            for (int q = 0; q < 12; ++q) R[q] = *(const u32x4_t*)(s0 + q * 512);
        }
        *(float*)(dst + 12288 + 4 * j) = gam;
        {
            const int mt = j >> 4, jl = j & 15;
            unsigned char* pB = dst + 4096 + (mt >> 1) * 1024 + (mt & 1) * 8;
            unsigned char* pK = dst + 4096 + 2048 + (mt >> 1) * 1024 + (mt & 1) * 8;
            unsigned char* pV = dst + 10240 + mt * 512;
#pragma unroll
            for (int q2 = 0; q2 < 4; ++q2) {
                const int le = q2 * 16 + jl;
                u32x2_t o; o.x = pk(be[4 * q2], be[4 * q2 + 1]); o.y = pk(be[4 * q2 + 2], be[4 * q2 + 3]); *(u32x2_t*)(pB + le * 16) = o;
                o.x = pk(ka[4 * q2], ka[4 * q2 + 1]); o.y = pk(ka[4 * q2 + 2], ka[4 * q2 + 3]); *(u32x2_t*)(pK + le * 16) = o;
                o.x = pk(vv[4 * q2], vv[4 * q2 + 1]); o.y = pk(vv[4 * q2 + 2], vv[4 * q2 + 3]); *(u32x2_t*)(pV + le * 8) = o;
            }
        }
        asm volatile("s_waitcnt lgkmcnt(0)" ::: "memory");
#pragma unroll
        for (int ks = 0; ks < 2; ++ks) {
            const u32x2_t a0 = *(const LAS u32x2_t*)(tA + m * TP + 32 * ks + 4 * kq), a1 = *(const LAS u32x2_t*)(tA + m * TP + 32 * ks + 16 + 4 * kq);
            *(u32x4_t*)(dst + ks * 1024 + lane * 16) = (u32x4_t){a0.x, a0.y, a1.x, a1.y};
            const u32x2_t r0 = *(const LAS u32x2_t*)(tR + m * TP + 32 * ks + 4 * kq), r1 = *(const LAS u32x2_t*)(tR + m * TP + 32 * ks + 16 + 4 * kq);
            *(u32x4_t*)(dst + 2048 + ks * 1024 + lane * 16) = (u32x4_t){r0.x, r0.y, r1.x, r1.y};
        }
        pg8::f32x4 d1 = {0.f, 0.f, 0.f, 0.f}, d2 = d1, d3 = d1, d4 = d1;
#pragma unroll
        for (int ks = 0; ks < 2; ++ks) {
            const bf16x8 fb = *(const LAS bf16x8*)(tB + m * TP + 32 * ks + 8 * kq), fk = *(const LAS bf16x8*)(tK + m * TP + 32 * ks + 8 * kq);
            const bf16x8 fa = *(const LAS bf16x8*)(tA + m * TP + 32 * ks + 8 * kq), fr = *(const LAS bf16x8*)(tR + m * TP + 32 * ks + 8 * kq);
            d1 = __builtin_amdgcn_mfma_f32_16x16x32_bf16(fb, fa, d1, 0, 0, 0);
            d2 = __builtin_amdgcn_mfma_f32_16x16x32_bf16(fk, fa, d2, 0, 0, 0);
            d3 = __builtin_amdgcn_mfma_f32_16x16x32_bf16(fb, fr, d3, 0, 0, 0);
            d4 = __builtin_amdgcn_mfma_f32_16x16x32_bf16(fk, fr, d4, 0, 0, 0);
        }
#pragma unroll
        for (int rg = 0; rg < 4; ++rg) {
            const int s_ = 4 * kq + rg, t_ = m;
            if (!(s_ < t_)) { d1[rg] = 0.f; d2[rg] = 0.f; }
            if (!(s_ <= t_)) { d3[rg] = 0.f; d4[rg] = 0.f; }
            M1s[s_ * 17 + t_] = d1[rg];
        }
        asm volatile("s_waitcnt lgkmcnt(0)" ::: "memory");
        {
            float tr[16];
#pragma unroll
            for (int t = 0; t < 16; ++t) {
                float a = (m == t) ? 1.0f : 0.0f;
#pragma unroll
                for (int s2 = 0; s2 < t; ++s2) a += tr[s2] * M1s[s2 * 17 + t];
                tr[t] = a;
            }
            if (kq == 0) {
#pragma unroll
                for (int t = 0; t < 16; ++t) Ts[m * 17 + t] = tr[t];
            }
        }
        asm volatile("s_waitcnt lgkmcnt(0)" ::: "memory");
        {
            u32x4_t o;
            o.x = pk(Ts[(4 * kq + 0) * 17 + m], Ts[(4 * kq + 1) * 17 + m]); o.y = pk(Ts[(4 * kq + 2) * 17 + m], Ts[(4 * kq + 3) * 17 + m]);
            o.z = pk(d2[0], d2[1]); o.w = pk(d2[2], d2[3]);
            *(u32x4_t*)(dst + 4096 + 4 * 1024 + lane * 16) = o;
            o.x = pk(d3[0], d3[1]); o.y = pk(d3[2], d3[3]); o.z = pk(d4[0], d4[1]); o.w = pk(d4[2], d4[3]);
            *(u32x4_t*)(dst + 4096 + 5 * 1024 + lane * 16) = o;
        }
        asm volatile("s_waitcnt lgkmcnt(0)" ::: "memory");
    }
}

namespace chk { constexpr int SL = 12800, NS = 9, DD = 7; static_assert(NS * SL <= 131072 && NS >= DD + 2, "ring"); }
__device__ __forceinline__ void p_rw_scan2(Frame& F, int bh) {
    RELAUNDER(F);
    using namespace chk;
    const int w = F.wave, lane = F.lane, il = lane & 15, kq = lane >> 4;
    const unsigned char* base = F.ws + WS_S + S_CH + (size_t)bh * 128 * CH_BYTES;
    LAS unsigned char* L = F.lds;
#define CH_ISSUE(c_) do { const unsigned char* cb_ = base + (size_t)(c_) * CH_BYTES; LAS unsigned char* sl_ = L + ((c_) % NS) * SL; const int lw_ = w - 4; \
        __builtin_amdgcn_global_load_lds((const unsigned*)(cb_ + (lw_) * 1024 + lane * 16), (LAS unsigned*)(sl_ + (lw_) * 1024), 16, 0, 0); \
        __builtin_amdgcn_global_load_lds((const unsigned*)(cb_ + (lw_ + 4) * 1024 + lane * 16), (LAS unsigned*)(sl_ + (lw_ + 4) * 1024), 16, 0, 0); \
        __builtin_amdgcn_global_load_lds((const unsigned*)(cb_ + (lw_ + 8) * 1024 + lane * 16), (LAS unsigned*)(sl_ + (lw_ + 8) * 1024), 16, 0, 0); \
        if (lw_ == 0) __builtin_amdgcn_global_load_lds((const unsigned*)(cb_ + 12288 + lane * 4), (LAS unsigned*)(sl_ + 12288), 4, 0, 0); } while (0)
    if (w >= 4) {
#pragma unroll 1
        for (int c = 0; c < DD; ++c) CH_ISSUE(c);
#pragma unroll 1
        for (int c = 0; c < 128; ++c) {
            if (c + DD < 128) {
                CH_ISSUE(c + DD);
                if (w == 4) asm volatile("s_waitcnt vmcnt(28)" ::: "memory"); else asm volatile("s_waitcnt vmcnt(21)" ::: "memory");
            } else asm volatile("s_waitcnt vmcnt(0)" ::: "memory");
            __builtin_amdgcn_s_barrier();
        }
    } else {
        const int qtr = w;
        float* Y = (float*)((unsigned char*)F.out + O_Y) + ((size_t)(bh >> 3) * T_) * W_ + (bh & 7) * 64 + 16 * qtr + il;
        pg8::f32x4 acc0 = {0.f, 0.f, 0.f, 0.f}, acc1 = acc0, acc2 = acc0, acc3 = acc0;
        typedef short s16x4_ __attribute__((ext_vector_type(4)));
#define HALF_LO(q_) __builtin_bit_cast(s16x4_, (u32x2_t){(q_).x, (q_).y})
#define HALF_HI(q_) __builtin_bit_cast(s16x4_, (u32x2_t){(q_).z, (q_).w})
#define FULL(q_) __builtin_bit_cast(bf16x8, (q_))
#define MMAH(a_, b_, c_) __builtin_amdgcn_mfma_f32_16x16x16bf16_1k(a_, b_, c_, 0, 0, 0)
#pragma unroll 1
        for (int c = 0; c < 128; ++c) {
            __builtin_amdgcn_s_barrier();
            asm volatile("" ::: "memory");
            const LAS unsigned char* sl = L + (c % NS) * SL + lane * 16;
            const u32x4_t at0 = *(const LAS u32x4_t*)(sl), at1 = *(const LAS u32x4_t*)(sl + 1024), rt0 = *(const LAS u32x4_t*)(sl + 2048), rt1 = *(const LAS u32x4_t*)(sl + 3072);
            const u32x4_t p0 = *(const LAS u32x4_t*)(sl + 4096), p1 = *(const LAS u32x4_t*)(sl + 5120), p2 = *(const LAS u32x4_t*)(sl + 6144), p3 = *(const LAS u32x4_t*)(sl + 7168);
            const u32x4_t p4 = *(const LAS u32x4_t*)(sl + 8192), p5 = *(const LAS u32x4_t*)(sl + 9216);
            const u32x2_t vt = *(const LAS u32x2_t*)(L + (c % NS) * SL + 10240 + qtr * 512 + lane * 8);
            const LAS float* gp = (const LAS float*)(L + (c % NS) * SL + 12288) + 4 * kq;
            const f32x4_t g0 = *(const LAS f32x4_t*)(gp), g1 = *(const LAS f32x4_t*)(gp + 16), g2 = *(const LAS f32x4_t*)(gp + 32), g3 = *(const LAS f32x4_t*)(gp + 48);
            const bf16x8 S0 = __builtin_bit_cast(bf16x8, (u32x4_t){pk(acc0[0], acc0[1]), pk(acc0[2], acc0[3]), pk(acc1[0], acc1[1]), pk(acc1[2], acc1[3])});
            const bf16x8 S1 = __builtin_bit_cast(bf16x8, (u32x4_t){pk(acc2[0], acc2[1]), pk(acc2[2], acc2[3]), pk(acc3[0], acc3[1]), pk(acc3[2], acc3[3])});
            const s16x4_ VT = __builtin_bit_cast(s16x4_, vt);
            pg8::f32x4 wt = {0.f, 0.f, 0.f, 0.f};
            wt = MMAH(HALF_HI(p4), VT, wt);
            wt = __builtin_amdgcn_mfma_f32_16x16x32_bf16(FULL(at0), S0, wt, 0, 0, 0);
            wt = __builtin_amdgcn_mfma_f32_16x16x32_bf16(FULL(at1), S1, wt, 0, 0, 0);
            acc0 = MMAH(HALF_LO(p2), VT, acc0);
            acc1 = MMAH(HALF_HI(p2), VT, acc1);
            acc2 = MMAH(HALF_LO(p3), VT, acc2);
            acc3 = MMAH(HALF_HI(p3), VT, acc3);
            pg8::f32x4 yt = {0.f, 0.f, 0.f, 0.f};
            yt = __builtin_amdgcn_mfma_f32_16x16x32_bf16(FULL(rt0), S0, yt, 0, 0, 0);
            yt = __builtin_amdgcn_mfma_f32_16x16x32_bf16(FULL(rt1), S1, yt, 0, 0, 0);
            yt = MMAH(HALF_HI(p5), VT, yt);
            const s16x4_ WB = __builtin_bit_cast(s16x4_, (u32x2_t){pk(wt[0], wt[1]), pk(wt[2], wt[3])});
            pg8::f32x4 ut = {0.f, 0.f, 0.f, 0.f};
            ut = MMAH(HALF_LO(p4), WB, ut);
            const s16x4_ UB = __builtin_bit_cast(s16x4_, (u32x2_t){pk(ut[0], ut[1]), pk(ut[2], ut[3])});
            acc0 = MMAH(HALF_LO(p0), UB, acc0);
            acc1 = MMAH(HALF_HI(p0), UB, acc1);
            acc2 = MMAH(HALF_LO(p1), UB, acc2);
            acc3 = MMAH(HALF_HI(p1), UB, acc3);
            yt = MMAH(HALF_LO(p5), UB, yt);
            acc0 = acc0 * g0; acc1 = acc1 * g1; acc2 = acc2 * g2; acc3 = acc3 * g3;
            { float* yp = Y + (size_t)(16 * c + 4 * kq) * W_; yp[0] = yt[0]; yp[W_] = yt[1]; yp[2 * W_] = yt[2]; yp[3 * W_] = yt[3]; }
        }
#undef HALF_LO
#undef HALF_HI
#undef FULL
#undef MMAH
    }
#undef CH_ISSUE
}
#ifndef MK_FUSED
#define MK_FUSED 1
#endif
#if !MK_FUSED
__global__ void __launch_bounds__(NWAVES * 64, 2) mega(Args args) {
    extern __shared__ __attribute__((aligned(16))) unsigned char lds[];
    {
        LAS unsigned char* l3 = (LAS unsigned char*)lds;
        for (int u = threadIdx.x; u < (LDS_BYTES - LDSCTL_OFF) / 4; u += NWAVES * 64) ((LAS unsigned*)(l3 + LDSCTL_OFF))[u] = 0u;
    }
    __syncthreads();
    {
        const int ph = args.ph[0];
        Frame F;
        F.ws = launder_ptr(args.ws);
        { int t = threadIdx.x; asm volatile("" : "+v"(t)); F.tid = t; }
        F.lds = (LAS unsigned char*)lds;
        F.MISC = (volatile LAS unsigned*)(F.lds + MISC_OFF);
        F.lane = F.tid & 63; F.wave = __builtin_amdgcn_readfirstlane(F.tid >> 6);
        F.G = gridDim.x; { const int bx = blockIdx.x; F.vcu = (F.G % 8 == 0) ? (bx % 8) * (F.G / 8) + bx / 8 : bx; }
        F.in = args.in; F.out = (float*)(GAS float*)args.out;
        if (ph == 0) p_prologue(F);
        else if (ph == 1) p_kv(F);
        else if (ph == 10 || ph == 11) p_inproj(F, ph - 10);
        else if (ph == 20 || ph == 21) p_rw_prep(F, ph - 20);
        else if (ph == 25 || ph == 26) p_nsa_cmp(F, ph - 25);
        else if (ph == 30 || ph == 31) p_rw_scan(F);
        else if (ph == 45 || ph == 46) p_nsa_attn(F, ph - 45);
        else if (ph == 40 || ph == 41) p_rw_post(F, ph - 40);
        else if (ph == 50 || ph == 51) p_resid_gemm(F, (const bf16_t*)(F.ws + WS_S + S_CONCAT), (const bf16_t*)(F.ws + WS_WB + WB_WOUT) + (size_t)(ph - 50) * D_ * D_, 1024);
        else if (ph == 60 || ph == 61) p_crossq(F, ph - 60);
        else if (ph == 70 || ph == 71) p_cross_attn(F, ph - 70);
        else if (ph == 80 || ph == 81) p_resid_gemm(F, (const bf16_t*)(F.ws + WS_S + S_OC), (const bf16_t*)(F.ws + WS_WB + WB_WO) + (size_t)(ph - 80) * D_ * D_, 1024);
        else if (ph == 90) p_ffn_up(F);
        else if (ph == 100) p_route(F);
        else if (ph == 101) p_moe_prep(F);
        else if (ph == 102 || ph == 104) p_moe_gemm1(F, (ph - 102) >> 1);
        else if (ph == 103 || ph == 105) p_moe_gemm2(F, (ph - 103) >> 1);
        else if (ph == 110) p_final(F, true);
        else if (ph == 91) p_resid_gemm(F, (const bf16_t*)(F.ws + WS_S + S_ACT), (const bf16_t*)(F.ws + WS_WB + WB_WD), FFD);
        __syncthreads();
    }
}
#else
__global__ void __launch_bounds__(NWAVES * 64, 2) mega(Args args) {
    extern __shared__ __attribute__((aligned(16))) unsigned char lds[];
    {
        LAS unsigned char* l3 = (LAS unsigned char*)lds;
        for (int u = threadIdx.x; u < (LDS_BYTES - LDSCTL_OFF) / 4; u += NWAVES * 64) ((LAS unsigned*)(l3 + LDSCTL_OFF))[u] = 0u;
    }
    __syncthreads();
    const XcdBarrier bar = xcd_barrier_post((unsigned*)(args.ws + WS_CTL) + CW_BAR, (volatile LAS unsigned*)((LAS unsigned char*)lds + MISC_OFF) + 8);
    Frame F;
    F.ws = launder_ptr(args.ws);
    { int t = threadIdx.x; asm volatile("" : "+v"(t)); F.tid = t; }
    F.lds = (LAS unsigned char*)lds;
    F.MISC = (volatile LAS unsigned*)(F.lds + MISC_OFF);
    F.lane = F.tid & 63; F.wave = __builtin_amdgcn_readfirstlane(F.tid >> 6);
    F.G = gridDim.x; { const int bx = blockIdx.x; F.vcu = (F.G % 8 == 0) ? (bx % 8) * (F.G / 8) + bx / 8 : bx; }
    F.in = args.in; F.out = (float*)(GAS float*)args.out;
#ifndef MK_DIAG_MASK
#define MK_DIAG_MASK 0ull
#endif
    unsigned long long* TS = (unsigned long long*)(args.ws + WS_CTL + 600 * 1024); int nseam = 0;
#define SEAM() do { xcd_barrier(bar); if (MK_DIAG_MASK != 0ull && blockIdx.x == 0 && threadIdx.x == 0) TS[++nseam] = __builtin_amdgcn_s_memrealtime(); } while (0)
    if (MK_DIAG_MASK != 0ull && blockIdx.x == 0 && threadIdx.x == 0) TS[0] = __builtin_amdgcn_s_memrealtime();
    p_prologue(F); SEAM();
    p_inproj(F, 0); SEAM();
    p_rw_prep(F, 0);
    SEAM();
    p_rw_chunk(F); SEAM();
    if (F.vcu < 64) p_rw_scan2(F, F.vcu);
    else { const int k = F.vcu - 64; p_kv(F, k); __syncthreads(); if (k < 128) p_nsa_cmp(F, 0, k, 1); else p_nsa_cmp(F, 0, 128 + 2 * (k - 128), 2); }
    SEAM();
    p_nsa_attn(F, 0); __syncthreads(); p_rw_post(F, 0); SEAM();
    p_resid_gemm(F, (const bf16_t*)(F.ws + WS_S + S_CONCAT), (const bf16_t*)(F.ws + WS_WB + WB_WOUT), 1024); SEAM();
    (void)p_crossq(F, 0); SEAM();
    p_cross_attn(F, 0, F.vcu, F.G); SEAM();
    p_resid_gemm(F, (const bf16_t*)(F.ws + WS_S + S_OC), (const bf16_t*)(F.ws + WS_WB + WB_WO), 1024); SEAM();
    p_ffn_up(F); SEAM();
    p_ffn_down8(F); SEAM();
    p_inproj(F, 1); SEAM();
    p_rw_prep(F, 1);
    SEAM();
    p_rw_chunk(F); SEAM();
    if (F.vcu < 64) p_rw_scan2(F, F.vcu);
    else { const int k = F.vcu - 64; if (k < 64) p_nsa_cmp(F, 1, 2 * k, 2); else p_nsa_cmp(F, 1, 128 + (k - 64), 1); }
    SEAM();
    p_nsa_attn(F, 1); __syncthreads(); p_rw_post(F, 1); SEAM();
    p_resid_gemm(F, (const bf16_t*)(F.ws + WS_S + S_CONCAT), (const bf16_t*)(F.ws + WS_WB + WB_WOUT) + (size_t)D_ * D_, 1024); SEAM();
    (void)p_crossq(F, 1); SEAM();
    p_cross_attn(F, 1, F.vcu, F.G); SEAM();
    p_resid_gemm(F, (const bf16_t*)(F.ws + WS_S + S_OC), (const bf16_t*)(F.ws + WS_WB + WB_WO) + (size_t)D_ * D_, 1024); SEAM();
    p_route(F); SEAM();
    p_moe_prep(F); __syncthreads(); p_moe_conv(F); SEAM();
    p_moe_gemm1(F); SEAM();
    p_moe_gemm2(F); SEAM(); p_moe_gemm2_split(F);
    if (MK_DIAG_MASK != 0ull && blockIdx.x == 0 && threadIdx.x == 0) {
        TS[nseam + 1] = __builtin_amdgcn_s_memrealtime();
        unsigned long long tot = 0;
        for (int i = 0; i <= nseam; ++i) if ((MK_DIAG_MASK >> i) & 1ull) tot += TS[i + 1] - TS[i];
        *(float*)(args.ws + WS_CTL + 640 * 1024) = (float)tot * 1e-5f;
        __threadfence();
    }
    SEAM();
    p_final(F, true);
#undef SEAM
}
#endif

namespace v0 {
constexpr int B = B_, T = T_, D = D_, W = W_, H = H_, DH = DH_, MEM = MEM_;
constexpr int ECAP = 8192;
__global__ void k_rmsnorm(const float* __restrict__ x, const float* __restrict__ g, float* __restrict__ out, int rows) {
    const int wave = (blockIdx.x * blockDim.x + threadIdx.x) >> 6, lane = threadIdx.x & 63;
    if (wave >= rows) return;
    const float* xr = x + (size_t)wave * D;
    float v[16]; float s = 0.f;
#pragma unroll
    for (int i = 0; i < 16; ++i) { v[i] = xr[lane + 64 * i]; s += v[i] * v[i]; }
    s = wave_sum(s);
    const float rinv = rsqrtf(s * (1.f / D) + 1e-6f);
#pragma unroll
    for (int i = 0; i < 16; ++i) out[(size_t)wave * D + lane + 64 * i] = v[i] * rinv * g[lane + 64 * i];
}

template <int MODE, bool GATHER>
__global__ void __launch_bounds__(256) k_gemm(const float* __restrict__ A, int lda, const int* __restrict__ rowidx, const int* __restrict__ Mdev, int M,
                                               const float* __restrict__ Wt, const float* __restrict__ W2, int ldw, float* __restrict__ C, int ldc, int N, int K,
                                               const float* __restrict__ scale) {
    if (Mdev) { M = *Mdev; if (M > ECAP) M = ECAP; }
    const int m0 = blockIdx.y * 64, n0 = blockIdx.x * 64;
    if (m0 >= M) return;
    __shared__ float As[16][65];
    __shared__ float Bs[16][65];
    __shared__ float B2s[(MODE == 2) ? 16 : 1][65];
    const int tid = threadIdx.x, tx = tid & 15, ty = tid >> 4;
    float acc[4][4] = {}; float acc2[4][4] = {};
    for (int k0 = 0; k0 < K; k0 += 16) {
        for (int i = tid; i < 64 * 16; i += 256) {
            const int r = i >> 4, kk = i & 15; const int m = m0 + r;
            float v = 0.f;
            if (m < M) { const int ar = GATHER ? rowidx[m] : m; v = A[(size_t)ar * lda + k0 + kk]; }
            As[kk][r] = v;
        }
        for (int i = tid; i < 16 * 64; i += 256) {
            const int kk = i >> 6, c = i & 63; const int n = n0 + c;
            Bs[kk][c] = (n < N) ? Wt[(size_t)(k0 + kk) * ldw + n] : 0.f;
            if (MODE == 2) B2s[kk][c] = (n < N) ? W2[(size_t)(k0 + kk) * ldw + n] : 0.f;
        }
        __syncthreads();
#pragma unroll
        for (int kk = 0; kk < 16; ++kk) {
            float a[4], b[4], b2[4];
#pragma unroll
            for (int i = 0; i < 4; ++i) a[i] = As[kk][ty * 4 + i];
#pragma unroll
            for (int j = 0; j < 4; ++j) { b[j] = Bs[kk][tx * 4 + j]; if (MODE == 2) b2[j] = B2s[kk][tx * 4 + j]; }
#pragma unroll
            for (int i = 0; i < 4; ++i)
#pragma unroll
                for (int j = 0; j < 4; ++j) { acc[i][j] += a[i] * b[j]; if (MODE == 2) acc2[i][j] += a[i] * b2[j]; }
        }
        __syncthreads();
    }
#pragma unroll
    for (int i = 0; i < 4; ++i) {
        const int m = m0 + ty * 4 + i; if (m >= M) continue;
#pragma unroll
        for (int j = 0; j < 4; ++j) {
            const int n = n0 + tx * 4 + j; if (n >= N) continue;
            if (MODE == 0) C[(size_t)m * ldc + n] = acc[i][j];
            else if (MODE == 1) C[(size_t)m * ldc + n] += acc[i][j];
            else if (MODE == 2) { const float gte = acc[i][j]; C[(size_t)m * ldc + n] = gte * sigmoidf_(gte) * acc2[i][j]; }
            else { const int orow = rowidx[m]; C[(size_t)orow * ldc + n] += scale[m] * acc[i][j]; }
        }
    }
}

struct RwPar {
    const float *mu, *w0, *w2, *a0, *a2, *g2, *k_k, *k_a, *v0, *v2;
};
template <class TP>
__global__ void __launch_bounds__(512) k_rw_prep(const TP* __restrict__ proj, int ncols, int n_rw, RwPar p, int layer,
                                                 float* __restrict__ DEC, float* __restrict__ AIC, float* __restrict__ VP, float* __restrict__ G, float* __restrict__ VFIRST) {
    const int tok = blockIdx.x, t = tok % T, c = threadIdx.x;
    __shared__ float lo[288];
    const TP* cur = proj + (size_t)tok * ncols;
    const TP* prv = cur - ncols;
    if (c < n_rw - 1536) {
        const int col = 1536 + c;
        const float u = ldf(cur, col), up = (t > 0) ? ldf(prv, col) : 0.f;
        float v = u + (up - u) * p.mu[col];
        if (c < 64) v = tanhf(v);
        else if (c >= 128 && c < 256) v = sigmoidf_(v);
        lo[c] = v;
    }
    __syncthreads();
    float wr = p.w0[c], ar = p.a0[c], gr = 0.f;
#pragma unroll 4
    for (int j = 0; j < 64; ++j) { wr += lo[j] * p.w2[j * W + c]; ar += lo[64 + j] * p.a2[j * W + c]; }
#pragma unroll 4
    for (int j = 0; j < 128; ++j) gr += lo[128 + j] * p.g2[j * W + c];
    const float sp = (-wr > 20.f) ? -wr : log1pf(__expf(-wr));
    const float w = -sp - 0.5f;
    DEC[(size_t)tok * W + c] = __expf(-__expf(w));
    AIC[(size_t)tok * W + c] = sigmoidf_(ar);
    G[(size_t)tok * W + c] = gr;
    {
        const int col = 1024 + c;
        const float u = ldf(cur, col), up = (t > 0) ? ldf(prv, col) : 0.f;
        float v = u + (up - u) * p.mu[col];
        if (layer == 0) { VFIRST[(size_t)tok * W + c] = v; }
        else {
            float vr = p.v0[c];
#pragma unroll 4
            for (int j = 0; j < 32; ++j) vr += lo[256 + j] * p.v2[j * W + c];
            const float vf = VFIRST[(size_t)tok * W + c];
            v = v + (vf - v) * sigmoidf_(vr);
        }
        VP[(size_t)tok * W + c] = v;
    }
}

template <class TP>
__global__ void __launch_bounds__(64) k_rw_scan(const TP* __restrict__ proj, int ncols, const float* __restrict__ mu, const float* __restrict__ k_k, const float* __restrict__ k_a,
                                                const float* __restrict__ r_k,
                                                const float* __restrict__ DEC, const float* __restrict__ AIC, const float* __restrict__ VP,
                                                float* __restrict__ Y, float* __restrict__ BON) {
    const int b = blockIdx.x / H, h = blockIdx.x % H, j = threadIdx.x, c = h * DH + j;
    __shared__ float sr[64], sw[64], sk[64], sa[64], sb[64];
    float S[64];
#pragma unroll
    for (int i = 0; i < 64; ++i) S[i] = 0.f;
    const float mur = mu[c], muk = mu[W + c], kkc = k_k[c], kac = k_a[c], rkc = r_k[c];
    float pr = 0.f, pk = 0.f;
    for (int t = 0; t < T; ++t) {
        const size_t tok = (size_t)b * T + t;
        const TP* cur = proj + tok * ncols;
        const float ur = ldf(cur, c), uk = ldf(cur, W + c);
        const float r = ur + (pr - ur) * mur, k = uk + (pk - uk) * muk;
        pr = ur; pk = uk;
        const float a = AIC[tok * W + c], dec = DEC[tok * W + c], v = VP[tok * W + c];
        float kk = k * kkc;
        const float nrm = sqrtf(wave_sum(kk * kk));
        kk = kk / fmaxf(nrm, 1e-12f);
        const float kh = k * (1.f + (a - 1.f) * kac);
        const float bon = wave_sum(r * kh * rkc);
        __syncthreads();
        sr[j] = r; sw[j] = dec; sk[j] = kh; sa[j] = -kk; sb[j] = kk * a;
        __syncthreads();
        float Sa = 0.f;
#pragma unroll
        for (int q = 0; q < 64; ++q) Sa += S[q] * sa[q];
        float y = 0.f;
#pragma unroll
        for (int q = 0; q < 64; ++q) { S[q] = S[q] * sw[q] + Sa * sb[q] + v * sk[q]; y += S[q] * sr[q]; }
        Y[tok * W + c] = y;
        if (j == 0) BON[tok * H + h] = bon;
    }
}

template <class TC>
__global__ void k_rw_post(const float* __restrict__ Y, const float* __restrict__ BON, const float* __restrict__ VP, const float* __restrict__ G, const float* __restrict__ ln_w, const float* __restrict__ ln_b,
                          TC* __restrict__ concat) {
    const int wid = (blockIdx.x * blockDim.x + threadIdx.x) >> 6, lane = threadIdx.x & 63;
    if (wid >= NTOK * H) return;
    const int tok = wid / H, h = wid % H, c = h * DH + lane;
    const float y = Y[(size_t)tok * W + c];
    const float mean = wave_sum(y) * (1.f / 64.f);
    const float d = y - mean;
    const float var = wave_sum(d * d) * (1.f / 64.f);
    const float yn = d * rsqrtf(var + 64e-5f) * ln_w[c] + ln_b[c];
    stf(concat, (size_t)tok * D + c, (yn + BON[(size_t)tok * H + h] * VP[(size_t)tok * W + c]) * G[(size_t)tok * W + c]);
}

template <class TP>
__global__ void __launch_bounds__(128) k_cmp_hidden(const TP* __restrict__ proj, int ncols, int colbase  , const float* __restrict__ pe,
                                                    const float* __restrict__ w1, float* __restrict__ hid) {
    const int row = blockIdx.x, n = row % NCMP, g = (row / NCMP) % 2, b = row / (NCMP * 2);
    __shared__ float blk[2048];
    for (int i = threadIdx.x; i < 2048; i += 128) {
        const int l = i >> 6, d = i & 63;
        blk[i] = ldf(proj, ((size_t)b * T + 16 * n + l) * ncols + colbase + g * 64 + d) + pe[i];
    }
    __syncthreads();
    float acc = 0.f;
    for (int k = 0; k < 2048; ++k) acc += blk[k] * w1[(size_t)k * 128 + threadIdx.x];
    const float x = acc;
    const float ge = 0.5f * x * (1.f + tanhf(0.7978845608028654f * (x + 0.044715f * x * x * x)));
    hid[(size_t)row * 128 + threadIdx.x] = ge;
}
__global__ void __launch_bounds__(64) k_cmp_out(const float* __restrict__ hid, const float* __restrict__ w2, float* __restrict__ out  ) {
    const int row = blockIdx.x, n = row % NCMP, bg = row / NCMP;
    float acc = 0.f;
    for (int k = 0; k < 128; ++k) acc += hid[(size_t)row * 128 + k] * w2[k * 64 + threadIdx.x];
    out[((size_t)bg * 128 + n) * 64 + threadIdx.x] = acc;
}

template <class TP, class TC>
__global__ void __launch_bounds__(512) k_nsa_attn(const TP* __restrict__ proj, int ncols, int n_rw, const float* __restrict__ KC, const float* __restrict__ VC, TC* __restrict__ concat) {
    const int tok = blockIdx.x, b = tok / T, t = tok % T;
    const int wave = threadIdx.x >> 6, lane = threadIdx.x & 63, g = wave >> 2, r = wave & 3, hq = wave;
    const TP* cols = proj + (size_t)tok * ncols + n_rw;
    __shared__ float qs[8][64];
    __shared__ float ps[8][128];
    __shared__ float imp[2][32];
    __shared__ unsigned selm[2];
    __shared__ float pbuf[8][64];
    const float slope = exp2f(-(float)(hq + 1));
    const float q = ldf(cols, g * 256 + r * 64 + lane) * 0.125f;
    qs[wave][lane] = q;
    const float gate0 = sigmoidf_(ldf(cols, 1280 + hq * 3 + 0)), gate1 = sigmoidf_(ldf(cols, 1280 + hq * 3 + 1)), gate2 = sigmoidf_(ldf(cols, 1280 + hq * 3 + 2));
    __syncthreads();
    float out = 0.f;
    {
        const float* kc = KC + ((size_t)(b * 2 + g) * 128) * 64;
        const float* vc = VC + ((size_t)(b * 2 + g) * 128) * 64;
        float s[2]; bool ok[2];
#pragma unroll
        for (int u = 0; u < 2; ++u) {
            const int n = lane + 64 * u;
            ok[u] = (n < NCMP) && (16 * n + 31 <= t);
            float acc = 0.f;
            if (ok[u]) { for (int d = 0; d < 64; ++d) acc += qs[wave][d] * kc[n * 64 + d]; acc -= slope * (float)(t - (16 * n + 31)); }
            s[u] = ok[u] ? acc : -1e30f;
        }
        const float m = wave_max(fmaxf(s[0], s[1]));
        float p0 = ok[0] ? __expf(s[0] - m) : 0.f, p1 = ok[1] ? __expf(s[1] - m) : 0.f;
        const float l = wave_sum(p0 + p1);
        const float inv = 1.f / fmaxf(l, 1e-30f);
        p0 *= inv; p1 *= inv;
        ps[wave][lane] = p0; ps[wave][lane + 64] = p1;
        __syncthreads();
        float o = 0.f;
        for (int n = 0; n < NCMP; ++n) o += ps[wave][n] * vc[n * 64 + lane];
        out += gate0 * o;
        if (threadIdx.x < 64) {
            const int g2 = threadIdx.x >> 5, j = threadIdx.x & 31;
            float acc = 0.f;
            for (int rr = 0; rr < 4; ++rr)
                for (int n = 4 * j - 1; n <= 4 * j + 3; ++n) if (n >= 0 && n < NCMP) acc += ps[g2 * 4 + rr][n];
            const int curb = t >> 6;
            if (j == 0 || j == curb || j == curb - 1) acc = 1e4f;
            if (j > curb) acc = -1.f;
            imp[g2][j] = acc;
        }
        __syncthreads();
        if (threadIdx.x < 64) {
            const int g2 = threadIdx.x >> 5, j = threadIdx.x & 31;
            const float mine = imp[g2][j]; int rank = 0;
            for (int jj = 0; jj < 32; ++jj) { const float o2 = imp[g2][jj]; rank += (o2 > mine || (o2 == mine && jj < j)) ? 1 : 0; }
            const unsigned long long bal = __ballot(rank < 16);
            if (j == 0) selm[g2] = (unsigned)(g2 == 0 ? (bal & 0xffffffffull) : (bal >> 32));
        }
        __syncthreads();
    }
    for (int br = 0; br < 2; ++br) {
        const int kcol = n_rw + 512 + (br == 0 ? 2 : 4) * 128 + g * 64, vcol = kcol + 128;
        const float gate = br == 0 ? gate1 : gate2;
        const unsigned mask = selm[g];
        float m = -1e30f, l = 0.f, o = 0.f;
        const int curb = t >> 6;
        const int jlo = (br == 0) ? 0 : ((curb - 8 > 0) ? curb - 8 : 0);
        for (int j = jlo; j <= curb; ++j) {
            if (br == 0 && !((mask >> j) & 1u)) continue;
            const int pos = j * 64 + lane;
            const int dist = t - pos;
            const bool ok = (dist >= 0) && (br == 0 || dist < 512);
            float sc = -1e30f;
            if (ok) {
                const TP* kr = proj + ((size_t)b * T + pos) * ncols + kcol;
                float acc = 0.f;
                for (int d = 0; d < 64; ++d) acc += qs[wave][d] * ldf(kr, d);
                sc = acc - slope * (float)dist;
            }
            const float mt = wave_max(sc);
            const float mn = fmaxf(m, mt);
            const float alpha = __expf(m - mn);
            const float p = ok ? __expf(sc - mn) : 0.f;
            l = l * alpha + wave_sum(p);
            pbuf[wave][lane] = p;
            __builtin_amdgcn_wave_barrier();
            float acc = 0.f;
            const int kmax = (t - j * 64 + 1 < 64) ? (t - j * 64 + 1) : 64;
            for (int kk = 0; kk < kmax; ++kk) acc += pbuf[wave][kk] * ldf(proj, ((size_t)b * T + j * 64 + kk) * ncols + vcol + lane);
            __builtin_amdgcn_wave_barrier();
            o = o * alpha + acc;
            m = mn;
        }
        out += gate * o / fmaxf(l, 1e-30f);
    }
    stf(concat, (size_t)tok * D + 512 + g * 256 + r * 64 + lane, out);
}

__global__ void __launch_bounds__(256) k_cross_attn(const bf16_t* __restrict__ Q, const bf16_t* __restrict__ Kc, const bf16_t* __restrict__ VT, bf16_t* __restrict__ O) {
    const int wid = (blockIdx.x * blockDim.x + threadIdx.x) >> 6, lane = threadIdx.x & 63;
    const int tok = wid >> 2, h = wid & 3, b = tok / T;
    float q[4];
    for (int i = 0; i < 4; ++i) q[i] = ldf(Q, (size_t)tok * D + h * 256 + lane * 4 + i);
    float s[4];
    for (int u = 0; u < 4; ++u) s[u] = 0.f;
    for (int key = 0; key < MEM; ++key) {
        const bf16_t* kr = Kc + ((size_t)b * MEM + key) * 1024 + h * 256 + lane * 4;
        float d = q[0] * bf2f(kr[0]) + q[1] * bf2f(kr[1]) + q[2] * bf2f(kr[2]) + q[3] * bf2f(kr[3]);
        d = wave_sum(d) * 0.0625f;
        if ((key & 63) == lane) s[key >> 6] = d;
    }
    float m = fmaxf(fmaxf(s[0], s[1]), fmaxf(s[2], s[3]));
    m = wave_max(m);
    float p[4], l = 0.f;
    for (int u = 0; u < 4; ++u) { p[u] = __expf(s[u] - m); l += p[u]; }
    l = wave_sum(l);
    float o[4] = {0.f, 0.f, 0.f, 0.f};
    for (int key = 0; key < MEM; ++key) {
        const float pk = __shfl(p[key >> 6], key & 63);
        for (int i = 0; i < 4; ++i) o[i] += pk * bf2f(VT[(size_t)(h * 256 + lane * 4 + i) * NMEM + b * MEM + key]);
    }
    const float inv = 1.f / l;
    for (int i = 0; i < 4; ++i) stf(O, (size_t)tok * D + h * 256 + lane * 4 + i, o[i] * inv);
}

__global__ void k_route(const float* __restrict__ Hn, const float* __restrict__ wr, int* __restrict__ top_e, float* __restrict__ top_g) {
    const int wid = (blockIdx.x * blockDim.x + threadIdx.x) >> 6, lane = threadIdx.x & 63;
    if (wid >= NTOK) return;
    float acc[8] = {};
    for (int i = 0; i < 16; ++i) {
        const int k = lane + 64 * i; const float hv = Hn[(size_t)wid * D + k];
#pragma unroll
        for (int e = 0; e < 8; ++e) acc[e] += hv * wr[k * 8 + e];
    }
#pragma unroll
    for (int e = 0; e < 8; ++e) acc[e] = wave_sum(acc[e]);
    if (lane == 0) {
        int e0 = 0; for (int e = 1; e < 8; ++e) if (acc[e] > acc[e0]) e0 = e;
        int e1 = -1; for (int e = 0; e < 8; ++e) if (e != e0 && (e1 < 0 || acc[e] > acc[e1])) e1 = e;
        const float m = acc[e0]; const float p0 = 1.f, p1 = __expf(acc[e1] - m); const float inv = 1.f / (p0 + p1);
        top_e[wid * 2] = e0; top_e[wid * 2 + 1] = e1; top_g[wid * 2] = p0 * inv; top_g[wid * 2 + 1] = p1 * inv;
    }
}
__global__ void __launch_bounds__(64) k_lists(const int* __restrict__ top_e, const float* __restrict__ top_g, int* __restrict__ list, float* __restrict__ lgate, int* __restrict__ counts) {
    const int e = blockIdx.x, lane = threadIdx.x; int cnt = 0;
    for (int t0 = 0; t0 < NTOK; t0 += 64) {
        const int tok = t0 + lane; int k = -1;
        if (top_e[tok * 2] == e) k = 0; else if (top_e[tok * 2 + 1] == e) k = 1;
        const unsigned long long bal = __ballot(k >= 0);
        if (k >= 0) { const int pos = cnt + __popcll(bal & ((1ull << lane) - 1ull)); if (pos < ECAP) { list[e * NTOK + pos] = tok; lgate[e * NTOK + pos] = top_g[tok * 2 + k]; } }
        cnt += __popcll(bal);
    }
    if (lane == 0) counts[e] = cnt;
}

__global__ void k_xb_ssq(const float* __restrict__ X, bf16_t* __restrict__ XB, float* __restrict__ SSQ) {
    const int m = (blockIdx.x * blockDim.x + threadIdx.x) >> 6, lane = threadIdx.x & 63;
    if (m >= NTOK) return;
    float s = 0.f;
    for (int i = 0; i < 16; ++i) { const float v = X[(size_t)m * D + lane + 64 * i]; s += v * v; XB[(size_t)m * D + lane + 64 * i] = (bf16_t)f2bf(v); }
    s = wave_sum(s);
    if (lane < 16) SSQ[(size_t)m * 16 + lane] = lane == 0 ? s : 0.f;
}
}

static int g_grid = 0;
static void launch_mega(const Args& base, std::initializer_list<int> phs, hipStream_t stream) {
    Args a = base; a.nph = 0;
    for (int p : phs) a.ph[a.nph++] = p;
    hipLaunchKernelGGL(mega, dim3(g_grid), dim3(NWAVES * 64), LDS_BYTES, stream, a);
}

extern "C" void kernel_launch(void* const* d_in, const int* in_sizes, int n_in, void* d_out, int out_size, void* d_ws, size_t ws_size, hipStream_t stream) {
    using namespace v0;
    if (g_grid == 0) {
        int dev = 0, cus = 0;
        if (hipGetDevice(&dev) != hipSuccess || hipDeviceGetAttribute(&cus, hipDeviceAttributeMultiprocessorCount, dev) != hipSuccess) { g_grid = -1; return; }
        if (hipFuncSetAttribute((const void*)mega, hipFuncAttributeMaxDynamicSharedMemorySize, LDS_BYTES) != hipSuccess) { fprintf(stderr, "kernel_launch: hipFuncSetAttribute failed\n"); g_grid = -1; return; }
        (void)hipGetLastError();
        if (cus != 256) { fprintf(stderr, "kernel_launch: built for a 256-CU device (one workgroup per CU), found %d\n", cus); g_grid = -1; return; }
        g_grid = cus;
    }
    if (g_grid < 0) return;
    const float* in[40];
    for (int i = 0; i < 40; ++i) in[i] = (const float*)d_in[i];
    unsigned char* wsb = (unsigned char*)d_ws;
    Args base{};
    for (int i = 0; i < 40; ++i) base.in[i] = in[i];
    base.out = (float*)d_out; base.ws = wsb;

    float* X = (float*)(wsb + WS_X);
    bf16_t* XB = (bf16_t*)(wsb + WS_XB);
    float* SSQ = (float*)(wsb + WS_SSQ);
    bf16_t* PROJ = (bf16_t*)(wsb + WS_S);
    size_t off = (WS_S + S_END + 1 * MiB) / 4;
    float* ws = (float*)d_ws;
    auto take = [&](size_t nfl) { float* p = ws + off; off += (nfl + 63) & ~(size_t)63; return p; };
    float* KC = take((size_t)B * 2 * 128 * 64);
    float* VC = take((size_t)B * 2 * 128 * 64);
    float* HID = take((size_t)B * 2 * NCMP * 128);
    if (off * 4 < WS_MOE_END) off = WS_MOE_END / 4;
    if (off * 4 > ws_size) { fprintf(stderr, "kernel_launch: workspace too small: need %zu have %zu\n", off * 4, ws_size); return; }

    hipMemsetAsync(wsb + WS_CTL, 0, 1 * MiB, stream);
#if MK_FUSED
    launch_mega(base, {0}, stream);
#else
    launch_mega(base, {0}, stream);
    launch_mega(base, {1}, stream);
    bf16_t* CONCATB = (bf16_t*)(wsb + WS_S + S_CONCAT);

    for (int layer = 0; layer < 2; ++layer) {
        const int ncols = layer == 0 ? 3096 : 3128;
        const int n_rw = ncols - NSA_COLS;
        launch_mega(base, {10 + layer}, stream);
        launch_mega(base, {20 + layer}, stream);
        launch_mega(base, {30 + layer}, stream);
        launch_mega(base, {40 + layer}, stream);
        launch_mega(base, {25 + layer}, stream);
        launch_mega(base, {45 + layer}, stream);
        launch_mega(base, {50 + layer}, stream);
        launch_mega(base, {60 + layer}, stream);
        launch_mega(base, {70 + layer}, stream);
        launch_mega(base, {80 + layer}, stream);
        if (layer == 0) {
            launch_mega(base, {90}, stream);
            launch_mega(base, {91}, stream);
        } else {
            launch_mega(base, {100}, stream);
            launch_mega(base, {101}, stream);
            launch_mega(base, {102}, stream);
            launch_mega(base, {103}, stream);
            launch_mega(base, {104}, stream);
            launch_mega(base, {105}, stream);
        }
    }
    launch_mega(base, {110}, stream);
#endif
}
```

```cpp
#include <hip/hip_runtime.h>
#include <cstdint>
#include <cstdio>
#include <initializer_list>

constexpr int B_ = 8, T_ = 2048, D_ = 1024, NTOK = B_ * T_, MEM_ = 256, NMEM = B_ * MEM_;
constexpr int W_ = 512, H_ = 8, DH_ = 64;
constexpr int NSA_COLS = 1304, NCMP = 127;
constexpr int FFD = 2816, NEXP = 8, EFF = 3584;
constexpr int NPJ = 3072;

typedef unsigned short bf16_t;
typedef float f32x4_t __attribute__((ext_vector_type(4)));
typedef unsigned u32x4_t __attribute__((ext_vector_type(4)));
typedef unsigned u32x2_t __attribute__((ext_vector_type(2)));
#define LAS __attribute__((address_space(3)))

__device__ __forceinline__ float bf2f(bf16_t v) { return __uint_as_float(((unsigned)v) << 16); }
__device__ __forceinline__ unsigned f2bf(float f) { unsigned u = __float_as_uint(f); return (u + 0x7fffu + ((u >> 16) & 1u)) >> 16; }
__device__ __forceinline__ unsigned pk2(float lo, float hi) { return f2bf(lo) | (f2bf(hi) << 16); }
__device__ __forceinline__ unsigned pk4_fp8(float a, float b, float c, float d) {
    a = __builtin_amdgcn_fmed3f(a, -448.f, 448.f); b = __builtin_amdgcn_fmed3f(b, -448.f, 448.f); c = __builtin_amdgcn_fmed3f(c, -448.f, 448.f); d = __builtin_amdgcn_fmed3f(d, -448.f, 448.f);
    int r = __builtin_amdgcn_cvt_pk_fp8_f32(a, b, 0, false);
    r = __builtin_amdgcn_cvt_pk_fp8_f32(c, d, r, true);
    return (unsigned)r;
}
constexpr float F8S_X = 4.0f, F8S_W = 64.0f, F8S_ACT = 8.0f;
constexpr int F8C_X = 125, F8C_W = 121, F8C_ACT = 124;
__device__ __forceinline__ float ldf(const float* p, size_t i) { return p[i]; }
__device__ __forceinline__ float ldf(const bf16_t* p, size_t i) { return bf2f(p[i]); }
__device__ __forceinline__ void stf(float* p, size_t i, float v) { p[i] = v; }
__device__ __forceinline__ void stf(bf16_t* p, size_t i, float v) { p[i] = (bf16_t)f2bf(v); }

__device__ __forceinline__ float wave_sum(float v) {
#pragma unroll
    for (int o = 1; o < 64; o <<= 1) v += __shfl_xor(v, o);
    return v;
}
__device__ __forceinline__ float wave_max(float v) {
#pragma unroll
    for (int o = 1; o < 64; o <<= 1) v = fmaxf(v, __shfl_xor(v, o));
    return v;
}
__device__ __forceinline__ float shx(float v, int lane, int m) { return __int_as_float(__builtin_amdgcn_ds_bpermute((lane ^ m) << 2, __float_as_int(v))); }
__device__ __forceinline__ float wave_sum_l(float v, int lane) {
#pragma unroll
    for (int o = 1; o < 64; o <<= 1) v += shx(v, lane, o);
    return v;
}
__device__ __forceinline__ float wave_max_l(float v, int lane) {
#pragma unroll
    for (int o = 1; o < 64; o <<= 1) v = fmaxf(v, shx(v, lane, o));
    return v;
}
__device__ __forceinline__ float sigmoidf_(float x) { return 1.f / (1.f + __expf(-x)); }
__device__ __forceinline__ float fexp(float x) { return __builtin_amdgcn_exp2f(x * 1.4426950408889634f); }
__device__ __forceinline__ float fsigmoid(float x) { return __builtin_amdgcn_rcpf(1.0f + __builtin_amdgcn_exp2f(x * -1.4426950408889634f)); }
__device__ __forceinline__ float ftanh(float x) { return 2.0f * fsigmoid(2.0f * x) - 1.0f; }

constexpr size_t MiB = (size_t)1 << 20;
constexpr size_t WS_CTL = 0;
constexpr size_t WS_MRINV = 512 * 1024;
constexpr size_t WS_X = 1 * MiB;
constexpr size_t WS_XB = WS_X + 64 * MiB;
constexpr size_t WS_SSQ = WS_XB + 32 * MiB;
constexpr size_t WS_WB = WS_SSQ + 1 * MiB;
constexpr size_t WS_MEMB = WS_WB + 54 * MiB;
constexpr size_t WS_KCR = WS_MEMB + 4 * MiB;
constexpr size_t WS_VT = WS_KCR + 8 * MiB;
constexpr size_t WS_VFIRST = WS_VT + 8 * MiB;
constexpr size_t WS_S = WS_VFIRST + 16 * MiB;
constexpr size_t WB_WIN = 0;
constexpr size_t WB_WOUT = WB_WIN + 2 * (size_t)NPJ * 1024 * 2;
constexpr size_t WB_WQ = WB_WOUT + 2 * 2 * MiB;
constexpr size_t WB_WK = WB_WQ + 2 * 2 * MiB;
constexpr size_t WB_WV = WB_WK + 2 * 2 * MiB;
constexpr size_t WB_WO = WB_WV + 2 * 2 * MiB;
constexpr size_t WB_WGU = WB_WO + 2 * 2 * MiB;
constexpr size_t WB_WD = WB_WGU + (size_t)2 * FFD * 1024 * 2;
constexpr size_t WB_LORA = WB_WD + (size_t)FFD * 1024 * 2;
constexpr size_t WB_CW1 = WB_LORA + 2 * 512 * 288 * 2;
constexpr size_t WB_CW2 = WB_CW1 + 4 * 128 * 2048 * 2;
constexpr size_t WB_CB = WB_CW2 + 4 * 64 * 128 * 2;
constexpr size_t WB_WSK = WB_CB + 4 * 128 * 4;
constexpr size_t WB_END = WB_WSK + 2 * 64 * 1024 * 2;
static_assert(WB_END <= 54 * MiB, "weight map");
constexpr size_t WS_WE = WS_WB;
constexpr size_t WE_D = (size_t)8 * 7168 * 1024 * 2;
constexpr size_t WS_XG = WS_WE + 168 * MiB;
constexpr int MOE_PASS_TILES = 64;
constexpr size_t WS_ACTM = WS_XG + 68 * MiB;
constexpr size_t WS_MT = WS_ACTM + 119 * MiB;
constexpr size_t MT_INV = 0;
constexpr size_t MT_ROWINFO = 512 * 1024;
constexpr size_t MT_ROWG = 768 * 1024;
constexpr size_t MT_TOKG = 1024 * 1024;
constexpr size_t MT_TILE = 1280 * 1024;
constexpr size_t MT_ROWOF = 1536 * 1024;
constexpr int MOE_NS = 7, MOE_KS = 512;
constexpr size_t WS_MOE_END = WS_MT + 2 * MiB;
constexpr size_t CTL_CNT = 64 * 1024;
namespace pg8 {
#define PG8_LAS __attribute__((address_space(3)))
typedef unsigned short bf16_t;
typedef short bf16x8 __attribute__((ext_vector_type(8)));
typedef float f32x4 __attribute__((ext_vector_type(4)));
typedef unsigned u32x4 __attribute__((ext_vector_type(4)));
constexpr int BM = 256, BK = 64, HALF = 128, HTB = HALF * BK * 2  , STAGE_BYTES = 8 * HTB, NXCD = 8, WGM = 8;

__host__ __device__ __forceinline__ int lds_byte(int r, int c) { const int st = (r >> 4) * 2 + (c >> 5), rr = r & 15, cc = c & 31, ob = rr * 64 + cc * 2; return st * 1024 + (ob ^ (((ob >> 9) & 1) << 5)); }
__host__ __device__ __forceinline__ void stage_rc(int b, int& R, int& C) { const int st = b / 1024, sb = b % 1024, swz = sb ^ (((sb >> 9) & 1) << 5); R = (st >> 1) * 16 + swz / 64; C = (st & 1) * 32 + (swz % 64) / 2; }
__host__ __device__ __forceinline__ int perm32(int rho) { const int n = rho >> 4, i = rho & 15; return 8 * (i >> 2) + 4 * n + (i & 3); }

struct Unit { int pm, pn, e, ord, ks; };
struct Gemm { const bf16_t* A; const bf16_t* Bt; int M, N, K; size_t bstride; };

struct StaticOrder {
    int nM, nN, nwg, G, c;
    __host__ __device__ void init(int M, int N, int G_, int c_) { nM = M / BM; nN = N / BM; nwg = nM * nN; G = G_; c = c_; }
    __host__ __device__ bool next(int i, Unit& u) const {
        const int L = i * G + c; if (L >= nwg) return false;
        int wgid = L; { const int q = nwg / NXCD, r = nwg % NXCD, xcd = wgid % NXCD, off = wgid / NXCD; wgid = (xcd < r ? xcd * (q + 1) : r * (q + 1) + (xcd - r) * q) + off; }
        const int nig = WGM * nN, gid = wgid / nig, fm = gid * WGM, gsz = (nM - fm) < WGM ? (nM - fm) : WGM;
        u.pm = fm + ((wgid % nig) % gsz); u.pn = (wgid % nig) / gsz; u.e = 0; u.ord = i; u.ks = 0; return true;
    }
    __device__ __forceinline__ void a_ready(const Unit&) const {}
    __device__ __forceinline__ void done(const Unit&) const {}
    __device__ __forceinline__ int kloop(int K) const { return K; }
    __device__ __forceinline__ size_t koff(const Unit&) const { return 0; }
};


__device__ __forceinline__ unsigned cvt_pk_bf16(float lo, float hi) { unsigned r; asm volatile("v_cvt_pk_bf16_f32 %0, %1, %2" : "=v"(r) : "v"(lo), "v"(hi)); return r; }
__device__ __forceinline__ float row_rinv(const float* ssq, int row) {
    const f32x4* p = (const f32x4*)(ssq + (size_t)row * 16);
    const f32x4 a = p[0], b = p[1], c = p[2], d = p[3];
    const float s = ((a[0] + a[1]) + (a[2] + a[3])) + ((b[0] + b[1]) + (b[2] + b[3])) + ((c[0] + c[1]) + (c[2] + c[3])) + ((d[0] + d[1]) + (d[2] + d[3]));
    return 1.0f / sqrtf(s * (1.0f / 1024.0f) + 1e-6f);
}
struct EpiRowScaleBf16 {
    static constexpr bool PERM = true, AFTER_DRAIN = false;
    bf16_t* O; int ldc; const PG8_LAS float* rtab; float mul;
    __device__ __forceinline__ void operator()(const f32x4 (&acc)[2][2][4][2], const Unit& u, int wr, int wc, int fr, int fq) const {
        const int row0 = u.pm * BM + wr * 64 + fr, col0 = u.pn * BM + wc * 32 + 8 * fq;
#pragma unroll
        for (int ai = 0; ai < 2; ++ai)
#pragma unroll
            for (int m = 0; m < 4; ++m) {
                const int row = row0 + ai * HALF + m * 16;
                const float rs = (rtab ? rtab[u.ord * 256 + (row - u.pm * BM)] : 1.0f) * mul;
                bf16_t* rowp = O + (size_t)row * ldc + col0;
#pragma unroll
                for (int bj = 0; bj < 2; ++bj) {
                    const f32x4 v0 = acc[ai][bj][m][0] * rs, v1 = acc[ai][bj][m][1] * rs;
                    u32x4 w; w.x = cvt_pk_bf16(v0[0], v0[1]); w.y = cvt_pk_bf16(v0[2], v0[3]); w.z = cvt_pk_bf16(v1[0], v1[1]); w.w = cvt_pk_bf16(v1[2], v1[3]);
                    *(u32x4*)(rowp + bj * HALF) = w;
                }
            }
    }
};
struct EpiColScaleBf16 {
    static constexpr bool PERM = true, AFTER_DRAIN = false;
    bf16_t* O; int ldc; const float* cs;
    __device__ __forceinline__ void operator()(const f32x4 (&acc)[2][2][4][2], const Unit& u, int wr, int wc, int fr, int fq) const {
        const int row0 = u.pm * BM + wr * 64 + fr, col0 = u.pn * BM + wc * 32 + 8 * fq;
        f32x4 sc[2][2];
#pragma unroll
        for (int bj = 0; bj < 2; ++bj)
#pragma unroll
            for (int n = 0; n < 2; ++n) sc[bj][n] = *(const f32x4*)(cs + col0 + bj * HALF + 4 * n);
#pragma unroll
        for (int ai = 0; ai < 2; ++ai)
#pragma unroll
            for (int m = 0; m < 4; ++m) {
                bf16_t* rowp = O + (size_t)(row0 + ai * HALF + m * 16) * ldc + col0;
#pragma unroll
                for (int bj = 0; bj < 2; ++bj) {
                    const f32x4 v0 = acc[ai][bj][m][0] * sc[bj][0], v1 = acc[ai][bj][m][1] * sc[bj][1];
                    u32x4 w; w.x = cvt_pk_bf16(v0[0], v0[1]); w.y = cvt_pk_bf16(v0[2], v0[3]); w.z = cvt_pk_bf16(v1[0], v1[1]); w.w = cvt_pk_bf16(v1[2], v1[3]);
                    *(u32x4*)(rowp + bj * HALF) = w;
                }
            }
    }
};
struct EpiResid {
    static constexpr bool PERM = false, AFTER_DRAIN = false;
    bf16_t* XB; float* ssq;
    __device__ __forceinline__ void operator()(const f32x4 (&acc)[2][2][4][2], const Unit& u, int wr, int wc, int fr, int fq) const {
        const int row0 = u.pm * BM + wr * 64 + fr, col0 = u.pn * BM + wc * 32 + 4 * fq;
        typedef unsigned u32x2v __attribute__((ext_vector_type(2)));
#pragma unroll
        for (int ai = 0; ai < 2; ++ai)
#pragma unroll
            for (int m = 0; m < 4; ++m) {
                const int row = row0 + ai * HALF + m * 16;
                bf16_t* br = XB + (size_t)row * 1024 + col0;
                float q = 0.f;
#pragma unroll
                for (int bj = 0; bj < 2; ++bj)
#pragma unroll
                    for (int n = 0; n < 2; ++n) {
                        const u32x2v o = *(const u32x2v*)(br + bj * HALF + n * 16);
                        f32x4 x = {__uint_as_float(o.x << 16), __uint_as_float(o.x & 0xffff0000u), __uint_as_float(o.y << 16), __uint_as_float(o.y & 0xffff0000u)};
                        x = x + acc[ai][bj][m][n];
                        q += (x[0] * x[0] + x[1] * x[1]) + (x[2] * x[2] + x[3] * x[3]);
                        u32x2v w; w.x = cvt_pk_bf16(x[0], x[1]); w.y = cvt_pk_bf16(x[2], x[3]);
                        *(u32x2v*)(br + bj * HALF + n * 16) = w;
                    }
                q += shx(q, fq * 16 + fr, 16); q += shx(q, fq * 16 + fr, 32);
                if (fq == 0) ssq[(size_t)row * 16 + u.pn * 4 + wc] = q;
                asm volatile("" ::: "memory");
            }
    }
};
struct EpiSwiGLU {
    static constexpr bool PERM = true, AFTER_DRAIN = false;
    bf16_t* O; int ldc; const PG8_LAS float* rtab;
    __device__ __forceinline__ void operator()(const f32x4 (&acc)[2][2][4][2], const Unit& u, int wr, int wc, int fr, int fq) const {
        const int row0 = u.pm * BM + wr * 64 + fr, col0 = u.pn * HALF + wc * 32 + 8 * fq;
#pragma unroll
        for (int ai = 0; ai < 2; ++ai)
#pragma unroll
            for (int m = 0; m < 4; ++m) {
                const int row = row0 + ai * HALF + m * 16;
                const float rs = rtab ? rtab[u.ord * 256 + (row - u.pm * BM)] : 1.0f;
                float o[8];
#pragma unroll
                for (int n = 0; n < 2; ++n)
#pragma unroll
                    for (int e = 0; e < 4; ++e) {
                        const float gg = acc[ai][0][m][n][e] * rs, uu = acc[ai][1][m][n][e] * rs;
                        o[n * 4 + e] = gg * __builtin_amdgcn_rcpf(1.0f + __builtin_amdgcn_exp2f(gg * -1.4426950408889634f)) * uu;
                    }
                u32x4 w; w.x = cvt_pk_bf16(o[0], o[1]); w.y = cvt_pk_bf16(o[2], o[3]); w.z = cvt_pk_bf16(o[4], o[5]); w.w = cvt_pk_bf16(o[6], o[7]);
                *(u32x4*)(O + (size_t)row * ldc + col0) = w;
            }
    }
};

struct EpiSwiGLU8 {
    static constexpr bool PERM = true, AFTER_DRAIN = false;
    unsigned char* O; int ldc; float osc;
    __device__ __forceinline__ void operator()(const f32x4 (&acc)[2][2][4][2], const Unit& u, int wr, int wc, int fr, int fq) const {
        const int row0 = u.pm * BM + wr * 64 + fr, col0 = u.pn * HALF + wc * 32 + 8 * fq;
        typedef unsigned u32x2v __attribute__((ext_vector_type(2)));
#pragma unroll
        for (int ai = 0; ai < 2; ++ai)
#pragma unroll
            for (int m = 0; m < 4; ++m) {
                const int row = row0 + ai * HALF + m * 16;
                float o[8];
#pragma unroll
                for (int n = 0; n < 2; ++n)
#pragma unroll
                    for (int e = 0; e < 4; ++e) {
                        const float gg = acc[ai][0][m][n][e], uu = acc[ai][1][m][n][e] * osc;
                        o[n * 4 + e] = gg * __builtin_amdgcn_rcpf(1.0f + __builtin_amdgcn_exp2f(gg * -1.4426950408889634f)) * uu;
                    }
                u32x2v w; w.x = pk4_fp8(o[0], o[1], o[2], o[3]); w.y = pk4_fp8(o[4], o[5], o[6], o[7]);
                *(u32x2v*)(O + (size_t)row * ldc + col0) = w;
            }
    }
};
struct EpiSwiGLU8R {
    static constexpr bool PERM = true, AFTER_DRAIN = false;
    unsigned char* O; int ldc; const PG8_LAS float* rtab; float osc;
    __device__ __forceinline__ void operator()(const f32x4 (&acc)[2][2][4][2], const Unit& u, int wr, int wc, int fr, int fq) const {
        const int row0 = u.pm * BM + wr * 64 + fr, col0 = u.pn * HALF + wc * 32 + 8 * fq;
        typedef unsigned u32x2v __attribute__((ext_vector_type(2)));
#pragma unroll
        for (int ai = 0; ai < 2; ++ai)
#pragma unroll
            for (int m = 0; m < 4; ++m) {
                const int row = row0 + ai * HALF + m * 16;
                const float rs = rtab[u.ord * 256 + (row - u.pm * BM)];
                float o[8];
#pragma unroll
                for (int n = 0; n < 2; ++n)
#pragma unroll
                    for (int e = 0; e < 4; ++e) {
                        const float gg = acc[ai][0][m][n][e] * rs, uu = acc[ai][1][m][n][e] * (rs * osc);
                        o[n * 4 + e] = gg * __builtin_amdgcn_rcpf(1.0f + __builtin_amdgcn_exp2f(gg * -1.4426950408889634f)) * uu;
                    }
                u32x2v w; w.x = pk4_fp8(o[0], o[1], o[2], o[3]); w.y = pk4_fp8(o[4], o[5], o[6], o[7]);
                *(u32x2v*)(O + (size_t)row * ldc + col0) = w;
            }
    }
};
struct EpiMoeDown {
    static constexpr bool PERM = true, AFTER_DRAIN = false;
    bf16_t* Y2; const int* rinfo; const float* rg;
    __device__ __forceinline__ void operator()(const f32x4 (&acc)[2][2][4][2], const Unit& u, int wr, int wc, int fr, int fq) const {
        const int row0 = u.pm * BM + wr * 64 + fr, col0 = u.pn * BM + wc * 32 + 8 * fq;
#pragma unroll
        for (int ai = 0; ai < 2; ++ai)
#pragma unroll
            for (int m = 0; m < 4; ++m) {
                const int row = row0 + ai * HALF + m * 16;
                const int t2 = rinfo[row];
                if (t2 >= 0) {
                    const float gte = rg[row];
                    bf16_t* rowp = Y2 + (size_t)t2 * 1024 + col0;
#pragma unroll
                    for (int bj = 0; bj < 2; ++bj) {
                        const f32x4 v0 = acc[ai][bj][m][0] * gte, v1 = acc[ai][bj][m][1] * gte;
                        u32x4 w; w.x = cvt_pk_bf16(v0[0], v0[1]); w.y = cvt_pk_bf16(v0[2], v0[3]); w.z = cvt_pk_bf16(v1[0], v1[1]); w.w = cvt_pk_bf16(v1[2], v1[3]);
                        *(u32x4*)(rowp + bj * HALF) = w;
                    }
                }
                asm volatile("" ::: "memory");
            }
    }
};
struct MoeOrder {
    int nM, nN, nwg, G, c, pm_lo; const int* tile_e;
    __device__ void init(int nM_, int nN_, int G_, int c_, int pm_lo_, const int* te) { nM = nM_; nN = nN_; nwg = nM * nN; G = G_; c = c_; pm_lo = pm_lo_; tile_e = te; }
    __device__ bool next(int i, Unit& u) const {
        const int L = i * G + c; if (L >= nwg) return false;
        int wgid = L; { const int q = nwg / NXCD, r = nwg % NXCD, xcd = wgid % NXCD, off = wgid / NXCD; wgid = (xcd < r ? xcd * (q + 1) : r * (q + 1) + (xcd - r) * q) + off; }
        const int nig = WGM * nN, gid = wgid / nig, fm = gid * WGM, gsz = (nM - fm) < WGM ? (nM - fm) : WGM;
        u.pm = fm + ((wgid % nig) % gsz); u.pn = (wgid % nig) / gsz; u.e = ((const __attribute__((address_space(4))) int*)(uintptr_t)tile_e)[pm_lo + u.pm]    ; u.ord = i; u.ks = 0; return true;
    }
    __device__ __forceinline__ void a_ready(const Unit&) const {}
    __device__ __forceinline__ void done(const Unit&) const {}
    __device__ __forceinline__ int kloop(int K) const { return K; }
    __device__ __forceinline__ size_t koff(const Unit&) const { return 0; }
};
struct MoeSplitOrder {
    int nM, nwg, G, c, pm_lo, NS, KS; const int* tile_e;
    __device__ void init(int nM_, int G_, int c_, int pm_lo_, const int* te, int NS_, int KS_) { nM = nM_; NS = NS_; KS = KS_; nwg = nM * 4 * NS; G = G_; c = c_; pm_lo = pm_lo_; tile_e = te; }
    __device__ bool next(int i, Unit& u) const {
        const int L = i * G + c; if (L >= nwg) return false;
        const int w = L, tile = w / NS; u.ks = w - tile * NS; u.pm = tile >> 2; u.pn = tile & 3;
        u.e = ((const __attribute__((address_space(4))) int*)(uintptr_t)tile_e)[pm_lo + u.pm]    ; u.ord = i; return true;
    }
    __device__ __forceinline__ void a_ready(const Unit&) const {}
    __device__ __forceinline__ void done(const Unit&) const {}
    __device__ __forceinline__ int kloop(int) const { return KS; }
    __device__ __forceinline__ size_t koff(const Unit& u) const { return (size_t)u.ks * KS * 2; }
};
struct EpiSplitF32 {
    static constexpr bool PERM = true, AFTER_DRAIN = false;
    float* PART; const int* rinfo; int nrows;
    __device__ __forceinline__ void operator()(const f32x4 (&acc)[2][2][4][2], const Unit& u, int wr, int wc, int fr, int fq) const {
        const int row0 = u.pm * BM + wr * 64 + fr, col0 = u.pn * BM + wc * 32 + 8 * fq;
#pragma unroll
        for (int ai = 0; ai < 2; ++ai)
#pragma unroll
            for (int m = 0; m < 4; ++m) {
                const int row = row0 + ai * HALF + m * 16;
                if (rinfo[row] >= 0) {
                    float* rowp = PART + ((size_t)u.ks * nrows + row) * 1024 + col0;
#pragma unroll
                    for (int bj = 0; bj < 2; ++bj) { *(f32x4*)(rowp + bj * HALF) = acc[ai][bj][m][0]; *(f32x4*)(rowp + bj * HALF + 4) = acc[ai][bj][m][1]; }
                }
                asm volatile("" ::: "memory");
            }
    }
};
template <class Epi, class Sched, bool ALIGN_EPI = false, bool SP2 = false, bool FP8 = false, int DBG = 0, bool ROT = false>
__device__ __forceinline__ void gemm_phase(PG8_LAS unsigned char* lds, const Gemm g, const Sched& S, const Epi& E, const int tid_in, const int sa = 127, const int sb = 127) {
    const int tid = tid_in, wid = __builtin_amdgcn_readfirstlane(tid >> 6), lane = tid & 63, wr = wid >> 2, wc = wid & 3, fr = lane & 15, fq = lane >> 4;
    const int K = g.K; int nt = S.kloop(K) / BK;
    if constexpr (FP8) asm volatile("" : "+s"(nt));
    unsigned voffA[2], voffB[2];
#pragma unroll
    for (int i = 0; i < 2; ++i) { int R, C; stage_rc(tid * 16 + i * 8192, R, C); const int Rb = Epi::PERM ? ((R & ~31) + perm32(R & 31)) : R;
        voffA[i] = (unsigned)(R * K + C) * 2u; voffB[i] = (unsigned)(Rb * K + C) * 2u; }
    const size_t kstep = (size_t)(BK * 2);
    const size_t hstep = (size_t)HALF * K * 2;
    const size_t tstep = 2 * hstep;
    const unsigned ldsw = (unsigned)wid * 1024u;
    const int aoff = lds_byte(wr * 64 + fr, fq * 8), boff = lds_byte(wc * 32 + fr, fq * 8);
#define PG8_SA(b, h) (((b) * 2 + (h)) * HTB)
#define PG8_SB(b, h) ((4 + (b) * 2 + (h)) * HTB)
#define PG8_STAGE(bufoff, gbase, voff) do { if constexpr (DBG != 1) _Pragma("unroll") for (int _i = 0; _i < 2; ++_i) { unsigned vo_ = (voff)[_i]; asm volatile("" : "+v"(vo_));     \
        __builtin_amdgcn_global_load_lds((const unsigned*)((const char*)(gbase) + vo_), (PG8_LAS unsigned*)(lds + (bufoff) + ldsw + _i * 8192), 16, 0, 0); } } while (0)
    typedef int i32x4_ __attribute__((ext_vector_type(4))); typedef int i32x8_ __attribute__((ext_vector_type(8)));
#define PG8_LD8(P) __builtin_shufflevector(*(const PG8_LAS i32x4_*)(P), *(const PG8_LAS i32x4_*)((P) + 1024), 0, 1, 2, 3, 4, 5, 6, 7)
#define PG8_LDA(dst, b, h) do { if constexpr (DBG != 3) _Pragma("unroll") for (int m = 0; m < 4; ++m) { if constexpr (FP8) dst##8[m] = PG8_LD8(lds + PG8_SA(b, h) + aoff + m * 2048); else { _Pragma("unroll") for (int k = 0; k < 2; ++k) dst[m][k] = *(const PG8_LAS bf16x8*)(lds + PG8_SA(b, h) + aoff + m * 2048 + k * 1024); } } } while (0)
#define PG8_LDB(dst, b, h) do { if constexpr (DBG != 3) _Pragma("unroll") for (int n = 0; n < 2; ++n) { if constexpr (FP8) dst##8[n] = PG8_LD8(lds + PG8_SB(b, h) + boff + n * 2048); else { _Pragma("unroll") for (int k = 0; k < 2; ++k) dst[n][k] = *(const PG8_LAS bf16x8*)(lds + PG8_SB(b, h) + boff + n * 2048 + k * 1024); } } } while (0)
#define PG8_MMA(ai, bj, At, Bt) do { __builtin_amdgcn_s_setprio(1); if constexpr (DBG != 2) _Pragma("unroll") for (int m = 0; m < 4; ++m) _Pragma("unroll") for (int n = 0; n < 2; ++n) { \
        if constexpr (FP8) acc[ai][bj][m][n] = __builtin_amdgcn_mfma_scale_f32_16x16x128_f8f6f4(Bt##8[n], At##8[m], acc[ai][bj][m][n], 0, 0, 0, sb, 0, sa); \
        else { _Pragma("unroll") for (int k = 0; k < 2; ++k) acc[ai][bj][m][n] = __builtin_amdgcn_mfma_f32_16x16x32_bf16(Bt[n][k], At[m][k], acc[ai][bj][m][n], 0, 0, 0); } } \
        __builtin_amdgcn_s_setprio(0); } while (0)
#define PG8_WAIT_V(n) asm volatile("s_waitcnt vmcnt(" #n ")" ::: "memory")
#define PG8_WAIT_L(n) asm volatile("s_waitcnt lgkmcnt(" #n ")" ::: "memory")
#define PG8_BAR __builtin_amdgcn_s_barrier()
#define PG8_SCHED __builtin_amdgcn_sched_barrier(0)
    Unit cur, nxt; int ui = 0;
    if (!S.next(0, cur)) return;
    f32x4 acc[2][2][4][2];
#pragma unroll
    for (int a = 0; a < 2; ++a)
#pragma unroll
        for (int b = 0; b < 2; ++b)
#pragma unroll
            for (int m = 0; m < 4; ++m)
#pragma unroll
                for (int n = 0; n < 2; ++n) acc[a][b][m][n] = (f32x4){0.f, 0.f, 0.f, 0.f};
    bf16x8 At[4][2], B0[2][2], B1[2][2]; i32x8_ At8[4], B08[2], B18[2];
    const char* cA = (const char*)g.A + (size_t)cur.pm * tstep + S.koff(cur); const char* cB = (const char*)g.Bt + (size_t)cur.e * g.bstride + (size_t)cur.pn * tstep + S.koff(cur);
    S.a_ready(cur);
    const auto ktb = [&](int x, int r) -> size_t { int v = x + r; if (v >= nt) v -= nt; return (size_t)v * kstep; };
    int rot = ROT ? ((cur.pm + cur.pn) & 3) : 0;
    const size_t p0_ = ktb(0, rot), p1_ = ktb(1, rot);
    if constexpr (SP2) {
        PG8_STAGE(PG8_SB(0, 0), cB + p0_, voffB); PG8_STAGE(PG8_SB(0, 1), cB + p0_ + hstep, voffB); PG8_STAGE(PG8_SA(0, 0), cA + p0_, voffA); PG8_STAGE(PG8_SA(0, 1), cA + p0_ + hstep, voffA);
        if (wr == 1) PG8_BAR;
        PG8_WAIT_V(2); PG8_BAR;
        PG8_STAGE(PG8_SB(1, 0), cB + p1_, voffB); PG8_STAGE(PG8_SA(1, 0), cA + p1_, voffA); PG8_STAGE(PG8_SB(1, 1), cB + hstep + p1_, voffB);
        PG8_WAIT_V(6); PG8_BAR;
    } else {
        PG8_STAGE(PG8_SB(0, 0), cB + p0_, voffB); PG8_STAGE(PG8_SA(0, 0), cA + p0_, voffA); PG8_STAGE(PG8_SB(0, 1), cB + p0_ + hstep, voffB); PG8_STAGE(PG8_SA(0, 1), cA + p0_ + hstep, voffA);
        if (wr == 1) PG8_BAR;
        PG8_WAIT_V(4); PG8_BAR;
        PG8_STAGE(PG8_SB(1, 0), cB + p1_, voffB); PG8_STAGE(PG8_SA(1, 0), cA + p1_, voffA); PG8_STAGE(PG8_SB(1, 1), cB + hstep + p1_, voffB);
        PG8_WAIT_V(6); PG8_BAR;
    }
    for (;;) {
        const bool has_next = S.next(ui + 1, nxt);
        const char* nA = has_next ? (const char*)g.A + (size_t)nxt.pm * tstep + S.koff(nxt) : cA; const char* nB = has_next ? (const char*)g.Bt + (size_t)nxt.e * g.bstride + (size_t)nxt.pn * tstep + S.koff(nxt) : cB;
        const int rotn = (ROT && has_next) ? ((nxt.pm + nxt.pn) & 3) : rot;
        for (int t = 0; t < nt; t += 2) {
            const bool last = (t == nt - 2);
            const char* a1 = cA + ktb(t + 1, rot);
            const size_t o2 = last ? ktb(0, rotn) : ktb(t + 2, rot), o3 = last ? ktb(1, rotn) : ktb(t + 3, rot);
            const char* a2 = (last ? nA : cA) + o2; const char* b2 = (last ? nB : cB) + o2;
            const char* a3 = (last ? nA : cA) + o3; const char* b3 = (last ? nB : cB) + o3;
            if (last && has_next) S.a_ready(nxt);
            if constexpr (SP2) {
            PG8_LDB(B0, 0, 0); PG8_LDB(B1, 0, 1); PG8_SCHED; PG8_LDA(At, 0, 0); PG8_STAGE(PG8_SA(1, 1), a1 + hstep, voffA);
            PG8_WAIT_V(8); PG8_WAIT_L(0); PG8_BAR; PG8_MMA(0, 0, At, B0); PG8_MMA(0, 1, At, B1); PG8_BAR; PG8_SCHED;
            PG8_LDA(At, 0, 1); PG8_STAGE(PG8_SB(0, 0), b2, voffB); PG8_STAGE(PG8_SB(0, 1), b2 + hstep, voffB); PG8_STAGE(PG8_SA(0, 0), a2, voffA);
            PG8_WAIT_V(8); PG8_WAIT_L(0); PG8_BAR; PG8_MMA(1, 0, At, B0); PG8_MMA(1, 1, At, B1); PG8_BAR; PG8_SCHED;
            PG8_LDB(B0, 1, 0); PG8_LDB(B1, 1, 1); PG8_SCHED; PG8_LDA(At, 1, 0); PG8_STAGE(PG8_SA(0, 1), a2 + hstep, voffA);
            PG8_WAIT_V(8); PG8_WAIT_L(0); PG8_BAR; PG8_MMA(0, 0, At, B0); PG8_MMA(0, 1, At, B1); PG8_BAR; PG8_SCHED;
            PG8_LDA(At, 1, 1); PG8_STAGE(PG8_SB(1, 0), b3, voffB); PG8_STAGE(PG8_SB(1, 1), b3 + hstep, voffB); PG8_STAGE(PG8_SA(1, 0), a3, voffA);
            PG8_WAIT_V(8); PG8_WAIT_L(0); PG8_BAR; PG8_MMA(1, 0, At, B0); PG8_MMA(1, 1, At, B1); PG8_BAR; PG8_SCHED;
            } else {
            PG8_LDB(B0, 0, 0); PG8_SCHED; PG8_LDA(At, 0, 0); PG8_STAGE(PG8_SA(1, 1), a1 + hstep, voffA);
            PG8_WAIT_L(8); PG8_BAR; PG8_WAIT_L(0); PG8_MMA(0, 0, At, B0); PG8_BAR; PG8_SCHED;
            PG8_LDB(B1, 0, 1); PG8_STAGE(PG8_SB(0, 0), b2, voffB);
            PG8_BAR; PG8_WAIT_L(0); PG8_MMA(0, 1, At, B1); PG8_BAR;
            PG8_LDA(At, 0, 1); PG8_STAGE(PG8_SA(0, 0), a2, voffA);
            PG8_BAR; PG8_WAIT_L(0); PG8_MMA(1, 0, At, B0); PG8_BAR; PG8_SCHED;
            PG8_STAGE(PG8_SB(0, 1), b2 + hstep, voffB);
            PG8_WAIT_V(6); PG8_BAR; PG8_MMA(1, 1, At, B1); PG8_BAR;
            PG8_LDB(B0, 1, 0); PG8_SCHED; PG8_LDA(At, 1, 0); PG8_STAGE(PG8_SA(0, 1), a2 + hstep, voffA);
            PG8_WAIT_L(8); PG8_BAR; PG8_WAIT_L(0); PG8_MMA(0, 0, At, B0); PG8_BAR; PG8_SCHED;
            PG8_LDB(B1, 1, 1); PG8_STAGE(PG8_SB(1, 0), b3, voffB);
            PG8_BAR; PG8_WAIT_L(0); PG8_MMA(0, 1, At, B1); PG8_BAR;
            PG8_LDA(At, 1, 1); PG8_STAGE(PG8_SA(1, 0), a3, voffA);
            PG8_BAR; PG8_WAIT_L(0); PG8_MMA(1, 0, At, B0); PG8_BAR; PG8_SCHED;
            PG8_STAGE(PG8_SB(1, 1), b3 + hstep, voffB);
            PG8_WAIT_V(6); PG8_BAR; PG8_MMA(1, 1, At, B1); PG8_BAR;
            }
        }
        if constexpr (ALIGN_EPI) { if (wr == 0) PG8_BAR; }
        if constexpr (!Epi::AFTER_DRAIN) {
            if constexpr (FP8) { int l2; asm volatile("v_mbcnt_lo_u32_b32 %0, -1, 0\n\tv_mbcnt_hi_u32_b32 %0, -1, %0" : "=v"(l2)); E(acc, cur, wr, wc, l2 & 15, l2 >> 4); }
            else E(acc, cur, wr, wc, fr, fq);
            S.done(cur); }
        if (!has_next) break;
#pragma unroll
        for (int a = 0; a < 2; ++a)
#pragma unroll
            for (int b = 0; b < 2; ++b)
#pragma unroll
                for (int m = 0; m < 4; ++m)
#pragma unroll
                    for (int n = 0; n < 2; ++n) acc[a][b][m][n] = (f32x4){0.f, 0.f, 0.f, 0.f};
        cur = nxt; cA = nA; cB = nB; rot = rotn; ++ui;
        if constexpr (ALIGN_EPI) { if (wr == 1) PG8_BAR; }
    }
    PG8_WAIT_V(0);
    if constexpr (!ALIGN_EPI) { if (wr == 0) PG8_BAR; }
    PG8_BAR;
    if constexpr (Epi::AFTER_DRAIN) { E.fused(acc, cur, wr, wc, fr, fq, lds, wid, lane); S.done(cur); }
#undef PG8_SA
#undef PG8_SB
#undef PG8_STAGE
#undef PG8_LDA
#undef PG8_LDB
#undef PG8_MMA
#undef PG8_WAIT_V
#undef PG8_WAIT_L
#undef PG8_BAR
#undef PG8_SCHED
}
}
#define GAS __attribute__((address_space(1)))
typedef unsigned v4u __attribute__((ext_vector_type(4)));
typedef GAS unsigned gu32;
typedef GAS unsigned long long gu64;
__device__ __forceinline__ const float* gin(const float* p) { return (const float*)(const GAS float*)p; }
#define RLX_AGENT __ATOMIC_RELAXED, __HIP_MEMORY_SCOPE_AGENT
#define LDS_WAIT() asm volatile("s_waitcnt lgkmcnt(0)" ::: "memory")
#define VM_WAIT() asm volatile("s_waitcnt vmcnt(0)" ::: "memory")
#define XB_TMO      128
#define XB_XCNT(j)  (256  + 64 * (j))
#define XB_XSUB(j)  (1280 + 64 * (j))
#define XB_XGEN(j)  (2304 + 64 * (j))
#define XB_TOP      3328
#define XB_TOPGEN   3392
#define XCD_BAR_WORDS 3456
#define XB_SPIN_CAP (1u << 18)

__device__ __forceinline__ unsigned xb_ld(unsigned* p)              { return __hip_atomic_load(p, __ATOMIC_RELAXED, __HIP_MEMORY_SCOPE_AGENT); }
__device__ __forceinline__ unsigned xb_add(unsigned* p, unsigned v) { return __hip_atomic_fetch_add(p, v, __ATOMIC_RELAXED, __HIP_MEMORY_SCOPE_AGENT); }
__device__ __forceinline__ unsigned xb_xcc_id() { return (unsigned)__builtin_amdgcn_s_getreg((3 << 11) | 20) & 0xFu; }
#define XB_SPIN(cond, bar) do { unsigned _sp = 0; while (cond) { __builtin_amdgcn_s_sleep(1); \
    if ((++_sp & 255u) == 0u) { if (xb_ld(&(bar)[XB_TMO])) break; if (_sp > XB_SPIN_CAP) { atomicAdd(&(bar)[XB_TMO], 1u); break; } } } } while (0)

struct XcdBarrier {
    unsigned* bar; unsigned x;
    volatile LAS unsigned* st;
};

__device__ __forceinline__ XcdBarrier xcd_barrier_post(unsigned* bar, volatile LAS unsigned* st) {
    XcdBarrier b; b.bar = bar; b.x = xb_xcc_id(); b.st = st;
    if (threadIdx.x == 0) (void)xb_add(&bar[XB_XCNT(b.x)], 1u);
    return b;
}
__device__ __forceinline__ void xcd_barrier_complete(unsigned* bar, unsigned x, unsigned& nloc, unsigned& nx) {
    const unsigned G = gridDim.x * gridDim.y * gridDim.z;
    unsigned sum, cnt, mine, sp = 0u;
    for (;;) {
        sum = 0u; cnt = 0u; mine = 0u;
#pragma unroll
        for (unsigned j = 0; j < 16; ++j) { const unsigned c = xb_ld(&bar[XB_XCNT(j)]); sum += c; cnt += (c > 0u) ? 1u : 0u; mine = (j == x) ? c : mine; }
        if (sum == G) break;
        __builtin_amdgcn_s_sleep(1);
        if ((++sp & 255u) == 0u) { if (xb_ld(&bar[XB_TMO])) break; if (sp > XB_SPIN_CAP) { atomicAdd(&bar[XB_TMO], 1u); break; } }
    }
    nloc = mine > 0u ? mine : 1u; nx = cnt > 0u ? cnt : 1u;
}

__device__ __forceinline__ void xcd_barrier(const XcdBarrier& b) {
    asm volatile("s_waitcnt vmcnt(0)" ::: "memory");
    __syncthreads();
    if (threadIdx.x == 0) {
        unsigned* bar = b.bar;
        __builtin_amdgcn_s_waitcnt(0);
        unsigned nloc = b.st[0], nx = b.st[1];
        if (nloc == 0u) { xcd_barrier_complete(bar, b.x, nloc, nx); b.st[0] = nloc; b.st[1] = nx; }
        const unsigned old = xb_add(&bar[XB_XSUB(b.x)], 1u);
        const unsigned gen = old / nloc;
        if (old + 1u == (gen + 1u) * nloc) {
            __builtin_amdgcn_fence(__ATOMIC_RELEASE, "agent");
            asm volatile("s_waitcnt vmcnt(0)" ::: "memory");
            const unsigned og = xb_add(&bar[XB_TOP], 1u);
            const unsigned tg = og / nx;
            if (og + 1u == (tg + 1u) * nx) xb_add(&bar[XB_TOPGEN], 1u);
            else XB_SPIN(xb_ld(&bar[XB_TOPGEN]) == tg, bar);
            __builtin_amdgcn_fence(__ATOMIC_ACQUIRE, "agent");
            xb_add(&bar[XB_XGEN(b.x)], 1u);
            asm volatile("s_waitcnt vmcnt(0)" ::: "memory");
        } else {
            XB_SPIN(xb_ld(&bar[XB_XGEN(b.x)]) == gen, bar);
            __builtin_amdgcn_fence(__ATOMIC_ACQUIRE, "agent");
            asm volatile("s_waitcnt vmcnt(0)" ::: "memory");
        }
    }
    __syncthreads();
}

#define XB2_SLOT(x, i) (3456 + 256 * (x) + (i))
#define XB2_FLAG(j)    (3456 + 256 * 16 + 64 * (j))
__device__ __forceinline__ XcdBarrier xcd_barrier2_post(unsigned* bar, volatile LAS unsigned* st) {
    XcdBarrier b; b.bar = bar; b.x = xb_xcc_id(); b.st = st;
    if (threadIdx.x == 0) st[2] = xb_add(&bar[XB_XCNT(b.x)], 1u) + 1u;
    return b;
}
__device__ __forceinline__ void xcd_barrier2(const XcdBarrier& b, int wave) {
    asm volatile("s_waitcnt vmcnt(0)" ::: "memory");
    __syncthreads();
    if (wave == 0) {
        unsigned* bar = b.bar; unsigned lane; asm volatile("v_mbcnt_lo_u32_b32 %0, -1, 0\n\tv_mbcnt_hi_u32_b32 %0, -1, %0" : "=v"(lane));
        __builtin_amdgcn_s_waitcnt(0);
        unsigned nloc = b.st[0], mask = b.st[1];
        if (nloc == 0u) {
            const unsigned G = gridDim.x * gridDim.y * gridDim.z; unsigned sp = 0u;
            for (;;) {
                unsigned sum = 0u, mine = 0u; mask = 0u;
#pragma unroll
                for (unsigned j = 0; j < 16; ++j) { const unsigned c = xb_ld(&bar[XB_XCNT(j)]); sum += c; mask |= (c > 0u) ? (1u << j) : 0u; mine = (j == b.x) ? c : mine; }
                nloc = mine;
                if (sum == G) break;
                __builtin_amdgcn_s_sleep(1);
                if ((++sp & 255u) == 0u) { if (xb_ld(&bar[XB_TMO])) break; if (sp > XB_SPIN_CAP) { atomicAdd(&bar[XB_TMO], 1u); break; } }
            }
            nloc = nloc > 0u ? nloc : 1u;
            if (lane == 0) { b.st[0] = nloc; b.st[1] = mask; }
        }
        const unsigned idx = b.st[2] - 1u, g = b.st[3] + 1u;
        if (lane == 0) (void)xb_add(&bar[XB2_SLOT(b.x, idx)], 1u);
        if (idx == 0u) {
            unsigned sp = 0u;
            for (;;) {
                bool ok = true;
                for (unsigned i = lane; i < nloc; i += 64u) ok = ok && ((int)(xb_ld(&bar[XB2_SLOT(b.x, i)]) - g) >= 0);
                if (__builtin_amdgcn_ballot_w64(!ok) == 0ull) break;
                __builtin_amdgcn_s_sleep(1);
                if ((++sp & 255u) == 0u) { if (xb_ld(&bar[XB_TMO])) break; if (sp > XB_SPIN_CAP) { atomicAdd(&bar[XB_TMO], 1u); break; } }
            }
            __builtin_amdgcn_fence(__ATOMIC_RELEASE, "agent");
            asm volatile("s_waitcnt vmcnt(0)" ::: "memory");
            if (lane == 0) (void)xb_add(&bar[XB2_FLAG(b.x)], 1u);
        }
        {
            unsigned sp = 0u;
            for (;;) {
                const bool ok = (lane < 16u && ((mask >> lane) & 1u)) ? ((int)(xb_ld(&bar[XB2_FLAG(lane)]) - g) >= 0) : true;
                if (__builtin_amdgcn_ballot_w64(!ok) == 0ull) break;
                __builtin_amdgcn_s_sleep(1);
                if ((++sp & 255u) == 0u) { if (xb_ld(&bar[XB_TMO])) break; if (sp > XB_SPIN_CAP) { atomicAdd(&bar[XB_TMO], 1u); break; } }
            }
        }
        __builtin_amdgcn_fence(__ATOMIC_ACQUIRE, "agent");
        asm volatile("s_waitcnt vmcnt(0)" ::: "memory");
        if (lane == 0) b.st[3] = g;
    }
    __syncthreads();
}

constexpr int RING_OFF = 0, RING_BYTES = 131072;
constexpr int LDSCTL_OFF = RING_BYTES, MISC_OFF = LDSCTL_OFF + 320;
constexpr int LDS_BYTES = 147456;
constexpr int NWAVES = 8;
constexpr int CW_BAR = 4096;

struct Args { const float* in[40]; float* out; unsigned char* ws; int nph; int ph[63]; };

struct Frame {
    LAS unsigned char* lds;
    volatile LAS unsigned* MISC;
    int tid, lane, wave, vcu, G;
    const float* const* in;
    unsigned char* ws; float* out;
};

struct ConvRegs { f32x4_t v[8]; };
__device__ __forceinline__ void conv_load(ConvRegs& R, const float* W, int ldw, int coff, int nvalid, const float* g, int nblk, int item, int lane) {
    const int kb = item / nblk, nb = item % nblk, k0 = 64 * kb, n0 = 32 * nb;
    const int nn = n0 + (lane & 7) * 4, kr = lane >> 3;
#pragma unroll
    for (int i = 0; i < 8; ++i) {
        const int kk = k0 + 8 * i + kr;
        const float* src = W + (size_t)kk * ldw + coff + nn;
        f32x4_t v = {0.f, 0.f, 0.f, 0.f};
        if (nn + 3 < nvalid) { if ((((size_t)kk * ldw + coff + nn) & 3) == 0) v = __builtin_nontemporal_load((const f32x4_t*)src);     else { v.x = src[0]; v.y = src[1]; v.z = src[2]; v.w = src[3]; } }
        else { if (nn < nvalid) v.x = src[0]; if (nn + 1 < nvalid) v.y = src[1]; if (nn + 2 < nvalid) v.z = src[2]; }
        if (g) v = v * g[kk];
        R.v[i] = v;
    }
}
__device__ __forceinline__ void conv_load64(ConvRegs& R, const float* W, int ldw, const float* g, int nblk64, int sitem, int h, int lane) {
    const int kb = sitem / nblk64, nb = sitem % nblk64, k0 = 64 * kb + 32 * h + 8 * (lane >> 4), n0 = 64 * nb;
#pragma unroll
    for (int i = 0; i < 8; ++i) { f32x4_t v = *(const f32x4_t*)(W + (size_t)(k0 + i) * ldw + n0 + (lane & 15) * 4); if (g) v = v * g[k0 + i]; R.v[i] = v; }
}
__device__ __forceinline__ void conv_units64(const ConvRegs& R, LAS unsigned char* img, int h, int lane) {
    const int kc = 4 * h + (lane >> 4);
#pragma unroll
    for (int e = 0; e < 4; ++e) {
        u32x2_t o; o.x = pk4_fp8(R.v[0][e] * F8S_W, R.v[1][e] * F8S_W, R.v[2][e] * F8S_W, R.v[3][e] * F8S_W); o.y = pk4_fp8(R.v[4][e] * F8S_W, R.v[5][e] * F8S_W, R.v[6][e] * F8S_W, R.v[7][e] * F8S_W);
        *(LAS u32x2_t*)(img + (4 * (lane & 15) + e) * 72 + kc * 8) = o;
    }
}
__device__ __forceinline__ void conv_flush64(LAS unsigned char* img, unsigned char* dst, int K, int nblk64, int rowmode, int sitem, int lane) {
    const int kb = sitem / nblk64, nb = sitem % nblk64, n0 = 64 * nb;
    LDS_WAIT(); asm volatile("" ::: "memory");
#pragma unroll
    for (int j = 0; j < 4; ++j) {
        const int nl = (lane >> 2) + 16 * j, n = n0 + nl, q = lane & 3;
        const int drow = rowmode == 0 ? n : ((n >> 7) * 256 + (n & 127) + (rowmode == 2 ? 128 : 0));
        const u32x2_t lo = *(const LAS u32x2_t*)(img + nl * 72 + q * 16), hi = *(const LAS u32x2_t*)(img + nl * 72 + q * 16 + 8);
        *(GAS u32x4_t*)(dst + (size_t)drow * K + 64 * kb + 16 * q) = (u32x4_t){lo.x, lo.y, hi.x, hi.y};
    }
    LDS_WAIT(); asm volatile("" ::: "memory");
}
template <bool FP8 = false> __device__ __forceinline__ void conv_store(const ConvRegs& R, bf16_t* dst, int K, int nblk, int rowmode, LAS float* scr, int item, int lane) {
    const int kb = item / nblk, nb = item % nblk, k0 = 64 * kb, n0 = 32 * nb;
    const int nl4 = (lane & 7) * 4, kr = lane >> 3;
#pragma unroll
    for (int i = 0; i < 8; ++i) { LAS float* d = scr + (8 * i + kr) * 33 + nl4; d[0] = R.v[i].x; d[1] = R.v[i].y; d[2] = R.v[i].z; d[3] = R.v[i].w; }
    LDS_WAIT(); asm volatile("" ::: "memory");
    const int c = lane & 7;
#pragma unroll
    for (int j = 0; j < 4; ++j) {
        const int nl = (lane >> 3) + 8 * j, n = n0 + nl; const LAS float* s = scr + (8 * c) * 33 + nl;
        const int drow = rowmode == 0 ? n : ((n >> 7) * 256 + (n & 127) + (rowmode == 2 ? 128 : 0));
        if constexpr (FP8) {
            u32x2_t o; o.x = pk4_fp8(s[0 * 33] * F8S_W, s[1 * 33] * F8S_W, s[2 * 33] * F8S_W, s[3 * 33] * F8S_W); o.y = pk4_fp8(s[4 * 33] * F8S_W, s[5 * 33] * F8S_W, s[6 * 33] * F8S_W, s[7 * 33] * F8S_W);
            *(GAS u32x2_t*)((unsigned char*)dst + (size_t)drow * K + k0 + 8 * c) = o;
        } else {
            v4u o; o.x = pk2(s[0 * 33], s[1 * 33]); o.y = pk2(s[2 * 33], s[3 * 33]); o.z = pk2(s[4 * 33], s[5 * 33]); o.w = pk2(s[6 * 33], s[7 * 33]);
            *(GAS v4u*)(dst + (size_t)drow * K + k0 + 8 * c) = o;
        }
    }
    LDS_WAIT(); asm volatile("" ::: "memory");
}
template <bool FP8 = false> __device__ __forceinline__ void conv_matrix(const float* W, int ldw, int coff, int nvalid, const float* g, bf16_t* dst, int K, int nblk, int rowmode, LAS float* scr, int it0, int items, int NGW, int lane) {
    if (it0 >= items) return;
    ConvRegs A, B;
    conv_load(A, W, ldw, coff, nvalid, g, nblk, it0, lane);
    if (it0 + NGW < items) conv_load(B, W, ldw, coff, nvalid, g, nblk, it0 + NGW, lane);
#pragma nounroll
    for (int it = it0; it < items; it += 2 * NGW) {
        { ConvRegs C = A; if (it + 2 * NGW < items) conv_load(A, W, ldw, coff, nvalid, g, nblk, it + 2 * NGW, lane); conv_store<FP8>(C, dst, K, nblk, rowmode, scr, it, lane); }
        if (it + NGW < items) { ConvRegs C = B; if (it + 3 * NGW < items) conv_load(B, W, ldw, coff, nvalid, g, nblk, it + 3 * NGW, lane); conv_store<FP8>(C, dst, K, nblk, rowmode, scr, it + NGW, lane); }
    }
}
struct ConvJob { const float* W; const float* g; bf16_t* dst; int ldw, coff, nvalid, npad, K, rowmode, fp8; };
__device__ __forceinline__ ConvJob conv_job(const Frame& F, int j) {
    bf16_t* WB = (bf16_t*)(F.ws + WS_WB);
    ConvJob c; c.g = nullptr; c.coff = 0; c.rowmode = 0; c.K = 1024; c.ldw = D_; c.nvalid = D_; c.npad = D_; c.fp8 = 0;
    if (j < 16) {
        const int l = j >> 3, k = j & 7;
        switch (k) {
        case 0: { const int ncols = l == 0 ? 3096 : 3128; c.W = l == 0 ? gin(F.in[2]) : gin(F.in[3]); c.ldw = ncols; c.g = gin(F.in[6]) + l * D_; c.dst = WB + (WB_WIN / 2) + (size_t)l * NPJ * 1024;
                  if (l == 0) { c.nvalid = 3072; c.npad = 3072; } else { c.nvalid = 1792; c.npad = 1792; } } break;
        case 1: c.W = gin(F.in[25]) + (size_t)l * D_ * D_; c.dst = WB + (WB_WOUT / 2) + (size_t)l * D_ * D_; break;
        case 2: c.W = gin(F.in[28]) + (size_t)l * D_ * D_; c.g = gin(F.in[26]) + l * D_; c.dst = WB + (WB_WQ / 2) + (size_t)l * D_ * D_; break;
        case 3: c.W = gin(F.in[29]) + (size_t)l * D_ * 2048; c.ldw = 2048; c.g = gin(F.in[27]) + l * D_; c.dst = WB + (WB_WK / 2) + (size_t)l * D_ * D_; break;
        case 4: c.W = gin(F.in[29]) + (size_t)l * D_ * 2048; c.ldw = 2048; c.coff = 1024; c.g = gin(F.in[27]) + l * D_; c.dst = WB + (WB_WV / 2) + (size_t)l * D_ * D_; break;
        case 5: c.W = gin(F.in[30]) + (size_t)l * D_ * D_; c.dst = WB + (WB_WO / 2) + (size_t)l * D_ * D_; break;
        case 6: c.W = gin(F.in[20]) + (size_t)l * 2048 * 128; c.ldw = 128; c.nvalid = 128; c.npad = 128; c.K = 2048; c.dst = WB + (WB_CW1 / 2) + (size_t)(l * 2 + 0) * 128 * 2048; break;
        default: c.W = gin(F.in[23]) + (size_t)l * 2048 * 128; c.ldw = 128; c.nvalid = 128; c.npad = 128; c.K = 2048; c.dst = WB + (WB_CW1 / 2) + (size_t)(l * 2 + 1) * 128 * 2048; break;
        }
    } else if (j == 16) { c.W = gin(F.in[32]); c.ldw = FFD; c.nvalid = FFD; c.npad = FFD; c.g = gin(F.in[31]); c.dst = WB + (WB_WGU / 2); c.rowmode = 1; }
    else if (j == 17) { c.W = gin(F.in[33]); c.ldw = FFD; c.nvalid = FFD; c.npad = FFD; c.g = gin(F.in[31]); c.dst = WB + (WB_WGU / 2); c.rowmode = 2; }
    else if (j == 18) { c.W = gin(F.in[34]); c.K = FFD; c.dst = WB + (WB_WD / 2); c.fp8 = 1; }
    else {
        const int l = j == 19 ? 0 : 1, ncols = l == 0 ? 3096 : 3128;
        c.W = l == 0 ? gin(F.in[2]) : gin(F.in[3]); c.ldw = ncols; c.g = gin(F.in[6]) + l * D_;
        bf16_t* wsk = WB + (WB_WSK / 2) + (size_t)l * 64 * 1024;
        if (j == 19) { c.coff = 3072; c.nvalid = 24; c.npad = 32; c.dst = wsk; }
        else if (j == 20) { c.coff = 1824; c.nvalid = 1280; c.npad = 1280; c.dst = WB + (WB_WIN / 2) + (size_t)NPJ * 1024 + (size_t)1792 * 1024; }
        else if (j == 21) { c.coff = 3104; c.nvalid = 24; c.npad = 32; c.dst = wsk; }
        else { c.coff = 1792; c.nvalid = 32; c.npad = 32; c.dst = wsk + (size_t)32 * 1024; }
    }
    return c;
}

__device__ __forceinline__ void p_prologue(Frame& F) {
    LAS float* scr = (LAS float*)(F.lds + RING_OFF + F.wave * 16384);
    const int gw = F.vcu * NWAVES + F.wave, NGW = F.G * NWAVES;
    bf16_t* WB = (bf16_t*)(F.ws + WS_WB);
    LAS int* pre = (LAS int*)(F.lds + LDSCTL_OFF + 1024);
    if (F.tid < 23) { const ConvJob c = conv_job(F, F.tid); pre[F.tid] = (c.K / 64) * (c.npad / 32); }
    __syncthreads();
    if (F.tid == 0) { int acc = 0; for (int j = 0; j < 23; ++j) { const int it = pre[j]; pre[j] = acc; acc += it; } pre[23] = acc; }
    __syncthreads();
    {
        const int TOT = pre[23];
#define PRO_JOB(gi) int j_ = 0; for (int q_ = 1; q_ < 23; ++q_) j_ += ((gi) >= pre[q_]) ? 1 : 0; j_ = __builtin_amdgcn_readfirstlane(j_); const ConvJob c_ = conv_job(F, j_); const int it_ = (gi) - pre[j_];
#define PRO_LOAD(R, gi) do { PRO_JOB(gi) conv_load(R, c_.W, c_.ldw, c_.coff, c_.nvalid, c_.g, c_.npad / 32, it_, F.lane); } while (0)
#define PRO_STORE(R, gi) do { PRO_JOB(gi) if (c_.fp8) conv_store<true>(R, c_.dst, c_.K, c_.npad / 32, c_.rowmode, scr, it_, F.lane); else conv_store<false>(R, c_.dst, c_.K, c_.npad / 32, c_.rowmode, scr, it_, F.lane); } while (0)
        ConvRegs A, B;
        if (gw < TOT) PRO_LOAD(A, gw);
        if (gw + NGW < TOT) PRO_LOAD(B, gw + NGW);
#pragma nounroll
        for (int gi = gw; gi < TOT; gi += 2 * NGW) {
            { ConvRegs C = A; if (gi + 2 * NGW < TOT) PRO_LOAD(A, gi + 2 * NGW); PRO_STORE(C, gi); }
            if (gi + NGW < TOT) { ConvRegs C = B; if (gi + 3 * NGW < TOT) PRO_LOAD(B, gi + 3 * NGW); PRO_STORE(C, gi + NGW); }
        }
#undef PRO_JOB
#undef PRO_LOAD
#undef PRO_STORE
    }
    const int gt = (F.vcu * NWAVES + F.wave) * 64 + F.lane, NGT = F.G * NWAVES * 64;
    for (int l = 0; l < 2; ++l) {
        bf16_t* LT = WB + (WB_LORA / 2) + (size_t)l * 512 * 288;
        for (int i = gt; i < 512 * 288; i += NGT) {
            const int c = i / 288, k = i % 288; float v;
            if (k < 64) v = gin(F.in[8])[((size_t)l * 64 + k) * 512 + c];
            else if (k < 128) v = gin(F.in[10])[((size_t)l * 64 + (k - 64)) * 512 + c];
            else if (k < 256) v = gin(F.in[11])[((size_t)l * 128 + (k - 128)) * 512 + c];
            else v = (l == 1) ? gin(F.in[18])[(size_t)(k - 256) * 512 + c] : 0.f;
            LT[i] = (bf16_t)f2bf(v);
        }
        for (int kv = 0; kv < 2; ++kv) {
            bf16_t* C2 = WB + (WB_CW2 / 2) + (size_t)(l * 2 + kv) * 64 * 128;
            const float* w2 = (kv == 0 ? gin(F.in[21]) : gin(F.in[24])) + (size_t)l * 128 * 64;
            for (int i = gt; i < 64 * 128; i += NGT) { const int d = i / 128, k = i % 128; C2[i] = (bf16_t)f2bf(w2[k * 64 + d]); }
        }
    }
    for (int o = gw; o < 512; o += NGW) {
        const int l = o >> 8, kv = (o >> 7) & 1, hid = o & 127;
        const float* pe = (kv == 0 ? gin(F.in[19]) : gin(F.in[22])) + (size_t)l * 2048;
        const float* w1 = (kv == 0 ? gin(F.in[20]) : gin(F.in[23])) + (size_t)l * 2048 * 128;
        float a = 0.f;
        for (int i = F.lane; i < 2048; i += 64) a += pe[i] * w1[(size_t)i * 128 + hid];
        a = wave_sum_l(a, F.lane);
        if (F.lane == 0) ((float*)(F.ws + WS_WB + WB_CB))[o] = a;
    }
    {
        bf16_t* XB = (bf16_t*)(F.ws + WS_XB); float* SSQ = (float*)(F.ws + WS_SSQ);
        for (int m = gw; m < NTOK; m += NGW) {
            const GAS f32x4_t* xr = (const GAS f32x4_t*)(gin(F.in[0]) + (size_t)m * D_) + F.lane;
            f32x4_t v[4]; float s = 0.f;
#pragma unroll
            for (int j = 0; j < 4; ++j) { v[j] = __builtin_nontemporal_load(xr + 64 * j); s += (v[j].x * v[j].x + v[j].y * v[j].y) + (v[j].z * v[j].z + v[j].w * v[j].w); }
            s = wave_sum_l(s, F.lane);
            GAS unsigned long long* o8 = (GAS unsigned long long*)(XB + (size_t)m * D_) + F.lane;
#pragma unroll
            for (int j = 0; j < 4; ++j) { o8[64 * j] = (unsigned long long)pk2(v[j].x, v[j].y) | ((unsigned long long)pk2(v[j].z, v[j].w) << 32); }
            if (F.lane < 16) SSQ[(size_t)m * 16 + F.lane] = (F.lane == 0) ? s : 0.f;
        }
        bf16_t* MB = (bf16_t*)(F.ws + WS_MEMB); float* MRINV = (float*)(F.ws + WS_MRINV);
        for (int m = gw; m < NMEM; m += NGW) {
            const GAS f32x4_t* xr = (const GAS f32x4_t*)(gin(F.in[1]) + (size_t)m * D_) + F.lane;
            f32x4_t v[4]; float s = 0.f;
#pragma unroll
            for (int j = 0; j < 4; ++j) { v[j] = __builtin_nontemporal_load(xr + 64 * j); s += (v[j].x * v[j].x + v[j].y * v[j].y) + (v[j].z * v[j].z + v[j].w * v[j].w); }
            s = wave_sum_l(s, F.lane);
            GAS unsigned long long* o8 = (GAS unsigned long long*)(MB + (size_t)m * D_) + F.lane;
#pragma unroll
            for (int j = 0; j < 4; ++j) o8[64 * j] = (unsigned long long)pk2(v[j].x, v[j].y) | ((unsigned long long)pk2(v[j].z, v[j].w) << 32);
            if (F.lane == 0) MRINV[m] = 1.0f / sqrtf(s * (1.0f / 1024.0f) + 1e-6f);
        }
    }
}


__device__ __forceinline__ unsigned char* launder_ptr(unsigned char* p) {
    unsigned lo = (unsigned)(uintptr_t)p, hi = (unsigned)((uintptr_t)p >> 32);
    asm volatile("" : "+v"(lo), "+v"(hi));
    lo = __builtin_amdgcn_readfirstlane(lo); hi = __builtin_amdgcn_readfirstlane(hi);
    return (unsigned char*)(GAS unsigned char*)(((uintptr_t)hi << 32) | (uintptr_t)lo);
}
__device__ __forceinline__ int lane_now() { int l; asm volatile("v_mbcnt_lo_u32_b32 %0, -1, 0\n\tv_mbcnt_hi_u32_b32 %0, -1, %0" : "=v"(l)); return l; }
#define RELAUNDER(F) do { int w_ = (F).wave; asm volatile("" : "+v"(w_)); w_ = __builtin_amdgcn_readfirstlane(w_); const int l_ = lane_now(); int t_ = w_ * 64 + l_; asm volatile("" : "+v"(t_)); \
    (F).tid = t_; (F).lane = t_ & 63; (F).wave = w_; (F).ws = launder_ptr((F).ws); } while (0)
constexpr size_t S_PROJ = 0;
constexpr size_t S_EX = 96 * MiB;
constexpr size_t S_CONCAT = 104 * MiB;
constexpr size_t S_SC = 104 * MiB;
constexpr size_t S_CH = 200 * MiB;
constexpr int CH_BYTES = 12544;
constexpr size_t S_BON = 298 * MiB;
constexpr size_t S_END = 299 * MiB;
constexpr size_t O_Y = 0;
constexpr size_t O_G = 32 * MiB;
constexpr size_t O_VP = 48 * MiB;
constexpr size_t S_QC = 0, S_OC = 32 * MiB;
constexpr size_t S_ACT = 0;

constexpr int RTAB_OFF = 132096, RTAB_UNITS = 8;
static_assert(RTAB_OFF + RTAB_UNITS * 256 * 4 <= LDS_BYTES && RTAB_OFF >= MISC_OFF + 128, "LDS map");
template <class Sched> __device__ __forceinline__ void fill_rtab(Frame& F, const Sched& S, const float* direct = nullptr) {
    const float* ssq = (const float*)(F.ws + WS_SSQ);
    LAS float* rtab = (LAS float*)(F.lds + RTAB_OFF);
    pg8::Unit u;
    for (int i = 0; i < RTAB_UNITS && S.next(i, u); ++i)
        if (F.tid < 256) rtab[i * 256 + F.tid] = direct ? direct[u.pm * 256 + F.tid] : pg8::row_rinv(ssq, u.pm * 256 + F.tid);
    __syncthreads();
}
__device__ __forceinline__ void p_inproj(Frame& F, int l) {
    RELAUNDER(F);
    pg8::Gemm g{(const bf16_t*)(F.ws + WS_XB), (const bf16_t*)(F.ws + WS_WB + WB_WIN) + (size_t)l * NPJ * 1024, NTOK, NPJ, 1024, 0};
    pg8::StaticOrder S; S.init(NTOK, NPJ, F.G, (int)blockIdx.x);
    fill_rtab(F, S);
    pg8::EpiRowScaleBf16 E{(bf16_t*)(F.ws + WS_S), NPJ, (const LAS float*)(F.lds + RTAB_OFF), 1.0f};
    pg8::gemm_phase<pg8::EpiRowScaleBf16, pg8::StaticOrder, true, true>(F.lds + RING_OFF, g, S, E, F.tid);
    __syncthreads();
    for (int chunk = F.vcu; chunk < NTOK / 64; chunk += F.G) {
        const int w = F.wave, m = F.lane & 15, kq = F.lane >> 4, tokb = chunk * 64 + (w >> 1) * 16, colb = (w & 1) * 32;
        const bf16_t* ap = (const bf16_t*)(F.ws + WS_XB) + (size_t)(tokb + m) * D_ + kq * 8;
        const bf16_t* bp = (const bf16_t*)(F.ws + WS_WB + WB_WSK) + (size_t)l * 64 * 1024 + (size_t)(colb + m) * D_ + kq * 8;
        pg8::f32x4 a0 = {0.f, 0.f, 0.f, 0.f}, a1 = a0;
#pragma unroll 8
        for (int ks = 0; ks < 32; ++ks) {
            const pg8::bf16x8 af = *(const pg8::bf16x8*)(ap + ks * 32), b0 = *(const pg8::bf16x8*)(bp + ks * 32), b1 = *(const pg8::bf16x8*)(bp + (size_t)16 * D_ + ks * 32);
            a0 = __builtin_amdgcn_mfma_f32_16x16x32_bf16(af, b0, a0, 0, 0, 0);
            a1 = __builtin_amdgcn_mfma_f32_16x16x32_bf16(af, b1, a1, 0, 0, 0);
        }
        bf16_t* EX = (bf16_t*)(F.ws + WS_S + S_EX);
#pragma unroll
        for (int rg = 0; rg < 4; ++rg) {
            const int tok = tokb + 4 * kq + rg; const float rs = pg8::row_rinv((const float*)(F.ws + WS_SSQ), tok);
            EX[(size_t)tok * 64 + colb + m] = (bf16_t)f2bf(a0[rg] * rs); EX[(size_t)tok * 64 + colb + 16 + m] = (bf16_t)f2bf(a1[rg] * rs);
        }
    }
}

template <int DBG = 0> __device__ __forceinline__ void p_gprobe(Frame& F, int N, int K) {
    RELAUNDER(F);
    pg8::Gemm g{(const bf16_t*)(F.ws + WS_XB), (const bf16_t*)(F.ws + WS_WB + WB_WIN), NTOK, N, K, 0};
    pg8::StaticOrder S; S.init(NTOK, N, F.G, (int)blockIdx.x);
    fill_rtab(F, S);
    pg8::EpiRowScaleBf16 E{(bf16_t*)(F.ws + WS_S), N, (const LAS float*)(F.lds + RTAB_OFF), 1.0f};
    pg8::gemm_phase<pg8::EpiRowScaleBf16, pg8::StaticOrder, true, true, false, DBG>(F.lds + RING_OFF, g, S, E, F.tid);
}
struct SameTileOrder {
    int nU, pm0, pn0;
    __device__ bool next(int i, pg8::Unit& u) const { if (i >= nU) return false; u.pm = pm0; u.pn = pn0; u.e = 0; u.ord = 0; u.ks = 0; return true; }
    __device__ __forceinline__ void a_ready(const pg8::Unit&) const {}
    __device__ __forceinline__ void done(const pg8::Unit&) const {}
    __device__ __forceinline__ int kloop(int K) const { return K; }
    __device__ __forceinline__ size_t koff(const pg8::Unit&) const { return 0; }
};
__device__ __forceinline__ void p_gprobe2(Frame& F, int nU, int K, int mode) {
    RELAUNDER(F);
    pg8::Gemm g{(const bf16_t*)(F.ws + WS_XB), (const bf16_t*)(F.ws + WS_WB + WB_WIN), NTOK, 1024, K, 0};
    SameTileOrder S; S.nU = nU; S.pm0 = mode == 0 ? 0 : (mode == 1 ? (int)(blockIdx.x & 7) : (int)(blockIdx.x >> 2)); S.pn0 = mode == 0 ? 0 : (mode == 1 ? 0 : (int)(blockIdx.x & 3));
    fill_rtab(F, S);
    pg8::EpiRowScaleBf16 E{(bf16_t*)(F.ws + WS_S), 1024, (const LAS float*)(F.lds + RTAB_OFF), 1.0f};
    pg8::gemm_phase<pg8::EpiRowScaleBf16, SameTileOrder, true, true>(F.lds + RING_OFF, g, S, E, F.tid);
}
__device__ __forceinline__ void p_resid_gemm(Frame& F, const bf16_t* A, const bf16_t* Bt, int K) {
    RELAUNDER(F);
    pg8::Gemm g{A, Bt, NTOK, 1024, K, 0};
    pg8::StaticOrder S; S.init(NTOK, 1024, F.G, (int)blockIdx.x);
    pg8::EpiResid E{(bf16_t*)(F.ws + WS_XB), (float*)(F.ws + WS_SSQ)};
    pg8::gemm_phase<pg8::EpiResid, pg8::StaticOrder, true, true>(F.lds + RING_OFF, g, S, E, F.tid);
}
__device__ __forceinline__ int p_crossq(Frame& F, int l) {
    RELAUNDER(F);
    pg8::Gemm g{(const bf16_t*)(F.ws + WS_XB), (const bf16_t*)(F.ws + WS_WB + WB_WQ) + (size_t)l * D_ * D_, NTOK, 1024, 1024, 0};
    pg8::StaticOrder S; S.init(NTOK, 1024, F.G, (int)blockIdx.x);
    fill_rtab(F, S);
    pg8::EpiRowScaleBf16 E{(bf16_t*)(F.ws + WS_S + S_QC), 1024, (const LAS float*)(F.lds + RTAB_OFF), 0.0625f * 1.4426950408889634f};
    pg8::gemm_phase<pg8::EpiRowScaleBf16, pg8::StaticOrder, true, true>(F.lds + RING_OFF, g, S, E, F.tid);
    pg8::Unit u; if (F.G != 256 || !S.next(0, u)) return -1;
    return ((u.pm >> 3) * 4 + u.pn) * 8 + (u.pm & 7);
}
__device__ __forceinline__ void p_kv(Frame& F, int cb) {
    RELAUNDER(F);
    if (cb < 0 || cb >= 128) return;
    const int which = cb >> 5, l = which >> 1, c = cb & 31;
    const bf16_t* MB = (const bf16_t*)(F.ws + WS_MEMB); const float* MRINV = (const float*)(F.ws + WS_MRINV);
    if ((which & 1) == 0) {
        pg8::Gemm g{MB, (const bf16_t*)(F.ws + WS_WB + WB_WK) + (size_t)l * D_ * D_, NMEM, 1024, 1024, 0};
        pg8::StaticOrder S; S.init(NMEM, 1024, 32, c);
        fill_rtab(F, S, MRINV);
        pg8::EpiRowScaleBf16 E{(bf16_t*)(F.ws + WS_KCR) + (size_t)l * NMEM * 1024, 1024, (const LAS float*)(F.lds + RTAB_OFF), 1.0f};
        pg8::gemm_phase<pg8::EpiRowScaleBf16, pg8::StaticOrder, true, true>(F.lds + RING_OFF, g, S, E, F.tid);
    } else {
        pg8::Gemm g{(const bf16_t*)(F.ws + WS_WB + WB_WV) + (size_t)l * D_ * D_, MB, 1024, NMEM, 1024, 0};
        pg8::StaticOrder S; S.init(1024, NMEM, 32, c);
        pg8::EpiColScaleBf16 E{(bf16_t*)(F.ws + WS_VT) + (size_t)l * 1024 * NMEM, NMEM, MRINV};
        pg8::gemm_phase<pg8::EpiColScaleBf16, pg8::StaticOrder, true, true>(F.lds + RING_OFF, g, S, E, F.tid);
    }
}
__device__ __forceinline__ void p_ffn_up(Frame& F) {
    RELAUNDER(F);
    pg8::Gemm g{(const bf16_t*)(F.ws + WS_XB), (const bf16_t*)(F.ws + WS_WB + WB_WGU), NTOK, 2 * FFD, 1024, 0};
    pg8::StaticOrder S; S.init(NTOK, 2 * FFD, F.G, (int)blockIdx.x);
    fill_rtab(F, S);
    pg8::EpiSwiGLU8R E{(unsigned char*)(F.ws + WS_S + S_ACT), FFD, (const LAS float*)(F.lds + RTAB_OFF), F8S_ACT};
    pg8::gemm_phase<pg8::EpiSwiGLU8R, pg8::StaticOrder, true, true>(F.lds + RING_OFF, g, S, E, F.tid);
}
__device__ __forceinline__ void p_ffn_down8(Frame& F) {
    RELAUNDER(F);
    pg8::Gemm g{(const bf16_t*)(F.ws + WS_S + S_ACT), (const bf16_t*)(F.ws + WS_WB + WB_WD), NTOK, 1024, FFD / 2, 0};
    pg8::StaticOrder S; S.init(NTOK, 1024, F.G, (int)blockIdx.x);
    pg8::EpiResid E{(bf16_t*)(F.ws + WS_XB), (float*)(F.ws + WS_SSQ)};
    pg8::gemm_phase<pg8::EpiResid, pg8::StaticOrder, true, true, true>(F.lds + RING_OFF, g, S, E, F.tid, F8C_ACT, F8C_W);
}

typedef short bf16x8_t __attribute__((ext_vector_type(8)));
constexpr int LDX = 296;
__device__ __forceinline__ void p_rw_prep(Frame& F, int l) {
    RELAUNDER(F);
    const int n_lo = l == 0 ? 256 : 288;
    const bf16_t* P = (const bf16_t*)(F.ws + WS_S + S_PROJ); const bf16_t* EXp = (const bf16_t*)(F.ws + WS_S + S_EX);
    const float* mu = l == 0 ? gin(F.in[4]) : gin(F.in[5]);
    const bf16_t* LT0 = (const bf16_t*)(F.ws + WS_WB + WB_LORA) + (size_t)l * 512 * 288;
    bf16_t* SC = (bf16_t*)(F.ws + WS_S + S_SC); bf16_t* Gb = (bf16_t*)((unsigned char*)F.out + O_G); bf16_t* VPb = (bf16_t*)((unsigned char*)F.out + O_VP); float* BON = (float*)(F.ws + WS_S + S_BON);
    bf16_t* VF = (bf16_t*)(F.ws + WS_VFIRST);
    LAS bf16_t* Xs = (LAS bf16_t*)F.lds;
    const float* w0 = gin(F.in[7]) + l * W_; const float* a0 = gin(F.in[9]) + l * W_; const float* kkp = gin(F.in[12]) + l * W_; const float* kap = gin(F.in[13]) + l * W_; const float* rkp = gin(F.in[14]) + l * W_;
    const float* v0p = gin(F.in[17]);
    for (int chunk = F.vcu; chunk < NTOK / 64; chunk += F.G) {
        const int tok0 = chunk * 64;
        __syncthreads();
        for (int c = F.tid; c < 64 * 36; c += NWAVES * 64) {
            const int row = c / 36, ch = c % 36, tok = tok0 + row, t = tok & (T_ - 1);
            u32x4_t o = {0u, 0u, 0u, 0u};
            if (ch * 8 < n_lo) {
                const bf16_t* srcp = ch < 32 ? P + (size_t)tok * NPJ + 1536 + ch * 8 : EXp + (size_t)tok * 64 + 32 + (ch - 32) * 8;
                const int rstride = ch < 32 ? NPJ : 64;
                const u32x4_t cu = *(const u32x4_t*)(srcp);
                u32x4_t pv = {0u, 0u, 0u, 0u};
                if (t > 0) pv = *(const u32x4_t*)(srcp - rstride);
                const f32x4_t m0 = *(const f32x4_t*)(mu + 1536 + ch * 8), m1 = *(const f32x4_t*)(mu + 1536 + ch * 8 + 4);
                float v[8];
#pragma unroll
                for (int q = 0; q < 4; ++q) {
                    const float u0 = __uint_as_float(cu[q] << 16), u1 = __uint_as_float(cu[q] & 0xffff0000u), p0 = __uint_as_float(pv[q] << 16), p1 = __uint_as_float(pv[q] & 0xffff0000u);
                    const float ma = q < 2 ? m0[2 * q] : m1[2 * q - 4], mb = q < 2 ? m0[2 * q + 1] : m1[2 * q - 3];
                    v[2 * q] = u0 + (p0 - u0) * ma; v[2 * q + 1] = u1 + (p1 - u1) * mb;
                }
                if (ch < 8) { for (int q = 0; q < 8; ++q) v[q] = ftanh(v[q]); }
                else if (ch >= 16 && ch < 32) { for (int q = 0; q < 8; ++q) v[q] = fsigmoid(v[q]); }
                o.x = pk2(v[0], v[1]); o.y = pk2(v[2], v[3]); o.z = pk2(v[4], v[5]); o.w = pk2(v[6], v[7]);
            }
            *(LAS u32x4_t*)(Xs + row * LDX + ch * 8) = o;
        }
        __syncthreads();
        const int h = F.wave, fr = F.lane & 15, fq = F.lane >> 4;
        const bf16_t* LT = (const bf16_t*)(const GAS bf16_t*)(uintptr_t)LT0;
        pg8::f32x4 acc[4][4];
#define LORA_MMA4(KS0, KS1) do { _Pragma("unroll") for (int nt = 0; nt < 4; ++nt) _Pragma("unroll") for (int mt = 0; mt < 4; ++mt) acc[nt][mt] = (pg8::f32x4){0.f, 0.f, 0.f, 0.f}; \
        _Pragma("unroll") for (int ks = KS0; ks < KS1; ++ks) { bf16x8_t ax[4]; \
            _Pragma("unroll") for (int mt = 0; mt < 4; ++mt) ax[mt] = *(const bf16x8_t*)(LT + (size_t)(h * 64 + mt * 16 + fr) * 288 + ks * 32 + fq * 8); \
            _Pragma("unroll") for (int nt = 0; nt < 4; ++nt) { const bf16x8_t bx = *(const LAS bf16x8_t*)(Xs + (nt * 16 + fr) * LDX + ks * 32 + fq * 8); \
                _Pragma("unroll") for (int mt = 0; mt < 4; ++mt) acc[nt][mt] = __builtin_amdgcn_mfma_f32_16x16x32_bf16(ax[mt], bx, acc[nt][mt], 0, 0, 0); } } } while (0)
#define UNPK(w, e) (((e) & 1) ? __uint_as_float(((e) < 2 ? (w).x : (w).y) & 0xffff0000u) : __uint_as_float(((e) < 2 ? (w).x : (w).y) << 16))
#define SHIFTED(dst, colbase, mt) do { const int c_ = h * 64 + (mt) * 16 + fq * 4; const u32x2_t cu_ = *(const u32x2_t*)(pc + (colbase) + c_); u32x2_t pu_ = {0u, 0u}; \
        if (t > 0) pu_ = *(const u32x2_t*)(pp + (colbase) + c_); const f32x4_t m_ = *(const f32x4_t*)(mu + (colbase) + c_); \
        _Pragma("unroll") for (int e = 0; e < 4; ++e) { const float u_ = UNPK(cu_, e), q_ = UNPK(pu_, e); dst[e] = u_ + (q_ - u_) * m_[e]; } } while (0)
#define NT_VARS const int tok = tok0 + nt * 16 + fr, t = tok & (T_ - 1), b = tok >> 11; const bf16_t* pc = P + (size_t)tok * NPJ; const bf16_t* pp = pc - NPJ; \
        const size_t sb0 = ((((size_t)b * 8 + h) * T_ + t) * 6) * 64 + fq * 4; (void)pc; (void)pp; (void)sb0;
        LORA_MMA4(0, 2);
#pragma unroll
        for (int nt = 0; nt < 4; ++nt) { NT_VARS
#pragma unroll
            for (int mt = 0; mt < 4; ++mt) {
                const int c = h * 64 + mt * 16 + fq * 4; const f32x4_t w0v = *(const f32x4_t*)(w0 + c); float om[4];
#pragma unroll
                for (int e = 0; e < 4; ++e) { const float wraw = w0v[e] + acc[nt][mt][e]; om[e] = 1.0f - fexp(-0.6065306597126334f * fsigmoid(wraw));   }
                u32x2_t o; o.x = pk2(om[0], om[1]); o.y = pk2(om[2], om[3]); *(u32x2_t*)(SC + sb0 + mt * 16 + 1 * 64) = o;
            }
        }
        LORA_MMA4(4, 8);
#pragma unroll
        for (int nt = 0; nt < 4; ++nt) { NT_VARS
#pragma unroll
            for (int mt = 0; mt < 4; ++mt) { const int c = h * 64 + mt * 16 + fq * 4; u32x2_t o; o.x = pk2(acc[nt][mt][0], acc[nt][mt][1]); o.y = pk2(acc[nt][mt][2], acc[nt][mt][3]); *(u32x2_t*)(Gb + (size_t)tok * W_ + c) = o; }
        }
        if (l == 1) LORA_MMA4(8, 9);
#pragma unroll
        for (int nt = 0; nt < 4; ++nt) { NT_VARS
#pragma unroll
            for (int mt = 0; mt < 4; ++mt) {
                const int c = h * 64 + mt * 16 + fq * 4; float v[4]; SHIFTED(v, 1024, mt);
                if (l == 1) {
                    const f32x4_t v0v = *(const f32x4_t*)(v0p + c); const u32x2_t vfr = *(const u32x2_t*)(VF + (size_t)tok * W_ + c);
#pragma unroll
                    for (int e = 0; e < 4; ++e) { const float vf = UNPK(vfr, e); v[e] = v[e] + (vf - v[e]) * fsigmoid(v0v[e] + acc[nt][mt][e]); }
                }
                u32x2_t o; o.x = pk2(v[0], v[1]); o.y = pk2(v[2], v[3]);
                *(u32x2_t*)(SC + sb0 + mt * 16 + 3 * 64) = o;
                *(u32x2_t*)(VPb + (size_t)tok * W_ + c) = o;
                if (l == 0) *(u32x2_t*)(VF + (size_t)tok * W_ + c) = o;
            }
        }
        LORA_MMA4(2, 4);
#pragma unroll
        for (int nt = 0; nt < 4; ++nt) { NT_VARS
            float kn[4][4], ai[4][4]; float ssk = 0.f, bsum = 0.f;
#pragma unroll
            for (int mt = 0; mt < 4; ++mt) {
                const int c = h * 64 + mt * 16 + fq * 4; float r[4], k[4]; SHIFTED(r, 0, mt); SHIFTED(k, 512, mt);
                const f32x4_t a0v = *(const f32x4_t*)(a0 + c), kkv = *(const f32x4_t*)(kkp + c), kav = *(const f32x4_t*)(kap + c), rkv = *(const f32x4_t*)(rkp + c);
                float kh[4];
#pragma unroll
                for (int e = 0; e < 4; ++e) {
                    const float a = fsigmoid(a0v[e] + acc[nt][mt][e]); const float kk = k[e] * kkv[e];
                    ssk += kk * kk; kh[e] = k[e] * (1.f + (a - 1.f) * kav[e]); bsum += r[e] * kh[e] * rkv[e];
                    kn[mt][e] = kk; ai[mt][e] = a;
                }
                { u32x2_t o; o.x = pk2(r[0], r[1]); o.y = pk2(r[2], r[3]); *(u32x2_t*)(SC + sb0 + mt * 16 + 0 * 64) = o; }
                { u32x2_t o; o.x = pk2(kh[0], kh[1]); o.y = pk2(kh[2], kh[3]); *(u32x2_t*)(SC + sb0 + mt * 16 + 2 * 64) = o; }
            }
            ssk += shx(ssk, F.lane, 16); ssk += shx(ssk, F.lane, 32);
            bsum += shx(bsum, F.lane, 16); bsum += shx(bsum, F.lane, 32);
            const float kinv = 1.0f / fmaxf(sqrtf(ssk), 1e-12f);
            if (fq == 0) BON[(size_t)tok * 8 + h] = bsum;
#pragma unroll
            for (int mt = 0; mt < 4; ++mt) {
                float kq[4], bq[4];
#pragma unroll
                for (int e = 0; e < 4; ++e) { kq[e] = kn[mt][e] * kinv; bq[e] = kq[e] * ai[mt][e]; }
                { u32x2_t o; o.x = pk2(kq[0], kq[1]); o.y = pk2(kq[2], kq[3]); *(u32x2_t*)(SC + sb0 + mt * 16 + 4 * 64) = o; }
                { u32x2_t o; o.x = pk2(bq[0], bq[1]); o.y = pk2(bq[2], bq[3]); *(u32x2_t*)(SC + sb0 + mt * 16 + 5 * 64) = o; }
            }
        }
#undef LORA_MMA4
#undef NT_VARS
#undef UNPK
#undef SHIFTED
    }
}

constexpr int SC_STEPS = 32, SC_CHUNK_F = SC_STEPS * 6 * 64;
constexpr int SCAN_YB = 2 * SC_CHUNK_F * 4;
__device__ __forceinline__ float dpp_ror_add(float v, int) { return v; }
#define ROW_ALLREDUCE(v) do { \
    v += __int_as_float(__builtin_amdgcn_update_dpp(0, __float_as_int(v), 0x128, 0xf, 0xf, false)); \
    v += __int_as_float(__builtin_amdgcn_update_dpp(0, __float_as_int(v), 0x124, 0xf, 0xf, false)); \
    v += __int_as_float(__builtin_amdgcn_update_dpp(0, __float_as_int(v), 0x122, 0xf, 0xf, false)); \
    v += __int_as_float(__builtin_amdgcn_update_dpp(0, __float_as_int(v), 0x121, 0xf, 0xf, false)); } while (0)
__device__ __forceinline__ void p_rw_scan(Frame& F) {
    RELAUNDER(F);
    const bf16_t* SC = (const bf16_t*)(F.ws + WS_S + S_SC); float* Y = (float*)((unsigned char*)F.out + O_Y);
    LAS float* ring = (LAS float*)F.lds; LAS float* yring = (LAS float*)(F.lds + SCAN_YB);
    constexpr int NCH = T_ / SC_STEPS;
    for (int unit = F.vcu; unit < B_ * H_ * 4; unit += F.G) {
        const int bh = unit >> 2, qtr = unit & 3;
        const bf16_t* src = SC + (size_t)bh * T_ * 384;
        __syncthreads();
        if (F.wave >= 4) {
            const int lt = F.tid - 256;
            u32x4_t regs[6];
#pragma unroll
            for (int i = 0; i < 6; ++i) regs[i] = *(const u32x4_t*)(src + (size_t)(lt + 256 * i) * 8);
#pragma unroll
            for (int i = 0; i < 6; ++i) {
                LAS f32x4_t* d = (LAS f32x4_t*)(ring + (lt + 256 * i) * 8);
                d[0] = (f32x4_t){__uint_as_float(regs[i].x << 16), __uint_as_float(regs[i].x & 0xffff0000u), __uint_as_float(regs[i].y << 16), __uint_as_float(regs[i].y & 0xffff0000u)};
                d[1] = (f32x4_t){__uint_as_float(regs[i].z << 16), __uint_as_float(regs[i].z & 0xffff0000u), __uint_as_float(regs[i].w << 16), __uint_as_float(regs[i].w & 0xffff0000u)};
            }
#pragma unroll
            for (int i = 0; i < 6; ++i) regs[i] = *(const u32x4_t*)(src + (size_t)SC_CHUNK_F + (size_t)(lt + 256 * i) * 8);
            __syncthreads();
            for (int c = 0; c < NCH; ++c) {
                if (c + 1 < NCH) {
                    LAS float* dst = ring + ((c + 1) & 1) * SC_CHUNK_F;
#pragma unroll
                    for (int i = 0; i < 6; ++i) {
                        LAS f32x4_t* d = (LAS f32x4_t*)(dst + (lt + 256 * i) * 8);
                        d[0] = (f32x4_t){__uint_as_float(regs[i].x << 16), __uint_as_float(regs[i].x & 0xffff0000u), __uint_as_float(regs[i].y << 16), __uint_as_float(regs[i].y & 0xffff0000u)};
                        d[1] = (f32x4_t){__uint_as_float(regs[i].z << 16), __uint_as_float(regs[i].z & 0xffff0000u), __uint_as_float(regs[i].w << 16), __uint_as_float(regs[i].w & 0xffff0000u)};
                    }
                    if (c + 2 < NCH) {
#pragma unroll
                        for (int i = 0; i < 6; ++i) regs[i] = *(const u32x4_t*)(src + (size_t)(c + 2) * SC_CHUNK_F + (size_t)(lt + 256 * i) * 8);
                    }
                }
                if (c > 0) {
                    const int st = lt >> 3, r2 = (lt & 7) * 2;
                    const LAS float* ys = yring + ((c - 1) & 1) * (SC_STEPS * 16) + st * 16 + r2;
                    const size_t tok = (size_t)(bh >> 3) * T_ + (size_t)(c - 1) * SC_STEPS + st;
                    typedef float f32x2_t __attribute__((ext_vector_type(2)));
                    *(f32x2_t*)(Y + tok * W_ + (bh & 7) * 64 + qtr * 16 + r2) = (f32x2_t){ys[0], ys[1]};
                }
                __syncthreads();
            }
            {
                const int c = NCH;
                const int st = lt >> 3, r2 = (lt & 7) * 2;
                const LAS float* ys = yring + ((c - 1) & 1) * (SC_STEPS * 16) + st * 16 + r2;
                const size_t tok = (size_t)(bh >> 3) * T_ + (size_t)(c - 1) * SC_STEPS + st;
                typedef float f32x2_t __attribute__((ext_vector_type(2)));
                *(f32x2_t*)(Y + tok * W_ + (bh & 7) * 64 + qtr * 16 + r2) = (f32x2_t){ys[0], ys[1]};
            }
        } else {
            typedef float f32x2_t __attribute__((ext_vector_type(2)));
            const int rl = F.wave * 4 + (F.lane >> 4);
            const int cl = F.lane & 15, cj = cl * 4;
            const int vch = qtr * 16 + rl;
            f32x2_t Sa = {0.f, 0.f}, Sb = {0.f, 0.f};
            float ykeep = 0.f;
            __syncthreads();
            for (int c = 0; c < NCH; ++c) {
                const LAS float* buf = ring + (c & 1) * SC_CHUNK_F;
                LAS float* yb = yring + (c & 1) * (SC_STEPS * 16);
                f32x4_t nr = *(const LAS f32x4_t*)(buf + 0 * 64 + cj), nom = *(const LAS f32x4_t*)(buf + 1 * 64 + cj), nk = *(const LAS f32x4_t*)(buf + 2 * 64 + cj),
                        nkk = *(const LAS f32x4_t*)(buf + 4 * 64 + cj), nb = *(const LAS f32x4_t*)(buf + 5 * 64 + cj);
                float nv = buf[3 * 64 + vch];
#pragma unroll
                for (int st = 0; st < SC_STEPS; ++st) {
                    const f32x4_t r4 = nr, om4 = nom, k4 = nk, kk4 = nkk, b4 = nb; const float v = nv;
                    if (st + 1 < SC_STEPS) {
                        const LAS float* sp = buf + (st + 1) * 384;
                        nr = *(const LAS f32x4_t*)(sp + 0 * 64 + cj); nom = *(const LAS f32x4_t*)(sp + 1 * 64 + cj); nk = *(const LAS f32x4_t*)(sp + 2 * 64 + cj);
                        nkk = *(const LAS f32x4_t*)(sp + 4 * 64 + cj); nb = *(const LAS f32x4_t*)(sp + 5 * 64 + cj); nv = sp[3 * 64 + vch];
                    }
                    f32x2_t t2 = Sa * (f32x2_t){kk4.x, kk4.y};
                    t2 = Sb * (f32x2_t){kk4.z, kk4.w} + t2;
                    float sa = t2.x + t2.y;
                    ROW_ALLREDUCE(sa);
                    const f32x2_t sa2 = {sa, sa}, v2 = {v, v};
                    Sa = Sa - Sa * (f32x2_t){om4.x, om4.y}; Sb = Sb - Sb * (f32x2_t){om4.z, om4.w};
                    Sa = v2 * (f32x2_t){k4.x, k4.y} + Sa;     Sb = v2 * (f32x2_t){k4.z, k4.w} + Sb;
                    Sa = Sa - sa2 * (f32x2_t){b4.x, b4.y};    Sb = Sb - sa2 * (f32x2_t){b4.z, b4.w};
                    f32x2_t y2 = Sa * (f32x2_t){r4.x, r4.y};
                    y2 = Sb * (f32x2_t){r4.z, r4.w} + y2;
                    float y = y2.x + y2.y;
                    ROW_ALLREDUCE(y);
                    ykeep = (cl == (st & 15)) ? y : ykeep;
                    if ((st & 15) == 15) yb[((st & ~15) + cl) * 16 + rl] = ykeep;
                }
                __syncthreads();
            }
        }
    }
}

__device__ __forceinline__ void p_rw_post(Frame& F, int l) {
    RELAUNDER(F);
    const int gw = F.vcu * NWAVES + F.wave, NGW = F.G * NWAVES;
    const float* Y = (const float*)((const unsigned char*)F.out + O_Y); const bf16_t* VPb = (const bf16_t*)((const unsigned char*)F.out + O_VP); const bf16_t* Gb = (const bf16_t*)((const unsigned char*)F.out + O_G);
    const float* BON = (const float*)(F.ws + WS_S + S_BON); bf16_t* CC = (bf16_t*)(F.ws + WS_S + S_CONCAT);
    const float* lnw = gin(F.in[15]) + l * W_; const float* lnb = gin(F.in[16]) + l * W_;
    for (int tok = gw; tok < NTOK; tok += NGW) {
        const int c = F.lane * 8, h = F.lane >> 3, b = tok >> 11, t = tok & (T_ - 1);
        const f32x4_t y0 = __builtin_nontemporal_load((const f32x4_t*)(Y + (size_t)tok * W_ + c)), y1 = __builtin_nontemporal_load((const f32x4_t*)(Y + (size_t)tok * W_ + c + 4));
        float s = ((y0.x + y0.y) + (y0.z + y0.w)) + ((y1.x + y1.y) + (y1.z + y1.w));
        s += shx(s, F.lane, 1); s += shx(s, F.lane, 2); s += shx(s, F.lane, 4);
        const float mean = s * (1.f / 64.f);
        const f32x4_t d0 = y0 - mean, d1 = y1 - mean;
        float q = ((d0.x * d0.x + d0.y * d0.y) + (d0.z * d0.z + d0.w * d0.w)) + ((d1.x * d1.x + d1.y * d1.y) + (d1.z * d1.z + d1.w * d1.w));
        q += shx(q, F.lane, 1); q += shx(q, F.lane, 2); q += shx(q, F.lane, 4);
        const float rstd = 1.0f / sqrtf(q * (1.f / 64.f) + 64e-5f);
        const float bon = BON[(size_t)tok * 8 + h];
        const u32x4_t vw = __builtin_nontemporal_load((const u32x4_t*)(VPb + (size_t)tok * W_ + c));
        const u32x4_t gw4 = __builtin_nontemporal_load((const u32x4_t*)(Gb + (size_t)tok * W_ + c));
        const f32x4_t w0 = *(const f32x4_t*)(lnw + c), w1 = *(const f32x4_t*)(lnw + c + 4), b0 = *(const f32x4_t*)(lnb + c), b1 = *(const f32x4_t*)(lnb + c + 4);
        float o[8];
#pragma unroll
        for (int e = 0; e < 8; ++e) {
            const float d = e < 4 ? d0[e] : d1[e - 4], lw = e < 4 ? w0[e] : w1[e - 4], lb = e < 4 ? b0[e] : b1[e - 4];
            const unsigned vq = vw[e >> 1], gq = gw4[e >> 1];
            const float v = (e & 1) ? __uint_as_float(vq & 0xffff0000u) : __uint_as_float(vq << 16), g = (e & 1) ? __uint_as_float(gq & 0xffff0000u) : __uint_as_float(gq << 16);
            o[e] = (d * rstd * lw + lb + bon * v) * g;
        }
        u32x4_t ow; ow.x = pk2(o[0], o[1]); ow.y = pk2(o[2], o[3]); ow.z = pk2(o[4], o[5]); ow.w = pk2(o[6], o[7]);
        *(u32x4_t*)(CC + (size_t)tok * D_ + c) = ow;
    }
}

__device__ __forceinline__ void p_route(Frame& F) {
    RELAUNDER(F);
    LAS int* lcnt = (LAS int*)F.lds;
    LAS int* gbase = lcnt + 8;
    LAS int* te = lcnt + 16;
    LAS int* tr = te + 128;
    LAS float* tg = (LAS float*)(tr + 128);
    const bf16_t* XBp = (const bf16_t*)(F.ws + WS_XB); const float* ssq = (const float*)(F.ws + WS_SSQ);
    const float* gn = gin(F.in[31]) + D_; const float* wr = gin(F.in[35]);
    int* CNT = (int*)(F.ws + WS_CTL + CTL_CNT);
    int* INV = (int*)(F.ws + WS_MT + MT_INV); float* TOKG = (float*)(F.ws + WS_MT + MT_TOKG);
    for (int chunk = F.vcu; chunk < NTOK / 64; chunk += F.G) {
        if (F.tid < 8) lcnt[F.tid] = 0;
        __syncthreads();
        for (int i = 0; i < 8; ++i) {
            const int tokl = F.wave * 8 + i, tok = chunk * 64 + tokl;
            float acc[8];
#pragma unroll
            for (int e = 0; e < 8; ++e) acc[e] = 0.f;
#pragma unroll
            for (int j = 0; j < 4; ++j) {
                const int k0 = F.lane * 4 + 256 * j;
                const u32x2_t xw = *(const u32x2_t*)(XBp + (size_t)tok * D_ + k0); const f32x4_t gv = *(const f32x4_t*)(gn + k0);
                const f32x4_t xv = {__uint_as_float(xw.x << 16), __uint_as_float(xw.x & 0xffff0000u), __uint_as_float(xw.y << 16), __uint_as_float(xw.y & 0xffff0000u)};
#pragma unroll
                for (int q = 0; q < 4; ++q) {
                    const float hv = xv[q] * gv[q];
                    const f32x4_t w0 = *(const f32x4_t*)(wr + (size_t)(k0 + q) * 8), w1 = *(const f32x4_t*)(wr + (size_t)(k0 + q) * 8 + 4);
                    acc[0] += hv * w0[0]; acc[1] += hv * w0[1]; acc[2] += hv * w0[2]; acc[3] += hv * w0[3];
                    acc[4] += hv * w1[0]; acc[5] += hv * w1[1]; acc[6] += hv * w1[2]; acc[7] += hv * w1[3];
                }
            }
            const float rinv = pg8::row_rinv(ssq, tok);
#pragma unroll
            for (int e = 0; e < 8; ++e) acc[e] = wave_sum_l(acc[e], F.lane) * rinv;
            int e0 = 0; float v0 = acc[0];
#pragma unroll
            for (int e = 1; e < 8; ++e) if (acc[e] > v0) { v0 = acc[e]; e0 = e; }
            int e1 = -1; float v1 = 0.f;
#pragma unroll
            for (int e = 0; e < 8; ++e) if (e != e0 && (e1 < 0 || acc[e] > v1)) { v1 = acc[e]; e1 = e; }
            if (F.lane == 0) {
                const float p1 = __expf(v1 - v0), inv = 1.f / (1.f + p1);
                te[tokl * 2] = e0; te[tokl * 2 + 1] = e1; tg[tokl * 2] = inv; tg[tokl * 2 + 1] = p1 * inv;
                tr[tokl * 2] = __hip_atomic_fetch_add(lcnt + e0, 1, __ATOMIC_RELAXED, __HIP_MEMORY_SCOPE_WORKGROUP);
                tr[tokl * 2 + 1] = __hip_atomic_fetch_add(lcnt + e1, 1, __ATOMIC_RELAXED, __HIP_MEMORY_SCOPE_WORKGROUP);
            }
        }
        __syncthreads();
        if (F.tid < 8) gbase[F.tid] = atomicAdd(CNT + F.tid, lcnt[F.tid]);
        __syncthreads();
        if (F.tid < 128) {
            const int e = te[F.tid], idx = gbase[e] + tr[F.tid], t2 = chunk * 128 + F.tid;
            TOKG[t2] = tg[F.tid]; INV[(size_t)e * NTOK + idx] = t2;
        }
        __syncthreads();
    }
}
__device__ __forceinline__ ConvJob conv_job_exp(const Frame& F, int j) {
    const int e = j / 3, k = j % 3; ConvJob c; c.coff = 0; c.fp8 = 1;
    if (k < 2) { c.W = (k == 0 ? gin(F.in[36]) : gin(F.in[37])) + (size_t)e * D_ * EFF; c.ldw = EFF; c.nvalid = EFF; c.npad = EFF; c.K = 1024; c.g = gin(F.in[31]) + D_; c.rowmode = 1 + k;
                 c.dst = (bf16_t*)(F.ws + WS_WE + (size_t)e * 7168 * 1024); }
    else { c.W = gin(F.in[38]) + (size_t)e * EFF * D_; c.ldw = D_; c.nvalid = D_; c.npad = D_; c.K = EFF; c.g = nullptr; c.rowmode = 0; c.dst = (bf16_t*)(F.ws + WS_WE + WE_D + (size_t)e * 1024 * EFF); }
    return c;
}
__device__ __forceinline__ void p_moe_prep(Frame& F) {
    RELAUNDER(F);
    LAS int* tb = (LAS int*)F.lds;
    LAS int* cn = tb + 16;
    const int* CNT = (const int*)(F.ws + WS_CTL + CTL_CNT);
    int* TILE = (int*)(F.ws + WS_MT + MT_TILE);
    if (F.tid == 0) { int acc = 0; for (int e = 0; e < 8; ++e) { const int c = CNT[e]; cn[e] = c; tb[e] = acc; acc += (c + 255) >> 8; } tb[8] = acc; }
    __syncthreads();
    const int MT = tb[8];
    if (F.vcu == 0) {
        if (F.tid == 0) TILE[0] = MT;
        if (F.tid < 9) TILE[16 + F.tid] = tb[F.tid];
        for (int pm = F.tid; pm < MT; pm += NWAVES * 64) { int e = 0; for (int q = 1; q < 8; ++q) if (pm >= tb[q]) e = q; TILE[64 + pm] = e; }
    }
    const int gw = F.vcu * NWAVES + F.wave, NGW = F.G * NWAVES;
    const bf16_t* XBp = (const bf16_t*)(F.ws + WS_XB); const float* ssq = (const float*)(F.ws + WS_SSQ);
    const int* INV = (const int*)(F.ws + WS_MT + MT_INV); const float* TOKG = (const float*)(F.ws + WS_MT + MT_TOKG);
    int* ROWINFO = (int*)(F.ws + WS_MT + MT_ROWINFO); float* ROWG = (float*)(F.ws + WS_MT + MT_ROWG); int* ROWOF = (int*)(F.ws + WS_MT + MT_ROWOF);
    bf16_t* XG = (bf16_t*)(F.ws + WS_XG);
    const int NR = MT * 256; constexpr int GB = 8;
    for (int row0 = gw; row0 < NR; row0 += GB * NGW) {
        int t2[GB]; bool val[GB];
#pragma unroll
        for (int r = 0; r < GB; ++r) {
            const int row = row0 + r * NGW, rc = row < NR ? row : NR - 1, pm = rc >> 8; int e = 0;
            for (int q = 1; q < 8; ++q) if (pm >= tb[q]) e = q;
            const int idx = (pm - tb[e]) * 256 + (rc & 255);
            val[r] = row < NR && idx < cn[e];
            t2[r] = INV[(size_t)e * NTOK + (val[r] ? idx : 0)];
        }
        u32x2_t xw[GB][4]; float rinv[GB], tg[GB];
#pragma unroll
        for (int r = 0; r < GB; ++r) {
            const int tt = val[r] ? t2[r] : 0, tok = tt >> 1;
            rinv[r] = pg8::row_rinv(ssq, tok) * F8S_X; tg[r] = TOKG[tt];
            const GAS u32x2_t* xr = (const GAS u32x2_t*)(XBp + (size_t)tok * D_) + F.lane;
#pragma unroll
            for (int j = 0; j < 4; ++j) xw[r][j] = xr[64 * j];
        }
#pragma unroll
        for (int r = 0; r < GB; ++r) {
            const int row = row0 + r * NGW;
            if (row < NR) {
                GAS unsigned* o4 = (GAS unsigned*)((unsigned char*)XG + (size_t)row * D_) + F.lane;
#pragma unroll
                for (int j = 0; j < 4; ++j) {
                    const float v0 = __uint_as_float(xw[r][j].x << 16) * rinv[r], v1 = __uint_as_float(xw[r][j].x & 0xffff0000u) * rinv[r], v2 = __uint_as_float(xw[r][j].y << 16) * rinv[r], v3 = __uint_as_float(xw[r][j].y & 0xffff0000u) * rinv[r];
                    o4[64 * j] = val[r] ? pk4_fp8(v0, v1, v2, v3) : 0u; }
                if (F.lane == 0) { ROWINFO[row] = val[r] ? t2[r] : -1; ROWG[row] = val[r] ? tg[r] : 0.f; if (val[r]) ROWOF[t2[r]] = row; }
            }
        }
    }
}
__device__ __forceinline__ void p_moe_conv(Frame& F) {
    RELAUNDER(F);
    const int gw = F.vcu * NWAVES + F.wave, NGW = F.G * NWAVES;
    LAS float* scr = (LAS float*)(F.lds + RING_OFF + 1024 + F.wave * 16384);
    constexpr int IPJ = 1792, TOT = 24 * IPJ;
    static_assert((1024 / 64) * (EFF / 32) == IPJ && (EFF / 64) * (1024 / 32) == IPJ, "items per expert matrix");
#define EXP_LOAD(R, gi) do { const int j_ = (gi) / IPJ; const ConvJob c_ = conv_job_exp(F, j_); conv_load(R, c_.W, c_.ldw, 0, c_.nvalid, c_.g, c_.npad / 32, (gi) - j_ * IPJ, F.lane); } while (0)
#define EXP_STORE(R, gi) do { const int j_ = (gi) / IPJ; const ConvJob c_ = conv_job_exp(F, j_); conv_store<true>(R, c_.dst, c_.K, c_.npad / 32, c_.rowmode, scr, (gi) - j_ * IPJ, F.lane); } while (0)
    {
        ConvRegs A, B;
        if (gw < TOT) EXP_LOAD(A, gw);
        if (gw + NGW < TOT) EXP_LOAD(B, gw + NGW);
#pragma nounroll
        for (int gi = gw; gi < TOT; gi += 2 * NGW) {
            { ConvRegs C = A; if (gi + 2 * NGW < TOT) EXP_LOAD(A, gi + 2 * NGW); EXP_STORE(C, gi); }
            if (gi + NGW < TOT) { ConvRegs C = B; if (gi + 3 * NGW < TOT) EXP_LOAD(B, gi + 3 * NGW); EXP_STORE(C, gi + NGW); }
        }
    }
#undef EXP_LOAD
#undef EXP_STORE
}
__device__ __forceinline__ void p_moe_gemm1(Frame& F) {
    RELAUNDER(F);
    const int* TILE = (const int*)(F.ws + WS_MT + MT_TILE);
    int nMp = __builtin_amdgcn_readfirstlane(TILE[0]); nMp = nMp < 0 ? 0 : (nMp > 136 ? 136 : nMp);
    pg8::Gemm g{(const bf16_t*)(F.ws + WS_XG), (const bf16_t*)(F.ws + WS_WE), nMp * 256, 7168, 512, (size_t)7168 * 1024};
    pg8::MoeOrder S; S.init(nMp, 28, F.G, (int)blockIdx.x, 0, TILE + 64);
    pg8::EpiSwiGLU8 E{(unsigned char*)(F.ws + WS_ACTM), EFF, F8S_ACT};
    pg8::gemm_phase<pg8::EpiSwiGLU8, pg8::MoeOrder, true, true, true>(F.lds + RING_OFF, g, S, E, F.tid, F8C_X, F8C_W);
}
__device__ __forceinline__ void p_moe_gemm2(Frame& F) {
    RELAUNDER(F);
    const int* TILE = (const int*)(F.ws + WS_MT + MT_TILE);
    const int MT = __builtin_amdgcn_readfirstlane(TILE[0]); int nMp = MT < 0 ? 0 : (MT > 2 * MOE_PASS_TILES ? 2 * MOE_PASS_TILES : MT);
    pg8::Gemm g{(const bf16_t*)(F.ws + WS_ACTM), (const bf16_t*)(F.ws + WS_WE + WE_D), nMp * 256, 1024, EFF / 2, (size_t)1024 * EFF};
    pg8::MoeOrder S; S.init(nMp, 4, F.G, (int)blockIdx.x, 0, TILE + 64);
    pg8::EpiMoeDown E{(bf16_t*)F.out, (const int*)(F.ws + WS_MT + MT_ROWINFO), (const float*)(F.ws + WS_MT + MT_ROWG)};
    pg8::gemm_phase<pg8::EpiMoeDown, pg8::MoeOrder, true, true, true>(F.lds + RING_OFF, g, S, E, F.tid, F8C_ACT, F8C_W);
}
__device__ __forceinline__ void p_moe_gemm2_split(Frame& F) {
    RELAUNDER(F);
    const int* TILE = (const int*)(F.ws + WS_MT + MT_TILE);
    const int MT = __builtin_amdgcn_readfirstlane(TILE[0]), pm_lo = 2 * MOE_PASS_TILES; int nMp = MT - pm_lo; nMp = nMp < 0 ? 0 : (nMp > 8 ? 8 : nMp);
    pg8::Gemm g{(const bf16_t*)(F.ws + WS_ACTM + (size_t)pm_lo * 256 * EFF), (const bf16_t*)(F.ws + WS_WE + WE_D), nMp * 256, 1024, EFF / 2, (size_t)1024 * EFF};
    pg8::MoeSplitOrder S; S.init(nMp, F.G, (int)blockIdx.x, pm_lo, TILE + 64, MOE_NS, MOE_KS / 2);
    pg8::EpiSplitF32 E{(float*)(F.ws + WS_XG), (const int*)(F.ws + WS_MT + MT_ROWINFO) + pm_lo * 256, nMp * 256};
    pg8::gemm_phase<pg8::EpiSplitF32, pg8::MoeSplitOrder, true, true, true>(F.lds + RING_OFF, g, S, E, F.tid, F8C_ACT, F8C_W);
}
__device__ __forceinline__ void p_final(Frame& F, bool moe) {
    RELAUNDER(F);
    const int gw = F.vcu * NWAVES + F.wave, NGW = F.G * NWAVES;
    const bf16_t* XBp = (const bf16_t*)(F.ws + WS_XB); const float* gn = gin(F.in[39]);
    const float dscale = 1.0f + *(const float*)(F.ws + WS_CTL + 640 * 1024);
    const int* ROWOF = (const int*)(F.ws + WS_MT + MT_ROWOF); const float* ROWG = (const float*)(F.ws + WS_MT + MT_ROWG); const float* PART = (const float*)(F.ws + WS_XG);
    int nr2 = __builtin_amdgcn_readfirstlane(*(const int*)(F.ws + WS_MT + MT_TILE)) - 2 * MOE_PASS_TILES; nr2 = (nr2 < 0 ? 0 : (nr2 > 8 ? 8 : nr2)) * 256;
    for (int tok = gw; tok < NTOK; tok += NGW) {
        f32x4_t s[4]; float q = 0.f;
        int rs[2] = {0, 0}; float gs[2] = {0.f, 0.f};
        if (moe) {
#pragma unroll
            for (int k = 0; k < 2; ++k) { rs[k] = __builtin_amdgcn_readfirstlane(ROWOF[tok * 2 + k]) - 2 * MOE_PASS_TILES * 256; if (rs[k] >= 0) gs[k] = ROWG[rs[k] + 2 * MOE_PASS_TILES * 256]; }
        }
        u32x2_t xw[4];
#pragma unroll
        for (int j = 0; j < 4; ++j) xw[j] = __builtin_nontemporal_load((const u32x2_t*)(XBp + (size_t)tok * D_ + F.lane * 4 + 256 * j));
        if (!moe || (rs[0] & rs[1]) < 0) {
            u32x2_t ya[4], yb[4];
            if (moe) {
#pragma unroll
                for (int j = 0; j < 4; ++j) { const int col = F.lane * 4 + 256 * j; ya[j] = __builtin_nontemporal_load((const u32x2_t*)((const bf16_t*)F.out + (size_t)tok * 2048 + col)); yb[j] = __builtin_nontemporal_load((const u32x2_t*)((const bf16_t*)F.out + (size_t)tok * 2048 + 1024 + col)); }
            }
#pragma unroll
            for (int j = 0; j < 4; ++j) {
                f32x4_t v = {__uint_as_float(xw[j].x << 16), __uint_as_float(xw[j].x & 0xffff0000u), __uint_as_float(xw[j].y << 16), __uint_as_float(xw[j].y & 0xffff0000u)};
                if (moe) {
                    v.x += __uint_as_float(ya[j].x << 16) + __uint_as_float(yb[j].x << 16); v.y += __uint_as_float(ya[j].x & 0xffff0000u) + __uint_as_float(yb[j].x & 0xffff0000u);
                    v.z += __uint_as_float(ya[j].y << 16) + __uint_as_float(yb[j].y << 16); v.w += __uint_as_float(ya[j].y & 0xffff0000u) + __uint_as_float(yb[j].y & 0xffff0000u);
                }
                s[j] = v; q += (v.x * v.x + v.y * v.y) + (v.z * v.z + v.w * v.w);
            }
        } else {
#pragma unroll
            for (int j = 0; j < 4; ++j) {
                const int col = F.lane * 4 + 256 * j;
                f32x4_t v = {__uint_as_float(xw[j].x << 16), __uint_as_float(xw[j].x & 0xffff0000u), __uint_as_float(xw[j].y << 16), __uint_as_float(xw[j].y & 0xffff0000u)};
#pragma unroll
                for (int k = 0; k < 2; ++k) {
                    if (rs[k] < 0) {
                        const u32x2_t a = *(const u32x2_t*)((const bf16_t*)F.out + (size_t)tok * 2048 + k * 1024 + col);
                        v.x += __uint_as_float(a.x << 16); v.y += __uint_as_float(a.x & 0xffff0000u); v.z += __uint_as_float(a.y << 16); v.w += __uint_as_float(a.y & 0xffff0000u);
                    } else {
                        f32x4_t p = *(const f32x4_t*)(PART + (size_t)rs[k] * 1024 + col);
#pragma unroll
                        for (int sl = 1; sl < MOE_NS; ++sl) p += *(const f32x4_t*)(PART + ((size_t)sl * nr2 + rs[k]) * 1024 + col);
                        v += p * gs[k];
                    }
                }
                s[j] = v; q += (v.x * v.x + v.y * v.y) + (v.z * v.z + v.w * v.w);
            }
        }
        q = wave_sum_l(q, F.lane);
        const float rinv = 1.0f / sqrtf(q * (1.0f / 1024.0f) + 1e-6f);
#pragma unroll
        for (int j = 0; j < 4; ++j) {
            const int col = F.lane * 4 + 256 * j;
            const f32x4_t gv = *(const f32x4_t*)(gn + col);
            __builtin_nontemporal_store(s[j] * rinv * gv * dscale, (f32x4_t*)(F.out + (size_t)tok * D_ + col));
        }
    }
}


constexpr size_t S_KCB = S_BON + 512 * 1024;
constexpr size_t S_VCB = S_KCB + 256 * 1024;
static_assert(S_VCB + 256 * 1024 <= S_END, "scratch map");
namespace nsa {
typedef short bf16x8 __attribute__((ext_vector_type(8)));
typedef short s16x4 __attribute__((ext_vector_type(4)));
typedef float f32x16 __attribute__((ext_vector_type(16)));
typedef float f32x4 __attribute__((ext_vector_type(4)));
constexpr float LOG2E = 1.4426950408889634f;
__device__ __forceinline__ int crow(int r, int hi) { return (r & 3) + 8 * (r >> 2) + 4 * hi; }
typedef float f32x2_t __attribute__((ext_vector_type(2))); typedef __bf16 bf16x2_t __attribute__((ext_vector_type(2)));
__device__ __forceinline__ unsigned cvtpk(float lo, float hi) { f32x2_t v = {lo, hi}; bf16x2_t b = __builtin_convertvector(v, bf16x2_t); return __builtin_bit_cast(unsigned, b); }
constexpr int L_KB = 0, L_VB = 16384, L_WSF = 32768, L_IMPQ = 36864, L_IMPL = L_IMPQ + 4 * 64 * 33 * 4, L_IMPF = L_IMPL + 4 * 64 * 33 * 4, L_SELM = L_IMPF + 64 * 36 * 4, L_MISC = L_SELM + 256, L_LIST = L_MISC + 16, L_END = L_LIST + 64 * 4;
static_assert(L_END <= 131072, "NSA LDS map");

__device__ __forceinline__ void qkt(f32x16& p0, f32x16& p1, const LAS unsigned char* Kslot, const bf16x8* qr, int r32, int hi) {
    const LAS unsigned char* kb = Kslot + hi * 1024 + r32 * 16;
    p0 = (f32x16){}; p1 = (f32x16){};
#pragma unroll
    for (int d0 = 0; d0 < 4; ++d0) {
        const bf16x8 b0 = *(const LAS bf16x8*)(kb + d0 * 2048);
        const bf16x8 b1 = *(const LAS bf16x8*)(kb + d0 * 2048 + 512);
        p0 = __builtin_amdgcn_mfma_f32_32x32x16_bf16(b0, qr[d0], p0, 0, 0, 0);
        p1 = __builtin_amdgcn_mfma_f32_32x32x16_bf16(b1, qr[d0], p1, 0, 0, 0);
    }
}
__device__ __forceinline__ void qkt_a(f32x16& p0, f32x16& p1, const LAS unsigned char* Kslot, const bf16x8* qr, int r32, int hi, const bf16x8& ka0, const bf16x8& ka1, const bf16x8& qa) {
    const LAS unsigned char* kb = Kslot + hi * 1024 + r32 * 16;
    p0 = __builtin_amdgcn_mfma_f32_32x32x16_bf16(ka0, qa, (f32x16){}, 0, 0, 0);
    p1 = __builtin_amdgcn_mfma_f32_32x32x16_bf16(ka1, qa, (f32x16){}, 0, 0, 0);
#pragma unroll
    for (int d0 = 0; d0 < 4; ++d0) {
        const bf16x8 b0 = *(const LAS bf16x8*)(kb + d0 * 2048);
        const bf16x8 b1 = *(const LAS bf16x8*)(kb + d0 * 2048 + 512);
        p0 = __builtin_amdgcn_mfma_f32_32x32x16_bf16(b0, qr[d0], p0, 0, 0, 0);
        p1 = __builtin_amdgcn_mfma_f32_32x32x16_bf16(b1, qr[d0], p1, 0, 0, 0);
    }
}
__device__ __forceinline__ void qkt_c(f32x16& p0, f32x16& p1, const LAS unsigned char* Kslot, const bf16x8* qr, int r32, int hi, const f32x16& c0, const f32x16& c1) {
    const LAS unsigned char* kb = Kslot + hi * 1024 + r32 * 16;
    {
        const bf16x8 b0 = *(const LAS bf16x8*)(kb), b1 = *(const LAS bf16x8*)(kb + 512);
        p0 = __builtin_amdgcn_mfma_f32_32x32x16_bf16(b0, qr[0], c0, 0, 0, 0);
        p1 = __builtin_amdgcn_mfma_f32_32x32x16_bf16(b1, qr[0], c1, 0, 0, 0);
    }
#pragma unroll
    for (int d0 = 1; d0 < 4; ++d0) {
        const bf16x8 b0 = *(const LAS bf16x8*)(kb + d0 * 2048);
        const bf16x8 b1 = *(const LAS bf16x8*)(kb + d0 * 2048 + 512);
        p0 = __builtin_amdgcn_mfma_f32_32x32x16_bf16(b0, qr[d0], p0, 0, 0, 0);
        p1 = __builtin_amdgcn_mfma_f32_32x32x16_bf16(b1, qr[d0], p1, 0, 0, 0);
    }
}
__device__ __forceinline__ float max3f(float a, float b, float c) { float r; asm("v_max3_f32 %0, %1, %2, %3" : "=v"(r) : "v"(a), "v"(b), "v"(c)); return r; }
__device__ __forceinline__ void pv(f32x16* o, int vb, bf16x8 pa0, bf16x8 pa1, bf16x8 pa2, bf16x8 pa3) {
#pragma unroll
    for (int d0 = 0; d0 < 2; ++d0) {
        s16x4 lo[4], hi[4];
#pragma unroll
        for (int ks = 0; ks < 4; ++ks) {
            asm volatile("ds_read_b64_tr_b16 %0,%1 offset:%c2" : "=&v"(lo[ks]) : "v"(vb), "i"(d0 * 4096 + ks * 1024) : "memory");
            asm volatile("ds_read_b64_tr_b16 %0,%1 offset:%c2" : "=&v"(hi[ks]) : "v"(vb), "i"(d0 * 4096 + ks * 1024 + 512) : "memory");
        }
        asm volatile("s_waitcnt lgkmcnt(0)" ::: "memory"); __builtin_amdgcn_sched_barrier(0);
#define NSA_PK(k) (bf16x8){lo[k][0], lo[k][1], lo[k][2], lo[k][3], hi[k][0], hi[k][1], hi[k][2], hi[k][3]}
        o[d0] = __builtin_amdgcn_mfma_f32_32x32x16_bf16(pa0, NSA_PK(0), o[d0], 0, 0, 0);
        o[d0] = __builtin_amdgcn_mfma_f32_32x32x16_bf16(pa1, NSA_PK(1), o[d0], 0, 0, 0);
        o[d0] = __builtin_amdgcn_mfma_f32_32x32x16_bf16(pa2, NSA_PK(2), o[d0], 0, 0, 0);
        o[d0] = __builtin_amdgcn_mfma_f32_32x32x16_bf16(pa3, NSA_PK(3), o[d0], 0, 0, 0);
#undef NSA_PK
    }
}
__device__ __forceinline__ float swap_max(float m) { auto rr = __builtin_amdgcn_permlane32_swap(__float_as_uint(m), __float_as_uint(m), false, false); return fmaxf(__uint_as_float(rr[0]), __uint_as_float(rr[1])); }
__device__ __forceinline__ float swap_sum(float m) { auto rr = __builtin_amdgcn_permlane32_swap(__float_as_uint(m), __float_as_uint(m), false, false); return __uint_as_float(rr[0]) + __uint_as_float(rr[1]); }
__device__ __forceinline__ void pack_p(const f32x16& p0, const f32x16& p1, bf16x8& a0, bf16x8& a1, bf16x8& a2, bf16x8& a3) {
    u32x4_t w0, w1, w2, w3;
    w0.x = cvtpk(p0[0], p0[1]); w0.y = cvtpk(p0[2], p0[3]); w0.z = cvtpk(p0[4], p0[5]); w0.w = cvtpk(p0[6], p0[7]);
    w1.x = cvtpk(p0[8], p0[9]); w1.y = cvtpk(p0[10], p0[11]); w1.z = cvtpk(p0[12], p0[13]); w1.w = cvtpk(p0[14], p0[15]);
    w2.x = cvtpk(p1[0], p1[1]); w2.y = cvtpk(p1[2], p1[3]); w2.z = cvtpk(p1[4], p1[5]); w2.w = cvtpk(p1[6], p1[7]);
    w3.x = cvtpk(p1[8], p1[9]); w3.y = cvtpk(p1[10], p1[11]); w3.z = cvtpk(p1[12], p1[13]); w3.w = cvtpk(p1[14], p1[15]);
    a0 = __builtin_bit_cast(bf16x8, w0); a1 = __builtin_bit_cast(bf16x8, w1); a2 = __builtin_bit_cast(bf16x8, w2); a3 = __builtin_bit_cast(bf16x8, w3);
}
__device__ __forceinline__ void scale_o(f32x16* o, float fac, LAS float* wsf, int r32, int hi) {
    if (hi == 0) wsf[r32] = fac;
    asm volatile("s_waitcnt lgkmcnt(0)" ::: "memory");
#pragma unroll
    for (int r = 0; r < 16; ++r) { const float f = wsf[crow(r, hi)]; o[0][r] *= f; o[1][r] *= f; }
}
__device__ __forceinline__ void psum(f32x16& ol, bf16x8 pa0, bf16x8 pa1, bf16x8 pa2, bf16x8 pa3) {
    const bf16x8 one = {(short)0x3f80, (short)0x3f80, (short)0x3f80, (short)0x3f80, (short)0x3f80, (short)0x3f80, (short)0x3f80, (short)0x3f80};
    ol = __builtin_amdgcn_mfma_f32_32x32x16_bf16(pa0, one, ol, 0, 0, 0);
    ol = __builtin_amdgcn_mfma_f32_32x32x16_bf16(pa1, one, ol, 0, 0, 0);
    ol = __builtin_amdgcn_mfma_f32_32x32x16_bf16(pa2, one, ol, 0, 0, 0);
    ol = __builtin_amdgcn_mfma_f32_32x32x16_bf16(pa3, one, ol, 0, 0, 0);
}
__device__ __forceinline__ void scale_ol(f32x16* o, f32x16& ol, float fac, LAS float* wsf, int r32, int hi) {
    if (hi == 0) wsf[r32] = fac;
    asm volatile("s_waitcnt lgkmcnt(0)" ::: "memory");
#pragma unroll
    for (int r = 0; r < 16; ++r) { const float f = wsf[crow(r, hi)]; o[0][r] *= f; o[1][r] *= f; ol[r] *= f; }
}
__device__ __forceinline__ void axpy_ol(f32x16* out, const f32x16* o, const f32x16& ol, float gate, LAS float* wsf, int r32, int hi) {
    if (hi == 0) wsf[32 + r32] = gate;
    asm volatile("s_waitcnt lgkmcnt(0)" ::: "memory");
#pragma unroll
    for (int r = 0; r < 16; ++r) { const float f = wsf[32 + crow(r, hi)] * __builtin_amdgcn_rcpf(fmaxf(ol[r], 1e-30f)); out[0][r] += f * o[0][r]; out[1][r] += f * o[1][r]; }
}
__device__ __forceinline__ void axpy_o(f32x16* out, const f32x16* o, float fac, LAS float* wsf, int r32, int hi) {
    if (hi == 0) wsf[32 + r32] = fac;
    asm volatile("s_waitcnt lgkmcnt(0)" ::: "memory");
#pragma unroll
    for (int r = 0; r < 16; ++r) { const float f = wsf[32 + crow(r, hi)]; out[0][r] += f * o[0][r]; out[1][r] += f * o[1][r]; }
}
}

__device__ __forceinline__ void p_nsa_cmp(Frame& F, int l, int first, int cnt) {
    RELAUNDER(F);
    const int n_rw = 1792;
    const bf16_t* P = (const bf16_t*)(F.ws + WS_S + S_PROJ);
    LAS bf16_t* Hs = (LAS bf16_t*)F.lds;
    const int w = F.wave, fr = F.lane & 15, fq = F.lane >> 4;
    for (int item = first; item < first + cnt; ++item) {
        const int kv = item >> 7, b = (item >> 4) & 7, g = (item >> 3) & 1, ch = item & 7;
        const int colbase = n_rw + 512 + kv * 128 + g * 64;
        const bf16_t* W1T = (const bf16_t*)(F.ws + WS_WB + WB_CW1) + (size_t)(l * 2 + kv) * 128 * 2048;
        const bf16_t* W2T = (const bf16_t*)(F.ws + WS_WB + WB_CW2) + (size_t)(l * 2 + kv) * 64 * 128;
        const float* cb = (const float*)(F.ws + WS_WB + WB_CB) + (l * 2 + kv) * 128;
        constexpr int APITCH = 4112;
        LAS unsigned char* As = F.lds + 8192;
        __syncthreads();
#pragma unroll
        for (int pc = 0; pc < 8; ++pc) {
            const int row = 2 * w + (pc >> 2), q = pc & 3, n_ = ch * 16 + row, nc_ = n_ < NCMP ? n_ : NCMP - 1;
            const bf16_t* src = P + ((size_t)b * T_ + 16 * nc_ + q * 8 + (F.lane >> 3)) * NPJ + colbase + (F.lane & 7) * 8;
            __builtin_amdgcn_global_load_lds((const unsigned*)(const GAS unsigned*)(uintptr_t)src, (LAS unsigned*)(As + row * APITCH + q * 1024), 16, 0, 0);
        }
        const bf16_t* brow = W1T + (size_t)(16 * w + fr) * 2048;
        pg8::f32x4 acc = {0.f, 0.f, 0.f, 0.f};
        asm volatile("s_waitcnt vmcnt(0)" ::: "memory");
        __syncthreads();
#pragma unroll 16
        for (int ks = 0; ks < 64; ++ks) {
            const int k0 = ks * 32 + fq * 8;
            const nsa::bf16x8 a = *(const LAS nsa::bf16x8*)(As + fr * APITCH + k0 * 2);
            const nsa::bf16x8 bw = *(const nsa::bf16x8*)(brow + k0);
            acc = __builtin_amdgcn_mfma_f32_16x16x32_bf16(a, bw, acc, 0, 0, 0);
        }
        __syncthreads();
        const float bias = cb[16 * w + fr];
#pragma unroll
        for (int r = 0; r < 4; ++r) {
            const float x = acc[r] + bias;
            const float ge = x * fsigmoid(1.5957691216057308f * (x + 0.044715f * x * x * x));
            Hs[(4 * fq + r) * 136 + 16 * w + fr] = (bf16_t)f2bf(ge);
        }
        __syncthreads();
        if (w < 4) {
            pg8::f32x4 acc2 = {0.f, 0.f, 0.f, 0.f};
#pragma unroll
            for (int ks = 0; ks < 4; ++ks) {
                const nsa::bf16x8 a = *(const LAS nsa::bf16x8*)(Hs + fr * 136 + ks * 32 + fq * 8);
                const nsa::bf16x8 bw = *(const nsa::bf16x8*)(W2T + (size_t)(16 * w + fr) * 128 + ks * 32 + fq * 8);
                acc2 = __builtin_amdgcn_mfma_f32_16x16x32_bf16(a, bw, acc2, 0, 0, 0);
            }
            bf16_t* dst = (bf16_t*)(F.ws + WS_S + (kv == 0 ? S_KCB : S_VCB)) + ((size_t)(b * 2 + g) * 128) * 64;
#pragma unroll
            for (int r = 0; r < 4; ++r) { const int nn = ch * 16 + 4 * fq + r; dst[(size_t)nn * 64 + 16 * w + fr] = (bf16_t)f2bf(nn < NCMP ? acc2[r] : 0.f); }
        }
    }
}

template <int DBG = 0> __device__ __forceinline__ void nsa_item(Frame& F, const bf16_t* P, int n_rw, int b, int g, int c) {
    using namespace nsa;
    int tidl = F.tid; asm volatile("" : "+v"(tidl));
    const int lanel = tidl & 63;
    const int w = __builtin_amdgcn_readfirstlane(tidl >> 6), rh = w >> 1, th = w & 1, r32 = lanel & 31, hi = lanel >> 5;
    const int t0 = c * 64, tq = t0 + th * 32 + r32;
    const int hq = g * 4 + rh;
    const float slope2 = exp2f(-(float)(hq + 1)) * LOG2E;
    const size_t tokrow = (size_t)b * T_ + tq;
    LAS unsigned char* L = F.lds;
    LAS float* wsf = (LAS float*)(L + L_WSF) + w * 64;
    LAS float* IMPQ = (LAS float*)(L + L_IMPQ); LAS float* IMPL = (LAS float*)(L + L_IMPL); LAS float* IMPF = (LAS float*)(L + L_IMPF);
    LAS unsigned* SELM = (LAS unsigned*)(L + L_SELM); LAS int* MISCL = (LAS int*)(L + L_MISC); LAS int* LIST = (LAS int*)(L + L_LIST);
    const unsigned lds0 = (unsigned)(uintptr_t)L;
    const int vboff = ((lanel >> 4) & 1) * 32 + (lanel & 3) * 8 + (4 * hi + ((lanel & 15) >> 2)) * 64;
    bf16x8 qr[4];
    {
        const bf16_t* qp = P + tokrow * NPJ + n_rw + g * 256 + rh * 64 + hi * 8;
#pragma unroll
        for (int d0 = 0; d0 < 4; ++d0) {
            const u32x4_t raw = *(const u32x4_t*)(qp + d0 * 16); u32x4_t sc;
#pragma unroll
            for (int e = 0; e < 4; ++e) sc[e] = cvtpk(__uint_as_float(raw[e] << 16) * (0.125f * LOG2E), __uint_as_float(raw[e] & 0xffff0000u) * (0.125f * LOG2E));
            qr[d0] = __builtin_bit_cast(bf16x8, sc);
        }
    }
    const bf16_t* gp = (const bf16_t*)(F.ws + WS_S + S_EX) + tokrow * 64 + hq * 3;
    const float gate0 = fsigmoid(bf2f(gp[0])), gate1 = fsigmoid(bf2f(gp[1])), gate2 = fsigmoid(bf2f(gp[2]));
    f32x16 out[2]; out[0] = (f32x16){}; out[1] = (f32x16){};
    const int lk_key = tidl & 63, lk_c8 = tidl >> 6, lv_key = tidl >> 3, lv_p = tidl & 7;
    const int lk_dst = lk_c8 * 1024 + lk_key * 16, lv_dst = (lv_p >> 2) * 4096 + lv_key * 64 + (lv_p & 3) * 16;
    const int lv_src = (lv_p >> 2) * 32 + (lv_p & 3) * 8;
    __syncthreads();
    {
        const bf16_t* KCB = (const bf16_t*)(F.ws + WS_S + S_KCB) + ((size_t)(b * 2 + g) * 128) * 64;
        const bf16_t* VCB = (const bf16_t*)(F.ws + WS_S + S_VCB) + ((size_t)(b * 2 + g) * 128) * 64;
#pragma unroll
        for (int jt = 0; jt < 2; ++jt) {
            *(LAS u32x4_t*)(L + L_KB + jt * 8192 + lk_dst) = *(const u32x4_t*)(KCB + (size_t)(jt * 64 + lk_key) * 64 + lk_c8 * 8);
            *(LAS u32x4_t*)(L + L_VB + jt * 8192 + lv_dst) = *(const u32x4_t*)(VCB + (size_t)(jt * 64 + lv_key) * 64 + lv_src);
        }
        __syncthreads();
        f32x16 s0a, s0b, s1a, s1b;
        qkt(s0a, s0b, L + L_KB, qr, r32, hi);
        qkt(s1a, s1b, L + L_KB + 8192, qr, r32, hi);
        float m = -INFINITY;
#pragma unroll
        for (int r = 0; r < 16; ++r) {
            const int key = crow(r, hi);
#define CMP_MASK(S, nn) { const int n_ = (nn); const int dist_ = tq - (16 * n_ + 31); const bool ok_ = (n_ < NCMP) && (dist_ >= 0); S[r] = ok_ ? S[r] - slope2 * (float)dist_ : -INFINITY; m = fmaxf(m, S[r]); }
            CMP_MASK(s0a, key) CMP_MASK(s0b, key + 32) CMP_MASK(s1a, 64 + key) CMP_MASK(s1b, 96 + key)
#undef CMP_MASK
        }
        m = swap_max(m);
        if (m == -INFINITY) m = 0.f;
        float lsum = 0.f;
#pragma unroll
        for (int r = 0; r < 16; ++r) { s0a[r] = __builtin_amdgcn_exp2f(s0a[r] - m); s0b[r] = __builtin_amdgcn_exp2f(s0b[r] - m); s1a[r] = __builtin_amdgcn_exp2f(s1a[r] - m); s1b[r] = __builtin_amdgcn_exp2f(s1b[r] - m); lsum += (s0a[r] + s0b[r]) + (s1a[r] + s1b[r]); }
        lsum = swap_sum(lsum);
        const float inv = lsum > 0.f ? 1.0f / lsum : 0.f;
#pragma unroll
        for (int r = 0; r < 16; ++r) { s0a[r] *= inv; s0b[r] *= inv; s1a[r] *= inv; s1b[r] *= inv; }
        {
            LAS float* iq = IMPQ + (rh * 64 + th * 32 + r32) * 33; LAS float* il = IMPL + (rh * 64 + th * 32 + r32) * 33;
#pragma unroll
            for (int rq = 0; rq < 4; ++rq) {
#define IMP_Q(S, Qb) { const int Q_ = (Qb) + 2 * rq + hi; iq[Q_] = (S[4 * rq] + S[4 * rq + 1]) + (S[4 * rq + 2] + S[4 * rq + 3]); il[Q_] = S[4 * rq + 3]; }
                IMP_Q(s0a, 0) IMP_Q(s0b, 8) IMP_Q(s1a, 16) IMP_Q(s1b, 24)
#undef IMP_Q
            }
        }
        bf16x8 a0, a1, a2, a3;
        pack_p(s0a, s0b, a0, a1, a2, a3); pv(out, (int)(lds0 + L_VB) + vboff, a0, a1, a2, a3);
        pack_p(s1a, s1b, a0, a1, a2, a3); pv(out, (int)(lds0 + L_VB + 8192) + vboff, a0, a1, a2, a3);
        scale_o(out, gate0, wsf, r32, hi);
    }
    __syncthreads();
    for (int idx = tidl; idx < 64 * 32; idx += NWAVES * 64) {
        const int tokl = idx >> 5, j = idx & 31; float s = 0.f;
#pragma unroll
        for (int h4 = 0; h4 < 4; ++h4) { s += IMPQ[(h4 * 64 + tokl) * 33 + j]; if (j > 0) s += IMPL[(h4 * 64 + tokl) * 33 + j - 1]; }
        IMPF[tokl * 36 + j] = s;
    }
    __syncthreads();
#pragma unroll 1
    for (int pass = 0; pass < 4; ++pass) {
        const int tokl = pass * 16 + (tidl >> 5), j = tidl & 31;
        bool sel;
        if (c < 16) sel = (j <= c);
        else {
            const LAS f32x4_t* row = (const LAS f32x4_t*)(IMPF + tokl * 36);
            f32x4_t vq[8];
#pragma unroll
            for (int q4 = 0; q4 < 8; ++q4) vq[q4] = row[q4];
            const float mine = IMPF[tokl * 36 + j]; int rank = 0;
#pragma unroll
            for (int jj = 1; jj < 30; ++jj) { const float o2 = vq[jj >> 2][jj & 3]; rank += (jj <= c - 2 && (o2 > mine || (o2 == mine && jj < j))) ? 1 : 0; }
            sel = (j == 0) || (j == c) || (j == c - 1) || (j >= 1 && j <= c - 2 && rank < 13);
        }
        const unsigned long long bal = __ballot(sel);
        if ((lanel & 31) == 0) SELM[tokl] = (lanel == 0) ? (unsigned)(bal & 0xffffffffull) : (unsigned)(bal >> 32);
    }
    __syncthreads();
    if (tidl < 64) {
        unsigned um = SELM[tidl];
#pragma unroll
        for (int o = 1; o < 64; o <<= 1) um |= (unsigned)__builtin_amdgcn_ds_bpermute((lanel ^ o) << 2, (int)um);
        const int j = lanel & 31, jlo = c - 8 > 0 ? c - 8 : 0;
        const bool on = (lanel < 32) ? (j >= jlo && j <= c) : (((um >> j) & 1u) != 0u && j <= c);
        const unsigned long long bal = __ballot(on);
        const unsigned lo32 = (unsigned)(bal & 0xffffffffull), hi32 = (unsigned)(bal >> 32);
        const unsigned above = (j == 31) ? 0u : (0xffffffffu << (j + 1));
        const int pos = (lanel < 32) ? __popc(lo32 & above) : (__popc(lo32) + __popc(hi32 & above));
        if (on) LIST[pos] = ((lanel < 32) ? 256 : 0) | j;
        if (lanel == 0) MISCL[0] = __popc(lo32) + __popc(hi32);
    }
    __syncthreads();
    const int ntl = DBG == 1 ? 1 : MISCL[0];
    const unsigned selq = SELM[th * 32 + r32];
    {
        const bf16_t* Pb = P + (size_t)b * T_ * NPJ;
        constexpr int NSR = 6, GRP = 3, RK = L_IMPQ;
        static_assert(RK == 2 * 16384 + 4096 && RK + (NSR - 2) * 16384 <= L_SELM && L_WSF == 32768, "ring stages: s * 16384 (+ 4096 past the per-wave scratch)");
#define STG_OFF(s_) ((s_) * 16384 + ((s_) >= 2 ? 4096 : 0))
        const int dv_key = (tidl >> 2) & 63, dv_src = (tidl >> 8) * 32 + (tidl & 3) * 8;
#define TILE_DMA(t_) do { const int ent_ = LIST[t_]; const int ty_ = ent_ >> 8, j_ = ent_ & 255; const int kc_ = n_rw + 512 + (ty_ ? 4 : 2) * 128 + g * 64; const int st_ = (t_) % NSR; \
        __builtin_amdgcn_global_load_lds((const unsigned*)(const GAS unsigned*)(uintptr_t)(Pb + (size_t)(j_ * 64 + lk_key) * NPJ + kc_ + lk_c8 * 8), (LAS unsigned*)(L + STG_OFF(st_) + w * 1024), 16, 0, 0); \
        __builtin_amdgcn_global_load_lds((const unsigned*)(const GAS unsigned*)(uintptr_t)(Pb + (size_t)(j_ * 64 + dv_key) * NPJ + kc_ + 128 + dv_src), (LAS unsigned*)(L + STG_OFF(st_) + 8192 + w * 1024), 16, 0, 0); } while (0)
#define TILE_WAIT(c_) do { if ((c_) >= 2) asm volatile("s_waitcnt vmcnt(4)" ::: "memory"); else if ((c_) == 1) asm volatile("s_waitcnt vmcnt(2)" ::: "memory"); else asm volatile("s_waitcnt vmcnt(0)" ::: "memory"); } while (0)
        asm volatile("s_waitcnt vmcnt(0)" ::: "memory");
        TILE_DMA(0);
        if (ntl > 1) TILE_DMA(1);
        if (ntl > 2) TILE_DMA(2);
        asm volatile("s_waitcnt vmcnt(0)" ::: "memory");
        __syncthreads();
        float m = -1e30f; f32x16 o[2], ol; o[0] = (f32x16){}; o[1] = (f32x16){}; ol = (f32x16){};
        int curty = 1;
        bf16x8 ka0 = {0, 0, 0, 0, 0, 0, 0, 0}, ka1 = ka0, qa = ka0;
        if (hi == 0) {
            const float b0_ = slope2 * (float)r32, b1_ = slope2 * (float)(r32 + 32);
            const unsigned h0_ = f2bf(b0_), h1_ = f2bf(b1_);
            ka0[0] = (short)h0_; ka0[1] = (short)f2bf(b0_ - bf2f((bf16_t)h0_)); ka1[0] = (short)h1_; ka1[1] = (short)f2bf(b1_ - bf2f((bf16_t)h1_));
            qa[0] = (short)0x3f80; qa[1] = (short)0x3f80;
        }
        for (int ip = 0; ip < ntl; ip += GRP) {
            if (ip + 3 < ntl) TILE_DMA(ip + 3);
            if (ip + 4 < ntl) TILE_DMA(ip + 4);
            if (ip + 5 < ntl) TILE_DMA(ip + 5);
            const int iend = ip + GRP < ntl ? ip + GRP : ntl;
        for (int i = ip; i < iend; ++i) {
            const int ent = LIST[i], ty = ent >> 8, j = ent & 255, stg = i % NSR;
            if (ty != curty) {
                axpy_ol(out, o, ol, gate2, wsf, r32, hi);
                m = -1e30f; o[0] = (f32x16){}; o[1] = (f32x16){}; ol = (f32x16){}; curty = ty;
            }
            const bool rowok = ty ? true : (((selq >> j) & 1u) != 0u);
            if (__any(rowok)) {
            f32x16 p0, p1;
            qkt_a(p0, p1, L + STG_OFF(stg), qr, r32, hi, ka0, ka1, qa);
            const float cb = slope2 * (float)(tq - 64 * j);
            const bool nomask = (j < c) && (ty ? (j > c - 8) : __all(rowok));
            float rm;
            if (nomask) {
                float ra = max3f(p0[0], p1[0], p0[1]), rb = max3f(p1[1], p0[2], p1[2]);
#pragma unroll
                for (int r = 3; r < 15; r += 2) { ra = max3f(ra, p0[r], p1[r]); rb = max3f(rb, p0[r + 1], p1[r + 1]); }
                ra = max3f(ra, p0[15], p1[15]);
                rm = max3f(ra, rb, rb);
            } else {
                rm = -INFINITY;
#pragma unroll
                for (int r = 0; r < 16; ++r) {
                    const int d0_ = tq - (j * 64 + crow(r, hi)), d1_ = d0_ - 32;
                    const bool ok0 = rowok && d0_ >= 0 && (ty == 0 || d0_ < 512), ok1 = rowok && d1_ >= 0 && (ty == 0 || d1_ < 512);
                    p0[r] = ok0 ? p0[r] : -INFINITY; p1[r] = ok1 ? p1[r] : -INFINITY;
                    rm = fmaxf(rm, fmaxf(p0[r], p1[r]));
                }
            }
            rm = swap_max(rm - cb);
            const float mn = fmaxf(m, rm);
            const float alpha = __builtin_amdgcn_exp2f(m - mn);
            m = mn;
            const float eref = mn + cb;
#pragma unroll
            for (int r = 0; r < 16; ++r) { p0[r] = __builtin_amdgcn_exp2f(p0[r] - eref); p1[r] = __builtin_amdgcn_exp2f(p1[r] - eref); }
            if (__any(alpha != 1.0f)) scale_ol(o, ol, alpha, wsf, r32, hi);
            bf16x8 a0, a1, a2, a3;
            pack_p(p0, p1, a0, a1, a2, a3);
            psum(ol, a0, a1, a2, a3);
            pv(o, (int)(lds0 + STG_OFF(stg) + 8192) + vboff, a0, a1, a2, a3);
            }
        }
            asm volatile("s_waitcnt vmcnt(0)" ::: "memory");
            __syncthreads();
        }
        {
            axpy_ol(out, o, ol, (curty ? gate2 : gate1), wsf, r32, hi);
        }
#undef TILE_DMA
#undef TILE_WAIT
#undef STG_OFF
    }
    {
        LAS bf16_t* ost = (LAS bf16_t*)(L + L_KB) + w * 2048;
#pragma unroll
        for (int r = 0; r < 16; ++r) { const int q = crow(r, hi); ost[q * 64 + r32] = (bf16_t)f2bf(out[0][r]); ost[q * 64 + 32 + r32] = (bf16_t)f2bf(out[1][r]); }
        asm volatile("s_waitcnt lgkmcnt(0)" ::: "memory");
        bf16_t* CC = (bf16_t*)(F.ws + WS_S + S_CONCAT) + ((size_t)b * T_ + t0 + th * 32) * D_ + 512 + g * 256 + rh * 64;
#pragma unroll
        for (int k = 0; k < 4; ++k) {
            const int q = k * 8 + (lanel >> 3), ch = lanel & 7;
            *(u32x4_t*)(CC + (size_t)q * D_ + ch * 8) = *(const LAS u32x4_t*)(ost + q * 64 + ch * 8);
        }
    }
}
template <int DBG = 0> __device__ __forceinline__ void p_nsa_attn(Frame& F, int l) {
    RELAUNDER(F);
    const int n_rw = 1792;
    const bf16_t* P = (const bf16_t*)(F.ws + WS_S + S_PROJ);
    for (int v = F.vcu; v < 256; v += F.G) {
        const int bg = v >> 4, s = v & 15;
#pragma unroll 1
        for (int half = 0; half < 2; ++half) nsa_item<DBG>(F, P, n_rw, bg >> 1, bg & 1, half == 0 ? 31 - s : s);
    }
}

namespace xat {
constexpr int L_P = 0, PPITCH = 264, L_PMAX = 64 * PPITCH * 2, L_PSUM = L_PMAX + 8 * 64 * 4, L_LINV = L_PSUM + 8 * 64 * 4, L_Q = L_LINV + 256, QPITCH = 264, L_OST = L_P  , L_END = L_Q + 2 * 64 * QPITCH * 2;
static_assert(8 * 64 * 32 * 2 <= 64 * PPITCH * 2, "O stage fits the P tile");
static_assert(L_END <= 131072, "cross LDS map");
constexpr float QSCALE = 0.0625f * 1.4426950408889634f;
}
__device__ __forceinline__ void p_cross_attn(Frame& F, int l, int grp_first, int grp_stride) {
    RELAUNDER(F);
    using namespace nsa;
    const bf16_t* QC = (const bf16_t*)(F.ws + WS_S + S_QC); bf16_t* OC = (bf16_t*)(F.ws + WS_S + S_OC);
    const bf16_t* KCR = (const bf16_t*)(F.ws + WS_KCR) + (size_t)l * NMEM * 1024; const bf16_t* VT = (const bf16_t*)(F.ws + WS_VT) + (size_t)l * 1024 * NMEM;
    const int tidl = F.tid, lanel = tidl & 63, w = F.wave, r32 = lanel & 31, hi = lanel >> 5;
    LAS unsigned char* L = F.lds;
    LAS bf16_t* Pl = (LAS bf16_t*)(L + xat::L_P); LAS float* PMAX = (LAS float*)(L + xat::L_PMAX); LAS float* PSUM = (LAS float*)(L + xat::L_PSUM); LAS float* LINV = (LAS float*)(L + xat::L_LINV);
    for (int grp = grp_first; grp < 256; grp += grp_stride) {
        const int bh = grp >> 3, b = bh >> 2, h = bh & 3;
        bf16x8 kf[16], vf[16];
        {
            const bf16_t* kp = KCR + ((size_t)b * MEM_ + 32 * w + r32) * 1024 + h * 256 + hi * 8;
            const bf16_t* vp = VT + ((size_t)(h * 256 + 32 * w + r32)) * NMEM + b * MEM_ + hi * 8;
#pragma unroll
            for (int d0 = 0; d0 < 16; ++d0) { kf[d0] = *(const bf16x8*)(kp + d0 * 16); vf[d0] = *(const bf16x8*)(vp + d0 * 16); }
        }
        LAS bf16_t* Ql = (LAS bf16_t*)(L + xat::L_Q);
        u32x4_t qreg[4];
        {
            const bf16_t* qsrc = QC + ((size_t)b * T_ + ((grp & 7) * 4) * 64 + (tidl >> 3)) * 1024 + h * 256 + (tidl & 7) * 8;
#pragma unroll
            for (int k = 0; k < 4; ++k) qreg[k] = *(const u32x4_t*)(qsrc + 64 * k);
        }
        __syncthreads();
#pragma unroll
        for (int k = 0; k < 4; ++k) *(LAS u32x4_t*)(Ql + (tidl >> 3) * xat::QPITCH + (tidl & 7) * 8 + 64 * k) = qreg[k];
#pragma unroll 1
        for (int i = 0; i < 4; ++i) {
            const int t0 = ((grp & 7) * 4 + i) * 64;
            LAS bf16_t* Qc = Ql + (i & 1) * 64 * xat::QPITCH;
            if (i < 3) {
                const bf16_t* qsrc = QC + ((size_t)b * T_ + t0 + 64 + (tidl >> 3)) * 1024 + h * 256 + (tidl & 7) * 8;
#pragma unroll
                for (int k = 0; k < 4; ++k) qreg[k] = *(const u32x4_t*)(qsrc + 64 * k);
            }
            __syncthreads();
            f32x16 s[2];
#pragma unroll
            for (int qs = 0; qs < 2; ++qs) {
                const LAS bf16_t* qp = Qc + (qs * 32 + r32) * xat::QPITCH + hi * 8;
                s[qs] = (f32x16){};
#pragma unroll
                for (int d0 = 0; d0 < 16; ++d0) { const bf16x8 qf = *(const LAS bf16x8*)(qp + d0 * 16); s[qs] = __builtin_amdgcn_mfma_f32_32x32x16_bf16(kf[d0], qf, s[qs], 0, 0, 0); }
            }
            if (i < 3) {
                LAS bf16_t* Qn = Ql + ((i + 1) & 1) * 64 * xat::QPITCH;
#pragma unroll
                for (int k = 0; k < 4; ++k) *(LAS u32x4_t*)(Qn + (tidl >> 3) * xat::QPITCH + (tidl & 7) * 8 + 64 * k) = qreg[k];
            }
#pragma unroll
            for (int qs = 0; qs < 2; ++qs) {
                float pm = s[qs][0];
#pragma unroll
                for (int r = 1; r < 16; ++r) pm = fmaxf(pm, s[qs][r]);
                pm = swap_max(pm);
                if (hi == 0) PMAX[w * 64 + qs * 32 + r32] = pm;
            }
            __syncthreads();
#pragma unroll
            for (int qs = 0; qs < 2; ++qs) {
                float m = PMAX[qs * 32 + r32];
#pragma unroll
                for (int ww = 1; ww < 8; ++ww) m = fmaxf(m, PMAX[ww * 64 + qs * 32 + r32]);
                float ps = 0.f;
#pragma unroll
                for (int r = 0; r < 16; ++r) { s[qs][r] = __builtin_amdgcn_exp2f(s[qs][r] - m); ps += s[qs][r]; }
                ps = swap_sum(ps);
                if (hi == 0) PSUM[w * 64 + qs * 32 + r32] = ps;
#pragma unroll
                for (int rq = 0; rq < 4; ++rq) {
                    u32x2_t pk; pk.x = cvtpk(s[qs][4 * rq], s[qs][4 * rq + 1]); pk.y = cvtpk(s[qs][4 * rq + 2], s[qs][4 * rq + 3]);
                    *(LAS u32x2_t*)(Pl + (qs * 32 + r32) * xat::PPITCH + 32 * w + 8 * rq + 4 * hi) = pk;
                }
            }
            __syncthreads();
            if (tidl < 64) { float t = 0.f;
#pragma unroll
                for (int ww = 0; ww < 8; ++ww) t += PSUM[ww * 64 + tidl];
                LINV[tidl] = __builtin_amdgcn_rcpf(t); }
            f32x16 o[2]; o[0] = (f32x16){}; o[1] = (f32x16){};
#pragma unroll
            for (int qs = 0; qs < 2; ++qs)
#pragma unroll
                for (int ks = 0; ks < 16; ++ks) {
                    const bf16x8 pf = *(const LAS bf16x8*)(Pl + (qs * 32 + r32) * xat::PPITCH + ks * 16 + hi * 8);
                    o[qs] = __builtin_amdgcn_mfma_f32_32x32x16_bf16(pf, vf[ks], o[qs], 0, 0, 0);
                }
            __syncthreads();
            {
                LAS bf16_t* ost = (LAS bf16_t*)(L + xat::L_OST) + w * 64 * 32;
#pragma unroll
                for (int qs = 0; qs < 2; ++qs)
#pragma unroll
                    for (int r = 0; r < 16; ++r) { const int q = qs * 32 + crow(r, hi); ost[q * 32 + r32] = (bf16_t)f2bf(o[qs][r] * LINV[q]); }
                asm volatile("s_waitcnt lgkmcnt(0)" ::: "memory");
#pragma unroll
                for (int k = 0; k < 4; ++k) {
                    const int q = k * 16 + (lanel >> 2), ch = lanel & 3;
                    const u32x4_t v = *(const LAS u32x4_t*)(ost + q * 32 + ch * 8);
                    *(u32x4_t*)(OC + ((size_t)b * T_ + t0 + q) * 1024 + h * 256 + 32 * w + ch * 8) = v;
                }
            }
        }
    }
}

namespace chk {
typedef short bf16x8 __attribute__((ext_vector_type(8)));
constexpr int TP = 72;
constexpr int WAVE_LDS = 4 * 16 * TP * 2 + 2 * 16 * 17 * 4 + 24 * 128;
typedef float f32x2_t __attribute__((ext_vector_type(2))); typedef __bf16 bf16x2_t __attribute__((ext_vector_type(2)));
__device__ __forceinline__ unsigned pk(float lo, float hi) { f32x2_t v = {lo, hi}; bf16x2_t b = __builtin_convertvector(v, bf16x2_t); return __builtin_bit_cast(unsigned, b); }
}
__device__ __forceinline__ void p_rw_chunk(Frame& F) {
    RELAUNDER(F);
    using namespace chk;
    const int lane = F.lane, j = lane;
    const int item0 = (((F.vcu >> 5) * 8 + F.wave) << 7) + 4 * (F.vcu & 31);
    const bf16_t* SC = (const bf16_t*)(F.ws + WS_S + S_SC);
    LAS unsigned char* wl = F.lds + F.wave * WAVE_LDS;
    LAS bf16_t* tA = (LAS bf16_t*)wl; LAS bf16_t* tB = tA + 16 * TP; LAS bf16_t* tK = tB + 16 * TP; LAS bf16_t* tR = tK + 16 * TP;
    LAS float* M1s = (LAS float*)(wl + 4 * 16 * TP * 2); LAS float* Ts = M1s + 16 * 17;
    const int m = lane & 15, kq = lane >> 4;
    LAS bf16_t* raw = (LAS bf16_t*)(wl + 4 * 16 * TP * 2 + 2 * 16 * 17 * 4);
    u32x4_t R[12];
    {
        const bf16_t* s0 = SC + (size_t)item0 * (16 * 384) + lane * 8;
#pragma unroll
        for (int q = 0; q < 12; ++q) R[q] = __builtin_nontemporal_load((const u32x4_t*)(s0 + q * 512));
    }
#pragma unroll 1
    for (int item = item0; item < item0 + 4; ++item) {
        unsigned char* dst = F.ws + WS_S + S_CH + (size_t)item * CH_BYTES;
        float gam = 1.0f;
        float be[16], ka[16], vv[16];
#pragma unroll
        for (int qt = 0; qt < 4; ++qt) {
#pragma unroll
            for (int q3 = 0; q3 < 3; ++q3) *(LAS u32x4_t*)(raw + (8 * q3 + (lane >> 3)) * 64 + (lane & 7) * 8) = R[3 * qt + q3];
            asm volatile("s_waitcnt lgkmcnt(0)" ::: "memory");
#pragma unroll
            for (int tl = 0; tl < 4; ++tl) {
                const int t = 4 * qt + tl;
                const float r = bf2f(raw[(tl * 6 + 0) * 64 + j]), om = bf2f(raw[(tl * 6 + 1) * 64 + j]), kt = bf2f(raw[(tl * 6 + 2) * 64 + j]), v = bf2f(raw[(tl * 6 + 3) * 64 + j]),
                            kh = bf2f(raw[(tl * 6 + 4) * 64 + j]), b = bf2f(raw[(tl * 6 + 5) * 64 + j]);
                const float al = -kh * gam;
                gam = gam - gam * om;
                const float ig = __builtin_amdgcn_rcpf(gam);
                be[t] = b * ig; ka[t] = kt * ig; vv[t] = v;
                tA[t * TP + j] = (bf16_t)f2bf(al); tB[t * TP + j] = (bf16_t)f2bf(be[t]); tK[t * TP + j] = (bf16_t)f2bf(ka[t]); tR[t * TP + j] = (bf16_t)f2bf(r * gam);
            }
            asm volatile("s_waitcnt lgkmcnt(0)" ::: "memory");
        }
        if (item + 1 < item0 + 4) {
            const bf16_t* s0 = SC + (size_t)(item + 1) * (16 * 384) + lane * 8;
#pragma unroll
            for (int q = 0; q < 12; ++q) R[q] = __builtin_nontemporal_load((const u32x4_t*)(s0 + q * 512));
        }
        *(float*)(dst + 12288 + 4 * j) = gam;
        {
            const int mt = j >> 4, jl = j & 15;
            unsigned char* pB = dst + 4096 + (mt >> 1) * 1024 + (mt & 1) * 8;
            unsigned char* pK = dst + 4096 + 2048 + (mt >> 1) * 1024 + (mt & 1) * 8;
            unsigned char* pV = dst + 10240 + mt * 512;
#pragma unroll
            for (int q2 = 0; q2 < 4; ++q2) {
                const int le = q2 * 16 + jl;
                u32x2_t o; o.x = pk(be[4 * q2], be[4 * q2 + 1]); o.y = pk(be[4 * q2 + 2], be[4 * q2 + 3]); *(u32x2_t*)(pB + le * 16) = o;
                o.x = pk(ka[4 * q2], ka[4 * q2 + 1]); o.y = pk(ka[4 * q2 + 2], ka[4 * q2 + 3]); *(u32x2_t*)(pK + le * 16) = o;
                o.x = pk(vv[4 * q2], vv[4 * q2 + 1]); o.y = pk(vv[4 * q2 + 2], vv[4 * q2 + 3]); *(u32x2_t*)(pV + le * 8) = o;
            }
        }
        asm volatile("s_waitcnt lgkmcnt(0)" ::: "memory");
#pragma unroll
        for (int ks = 0; ks < 2; ++ks) {
            const u32x2_t a0 = *(const LAS u32x2_t*)(tA + m * TP + 32 * ks + 4 * kq), a1 = *(const LAS u32x2_t*)(tA + m * TP + 32 * ks + 16 + 4 * kq);
            *(u32x4_t*)(dst + ks * 1024 + lane * 16) = (u32x4_t){a0.x, a0.y, a1.x, a1.y};
            const u32x2_t r0 = *(const LAS u32x2_t*)(tR + m * TP + 32 * ks + 4 * kq), r1 = *(const LAS u32x2_t*)(tR + m * TP + 32 * ks + 16 + 4 * kq);
            *(u32x4_t*)(dst + 2048 + ks * 1024 + lane * 16) = (u32x4_t){r0.x, r0.y, r1.x, r1.y};
        }
        pg8::f32x4 d1 = {0.f, 0.f, 0.f, 0.f}, d2 = d1, d3 = d1, d4 = d1;
#pragma unroll
        for (int ks = 0; ks < 2; ++ks) {
            const bf16x8 fb = *(const LAS bf16x8*)(tB + m * TP + 32 * ks + 8 * kq), fk = *(const LAS bf16x8*)(tK + m * TP + 32 * ks + 8 * kq);
            const bf16x8 fa = *(const LAS bf16x8*)(tA + m * TP + 32 * ks + 8 * kq), fr = *(const LAS bf16x8*)(tR + m * TP + 32 * ks + 8 * kq);
            d1 = __builtin_amdgcn_mfma_f32_16x16x32_bf16(fb, fa, d1, 0, 0, 0);
            d2 = __builtin_amdgcn_mfma_f32_16x16x32_bf16(fk, fa, d2, 0, 0, 0);
            d3 = __builtin_amdgcn_mfma_f32_16x16x32_bf16(fb, fr, d3, 0, 0, 0);
            d4 = __builtin_amdgcn_mfma_f32_16x16x32_bf16(fk, fr, d4, 0, 0, 0);
        }
#pragma unroll
        for (int rg = 0; rg < 4; ++rg) {
            const int s_ = 4 * kq + rg, t_ = m;
            if (!(s_ < t_)) { d1[rg] = 0.f; d2[rg] = 0.f; }
            if (!(s_ <= t_)) { d3[rg] = 0.f; d4[rg] = 0.f; }
            M1s[s_ * 17 + t_] = d1[rg];
        }
        asm volatile("s_waitcnt lgkmcnt(0)" ::: "memory");
        {
            float tr[16];
#pragma unroll
            for (int t = 0; t < 16; ++t) {
                float a = (m == t) ? 1.0f : 0.0f;
#pragma unroll
                for (int s2 = 0; s2 < t; ++s2) a += tr[s2] * M1s[s2 * 17 + t];
                tr[t] = a;
            }
            if (kq == 0) {
#pragma unroll
                for (int t = 0; t < 16; ++t) Ts[m * 17 + t] = tr[t];
            }
        }
        asm volatile("s_waitcnt lgkmcnt(0)" ::: "memory");
        {
            u32x4_t o;
            o.x = pk(Ts[(4 * kq + 0) * 17 + m], Ts[(4 * kq + 1) * 17 + m]); o.y = pk(Ts[(4 * kq + 2) * 17 + m], Ts[(4 * kq + 3) * 17 + m]);
            o.z = pk(d2[0], d2[1]); o.w = pk(d2[2], d2[3]);
            *(u32x4_t*)(dst + 4096 + 4 * 1024 + lane * 16) = o;
            o.x = pk(d3[0], d3[1]); o.y = pk(d3[2], d3[3]); o.z = pk(d4[0], d4[1]); o.w = pk(d4[2], d4[3]);
            *(u32x4_t*)(dst + 4096 + 5 * 1024 + lane * 16) = o;
        }
        asm volatile("s_waitcnt lgkmcnt(0)" ::: "memory");
    }
}

namespace chk { constexpr int SL = 12800, NS = 10, DD = 8; static_assert(NS * SL <= 131072 && NS >= DD + 2, "ring"); }
__device__ __forceinline__ void p_rw_scan2(Frame& F, int bh) {
    RELAUNDER(F);
    using namespace chk;
    const int w = F.wave, lane = F.lane, il = lane & 15, kq = lane >> 4;
    const unsigned char* base = F.ws + WS_S + S_CH + (size_t)bh * 128 * CH_BYTES;
    LAS unsigned char* L = F.lds;
#define CH_ISSUE(c_) do { const unsigned char* cb_ = base + (size_t)(c_) * CH_BYTES; LAS unsigned char* sl_ = L + ((c_) % NS) * SL; const int lw_ = w - 4; \
        __builtin_amdgcn_global_load_lds((const unsigned*)(cb_ + (lw_) * 1024 + lane * 16), (LAS unsigned*)(sl_ + (lw_) * 1024), 16, 0, 2); \
        __builtin_amdgcn_global_load_lds((const unsigned*)(cb_ + (lw_ + 4) * 1024 + lane * 16), (LAS unsigned*)(sl_ + (lw_ + 4) * 1024), 16, 0, 2); \
        __builtin_amdgcn_global_load_lds((const unsigned*)(cb_ + (lw_ + 8) * 1024 + lane * 16), (LAS unsigned*)(sl_ + (lw_ + 8) * 1024), 16, 0, 2); \
        if (lw_ == 0) __builtin_amdgcn_global_load_lds((const unsigned*)(cb_ + 12288 + lane * 4), (LAS unsigned*)(sl_ + 12288), 4, 0, 2); } while (0)
    if (w >= 4) {
#pragma unroll 1
        for (int c = 0; c < DD; ++c) CH_ISSUE(c);
#pragma unroll 1
        for (int c = 0; c < 128; ++c) {
            if (c + DD < 128) {
                CH_ISSUE(c + DD);
                if (w == 4) asm volatile("s_waitcnt vmcnt(32)" ::: "memory"); else asm volatile("s_waitcnt vmcnt(24)" ::: "memory");
            } else asm volatile("s_waitcnt vmcnt(0)" ::: "memory");
            __builtin_amdgcn_s_barrier();
        }
    } else {
        const int qtr = w;
        float* Y = (float*)((unsigned char*)F.out + O_Y) + ((size_t)(bh >> 3) * T_) * W_ + (bh & 7) * 64 + 16 * qtr + il;
        pg8::f32x4 acc0 = {0.f, 0.f, 0.f, 0.f}, acc1 = acc0, acc2 = acc0, acc3 = acc0;
        typedef short s16x4_ __attribute__((ext_vector_type(4)));
#define HALF_LO(q_) __builtin_bit_cast(s16x4_, (u32x2_t){(q_).x, (q_).y})
#define HALF_HI(q_) __builtin_bit_cast(s16x4_, (u32x2_t){(q_).z, (q_).w})
#define FULL(q_) __builtin_bit_cast(bf16x8, (q_))
#define MMAH(a_, b_, c_) __builtin_amdgcn_mfma_f32_16x16x16bf16_1k(a_, b_, c_, 0, 0, 0)
#pragma unroll 1
        for (int c = 0; c < 128; ++c) {
            __builtin_amdgcn_s_barrier();
            asm volatile("" ::: "memory");
            const LAS unsigned char* sl = L + (c % NS) * SL + lane * 16;
            const u32x4_t at0 = *(const LAS u32x4_t*)(sl), at1 = *(const LAS u32x4_t*)(sl + 1024), rt0 = *(const LAS u32x4_t*)(sl + 2048), rt1 = *(const LAS u32x4_t*)(sl + 3072);
            const u32x4_t p0 = *(const LAS u32x4_t*)(sl + 4096), p1 = *(const LAS u32x4_t*)(sl + 5120), p2 = *(const LAS u32x4_t*)(sl + 6144), p3 = *(const LAS u32x4_t*)(sl + 7168);
            const u32x4_t p4 = *(const LAS u32x4_t*)(sl + 8192), p5 = *(const LAS u32x4_t*)(sl + 9216);
            const u32x2_t vt = *(const LAS u32x2_t*)(L + (c % NS) * SL + 10240 + qtr * 512 + lane * 8);
            const LAS float* gp = (const LAS float*)(L + (c % NS) * SL + 12288) + 4 * kq;
            const f32x4_t g0 = *(const LAS f32x4_t*)(gp), g1 = *(const LAS f32x4_t*)(gp + 16), g2 = *(const LAS f32x4_t*)(gp + 32), g3 = *(const LAS f32x4_t*)(gp + 48);
            const bf16x8 S0 = __builtin_bit_cast(bf16x8, (u32x4_t){pk(acc0[0], acc0[1]), pk(acc0[2], acc0[3]), pk(acc1[0], acc1[1]), pk(acc1[2], acc1[3])});
            const bf16x8 S1 = __builtin_bit_cast(bf16x8, (u32x4_t){pk(acc2[0], acc2[1]), pk(acc2[2], acc2[3]), pk(acc3[0], acc3[1]), pk(acc3[2], acc3[3])});
            const s16x4_ VT = __builtin_bit_cast(s16x4_, vt);
            pg8::f32x4 wt = {0.f, 0.f, 0.f, 0.f};
            wt = MMAH(HALF_HI(p4), VT, wt);
            wt = __builtin_amdgcn_mfma_f32_16x16x32_bf16(FULL(at0), S0, wt, 0, 0, 0);
            wt = __builtin_amdgcn_mfma_f32_16x16x32_bf16(FULL(at1), S1, wt, 0, 0, 0);
            acc0 = MMAH(HALF_LO(p2), VT, acc0);
            acc1 = MMAH(HALF_HI(p2), VT, acc1);
            acc2 = MMAH(HALF_LO(p3), VT, acc2);
            acc3 = MMAH(HALF_HI(p3), VT, acc3);
            pg8::f32x4 yt = {0.f, 0.f, 0.f, 0.f};
            yt = __builtin_amdgcn_mfma_f32_16x16x32_bf16(FULL(rt0), S0, yt, 0, 0, 0);
            yt = __builtin_amdgcn_mfma_f32_16x16x32_bf16(FULL(rt1), S1, yt, 0, 0, 0);
            yt = MMAH(HALF_HI(p5), VT, yt);
            const s16x4_ WB = __builtin_bit_cast(s16x4_, (u32x2_t){pk(wt[0], wt[1]), pk(wt[2], wt[3])});
            pg8::f32x4 ut = {0.f, 0.f, 0.f, 0.f};
            ut = MMAH(HALF_LO(p4), WB, ut);
            const s16x4_ UB = __builtin_bit_cast(s16x4_, (u32x2_t){pk(ut[0], ut[1]), pk(ut[2], ut[3])});
            acc0 = MMAH(HALF_LO(p0), UB, acc0);
            acc1 = MMAH(HALF_HI(p0), UB, acc1);
            acc2 = MMAH(HALF_LO(p1), UB, acc2);
            acc3 = MMAH(HALF_HI(p1), UB, acc3);
            yt = MMAH(HALF_LO(p5), UB, yt);
            acc0 = acc0 * g0; acc1 = acc1 * g1; acc2 = acc2 * g2; acc3 = acc3 * g3;
            { float* yp = Y + (size_t)(16 * c + 4 * kq) * W_; yp[0] = yt[0]; yp[W_] = yt[1]; yp[2 * W_] = yt[2]; yp[3 * W_] = yt[3]; }
        }
#undef HALF_LO
#undef HALF_HI
#undef FULL
#undef MMAH
    }
#undef CH_ISSUE
}
#ifndef MK_FUSED
#define MK_FUSED 1
#endif
#if !MK_FUSED
__global__ void __launch_bounds__(NWAVES * 64, 2) mega(Args args) {
    extern __shared__ __attribute__((aligned(16))) unsigned char lds[];
    {
        LAS unsigned char* l3 = (LAS unsigned char*)lds;
        for (int u = threadIdx.x; u < (LDS_BYTES - LDSCTL_OFF) / 4; u += NWAVES * 64) ((LAS unsigned*)(l3 + LDSCTL_OFF))[u] = 0u;
    }
    __syncthreads();
    {
        const int ph = args.ph[0];
        Frame F;
        F.ws = launder_ptr(args.ws);
        { int t = threadIdx.x; asm volatile("" : "+v"(t)); F.tid = t; }
        F.lds = (LAS unsigned char*)lds;
        F.MISC = (volatile LAS unsigned*)(F.lds + MISC_OFF);
        F.lane = F.tid & 63; F.wave = __builtin_amdgcn_readfirstlane(F.tid >> 6);
        F.G = gridDim.x; { const int bx = blockIdx.x; F.vcu = (F.G % 8 == 0) ? (bx % 8) * (F.G / 8) + bx / 8 : bx; }
        F.in = args.in; F.out = (float*)(GAS float*)args.out;
        if (ph == 0) p_prologue(F);
        else if (ph == 1) p_kv(F);
        else if (ph == 10 || ph == 11) p_inproj(F, ph - 10);
        else if (ph == 20 || ph == 21) p_rw_prep(F, ph - 20);
        else if (ph == 25 || ph == 26) p_nsa_cmp(F, ph - 25);
        else if (ph == 30 || ph == 31) p_rw_scan(F);
        else if (ph == 45 || ph == 46) p_nsa_attn(F, ph - 45);
        else if (ph == 40 || ph == 41) p_rw_post(F, ph - 40);
        else if (ph == 50 || ph == 51) p_resid_gemm(F, (const bf16_t*)(F.ws + WS_S + S_CONCAT), (const bf16_t*)(F.ws + WS_WB + WB_WOUT) + (size_t)(ph - 50) * D_ * D_, 1024);
        else if (ph == 60 || ph == 61) p_crossq(F, ph - 60);
        else if (ph == 70 || ph == 71) p_cross_attn(F, ph - 70);
        else if (ph == 80 || ph == 81) p_resid_gemm(F, (const bf16_t*)(F.ws + WS_S + S_OC), (const bf16_t*)(F.ws + WS_WB + WB_WO) + (size_t)(ph - 80) * D_ * D_, 1024);
        else if (ph == 90) p_ffn_up(F);
        else if (ph == 100) p_route(F);
        else if (ph == 101) p_moe_prep(F);
        else if (ph == 102 || ph == 104) p_moe_gemm1(F, (ph - 102) >> 1);
        else if (ph == 103 || ph == 105) p_moe_gemm2(F, (ph - 103) >> 1);
        else if (ph == 110) p_final(F, true);
        else if (ph == 91) p_resid_gemm(F, (const bf16_t*)(F.ws + WS_S + S_ACT), (const bf16_t*)(F.ws + WS_WB + WB_WD), FFD);
        __syncthreads();
    }
}
#else
__global__ void __launch_bounds__(NWAVES * 64, 2) mega(Args args) {
    extern __shared__ __attribute__((aligned(16))) unsigned char lds[];
    {
        LAS unsigned char* l3 = (LAS unsigned char*)lds;
        for (int u = threadIdx.x; u < (LDS_BYTES - LDSCTL_OFF) / 4; u += NWAVES * 64) ((LAS unsigned*)(l3 + LDSCTL_OFF))[u] = 0u;
    }
    __syncthreads();
    const XcdBarrier bar = xcd_barrier_post((unsigned*)(args.ws + WS_CTL) + CW_BAR, (volatile LAS unsigned*)((LAS unsigned char*)lds + MISC_OFF) + 8);
    Frame F;
    F.ws = launder_ptr(args.ws);
    { int t = threadIdx.x; asm volatile("" : "+v"(t)); F.tid = t; }
    F.lds = (LAS unsigned char*)lds;
    F.MISC = (volatile LAS unsigned*)(F.lds + MISC_OFF);
    F.lane = F.tid & 63; F.wave = __builtin_amdgcn_readfirstlane(F.tid >> 6);
    F.G = gridDim.x; { const int bx = blockIdx.x; F.vcu = (F.G % 8 == 0) ? (bx % 8) * (F.G / 8) + bx / 8 : bx; }
    F.in = args.in; F.out = (float*)(GAS float*)args.out;
#ifndef MK_DIAG_MASK
#define MK_DIAG_MASK 0ull
#endif
    unsigned long long* TS = (unsigned long long*)(args.ws + WS_CTL + 600 * 1024); int nseam = 0;
#define SEAM() do { xcd_barrier(bar); if (MK_DIAG_MASK != 0ull && blockIdx.x == 0 && threadIdx.x == 0) TS[++nseam] = __builtin_amdgcn_s_memrealtime(); } while (0)
    if (MK_DIAG_MASK != 0ull && blockIdx.x == 0 && threadIdx.x == 0) TS[0] = __builtin_amdgcn_s_memrealtime();
    p_prologue(F); SEAM();
    p_inproj(F, 0); SEAM();
    p_rw_prep(F, 0);
    asm volatile("s_waitcnt vmcnt(0)" ::: "memory"); __syncthreads();
    p_rw_chunk(F); SEAM();
    if (F.vcu < 64) p_rw_scan2(F, F.vcu);
    else { const int k = F.vcu - 64; p_kv(F, k); __syncthreads(); if (k < 128) p_nsa_cmp(F, 0, k, 1); else p_nsa_cmp(F, 0, 128 + 2 * (k - 128), 2); }
    SEAM();
    p_nsa_attn(F, 0); p_rw_post(F, 0); SEAM();
    p_resid_gemm(F, (const bf16_t*)(F.ws + WS_S + S_CONCAT), (const bf16_t*)(F.ws + WS_WB + WB_WOUT), 1024); SEAM();
    { const int grp_ = p_crossq(F, 0);
      asm volatile("s_waitcnt vmcnt(0)" ::: "memory"); __syncthreads();
      p_cross_attn(F, 0, grp_ < 0 ? 256 : grp_, F.G); }
    SEAM();
    p_resid_gemm(F, (const bf16_t*)(F.ws + WS_S + S_OC), (const bf16_t*)(F.ws + WS_WB + WB_WO), 1024); SEAM();
    p_ffn_up(F); SEAM();
    p_ffn_down8(F); SEAM();
    p_inproj(F, 1); SEAM();
    p_rw_prep(F, 1);
    asm volatile("s_waitcnt vmcnt(0)" ::: "memory"); __syncthreads();
    p_rw_chunk(F); SEAM();
    if (F.vcu < 64) p_rw_scan2(F, F.vcu);
    else { const int k = F.vcu - 64; if (k < 64) p_nsa_cmp(F, 1, 2 * k, 2); else p_nsa_cmp(F, 1, 128 + (k - 64), 1); }
    SEAM();
    p_nsa_attn(F, 1); p_rw_post(F, 1); SEAM();
    p_resid_gemm(F, (const bf16_t*)(F.ws + WS_S + S_CONCAT), (const bf16_t*)(F.ws + WS_WB + WB_WOUT) + (size_t)D_ * D_, 1024); SEAM();
    { const int grp_ = p_crossq(F, 1);
      asm volatile("s_waitcnt vmcnt(0)" ::: "memory"); __syncthreads();
      p_cross_attn(F, 1, grp_ < 0 ? 256 : grp_, F.G); }
    SEAM();
    p_resid_gemm(F, (const bf16_t*)(F.ws + WS_S + S_OC), (const bf16_t*)(F.ws + WS_WB + WB_WO) + (size_t)D_ * D_, 1024); SEAM();
    p_route(F); SEAM();
    p_moe_prep(F); __syncthreads(); p_moe_conv(F); SEAM();
    p_moe_gemm1(F); SEAM();
    p_moe_gemm2(F); SEAM(); p_moe_gemm2_split(F);
    if (MK_DIAG_MASK != 0ull && blockIdx.x == 0 && threadIdx.x == 0) {
        TS[nseam + 1] = __builtin_amdgcn_s_memrealtime();
        unsigned long long tot = 0;
        for (int i = 0; i <= nseam; ++i) if ((MK_DIAG_MASK >> i) & 1ull) tot += TS[i + 1] - TS[i];
        *(float*)(args.ws + WS_CTL + 640 * 1024) = (float)tot * 1e-5f;
        __threadfence();
    }
    SEAM();
    p_final(F, true);
#undef SEAM
}
#endif

namespace v0 {
constexpr int B = B_, T = T_, D = D_, W = W_, H = H_, DH = DH_, MEM = MEM_;
constexpr int ECAP = 8192;
__global__ void k_rmsnorm(const float* __restrict__ x, const float* __restrict__ g, float* __restrict__ out, int rows) {
    const int wave = (blockIdx.x * blockDim.x + threadIdx.x) >> 6, lane = threadIdx.x & 63;
    if (wave >= rows) return;
    const float* xr = x + (size_t)wave * D;
    float v[16]; float s = 0.f;
#pragma unroll
    for (int i = 0; i < 16; ++i) { v[i] = xr[lane + 64 * i]; s += v[i] * v[i]; }
    s = wave_sum(s);
    const float rinv = rsqrtf(s * (1.f / D) + 1e-6f);
#pragma unroll
    for (int i = 0; i < 16; ++i) out[(size_t)wave * D + lane + 64 * i] = v[i] * rinv * g[lane + 64 * i];
}

template <int MODE, bool GATHER>
__global__ void __launch_bounds__(256) k_gemm(const float* __restrict__ A, int lda, const int* __restrict__ rowidx, const int* __restrict__ Mdev, int M,
                                               const float* __restrict__ Wt, const float* __restrict__ W2, int ldw, float* __restrict__ C, int ldc, int N, int K,
                                               const float* __restrict__ scale) {
    if (Mdev) { M = *Mdev; if (M > ECAP) M = ECAP; }
    const int m0 = blockIdx.y * 64, n0 = blockIdx.x * 64;
    if (m0 >= M) return;
    __shared__ float As[16][65];
    __shared__ float Bs[16][65];
    __shared__ float B2s[(MODE == 2) ? 16 : 1][65];
    const int tid = threadIdx.x, tx = tid & 15, ty = tid >> 4;
    float acc[4][4] = {}; float acc2[4][4] = {};
    for (int k0 = 0; k0 < K; k0 += 16) {
        for (int i = tid; i < 64 * 16; i += 256) {
            const int r = i >> 4, kk = i & 15; const int m = m0 + r;
            float v = 0.f;
            if (m < M) { const int ar = GATHER ? rowidx[m] : m; v = A[(size_t)ar * lda + k0 + kk]; }
            As[kk][r] = v;
        }
        for (int i = tid; i < 16 * 64; i += 256) {
            const int kk = i >> 6, c = i & 63; const int n = n0 + c;
            Bs[kk][c] = (n < N) ? Wt[(size_t)(k0 + kk) * ldw + n] : 0.f;
            if (MODE == 2) B2s[kk][c] = (n < N) ? W2[(size_t)(k0 + kk) * ldw + n] : 0.f;
        }
        __syncthreads();
#pragma unroll
        for (int kk = 0; kk < 16; ++kk) {
            float a[4], b[4], b2[4];
#pragma unroll
            for (int i = 0; i < 4; ++i) a[i] = As[kk][ty * 4 + i];
#pragma unroll
            for (int j = 0; j < 4; ++j) { b[j] = Bs[kk][tx * 4 + j]; if (MODE == 2) b2[j] = B2s[kk][tx * 4 + j]; }
#pragma unroll
            for (int i = 0; i < 4; ++i)
#pragma unroll
                for (int j = 0; j < 4; ++j) { acc[i][j] += a[i] * b[j]; if (MODE == 2) acc2[i][j] += a[i] * b2[j]; }
        }
        __syncthreads();
    }
#pragma unroll
    for (int i = 0; i < 4; ++i) {
        const int m = m0 + ty * 4 + i; if (m >= M) continue;
#pragma unroll
        for (int j = 0; j < 4; ++j) {
            const int n = n0 + tx * 4 + j; if (n >= N) continue;
            if (MODE == 0) C[(size_t)m * ldc + n] = acc[i][j];
            else if (MODE == 1) C[(size_t)m * ldc + n] += acc[i][j];
            else if (MODE == 2) { const float gte = acc[i][j]; C[(size_t)m * ldc + n] = gte * sigmoidf_(gte) * acc2[i][j]; }
            else { const int orow = rowidx[m]; C[(size_t)orow * ldc + n] += scale[m] * acc[i][j]; }
        }
    }
}

struct RwPar {
    const float *mu, *w0, *w2, *a0, *a2, *g2, *k_k, *k_a, *v0, *v2;
};
template <class TP>
__global__ void __launch_bounds__(512) k_rw_prep(const TP* __restrict__ proj, int ncols, int n_rw, RwPar p, int layer,
                                                 float* __restrict__ DEC, float* __restrict__ AIC, float* __restrict__ VP, float* __restrict__ G, float* __restrict__ VFIRST) {
    const int tok = blockIdx.x, t = tok % T, c = threadIdx.x;
    __shared__ float lo[288];
    const TP* cur = proj + (size_t)tok * ncols;
    const TP* prv = cur - ncols;
    if (c < n_rw - 1536) {
        const int col = 1536 + c;
        const float u = ldf(cur, col), up = (t > 0) ? ldf(prv, col) : 0.f;
        float v = u + (up - u) * p.mu[col];
        if (c < 64) v = tanhf(v);
        else if (c >= 128 && c < 256) v = sigmoidf_(v);
        lo[c] = v;
    }
    __syncthreads();
    float wr = p.w0[c], ar = p.a0[c], gr = 0.f;
#pragma unroll 4
    for (int j = 0; j < 64; ++j) { wr += lo[j] * p.w2[j * W + c]; ar += lo[64 + j] * p.a2[j * W + c]; }
#pragma unroll 4
    for (int j = 0; j < 128; ++j) gr += lo[128 + j] * p.g2[j * W + c];
    const float sp = (-wr > 20.f) ? -wr : log1pf(__expf(-wr));
    const float w = -sp - 0.5f;
    DEC[(size_t)tok * W + c] = __expf(-__expf(w));
    AIC[(size_t)tok * W + c] = sigmoidf_(ar);
    G[(size_t)tok * W + c] = gr;
    {
        const int col = 1024 + c;
        const float u = ldf(cur, col), up = (t > 0) ? ldf(prv, col) : 0.f;
        float v = u + (up - u) * p.mu[col];
        if (layer == 0) { VFIRST[(size_t)tok * W + c] = v; }
        else {
            float vr = p.v0[c];
#pragma unroll 4
            for (int j = 0; j < 32; ++j) vr += lo[256 + j] * p.v2[j * W + c];
            const float vf = VFIRST[(size_t)tok * W + c];
            v = v + (vf - v) * sigmoidf_(vr);
        }
        VP[(size_t)tok * W + c] = v;
    }
}

template <class TP>
__global__ void __launch_bounds__(64) k_rw_scan(const TP* __restrict__ proj, int ncols, const float* __restrict__ mu, const float* __restrict__ k_k, const float* __restrict__ k_a,
                                                const float* __restrict__ r_k,
                                                const float* __restrict__ DEC, const float* __restrict__ AIC, const float* __restrict__ VP,
                                                float* __restrict__ Y, float* __restrict__ BON) {
    const int b = blockIdx.x / H, h = blockIdx.x % H, j = threadIdx.x, c = h * DH + j;
    __shared__ float sr[64], sw[64], sk[64], sa[64], sb[64];
    float S[64];
#pragma unroll
    for (int i = 0; i < 64; ++i) S[i] = 0.f;
    const float mur = mu[c], muk = mu[W + c], kkc = k_k[c], kac = k_a[c], rkc = r_k[c];
    float pr = 0.f, pk = 0.f;
    for (int t = 0; t < T; ++t) {
        const size_t tok = (size_t)b * T + t;
        const TP* cur = proj + tok * ncols;
        const float ur = ldf(cur, c), uk = ldf(cur, W + c);
        const float r = ur + (pr - ur) * mur, k = uk + (pk - uk) * muk;
        pr = ur; pk = uk;
        const float a = AIC[tok * W + c], dec = DEC[tok * W + c], v = VP[tok * W + c];
        float kk = k * kkc;
        const float nrm = sqrtf(wave_sum(kk * kk));
        kk = kk / fmaxf(nrm, 1e-12f);
        const float kh = k * (1.f + (a - 1.f) * kac);
        const float bon = wave_sum(r * kh * rkc);
        __syncthreads();
        sr[j] = r; sw[j] = dec; sk[j] = kh; sa[j] = -kk; sb[j] = kk * a;
        __syncthreads();
        float Sa = 0.f;
#pragma unroll
        for (int q = 0; q < 64; ++q) Sa += S[q] * sa[q];
        float y = 0.f;
#pragma unroll
        for (int q = 0; q < 64; ++q) { S[q] = S[q] * sw[q] + Sa * sb[q] + v * sk[q]; y += S[q] * sr[q]; }
        Y[tok * W + c] = y;
        if (j == 0) BON[tok * H + h] = bon;
    }
}

template <class TC>
__global__ void k_rw_post(const float* __restrict__ Y, const float* __restrict__ BON, const float* __restrict__ VP, const float* __restrict__ G, const float* __restrict__ ln_w, const float* __restrict__ ln_b,
                          TC* __restrict__ concat) {
    const int wid = (blockIdx.x * blockDim.x + threadIdx.x) >> 6, lane = threadIdx.x & 63;
    if (wid >= NTOK * H) return;
    const int tok = wid / H, h = wid % H, c = h * DH + lane;
    const float y = Y[(size_t)tok * W + c];
    const float mean = wave_sum(y) * (1.f / 64.f);
    const float d = y - mean;
    const float var = wave_sum(d * d) * (1.f / 64.f);
    const float yn = d * rsqrtf(var + 64e-5f) * ln_w[c] + ln_b[c];
    stf(concat, (size_t)tok * D + c, (yn + BON[(size_t)tok * H + h] * VP[(size_t)tok * W + c]) * G[(size_t)tok * W + c]);
}

template <class TP>
__global__ void __launch_bounds__(128) k_cmp_hidden(const TP* __restrict__ proj, int ncols, int colbase  , const float* __restrict__ pe,
                                                    const float* __restrict__ w1, float* __restrict__ hid) {
    const int row = blockIdx.x, n = row % NCMP, g = (row / NCMP) % 2, b = row / (NCMP * 2);
    __shared__ float blk[2048];
    for (int i = threadIdx.x; i < 2048; i += 128) {
        const int l = i >> 6, d = i & 63;
        blk[i] = ldf(proj, ((size_t)b * T + 16 * n + l) * ncols + colbase + g * 64 + d) + pe[i];
    }
    __syncthreads();
    float acc = 0.f;
    for (int k = 0; k < 2048; ++k) acc += blk[k] * w1[(size_t)k * 128 + threadIdx.x];
    const float x = acc;
    const float ge = 0.5f * x * (1.f + tanhf(0.7978845608028654f * (x + 0.044715f * x * x * x)));
    hid[(size_t)row * 128 + threadIdx.x] = ge;
}
__global__ void __launch_bounds__(64) k_cmp_out(const float* __restrict__ hid, const float* __restrict__ w2, float* __restrict__ out  ) {
    const int row = blockIdx.x, n = row % NCMP, bg = row / NCMP;
    float acc = 0.f;
    for (int k = 0; k < 128; ++k) acc += hid[(size_t)row * 128 + k] * w2[k * 64 + threadIdx.x];
    out[((size_t)bg * 128 + n) * 64 + threadIdx.x] = acc;
}

template <class TP, class TC>
__global__ void __launch_bounds__(512) k_nsa_attn(const TP* __restrict__ proj, int ncols, int n_rw, const float* __restrict__ KC, const float* __restrict__ VC, TC* __restrict__ concat) {
    const int tok = blockIdx.x, b = tok / T, t = tok % T;
    const int wave = threadIdx.x >> 6, lane = threadIdx.x & 63, g = wave >> 2, r = wave & 3, hq = wave;
    const TP* cols = proj + (size_t)tok * ncols + n_rw;
    __shared__ float qs[8][64];
    __shared__ float ps[8][128];
    __shared__ float imp[2][32];
    __shared__ unsigned selm[2];
    __shared__ float pbuf[8][64];
    const float slope = exp2f(-(float)(hq + 1));
    const float q = ldf(cols, g * 256 + r * 64 + lane) * 0.125f;
    qs[wave][lane] = q;
    const float gate0 = sigmoidf_(ldf(cols, 1280 + hq * 3 + 0)), gate1 = sigmoidf_(ldf(cols, 1280 + hq * 3 + 1)), gate2 = sigmoidf_(ldf(cols, 1280 + hq * 3 + 2));
    __syncthreads();
    float out = 0.f;
    {
        const float* kc = KC + ((size_t)(b * 2 + g) * 128) * 64;
        const float* vc = VC + ((size_t)(b * 2 + g) * 128) * 64;
        float s[2]; bool ok[2];
#pragma unroll
        for (int u = 0; u < 2; ++u) {
            const int n = lane + 64 * u;
            ok[u] = (n < NCMP) && (16 * n + 31 <= t);
            float acc = 0.f;
            if (ok[u]) { for (int d = 0; d < 64; ++d) acc += qs[wave][d] * kc[n * 64 + d]; acc -= slope * (float)(t - (16 * n + 31)); }
            s[u] = ok[u] ? acc : -1e30f;
        }
        const float m = wave_max(fmaxf(s[0], s[1]));
        float p0 = ok[0] ? __expf(s[0] - m) : 0.f, p1 = ok[1] ? __expf(s[1] - m) : 0.f;
        const float l = wave_sum(p0 + p1);
        const float inv = 1.f / fmaxf(l, 1e-30f);
        p0 *= inv; p1 *= inv;
        ps[wave][lane] = p0; ps[wave][lane + 64] = p1;
        __syncthreads();
        float o = 0.f;
        for (int n = 0; n < NCMP; ++n) o += ps[wave][n] * vc[n * 64 + lane];
        out += gate0 * o;
        if (threadIdx.x < 64) {
            const int g2 = threadIdx.x >> 5, j = threadIdx.x & 31;
            float acc = 0.f;
            for (int rr = 0; rr < 4; ++rr)
                for (int n = 4 * j - 1; n <= 4 * j + 3; ++n) if (n >= 0 && n < NCMP) acc += ps[g2 * 4 + rr][n];
            const int curb = t >> 6;
            if (j == 0 || j == curb || j == curb - 1) acc = 1e4f;
            if (j > curb) acc = -1.f;
            imp[g2][j] = acc;
        }
        __syncthreads();
        if (threadIdx.x < 64) {
            const int g2 = threadIdx.x >> 5, j = threadIdx.x & 31;
            const float mine = imp[g2][j]; int rank = 0;
            for (int jj = 0; jj < 32; ++jj) { const float o2 = imp[g2][jj]; rank += (o2 > mine || (o2 == mine && jj < j)) ? 1 : 0; }
            const unsigned long long bal = __ballot(rank < 16);
            if (j == 0) selm[g2] = (unsigned)(g2 == 0 ? (bal & 0xffffffffull) : (bal >> 32));
        }
        __syncthreads();
    }
    for (int br = 0; br < 2; ++br) {
        const int kcol = n_rw + 512 + (br == 0 ? 2 : 4) * 128 + g * 64, vcol = kcol + 128;
        const float gate = br == 0 ? gate1 : gate2;
        const unsigned mask = selm[g];
        float m = -1e30f, l = 0.f, o = 0.f;
        const int curb = t >> 6;
        const int jlo = (br == 0) ? 0 : ((curb - 8 > 0) ? curb - 8 : 0);
        for (int j = jlo; j <= curb; ++j) {
            if (br == 0 && !((mask >> j) & 1u)) continue;
            const int pos = j * 64 + lane;
            const int dist = t - pos;
            const bool ok = (dist >= 0) && (br == 0 || dist < 512);
            float sc = -1e30f;
            if (ok) {
                const TP* kr = proj + ((size_t)b * T + pos) * ncols + kcol;
                float acc = 0.f;
                for (int d = 0; d < 64; ++d) acc += qs[wave][d] * ldf(kr, d);
                sc = acc - slope * (float)dist;
            }
            const float mt = wave_max(sc);
            const float mn = fmaxf(m, mt);
            const float alpha = __expf(m - mn);
            const float p = ok ? __expf(sc - mn) : 0.f;
            l = l * alpha + wave_sum(p);
            pbuf[wave][lane] = p;
            __builtin_amdgcn_wave_barrier();
            float acc = 0.f;
            const int kmax = (t - j * 64 + 1 < 64) ? (t - j * 64 + 1) : 64;
            for (int kk = 0; kk < kmax; ++kk) acc += pbuf[wave][kk] * ldf(proj, ((size_t)b * T + j * 64 + kk) * ncols + vcol + lane);
            __builtin_amdgcn_wave_barrier();
            o = o * alpha + acc;
            m = mn;
        }
        out += gate * o / fmaxf(l, 1e-30f);
    }
    stf(concat, (size_t)tok * D + 512 + g * 256 + r * 64 + lane, out);
}

__global__ void __launch_bounds__(256) k_cross_attn(const bf16_t* __restrict__ Q, const bf16_t* __restrict__ Kc, const bf16_t* __restrict__ VT, bf16_t* __restrict__ O) {
    const int wid = (blockIdx.x * blockDim.x + threadIdx.x) >> 6, lane = threadIdx.x & 63;
    const int tok = wid >> 2, h = wid & 3, b = tok / T;
    float q[4];
    for (int i = 0; i < 4; ++i) q[i] = ldf(Q, (size_t)tok * D + h * 256 + lane * 4 + i);
    float s[4];
    for (int u = 0; u < 4; ++u) s[u] = 0.f;
    for (int key = 0; key < MEM; ++key) {
        const bf16_t* kr = Kc + ((size_t)b * MEM + key) * 1024 + h * 256 + lane * 4;
        float d = q[0] * bf2f(kr[0]) + q[1] * bf2f(kr[1]) + q[2] * bf2f(kr[2]) + q[3] * bf2f(kr[3]);
        d = wave_sum(d) * 0.0625f;
        if ((key & 63) == lane) s[key >> 6] = d;
    }
    float m = fmaxf(fmaxf(s[0], s[1]), fmaxf(s[2], s[3]));
    m = wave_max(m);
    float p[4], l = 0.f;
    for (int u = 0; u < 4; ++u) { p[u] = __expf(s[u] - m); l += p[u]; }
    l = wave_sum(l);
    float o[4] = {0.f, 0.f, 0.f, 0.f};
    for (int key = 0; key < MEM; ++key) {
        const float pk = __shfl(p[key >> 6], key & 63);
        for (int i = 0; i < 4; ++i) o[i] += pk * bf2f(VT[(size_t)(h * 256 + lane * 4 + i) * NMEM + b * MEM + key]);
    }
    const float inv = 1.f / l;
    for (int i = 0; i < 4; ++i) stf(O, (size_t)tok * D + h * 256 + lane * 4 + i, o[i] * inv);
}

__global__ void k_route(const float* __restrict__ Hn, const float* __restrict__ wr, int* __restrict__ top_e, float* __restrict__ top_g) {
    const int wid = (blockIdx.x * blockDim.x + threadIdx.x) >> 6, lane = threadIdx.x & 63;
    if (wid >= NTOK) return;
    float acc[8] = {};
    for (int i = 0; i < 16; ++i) {
        const int k = lane + 64 * i; const float hv = Hn[(size_t)wid * D + k];
#pragma unroll
        for (int e = 0; e < 8; ++e) acc[e] += hv * wr[k * 8 + e];
    }
#pragma unroll
    for (int e = 0; e < 8; ++e) acc[e] = wave_sum(acc[e]);
    if (lane == 0) {
        int e0 = 0; for (int e = 1; e < 8; ++e) if (acc[e] > acc[e0]) e0 = e;
        int e1 = -1; for (int e = 0; e < 8; ++e) if (e != e0 && (e1 < 0 || acc[e] > acc[e1])) e1 = e;
        const float m = acc[e0]; const float p0 = 1.f, p1 = __expf(acc[e1] - m); const float inv = 1.f / (p0 + p1);
        top_e[wid * 2] = e0; top_e[wid * 2 + 1] = e1; top_g[wid * 2] = p0 * inv; top_g[wid * 2 + 1] = p1 * inv;
    }
}
__global__ void __launch_bounds__(64) k_lists(const int* __restrict__ top_e, const float* __restrict__ top_g, int* __restrict__ list, float* __restrict__ lgate, int* __restrict__ counts) {
    const int e = blockIdx.x, lane = threadIdx.x; int cnt = 0;
    for (int t0 = 0; t0 < NTOK; t0 += 64) {
        const int tok = t0 + lane; int k = -1;
        if (top_e[tok * 2] == e) k = 0; else if (top_e[tok * 2 + 1] == e) k = 1;
        const unsigned long long bal = __ballot(k >= 0);
        if (k >= 0) { const int pos = cnt + __popcll(bal & ((1ull << lane) - 1ull)); if (pos < ECAP) { list[e * NTOK + pos] = tok; lgate[e * NTOK + pos] = top_g[tok * 2 + k]; } }
        cnt += __popcll(bal);
    }
    if (lane == 0) counts[e] = cnt;
}

__global__ void k_xb_ssq(const float* __restrict__ X, bf16_t* __restrict__ XB, float* __restrict__ SSQ) {
    const int m = (blockIdx.x * blockDim.x + threadIdx.x) >> 6, lane = threadIdx.x & 63;
    if (m >= NTOK) return;
    float s = 0.f;
    for (int i = 0; i < 16; ++i) { const float v = X[(size_t)m * D + lane + 64 * i]; s += v * v; XB[(size_t)m * D + lane + 64 * i] = (bf16_t)f2bf(v); }
    s = wave_sum(s);
    if (lane < 16) SSQ[(size_t)m * 16 + lane] = lane == 0 ? s : 0.f;
}
}

static int g_grid = 0;
static void launch_mega(const Args& base, std::initializer_list<int> phs, hipStream_t stream) {
    Args a = base; a.nph = 0;
    for (int p : phs) a.ph[a.nph++] = p;
    hipLaunchKernelGGL(mega, dim3(g_grid), dim3(NWAVES * 64), LDS_BYTES, stream, a);
}

extern "C" void kernel_launch(void* const* d_in, const int* in_sizes, int n_in, void* d_out, int out_size, void* d_ws, size_t ws_size, hipStream_t stream) {
    using namespace v0;
    if (g_grid == 0) {
        int dev = 0, cus = 0;
        if (hipGetDevice(&dev) != hipSuccess || hipDeviceGetAttribute(&cus, hipDeviceAttributeMultiprocessorCount, dev) != hipSuccess) { g_grid = -1; return; }
        if (hipFuncSetAttribute((const void*)mega, hipFuncAttributeMaxDynamicSharedMemorySize, LDS_BYTES) != hipSuccess) { fprintf(stderr, "kernel_launch: hipFuncSetAttribute failed\n"); g_grid = -1; return; }
        (void)hipGetLastError();
        if (cus != 256) { fprintf(stderr, "kernel_launch: built for a 256-CU device (one workgroup per CU), found %d\n", cus); g_grid = -1; return; }
        g_grid = cus;
    }
    if (g_grid < 0) return;
    const float* in[40];
    for (int i = 0; i < 40; ++i) in[i] = (const float*)d_in[i];
    unsigned char* wsb = (unsigned char*)d_ws;
    Args base{};
    for (int i = 0; i < 40; ++i) base.in[i] = in[i];
    base.out = (float*)d_out; base.ws = wsb;

    float* X = (float*)(wsb + WS_X);
    bf16_t* XB = (bf16_t*)(wsb + WS_XB);
    float* SSQ = (float*)(wsb + WS_SSQ);
    bf16_t* PROJ = (bf16_t*)(wsb + WS_S);
    size_t off = (WS_S + S_END + 1 * MiB) / 4;
    float* ws = (float*)d_ws;
    auto take = [&](size_t nfl) { float* p = ws + off; off += (nfl + 63) & ~(size_t)63; return p; };
    float* KC = take((size_t)B * 2 * 128 * 64);
    float* VC = take((size_t)B * 2 * 128 * 64);
    float* HID = take((size_t)B * 2 * NCMP * 128);
    if (off * 4 < WS_MOE_END) off = WS_MOE_END / 4;
    if (off * 4 > ws_size) { fprintf(stderr, "kernel_launch: workspace too small: need %zu have %zu\n", off * 4, ws_size); return; }

    hipMemsetAsync(wsb + WS_CTL, 0, 1 * MiB, stream);
#if MK_FUSED
    launch_mega(base, {0}, stream);
#else
    launch_mega(base, {0}, stream);
    launch_mega(base, {1}, stream);
    bf16_t* CONCATB = (bf16_t*)(wsb + WS_S + S_CONCAT);

    for (int layer = 0; layer < 2; ++layer) {
        const int ncols = layer == 0 ? 3096 : 3128;
        const int n_rw = ncols - NSA_COLS;
        launch_mega(base, {10 + layer}, stream);
        launch_mega(base, {20 + layer}, stream);
        launch_mega(base, {30 + layer}, stream);
        launch_mega(base, {40 + layer}, stream);
        launch_mega(base, {25 + layer}, stream);
        launch_mega(base, {45 + layer}, stream);
        launch_mega(base, {50 + layer}, stream);
        launch_mega(base, {60 + layer}, stream);
        launch_mega(base, {70 + layer}, stream);
        launch_mega(base, {80 + layer}, stream);
        if (layer == 0) {
            launch_mega(base, {90}, stream);
            launch_mega(base, {91}, stream);
        } else {
            launch_mega(base, {100}, stream);
            launch_mega(base, {101}, stream);
            launch_mega(base, {102}, stream);
            launch_mega(base, {103}, stream);
            launch_mega(base, {104}, stream);
            launch_mega(base, {105}, stream);
        }
    }
    launch_mega(base, {110}, stream);
#endif
}
```
